# Optimizing an MI355X kernel written in HIP

```python
import math
import jax
import jax.numpy as jnp
from jax import lax
import numpy as np

D_MODEL = 1024
BATCH = 32
SEQ = 2048
DEPTH = 2
DEC_BATCH = 8
DEC_SEQ = 32
PAST_LEN = 4096

CHUNK = 64
N_META = 16
H_RET = 4
DK_RET = D_MODEL // 8
DV_RET = 2 * DK_RET
H_SB = 8
D_SB = D_MODEL // 8
Q_BLOCK = 128
POOL_WINDOWS = (2, 4, 8, 16)
N_POOL_GROUPS = 4
D_POOL = D_MODEL
DG_POOL = D_POOL // N_POOL_GROUPS
POOL_BUF = max(POOL_WINDOWS) - 1
N_BRANCH = 3
D_BRANCH = D_MODEL
D_FF = ((8 * D_MODEL // 3 + 127) // 128) * 128
ROPE_BASE = 10000.0
LN_EPS = 1e-5
ALPHA = (2 * DEPTH) ** 0.25
BETA = (8 * DEPTH) ** -0.25
IN_SPLITS = (H_RET * DK_RET, H_RET * DK_RET, H_RET * DV_RET, H_RET * DV_RET,
             H_SB * D_SB, H_SB * D_SB, H_SB * D_SB, D_POOL, N_BRANCH * D_MODEL)
D_IN = sum(IN_SPLITS)

kernel_name = 'hybrid_retention_stickbreak_pool_stream'


def layer_norm(x, g, b):
    xf = x.astype(jnp.float32)
    mu = xf.mean(-1, keepdims=True)
    var = jnp.square(xf - mu).mean(-1, keepdims=True)
    return ((xf - mu) * lax.rsqrt(var + LN_EPS) * g + b).astype(x.dtype)


def head_norm(x, g):
    xf = x.astype(jnp.float32)
    mu = xf.mean(-1, keepdims=True)
    var = jnp.square(xf - mu).mean(-1, keepdims=True)
    return ((xf - mu) * lax.rsqrt(var + LN_EPS) * g).astype(x.dtype)


def swiglu(x, w_up, w_down):
    gate, up = jnp.split(x @ w_up, 2, axis=-1)
    return (jax.nn.silu(gate) * up) @ w_down


def rotary(x, pos0):
    T = x.shape[1]
    half = x.shape[-1] // 2
    inv_freq = ROPE_BASE ** (-jnp.arange(half, dtype=jnp.float32) / half)
    ang = (pos0 + jnp.arange(T, dtype=jnp.float32))[:, None] * inv_freq[None, :]
    cos = jnp.cos(ang)[None, :, None, :]
    sin = jnp.sin(ang)[None, :, None, :]
    xf = x.astype(jnp.float32)
    x1, x2 = xf[..., :half], xf[..., half:]
    return jnp.concatenate([x1 * cos - x2 * sin, x2 * cos + x1 * sin], axis=-1)


def retention_log_decay():
    return jnp.log1p(-jnp.exp(jnp.linspace(math.log(1.0 / 32), math.log(1.0 / 512), H_RET,
                                           dtype=jnp.float32)))


def retention(q, k, v, s0):
    B, T, H, _ = q.shape
    L = min(CHUNK, T)
    n = T // L
    lg = retention_log_decay()
    i = jnp.arange(L, dtype=jnp.float32)
    diff = i[:, None] - i[None, :]
    d_intra = jnp.where(diff >= 0, jnp.exp(lg[:, None, None] * jnp.maximum(diff, 0.0)), 0.0)
    d_q = jnp.exp(lg[None, :] * (i[:, None] + 1.0))
    d_k = jnp.exp(lg[None, :] * (L - 1.0 - i[:, None]))
    d_c = jnp.exp(lg * L)

    def chunks(a):
        return a.astype(jnp.float32).reshape(B, n, L, H, a.shape[-1]).transpose(1, 0, 2, 3, 4)

    def step(s, xs):
        qc, kc, vc = xs
        att = jnp.einsum('blhk,bmhk->bhlm', qc, kc) * d_intra[None]
        o = (jnp.einsum('bhlm,bmhv->blhv', att, vc)
             + jnp.einsum('blhk,bhkv->blhv', qc, s) * d_q[None, :, :, None])
        s = s * d_c[None, :, None, None] + jnp.einsum('bmhk,bmhv->bhkv', kc * d_k[None, :, :, None], vc)
        return s, o

    s, o = lax.scan(step, s0.astype(jnp.float32), (chunks(q), chunks(k), chunks(v)))
    o = o.transpose(1, 0, 2, 3, 4).reshape(B, T, H, v.shape[-1])
    return o.astype(v.dtype), s.astype(s0.dtype)


def stick_breaking(q, k_all, v_all, q_start):
    B, T, H, D = q.shape
    S = k_all.shape[1]
    qb = min(Q_BLOCK, T)
    nb = T // qb
    scale = D ** -0.5
    key_idx = jnp.arange(S)
    q_blocks = q.reshape(B, nb, qb, H, D).transpose(1, 0, 2, 3, 4)

    def block(args):
        qblk, b = args
        z = jnp.einsum('bqhd,bshd->bhqs', qblk, k_all, preferred_element_type=jnp.float32) * scale
        q_idx = q_start + b * qb + jnp.arange(qb)
        visible = (key_idx[None, :] < q_idx[:, None])[None, None]
        log_stay = jnp.where(visible, jax.nn.log_sigmoid(-z), 0.0)
        later = lax.cumsum(log_stay, axis=3, reverse=True) - log_stay
        w = jnp.where(visible, jnp.exp(jax.nn.log_sigmoid(z) + later), 0.0)
        return jnp.einsum('bhqs,bshd->bqhd', w.astype(v_all.dtype), v_all,
                          preferred_element_type=jnp.float32).astype(v_all.dtype)

    out = lax.map(block, (q_blocks, jnp.arange(nb)))
    return out.transpose(1, 0, 2, 3, 4).reshape(B, T, H, D)


def pool_mixer(u, buf, mix_w, scale):
    B, T, C = u.shape
    Lb = buf.shape[1]
    z = jnp.concatenate([buf, u], axis=1)
    csum = jnp.concatenate([jnp.zeros((B, 1, C), jnp.float32),
                            jnp.cumsum(z.astype(jnp.float32), axis=1)], axis=1)
    idx = Lb + jnp.arange(T)
    hi = csum[:, Lb + 1:]
    uf = u.astype(jnp.float32)
    parts = []
    for g, w in enumerate(POOL_WINDOWS):
        sl = slice(g * DG_POOL, (g + 1) * DG_POOL)
        lo = jnp.maximum(idx + 1 - w, 0)
        cnt = jnp.minimum(idx + 1, w).astype(jnp.float32)
        parts.append((hi[..., sl] - csum[:, lo, sl]) / cnt[None, :, None] - uf[..., sl])
    pooled = jnp.stack(parts, axis=2).astype(u.dtype)
    mixed = jnp.einsum('btgc,gcd->btgd', pooled, mix_w).reshape(B, T, C) * scale
    return mixed, z[:, -POOL_BUF:]


def trunk_layer(h, past_k, past_v, s0, pool_buf, pos0, lp):
    (w_in, ret_g, pool_w, pool_scale, w_branch, w_out,
     up1, down1, up2, down2, ln_g, ln_b) = lp
    B, T, _ = h.shape
    h = layer_norm(ALPHA * h + 0.5 * swiglu(h, up1, down1), ln_g[0], ln_b[0])
    points = np.cumsum(IN_SPLITS)[:-1].tolist()
    q_r, k_r, v_r, g_r, q_s, k_s, v_s, u, gates = jnp.split(h @ w_in, points, axis=-1)
    q_r = rotary(q_r.reshape(B, T, H_RET, DK_RET), pos0)
    k_r = rotary(k_r.reshape(B, T, H_RET, DK_RET), pos0) * (DK_RET ** -0.5)
    o_r, s_new = retention(q_r, k_r, v_r.reshape(B, T, H_RET, DV_RET), s0)
    o_r = head_norm(o_r, ret_g).reshape(B, T, H_RET * DV_RET) * jax.nn.silu(g_r)
    k_s = k_s.reshape(B, T, H_SB, D_SB)
    v_s = v_s.reshape(B, T, H_SB, D_SB)
    k_all = jnp.concatenate([past_k, k_s], axis=1)
    v_all = jnp.concatenate([past_v, v_s], axis=1)
    o_s = stick_breaking(q_s.reshape(B, T, H_SB, D_SB), k_all, v_all, past_k.shape[1])
    o_s = o_s.reshape(B, T, H_SB * D_SB)
    o_p, buf_new = pool_mixer(u, pool_buf, pool_w, pool_scale)
    branch = jnp.stack([o_r, o_s, o_p], axis=2)
    proj_b = jnp.einsum('btnc,ncd->btnd', branch, w_branch)
    gate = jax.nn.sigmoid(gates.reshape(B, T, N_BRANCH, D_MODEL))
    mix = (gate * proj_b).sum(axis=2) @ w_out
    h = layer_norm(ALPHA * h + mix, ln_g[1], ln_b[1])
    h = layer_norm(ALPHA * h + 0.5 * swiglu(h, up2, down2), ln_g[2], ln_b[2])
    return h, (k_s, v_s, s_new, buf_new)


def setup_inputs(seed: int = 0) -> dict:
    key = jax.random.key(seed)
    ks = jax.random.split(key, 20)
    f32 = jnp.float32
    nrm = lambda k, shape: jax.random.normal(k, shape, f32)
    return {
        'x_prompt': nrm(ks[0], (BATCH, SEQ, D_MODEL)),
        'x_sample': nrm(ks[1], (DEC_BATCH, DEC_SEQ, D_MODEL)),
        'cache_sb_k': nrm(ks[2], (DEPTH, DEC_BATCH, PAST_LEN, H_SB, D_SB)),
        'cache_sb_v': nrm(ks[3], (DEPTH, DEC_BATCH, PAST_LEN, H_SB, D_SB)),
        'state_ret': 0.5 * nrm(ks[4], (DEPTH, DEC_BATCH, H_RET, DK_RET, DV_RET)),
        'state_pool': nrm(ks[5], (DEPTH, DEC_BATCH, POOL_BUF, D_POOL)),
        'meta_tokens': nrm(ks[6], (N_META, D_MODEL)),
        'w_in': nrm(ks[7], (DEPTH, D_MODEL, D_IN)) * D_MODEL ** -0.5,
        'ret_norm_g': 1.0 + 0.1 * nrm(ks[8], (DEPTH, H_RET, DV_RET)),
        'pool_mix_w': nrm(ks[9], (DEPTH, N_POOL_GROUPS, DG_POOL, DG_POOL)) * DG_POOL ** -0.5,
        'pool_scale': 1.0 + 0.1 * nrm(ks[10], (DEPTH, D_POOL)),
        'w_branch': nrm(ks[11], (DEPTH, N_BRANCH, D_BRANCH, D_MODEL)) * (D_BRANCH ** -0.5 * BETA),
        'w_out': nrm(ks[12], (DEPTH, D_MODEL, D_MODEL)) * (D_MODEL ** -0.5 * BETA),
        'ffn1_up': nrm(ks[13], (DEPTH, D_MODEL, 2 * D_FF)) * D_MODEL ** -0.5,
        'ffn1_down': nrm(ks[14], (DEPTH, D_FF, D_MODEL)) * (D_FF ** -0.5 * BETA),
        'ffn2_up': nrm(ks[15], (DEPTH, D_MODEL, 2 * D_FF)) * D_MODEL ** -0.5,
        'ffn2_down': nrm(ks[16], (DEPTH, D_FF, D_MODEL)) * (D_FF ** -0.5 * BETA),
        'ln_g': 1.0 + 0.1 * nrm(ks[17], (DEPTH, 3, D_MODEL)),
        'ln_b': 0.02 * nrm(ks[18], (DEPTH, 3, D_MODEL)),
    }


def reference(x_prompt, x_sample, cache_sb_k, cache_sb_v, state_ret, state_pool, meta_tokens,
              w_in, ret_norm_g, pool_mix_w, pool_scale, w_branch, w_out,
              ffn1_up, ffn1_down, ffn2_up, ffn2_down, ln_g, ln_b):
    dt = meta_tokens.dtype
    B = x_prompt.shape[0]
    bc = lambda a: jnp.broadcast_to(a, (B,) + a.shape[1:])
    h_meta = meta_tokens[None]
    h_p = x_prompt
    h_s = x_sample
    pk_l, pv_l, ps_l, pb_l = [], [], [], []
    sk_l, sv_l, ss_l, sb_l = [], [], [], []
    for l in range(DEPTH):
        lp = (w_in[l], ret_norm_g[l], pool_mix_w[l], pool_scale[l], w_branch[l], w_out[l],
              ffn1_up[l], ffn1_down[l], ffn2_up[l], ffn2_down[l], ln_g[l], ln_b[l])
        empty_kv = jnp.zeros((1, 0, H_SB, D_SB), dt)
        h_meta, (mk, mv, ms, mbuf) = trunk_layer(
            h_meta, empty_kv, empty_kv, jnp.zeros((1, H_RET, DK_RET, DV_RET), dt),
            jnp.zeros((1, 0, D_POOL), dt), 0, lp)
        h_p, (pk, pv, ps, pbuf) = trunk_layer(
            h_p, bc(mk), bc(mv), bc(ms), bc(mbuf), N_META, lp)
        h_s, (sk, sv, ss, sbuf) = trunk_layer(
            h_s, cache_sb_k[l], cache_sb_v[l], state_ret[l], state_pool[l], N_META + PAST_LEN, lp)
        pk_l.append(jnp.concatenate([bc(mk), pk], axis=1))
        pv_l.append(jnp.concatenate([bc(mv), pv], axis=1))
        ps_l.append(ps)
        pb_l.append(pbuf)
        sk_l.append(sk)
        sv_l.append(sv)
        ss_l.append(ss)
        sb_l.append(sbuf)
    new_sb_k_prompt = jnp.stack(pk_l)
    new_sb_v_prompt = jnp.stack(pv_l)
    new_ret_prompt = jnp.stack(ps_l)
    new_pool_prompt = jnp.stack(pb_l)
    new_sb_k_sample = jnp.stack(sk_l)
    new_sb_v_sample = jnp.stack(sv_l)
    new_ret_sample = jnp.stack(ss_l)
    new_pool_sample = jnp.stack(sb_l)
    return (h_p, h_s, new_sb_k_prompt, new_sb_v_prompt, new_ret_prompt, new_pool_prompt,
            new_sb_k_sample, new_sb_v_sample, new_ret_sample, new_pool_sample)
```

```cpp
#include <hip/hip_runtime.h>
#include <cstdio>
#include <cstdint>
__device__ __forceinline__ unsigned lane_lo_() { unsigned l; asm volatile("v_mbcnt_lo_u32_b32 %0, -1, 0" : "=v"(l)); return l; }
__device__ __forceinline__ int lane_id_() { unsigned l; asm volatile("v_mbcnt_lo_u32_b32 %0, -1, 0\n\tv_mbcnt_hi_u32_b32 %0, -1, %0" : "=v"(l)); return (int)l; }
namespace pg8 {
#define PG8_LAS __attribute__((address_space(3)))
typedef unsigned short bf16_t;
typedef short bf16x8 __attribute__((ext_vector_type(8)));
typedef float f32x4 __attribute__((ext_vector_type(4)));
typedef unsigned u32x4 __attribute__((ext_vector_type(4)));
constexpr int BM = 256, BK = 64, HALF = 128, HTB = HALF * BK * 2  , STAGE_BYTES = 8 * HTB, NXCD = 8, WGM = 4;

__host__ __device__ __forceinline__ int lds_byte(int r, int c) { const int st = (r >> 4) * 2 + (c >> 5), rr = r & 15, cc = c & 31, ob = rr * 64 + cc * 2; return st * 1024 + (ob ^ (((ob >> 9) & 1) << 5)); }
__host__ __device__ __forceinline__ void stage_rc(int b, int& R, int& C) { const int st = b / 1024, sb = b % 1024, swz = sb ^ (((sb >> 9) & 1) << 5); R = (st >> 1) * 16 + swz / 64; C = (st & 1) * 32 + (swz % 64) / 2; }
__host__ __device__ __forceinline__ int perm32(int rho) { const int n = rho >> 4, i = rho & 15; return 8 * (i >> 2) + 4 * n + (i & 3); }

struct Unit { int pm, pn; };
struct Gemm { const bf16_t* A; const bf16_t* Bt; int M, N, K; int ld = 0; };

struct StaticOrder {
    int nM, nN, nwg, G, c;
    __host__ __device__ void init(int M, int N, int G_, int c_) { nM = M / BM; nN = N / BM; nwg = nM * nN; G = G_; c = c_; }
    __host__ __device__ bool next(int i, Unit& u) const {
        const long L = (long)i * G + c; if (L >= nwg) return false;
        int wgid = (int)L; { const int q = nwg / NXCD, r = nwg % NXCD, xcd = wgid % NXCD, off = wgid / NXCD; wgid = (xcd < r ? xcd * (q + 1) : r * (q + 1) + (xcd - r) * q) + off; }
        const int nig = WGM * nN, gid = wgid / nig, fm = gid * WGM, gsz = (nM - fm) < WGM ? (nM - fm) : WGM;
        u.pm = fm + ((wgid % nig) % gsz); u.pn = (wgid % nig) / gsz; return true;
    }
    __device__ __forceinline__ void a_ready(const Unit&) const {}
    __device__ __forceinline__ void done(const Unit&) const {}
};

__device__ __forceinline__ unsigned cvt_pk_bf16(float lo, float hi) { unsigned r; asm volatile("v_cvt_pk_bf16_f32 %0, %1, %2" : "=v"(r) : "v"(lo), "v"(hi)); return r; }
template <class Epi, class Sched, bool ALIGN_EPI = false, bool SP2 = false>
__device__ __forceinline__ void gemm_phase(PG8_LAS unsigned char* lds, const Gemm g, const Sched& S, const Epi& E, const int wave_id) {
    int lane_ = lane_id_(); asm volatile("" : "+v"(lane_));
    const int tid = wave_id * 64 + lane_;
    int widq_ = wave_id; asm volatile("" : "+s"(widq_));
    const int wid = widq_, lane = tid & 63, wr = wid >> 2, wc = wid & 3, fr = lane & 15, fq = lane >> 4;
    const int K = g.K, nt = K / BK, LD = g.ld > 0 ? g.ld : K;
    unsigned voffA[2], voffB[2];
#pragma unroll
    for (int i = 0; i < 2; ++i) { int R, C; stage_rc(tid * 16 + i * 8192, R, C); const int Rb = Epi::PERM ? ((R & ~31) + perm32(R & 31)) : R;
        voffA[i] = (unsigned)(R * LD + C) * 2u; voffB[i] = (unsigned)(Rb * LD + C) * 2u; }
    const size_t kstep = (size_t)(BK * 2);
    const size_t hstep = (size_t)HALF * LD * 2;
    const size_t tstep = 2 * hstep;
    const unsigned ldsw = (unsigned)wid * 1024u;
    const int aoff = lds_byte(wr * 64 + fr, fq * 8), boff = lds_byte(wc * 32 + fr, fq * 8);
#define PG8_SA(b, h) (((b) * 2 + (h)) * HTB)
#define PG8_SB(b, h) ((4 + (b) * 2 + (h)) * HTB)
#define PG8_STAGE(bufoff, gbase, voff) do { _Pragma("unroll") for (int _i = 0; _i < 2; ++_i) \
        __builtin_amdgcn_global_load_lds((const unsigned*)((const char*)(gbase) + (voff)[_i]), (PG8_LAS unsigned*)(lds + (bufoff) + ldsw + _i * 8192), 16, 0, 0); } while (0)
#define PG8_LDA(dst, b, h) do { _Pragma("unroll") for (int m = 0; m < 4; ++m) _Pragma("unroll") for (int k = 0; k < 2; ++k) dst[m][k] = *(const PG8_LAS bf16x8*)(lds + PG8_SA(b, h) + aoff + m * 2048 + k * 1024); } while (0)
#define PG8_LDB(dst, b, h) do { _Pragma("unroll") for (int n = 0; n < 2; ++n) _Pragma("unroll") for (int k = 0; k < 2; ++k) dst[n][k] = *(const PG8_LAS bf16x8*)(lds + PG8_SB(b, h) + boff + n * 2048 + k * 1024); } while (0)
#define PG8_MMA(ai, bj, At, Bt) do { __builtin_amdgcn_s_setprio(1); _Pragma("unroll") for (int m = 0; m < 4; ++m) _Pragma("unroll") for (int n = 0; n < 2; ++n) _Pragma("unroll") for (int k = 0; k < 2; ++k) \
        acc[ai][bj][m][n] = __builtin_amdgcn_mfma_f32_16x16x32_bf16(Bt[n][k], At[m][k], acc[ai][bj][m][n], 0, 0, 0); __builtin_amdgcn_s_setprio(0); } while (0)
#define PG8_WAIT_V(n) asm volatile("s_waitcnt vmcnt(" #n ")" ::: "memory")
#define PG8_WAIT_VN(n) asm volatile("s_waitcnt vmcnt(%0)" :: "n"(n) : "memory")
#define PG8_WAIT_L(n) asm volatile("s_waitcnt lgkmcnt(" #n ")" ::: "memory")
#define PG8_BAR __builtin_amdgcn_s_barrier()
#define PG8_SCHED __builtin_amdgcn_sched_barrier(0)
    Unit cur, nxt; int ui = 0;
    if (!S.next(0, cur)) return;
    f32x4 acc[2][2][4][2];
#pragma unroll
    for (int a = 0; a < 2; ++a)
#pragma unroll
        for (int b = 0; b < 2; ++b)
#pragma unroll
            for (int m = 0; m < 4; ++m)
#pragma unroll
                for (int n = 0; n < 2; ++n) acc[a][b][m][n] = (f32x4){0.f, 0.f, 0.f, 0.f};
    bf16x8 At[4][2], B0[2][2], B1[2][2];
    const char* cA = (const char*)g.A + (size_t)cur.pm * tstep; const char* cB = (const char*)g.Bt + (size_t)cur.pn * tstep;
    S.a_ready(cur);
    if constexpr (SP2) {
        PG8_STAGE(PG8_SB(0, 0), cB, voffB); PG8_STAGE(PG8_SB(0, 1), cB + hstep, voffB); PG8_STAGE(PG8_SA(0, 0), cA, voffA); PG8_STAGE(PG8_SA(0, 1), cA + hstep, voffA);
        if (wr == 1) PG8_BAR;
        PG8_WAIT_V(2); PG8_BAR;
        PG8_STAGE(PG8_SB(1, 0), cB + kstep, voffB); PG8_STAGE(PG8_SA(1, 0), cA + kstep, voffA); PG8_STAGE(PG8_SB(1, 1), cB + hstep + kstep, voffB);
        PG8_WAIT_V(6); PG8_BAR;
    } else {
        PG8_STAGE(PG8_SB(0, 0), cB, voffB); PG8_STAGE(PG8_SA(0, 0), cA, voffA); PG8_STAGE(PG8_SB(0, 1), cB + hstep, voffB); PG8_STAGE(PG8_SA(0, 1), cA + hstep, voffA);
        if (wr == 1) PG8_BAR;
        PG8_WAIT_V(4); PG8_BAR;
        PG8_STAGE(PG8_SB(1, 0), cB + kstep, voffB); PG8_STAGE(PG8_SA(1, 0), cA + kstep, voffA); PG8_STAGE(PG8_SB(1, 1), cB + hstep + kstep, voffB);
        PG8_WAIT_V(6); PG8_BAR;
    }
    for (;;) {
        const bool has_next = S.next(ui + 1, nxt);
        const char* nA = has_next ? (const char*)g.A + (size_t)nxt.pm * tstep : cA; const char* nB = has_next ? (const char*)g.Bt + (size_t)nxt.pn * tstep : cB;
        for (int t = 0; t < nt; t += 2) {
            const bool last = (t == nt - 2);
            const char* a1 = cA + (size_t)(t + 1) * kstep;
            const char* a2 = last ? nA : cA + (size_t)(t + 2) * kstep; const char* b2 = last ? nB : cB + (size_t)(t + 2) * kstep;
            const char* a3 = a2 + kstep; const char* b3 = b2 + kstep;
            if (last && has_next) S.a_ready(nxt);
            if constexpr (SP2) {
            int tz_ = __builtin_amdgcn_readfirstlane(t | (ui > 0 ? 0 : 1)); asm volatile("" : "+s"(tz_));
            const bool strict = !(Epi::NS > 0 && tz_ == 0);
            PG8_LDB(B0, 0, 0); PG8_LDB(B1, 0, 1); PG8_SCHED; PG8_LDA(At, 0, 0); PG8_STAGE(PG8_SA(1, 1), a1 + hstep, voffA);
            PG8_WAIT_VN(8 + Epi::NS); if (strict) PG8_WAIT_V(8); PG8_WAIT_L(0); PG8_BAR; PG8_MMA(0, 0, At, B0); PG8_MMA(0, 1, At, B1); PG8_BAR; PG8_SCHED;
            PG8_LDA(At, 0, 1); PG8_STAGE(PG8_SB(0, 0), b2, voffB); PG8_STAGE(PG8_SB(0, 1), b2 + hstep, voffB); PG8_STAGE(PG8_SA(0, 0), a2, voffA);
            PG8_WAIT_VN(8 + Epi::NS); if (strict) PG8_WAIT_V(8); PG8_WAIT_L(0); PG8_BAR; PG8_MMA(1, 0, At, B0); PG8_MMA(1, 1, At, B1); PG8_BAR; PG8_SCHED;
            PG8_LDB(B0, 1, 0); PG8_LDB(B1, 1, 1); PG8_SCHED; PG8_LDA(At, 1, 0); PG8_STAGE(PG8_SA(0, 1), a2 + hstep, voffA);
            PG8_WAIT_V(8); PG8_WAIT_L(0); PG8_BAR; PG8_MMA(0, 0, At, B0); PG8_MMA(0, 1, At, B1); PG8_BAR; PG8_SCHED;
            PG8_LDA(At, 1, 1); PG8_STAGE(PG8_SB(1, 0), b3, voffB); PG8_STAGE(PG8_SB(1, 1), b3 + hstep, voffB); PG8_STAGE(PG8_SA(1, 0), a3, voffA);
            PG8_WAIT_V(8); PG8_WAIT_L(0); PG8_BAR; PG8_MMA(1, 0, At, B0); PG8_MMA(1, 1, At, B1); PG8_BAR; PG8_SCHED;
            } else {
            PG8_LDB(B0, 0, 0); PG8_SCHED; PG8_LDA(At, 0, 0); PG8_STAGE(PG8_SA(1, 1), a1 + hstep, voffA);
            PG8_WAIT_L(8); PG8_BAR; PG8_WAIT_L(0); PG8_MMA(0, 0, At, B0); PG8_BAR; PG8_SCHED;
            PG8_LDB(B1, 0, 1); PG8_STAGE(PG8_SB(0, 0), b2, voffB);
            PG8_BAR; PG8_WAIT_L(0); PG8_MMA(0, 1, At, B1); PG8_BAR;
            PG8_LDA(At, 0, 1); PG8_STAGE(PG8_SA(0, 0), a2, voffA);
            PG8_BAR; PG8_WAIT_L(0); PG8_MMA(1, 0, At, B0); PG8_BAR; PG8_SCHED;
            PG8_STAGE(PG8_SB(0, 1), b2 + hstep, voffB);
            PG8_WAIT_V(6); PG8_BAR; PG8_MMA(1, 1, At, B1); PG8_BAR;
            PG8_LDB(B0, 1, 0); PG8_SCHED; PG8_LDA(At, 1, 0); PG8_STAGE(PG8_SA(0, 1), a2 + hstep, voffA);
            PG8_WAIT_L(8); PG8_BAR; PG8_WAIT_L(0); PG8_MMA(0, 0, At, B0); PG8_BAR; PG8_SCHED;
            PG8_LDB(B1, 1, 1); PG8_STAGE(PG8_SB(1, 0), b3, voffB);
            PG8_BAR; PG8_WAIT_L(0); PG8_MMA(0, 1, At, B1); PG8_BAR;
            PG8_LDA(At, 1, 1); PG8_STAGE(PG8_SA(1, 0), a3, voffA);
            PG8_BAR; PG8_WAIT_L(0); PG8_MMA(1, 0, At, B0); PG8_BAR; PG8_SCHED;
            PG8_STAGE(PG8_SB(1, 1), b3 + hstep, voffB);
            PG8_WAIT_V(6); PG8_BAR; PG8_MMA(1, 1, At, B1); PG8_BAR;
            }
        }
        if constexpr (ALIGN_EPI) { if (wr == 0) PG8_BAR; }
        const bool keep_acc = E(acc, cur, wr, wc, fr, fq);
        if (!has_next) break;
        if (!keep_acc) {
#pragma unroll
        for (int a = 0; a < 2; ++a)
#pragma unroll
            for (int b = 0; b < 2; ++b)
#pragma unroll
                for (int m = 0; m < 4; ++m)
#pragma unroll
                    for (int n = 0; n < 2; ++n) acc[a][b][m][n] = (f32x4){0.f, 0.f, 0.f, 0.f};
        }
        cur = nxt; cA = nA; cB = nB; ++ui;
        if constexpr (ALIGN_EPI) { if (wr == 1) PG8_BAR; }
    }
    PG8_WAIT_V(0);
    if constexpr (!ALIGN_EPI) { if (wr == 0) PG8_BAR; }
    PG8_BAR;
#undef PG8_SA
#undef PG8_SB
#undef PG8_STAGE
#undef PG8_LDA
#undef PG8_LDB
#undef PG8_MMA
#undef PG8_WAIT_V
#undef PG8_WAIT_VN
#undef PG8_WAIT_L
#undef PG8_BAR
#undef PG8_SCHED
}
}

constexpr int D = 1024, NB = 32, T = 2048, DEPTH = 2, SBATCH = 8, ST = 32, PAST = 4096, NMETA = 16;
constexpr int HRET = 4, DKR = 128, DVR = 256, HSB = 8, DSB = 128, DFF = 2816, DIN = 10240, PBUF = 15;
constexpr int MP = NB * T;
constexpr int ROW_S = MP;
constexpr int ROW_M = MP + SBATCH * ST;
constexpr int M_PAD = ROW_M + 256;
constexpr int NPANEL = M_PAD / 256;
constexpr float LN_EPS = 1e-5f;
constexpr float ALPHA = 1.41421356237f;
constexpr float LOG2E = 1.44269504089f;
constexpr int KT_SP = PAST + ST;
constexpr int KT_PP = NMETA + T;

constexpr size_t O_YP = 0;
constexpr size_t O_YS = O_YP + (size_t)NB * T * D;
constexpr size_t O_KP = O_YS + (size_t)SBATCH * ST * D;
constexpr size_t O_VP = O_KP + (size_t)DEPTH * NB * KT_PP * D;
constexpr size_t O_RP = O_VP + (size_t)DEPTH * NB * KT_PP * D;
constexpr size_t O_PP = O_RP + (size_t)DEPTH * NB * HRET * DKR * DVR;
constexpr size_t O_KS = O_PP + (size_t)DEPTH * NB * PBUF * D;
constexpr size_t O_VS = O_KS + (size_t)DEPTH * SBATCH * ST * D;
constexpr size_t O_RS = O_VS + (size_t)DEPTH * SBATCH * ST * D;
constexpr size_t O_PS = O_RS + (size_t)DEPTH * SBATCH * HRET * DKR * DVR;
constexpr size_t O_END = O_PS + (size_t)DEPTH * SBATCH * PBUF * D;
static_assert(O_END == 350666752ull, "output size");

constexpr size_t MiB = 1u << 20;
constexpr size_t AL(size_t x) { return (x + 4095) & ~(size_t)4095; }
constexpr size_t WS_CTL = 0, CTL_ZERO_BYTES = 1 * MiB;
constexpr size_t WS_YB = WS_CTL + CTL_ZERO_BYTES;
constexpr size_t WS_HB = AL(WS_YB + (size_t)M_PAD * D * 2);
constexpr size_t WS_ACT = AL(WS_HB + (size_t)M_PAD * D * 2);
constexpr size_t WS_QR = AL(WS_ACT + (size_t)M_PAD * DFF * 2);
constexpr size_t WS_KR = AL(WS_QR + (size_t)M_PAD * 512 * 2);
constexpr size_t WS_VR = AL(WS_KR + (size_t)M_PAD * 512 * 2);
constexpr size_t WS_GR = AL(WS_VR + (size_t)M_PAD * D * 2);
constexpr size_t WS_QS = AL(WS_GR + (size_t)M_PAD * D * 2);
constexpr size_t WS_KS = AL(WS_QS + (size_t)M_PAD * D * 2);
constexpr size_t WS_VS = AL(WS_KS + (size_t)M_PAD * D * 2);
constexpr size_t WS_U = AL(WS_VS + (size_t)M_PAD * D * 2);
constexpr size_t WS_GT = AL(WS_U + (size_t)M_PAD * D * 2);
constexpr size_t WS_BR = AL(WS_GT + (size_t)M_PAD * 3 * D * 2);
constexpr size_t WS_MIX = AL(WS_BR + (size_t)3 * M_PAD * D * 2);
constexpr size_t WS_W = AL(WS_MIX + (size_t)M_PAD * D * 2);
constexpr size_t LW_UP1 = 0;
constexpr size_t LW_DN1 = LW_UP1 + (size_t)2 * DFF * D * 2;
constexpr size_t LW_IN = LW_DN1 + (size_t)D * DFF * 2;
constexpr size_t LW_BR = LW_IN + (size_t)DIN * D * 2;
constexpr size_t LW_OUT = LW_BR + (size_t)3 * D * D * 2;
constexpr size_t LW_UP2 = LW_OUT + (size_t)D * D * 2;
constexpr size_t LW_DN2 = LW_UP2 + (size_t)2 * DFF * D * 2;
constexpr size_t LW_SIZE = AL(LW_DN2 + (size_t)D * DFF * 2);
constexpr size_t WS_END = WS_W + DEPTH * LW_SIZE;
static_assert(WS_END < (size_t)4000 * MiB, "workspace budget");

constexpr int CW_BAR = 4096;
constexpr int CW_Q = 16384;
constexpr int CW_CH = 24576;
constexpr int CW_DBG = 32768;
constexpr int CW_KN = 65536;
static_assert((CW_KN + DEPTH * 33 * 8 * 16) * 4 <= (int)CTL_ZERO_BYTES, "ctl region");

constexpr int RING_BYTES = 131072;
constexpr int LDSCTL_OFF = RING_BYTES, MISC_OFF = LDSCTL_OFF + 320;
constexpr int LDS_BYTES = 147456;

#define GAS __attribute__((address_space(1)))
#define LAS __attribute__((address_space(3)))
typedef unsigned short bf16;
typedef unsigned v4u __attribute__((ext_vector_type(4)));
typedef unsigned v2u __attribute__((ext_vector_type(2)));
typedef float f32x4 __attribute__((ext_vector_type(4)));
typedef short bf16x8 __attribute__((ext_vector_type(8)));
typedef short s16x4 __attribute__((ext_vector_type(4)));
typedef GAS unsigned gu32;
#define RLX_AGENT __ATOMIC_RELAXED, __HIP_MEMORY_SCOPE_AGENT
__device__ __forceinline__ unsigned f2bf(float f) { unsigned u = __builtin_bit_cast(unsigned, f); return (u + 0x7fffu + ((u >> 16) & 1u)) >> 16; }
__device__ __forceinline__ unsigned pk2(float lo, float hi) { return f2bf(lo) | (f2bf(hi) << 16); }
__device__ __forceinline__ float bf2f(unsigned short b) { return __builtin_bit_cast(float, (unsigned)b << 16); }
__device__ __forceinline__ float bflo(unsigned w) { return __builtin_bit_cast(float, w << 16); }
__device__ __forceinline__ float bfhi(unsigned w) { return __builtin_bit_cast(float, w & 0xffff0000u); }
__device__ __forceinline__ float fast_exp2(float x) { return __builtin_amdgcn_exp2f(x); }
__device__ __forceinline__ float fast_log2(float x) { return __builtin_amdgcn_logf(x); }
__device__ __forceinline__ float fast_rcp(float x) { return __builtin_amdgcn_rcpf(x); }
__device__ __forceinline__ float sigmoidf_(float x) { return fast_rcp(1.0f + fast_exp2(-x * LOG2E)); }
__device__ __forceinline__ float siluf_(float x) { return x * sigmoidf_(x); }
__device__ __forceinline__ float wave_sum(float v) {
#pragma unroll
    for (int o = 1; o < 64; o <<= 1) v += __shfl_xor(v, o);
    return v;
}
#define XB_TMO      128
#define XB_XCNT(j)  (256  + 64 * (j))
#define XB_XSUB(j)  (1280 + 64 * (j))
#define XB_XGEN(j)  (2304 + 64 * (j))
#define XB_TOP      3328
#define XB_TOPGEN   3392
#define XCD_BAR_WORDS 3456
#define XB_SPIN_CAP (1u << 20)

__device__ __forceinline__ unsigned xb_ld(unsigned* p)              { return __hip_atomic_load(p, __ATOMIC_RELAXED, __HIP_MEMORY_SCOPE_AGENT); }
__device__ __forceinline__ unsigned xb_add(unsigned* p, unsigned v) { return __hip_atomic_fetch_add(p, v, __ATOMIC_RELAXED, __HIP_MEMORY_SCOPE_AGENT); }
__device__ __forceinline__ unsigned xb_xcc_id() { return (unsigned)__builtin_amdgcn_s_getreg((3 << 11) | 20) & 0xFu; }
#define XB_SPIN(cond, bar) do { unsigned _sp = 0; while (cond) { __builtin_amdgcn_s_sleep(1); \
    if ((++_sp & 255u) == 0u) { if (xb_ld(&(bar)[XB_TMO])) break; if (_sp > XB_SPIN_CAP) { atomicAdd(&(bar)[XB_TMO], 1u); break; } } } } while (0)

struct XcdBarrier {
    unsigned* bar; unsigned x; unsigned w0;
    volatile LAS unsigned* st;
};

__device__ __forceinline__ XcdBarrier xcd_barrier_post(unsigned* bar, volatile LAS unsigned* st) {
    XcdBarrier b; b.bar = bar; b.x = xb_xcc_id(); b.st = st; b.w0 = (__builtin_amdgcn_readfirstlane((int)threadIdx.x >> 6) == 0) ? 1u : 0u;
    if (threadIdx.x == 0) (void)xb_add(&bar[XB_XCNT(b.x)], 1u);
    return b;
}
__device__ __forceinline__ void xcd_barrier_complete(unsigned* bar, unsigned x, unsigned& nloc, unsigned& nx) {
    const unsigned G = gridDim.x * gridDim.y * gridDim.z;
    unsigned sum, cnt, mine, sp = 0u;
    for (;;) {
        sum = 0u; cnt = 0u; mine = 0u;
#pragma unroll
        for (unsigned j = 0; j < 16; ++j) { const unsigned c = xb_ld(&bar[XB_XCNT(j)]); sum += c; cnt += (c > 0u) ? 1u : 0u; mine = (j == x) ? c : mine; }
        if (sum == G) break;
        __builtin_amdgcn_s_sleep(1);
        if ((++sp & 255u) == 0u) { if (xb_ld(&bar[XB_TMO])) break; if (sp > XB_SPIN_CAP) { atomicAdd(&bar[XB_TMO], 1u); break; } }
    }
    nloc = mine > 0u ? mine : 1u; nx = cnt > 0u ? cnt : 1u;
}

__device__ __forceinline__ void xcd_barrier(const XcdBarrier& b) {
    asm volatile("s_waitcnt vmcnt(0)" ::: "memory");
    __syncthreads();
    if (b.w0 != 0u && lane_lo_() == 0u) {
        unsigned* bar = b.bar; unsigned bx = b.x; asm volatile("" : "+s"(bar), "+s"(bx));
        __builtin_amdgcn_s_waitcnt(0);
        unsigned nloc = b.st[0], nx = b.st[1];
        if (nloc == 0u) { xcd_barrier_complete(bar, bx, nloc, nx); b.st[0] = nloc; b.st[1] = nx; }
        const unsigned old = xb_add(&bar[XB_XSUB(bx)], 1u);
        const unsigned gen = old / nloc;
        if (old + 1u == (gen + 1u) * nloc) {
            __builtin_amdgcn_fence(__ATOMIC_RELEASE, "agent");
            asm volatile("s_waitcnt vmcnt(0)" ::: "memory");
            const unsigned og = xb_add(&bar[XB_TOP], 1u);
            const unsigned tg = og / nx;
            if (og + 1u == (tg + 1u) * nx) xb_add(&bar[XB_TOPGEN], 1u);
            else XB_SPIN(xb_ld(&bar[XB_TOPGEN]) == tg, bar);
            __builtin_amdgcn_fence(__ATOMIC_ACQUIRE, "agent");
            xb_add(&bar[XB_XGEN(bx)], 1u);
            asm volatile("s_waitcnt vmcnt(0)" ::: "memory");
        } else {
            XB_SPIN(xb_ld(&bar[XB_XGEN(bx)]) == gen, bar);
            __builtin_amdgcn_fence(__ATOMIC_ACQUIRE, "agent");
            asm volatile("s_waitcnt vmcnt(0)" ::: "memory");
        }
    }
    __syncthreads();
}

struct Frame {
    LAS unsigned char* lds;
    volatile LAS unsigned* MISC;
    gu32* ctl;
    int G, wave;
    float* out; unsigned char* ws;
};
__device__ __forceinline__ const float* in_ptr(int i) {
    const __attribute__((address_space(4))) char* k = (const __attribute__((address_space(4))) char*)__builtin_amdgcn_kernarg_segment_ptr();
    asm volatile("" : "+s"(k));
    return *(const float* const __attribute__((address_space(4)))*)(k + 8 * i);
}
enum { IN_XP = 0, IN_XS, IN_CK, IN_CV, IN_SRET, IN_SPOOL, IN_META, IN_WIN, IN_RETG, IN_PMIX, IN_PSCALE, IN_WBR, IN_WOUT, IN_UP1, IN_DN1, IN_UP2, IN_DN2, IN_LNG, IN_LNB };
__device__ __forceinline__ unsigned char* wsq(unsigned char* p) { asm volatile("" : "+s"(p)); return p; }
#define WSB(F, off) ((bf16*)(wsq((F).ws) + (off)))
struct TC { int tid, lane, wave; };
__device__ __forceinline__ TC thread_coords(int wave) { TC c; int l = lane_id_(); asm volatile("" : "+v"(l)); c.lane = l; c.wave = wave; c.tid = wave * 64 + l; return c; }
__device__ __forceinline__ bf16* lw(const Frame& F, int l, size_t off) { return (bf16*)(wsq(F.ws) + WS_W + (size_t)l * LW_SIZE + off); }
__device__ __forceinline__ float* yrow(const Frame& F, int m) {
    if (m < MP) return F.out + O_YP + (size_t)m * D;
    if (m < ROW_M) return F.out + O_YS + (size_t)(m - ROW_S) * D;
    return nullptr;
}

__device__ __forceinline__ int srccol(int kind, int n) {
    if (kind == 1) { const int pn = n >> 8, p = n & 255, bj = p >> 7, wc = (p >> 5) & 3, fq = (p >> 3) & 3, nn = (p >> 2) & 1, e = p & 3;
        return (nn ? DFF : 0) + 128 * pn + 64 * bj + 16 * wc + 4 * fq + e; }
    if (kind == 2 && n < 1024) { const int hb_ = n & ~127, p = n & 127, wc = p >> 5, fq = (p >> 3) & 3, nn = (p >> 2) & 1, e = p & 3;
        return hb_ + 16 * wc + 4 * fq + e + 64 * nn; }
    return n;
}
__device__ __forceinline__ void p0_transpose_item(const float* W, int K, int ldw, int N, bf16* WT, int kind, LAS float* scr, int item, int lane) {
    const int nblk = N / 32, kb = item / nblk, nb = item % nblk, k0 = 64 * kb, n0 = 32 * nb;
    const int sc = srccol(kind, n0 + (lane & 31));
    float t_[32];
#pragma unroll
    for (int i = 0; i < 32; ++i) t_[i] = W[(size_t)(k0 + 2 * i + (lane >> 5)) * ldw + sc];
#pragma unroll
    for (int i = 0; i < 32; ++i) scr[(2 * i + (lane >> 5)) * 33 + (lane & 31)] = t_[i];
    asm volatile("s_waitcnt lgkmcnt(0)" ::: "memory");
    const int c = lane & 7;
#pragma unroll
    for (int j = 0; j < 4; ++j) { const int n = (lane >> 3) + 8 * j; const LAS float* s = scr + (8 * c) * 33 + n;
        v4u o; o.x = pk2(s[0 * 33], s[1 * 33]); o.y = pk2(s[2 * 33], s[3 * 33]); o.z = pk2(s[4 * 33], s[5 * 33]); o.w = pk2(s[6 * 33], s[7 * 33]);
        *(GAS v4u*)(WT + (size_t)(n0 + n) * K + k0 + 8 * c) = o; }
    asm volatile("s_waitcnt lgkmcnt(0)" ::: "memory");
}
__device__ __forceinline__ void p0_poolfold_item(const float* mixw  , const float* scale  , const float* wb2  , bf16* WT  , int item, int lane) {
    const int g = item >> 7, r = item & 127, cb = r >> 4, nb = r & 15;
    const int n = nb * 64 + lane, c0 = cb * 32;
    float acc[32];
#pragma unroll
    for (int i = 0; i < 32; ++i) acc[i] = 0.f;
    const float* mw = mixw + ((size_t)g * 256 + c0) * 256;
    for (int d0 = 0; d0 < 256; d0 += 8) {
        float a[8];
#pragma unroll
        for (int j = 0; j < 8; ++j) a[j] = scale[g * 256 + d0 + j] * wb2[(size_t)(g * 256 + d0 + j) * D + n];
#pragma unroll
        for (int i = 0; i < 32; ++i)
#pragma unroll
            for (int j = 0; j < 8; ++j) acc[i] += mw[(size_t)i * 256 + d0 + j] * a[j];
    }
    bf16* dst = WT + (size_t)n * D + g * 256 + c0;
#pragma unroll
    for (int i = 0; i < 32; i += 8) { v4u o; o.x = pk2(acc[i], acc[i + 1]); o.y = pk2(acc[i + 2], acc[i + 3]); o.z = pk2(acc[i + 4], acc[i + 5]); o.w = pk2(acc[i + 6], acc[i + 7]); *(GAS v4u*)(dst + i) = o; }
}
__device__ __forceinline__ void p0_prologue(Frame& F) {
    const TC tc = thread_coords(F.wave); const int gw = blockIdx.x * 8 + tc.wave, NGW = F.G * 8;
    LAS float* scr = (LAS float*)(F.lds + tc.wave * 16384);
    for (int l = 0; l < DEPTH; ++l) {
        constexpr int I_UP = (D / 64) * (2 * DFF / 32), I_DN = (DFF / 64) * (D / 32), I_IN = (D / 64) * (DIN / 32), I_SQ = (D / 64) * (D / 32), I_PF = 4 * 4 * 32;
        constexpr int NIT = 2 * I_UP + 2 * I_DN + I_IN + 3 * I_SQ + I_PF;
        for (int it = (gw + l * (NGW / 2)) % NGW; it < NIT; it += NGW) {
            int r = it;
            if (r < I_UP) { p0_transpose_item(in_ptr(IN_UP1) + (size_t)l * D * 2 * DFF, D, 2 * DFF, 2 * DFF, lw(F, l, LW_UP1), 1, scr, r, tc.lane); continue; } r -= I_UP;
            if (r < I_UP) { p0_transpose_item(in_ptr(IN_UP2) + (size_t)l * D * 2 * DFF, D, 2 * DFF, 2 * DFF, lw(F, l, LW_UP2), 1, scr, r, tc.lane); continue; } r -= I_UP;
            if (r < I_DN) { p0_transpose_item(in_ptr(IN_DN1) + (size_t)l * DFF * D, DFF, D, D, lw(F, l, LW_DN1), 0, scr, r, tc.lane); continue; } r -= I_DN;
            if (r < I_DN) { p0_transpose_item(in_ptr(IN_DN2) + (size_t)l * DFF * D, DFF, D, D, lw(F, l, LW_DN2), 0, scr, r, tc.lane); continue; } r -= I_DN;
            if (r < I_IN) { p0_transpose_item(in_ptr(IN_WIN) + (size_t)l * D * DIN, D, DIN, DIN, lw(F, l, LW_IN), 2, scr, r, tc.lane); continue; } r -= I_IN;
            if (r < I_SQ) { p0_transpose_item(in_ptr(IN_WBR) + (size_t)(l * 3 + 0) * D * D, D, D, D, lw(F, l, LW_BR), 0, scr, r, tc.lane); continue; } r -= I_SQ;
            if (r < I_SQ) { p0_transpose_item(in_ptr(IN_WBR) + (size_t)(l * 3 + 1) * D * D, D, D, D, lw(F, l, LW_BR) + (size_t)D * D, 0, scr, r, tc.lane); continue; } r -= I_SQ;
            if (r < I_SQ) { p0_transpose_item(in_ptr(IN_WOUT) + (size_t)l * D * D, D, D, D, lw(F, l, LW_OUT), 0, scr, r, tc.lane); continue; } r -= I_SQ;
            p0_poolfold_item(in_ptr(IN_PMIX) + (size_t)l * 4 * 256 * 256, in_ptr(IN_PSCALE) + (size_t)l * D, in_ptr(IN_WBR) + (size_t)(l * 3 + 2) * D * D, lw(F, l, LW_BR) + (size_t)2 * D * D, r, tc.lane);
        }
    }
    for (int m0 = gw; m0 < M_PAD; m0 += 2 * NGW) {
        f32x4 v[2][4];
#pragma unroll
        for (int r = 0; r < 2; ++r) { const int m = m0 + r * NGW;
            const float* src = (m < MP) ? in_ptr(IN_XP) + (size_t)m * D : (m < ROW_M) ? in_ptr(IN_XS) + (size_t)(m - ROW_S) * D : (m - ROW_M < NMETA) ? in_ptr(IN_META) + (size_t)(m - ROW_M) * D : nullptr;
#pragma unroll
            for (int j = 0; j < 4; ++j) v[r][j] = (src && m < M_PAD) ? ((const GAS f32x4*)src)[tc.lane + 64 * j] : (f32x4){0.f, 0.f, 0.f, 0.f}; }
#pragma unroll
        for (int r = 0; r < 2; ++r) { const int m = m0 + r * NGW;
            if (m < M_PAD) { GAS v2u* o8 = (GAS v2u*)(WSB(F, WS_HB) + (size_t)m * D) + tc.lane;
#pragma unroll
                for (int j = 0; j < 4; ++j) o8[64 * j] = (v2u){pk2(v[r][j].x, v[r][j].y), pk2(v[r][j].z, v[r][j].w)}; } }
    }
}

__device__ __forceinline__ void ln_rows(const Frame& F, int idx, bool final_out, int row_lo, int row_hi, int gw0, int NGW, bool comb = false) {
    const TC tc = thread_coords(F.wave); const int gw = gw0 + tc.wave;
    const float* g = in_ptr(IN_LNG) + (size_t)idx * D; const float* b = in_ptr(IN_LNB) + (size_t)idx * D;
    f32x4 gv[4], bv[4];
#pragma unroll
    for (int j = 0; j < 2; ++j) { gv[2 * j] = ((const GAS f32x4*)g)[2 * tc.lane + 128 * j]; gv[2 * j + 1] = ((const GAS f32x4*)g)[2 * tc.lane + 128 * j + 1];
                                  bv[2 * j] = ((const GAS f32x4*)b)[2 * tc.lane + 128 * j]; bv[2 * j + 1] = ((const GAS f32x4*)b)[2 * tc.lane + 128 * j + 1]; }
    for (int m0 = row_lo + gw; m0 < row_hi; m0 += 2 * NGW) {
        v4u w[2][2]; const bool two = m0 + NGW < row_hi;
#pragma unroll
        for (int r = 0; r < 2; ++r) { const int m = (r == 0 || two) ? m0 + r * NGW : m0; const GAS v4u* yr = (const GAS v4u*)(WSB(F, comb ? WS_HB : WS_YB) + (size_t)m * D) + tc.lane; w[r][0] = yr[0]; w[r][1] = yr[64]; }
#pragma unroll
        for (int r = 0; r < 2; ++r) { const int m = m0 + r * NGW; if (r == 1 && !two) break;
        f32x4 v[4]; float s = 0.f;
#pragma unroll
        for (int j = 0; j < 2; ++j) { const v4u x = w[r][j]; v[2 * j] = (f32x4){bflo(x.x), bfhi(x.x), bflo(x.y), bfhi(x.y)}; v[2 * j + 1] = (f32x4){bflo(x.z), bfhi(x.z), bflo(x.w), bfhi(x.w)}; }
        if (comb) {
            const GAS f32x4* pa = (const GAS f32x4*)((const float*)WSB(F, WS_ACT) + (size_t)(m - MP) * D) + 2 * tc.lane; const GAS f32x4* pb = pa + (size_t)512 * D / 4;
#pragma unroll
            for (int j = 0; j < 2; ++j) { v[2 * j] = v[2 * j] * ALPHA + (pa[128 * j] + pb[128 * j]) * 0.5f; v[2 * j + 1] = v[2 * j + 1] * ALPHA + (pa[128 * j + 1] + pb[128 * j + 1]) * 0.5f; } }
#pragma unroll
        for (int j = 0; j < 4; ++j) s += (v[j].x + v[j].y) + (v[j].z + v[j].w);
        const float mean = wave_sum(s) * (1.f / D); float s2 = 0.f;
#pragma unroll
        for (int j = 0; j < 4; ++j) { v[j] = v[j] - mean; s2 += (v[j].x * v[j].x + v[j].y * v[j].y) + (v[j].z * v[j].z + v[j].w * v[j].w); }
        const float rstd = 1.f / sqrtf(wave_sum(s2) * (1.f / D) + LN_EPS);
#pragma unroll
        for (int j = 0; j < 4; ++j) v[j] = v[j] * rstd * gv[j] + bv[j];
        if (!final_out) { GAS v4u* o = (GAS v4u*)(WSB(F, WS_HB) + (size_t)m * D) + tc.lane;
#pragma unroll
            for (int j = 0; j < 2; ++j) o[64 * j] = (v4u){pk2(v[2 * j].x, v[2 * j].y), pk2(v[2 * j].z, v[2 * j].w), pk2(v[2 * j + 1].x, v[2 * j + 1].y), pk2(v[2 * j + 1].z, v[2 * j + 1].w)}; }
        else { float* yo = yrow(F, m); if (yo) { GAS f32x4* o = (GAS f32x4*)yo + 2 * tc.lane;
#pragma unroll
            for (int j = 0; j < 2; ++j) { o[128 * j] = v[2 * j]; o[128 * j + 1] = v[2 * j + 1]; } } }
        }
    }
}
__device__ __forceinline__ void ln_phase(const Frame& F, int idx, bool final_out, int row_lo, int row_hi, int cu_lo, bool comb = false) { ln_rows(F, idx, final_out, row_lo, row_hi, ((int)blockIdx.x - cu_lo) * 8, (F.G - cu_lo) * 8, comb); }
__device__ __forceinline__ float ret_lg2(int h);

using pg8::Unit;
typedef f32x4 AccT[2][2][4][2];
#ifndef LANE_TR
#define LANE_TR 1
#endif
struct LaneT { int tfr, tfq, pull, push; };
#if LANE_TR
__device__ __forceinline__ LaneT lane_t(int fr, int fq) { LaneT t; const int L = fq * 16 + fr; t.tfr = L >> 2; t.tfq = L & 3; t.pull = ((t.tfq << 4) + t.tfr) << 2; t.push = ((fr << 2) + fq) << 2; return t; }
__device__ __forceinline__ unsigned bperm(int a, unsigned x) { return (unsigned)__builtin_amdgcn_ds_bpermute(a, (int)x); }
__device__ __forceinline__ v4u tr4(int a, v4u x) { return (v4u){bperm(a, x.x), bperm(a, x.y), bperm(a, x.z), bperm(a, x.w)}; }
__device__ __forceinline__ v2u tr2(int a, v2u x) { return (v2u){bperm(a, x.x), bperm(a, x.y)}; }
#else
__device__ __forceinline__ LaneT lane_t(int fr, int fq) { LaneT t; t.tfr = fr; t.tfq = fq; t.pull = 0; t.push = 0; return t; }
__device__ __forceinline__ v4u tr4(int, v4u x) { return x; }
__device__ __forceinline__ v2u tr2(int, v2u x) { return x; }
#endif
__device__ __forceinline__ f32x4 tr4f(int a, f32x4 x) { return __builtin_bit_cast(f32x4, tr4(a, __builtin_bit_cast(v4u, x))); }
__device__ __forceinline__ v4u pack8(const f32x4& a, const f32x4& b) { return (v4u){pg8::cvt_pk_bf16(a[0], a[1]), pg8::cvt_pk_bf16(a[2], a[3]), pg8::cvt_pk_bf16(b[0], b[1]), pg8::cvt_pk_bf16(b[2], b[3])}; }

struct EpiSwiglu {
    static constexpr bool PERM = true; static constexpr int NS = 8;
    bf16* act;
    __device__ __forceinline__ bool operator()(AccT& acc, const Unit& u, int wr, int wc, int fr, int fq) const {
        asm volatile("" : "+s"(wr), "+s"(wc), "+v"(fr), "+v"(fq));
        const int row0 = u.pm * 256 + wr * 64 + fr + 16 * (fq & 1), col0 = u.pn * 128 + wc * 16 + 4 * (fq & 2);
#pragma unroll
        for (int ai = 0; ai < 2; ++ai)
#pragma unroll
            for (int mp = 0; mp < 2; ++mp) { bf16* rowp = act + (size_t)(row0 + ai * 128 + mp * 32) * DFF + col0;
#pragma unroll
                for (int bj = 0; bj < 2; ++bj) { unsigned pk[2][2];
#pragma unroll
                    for (int k = 0; k < 2; ++k) { const f32x4 g = acc[ai][bj][2 * mp + k][0], up = acc[ai][bj][2 * mp + k][1];
                        pk[k][0] = pg8::cvt_pk_bf16(siluf_(g[0]) * up[0], siluf_(g[1]) * up[1]); pk[k][1] = pg8::cvt_pk_bf16(siluf_(g[2]) * up[2], siluf_(g[3]) * up[3]); }
                    const auto sx = __builtin_amdgcn_permlane16_swap(pk[0][0], pk[1][0], false, false), sy = __builtin_amdgcn_permlane16_swap(pk[0][1], pk[1][1], false, false);
                    *(GAS v4u*)(rowp + bj * 64) = (v4u){sx[0], sy[0], sx[1], sy[1]}; } }
        return false;
    }
};

struct EpiResid {
    static constexpr bool PERM = true; static constexpr int NS = 16;
    unsigned char* ws; float ca, cb;
    __device__ __forceinline__ bool operator()(AccT& acc, const Unit& u, int wr, int wc, int fr, int fq) const {
        asm volatile("" : "+s"(wr), "+s"(wc), "+v"(fr), "+v"(fq));
        const LaneT t = lane_t(fr, fq);
        const bf16* src = (const bf16*)(ws + WS_HB); bf16* dst = (bf16*)(ws + WS_YB);
        const int row0 = u.pm * 256 + wr * 64 + t.tfr, col0 = u.pn * 256 + wc * 32 + 8 * t.tfq;
#pragma unroll
        for (int ai = 0; ai < 2; ++ai)
#pragma unroll
            for (int m = 0; m < 4; ++m) { const size_t off = (size_t)(row0 + ai * 128 + m * 16) * D + col0;
#pragma unroll
                for (int bj = 0; bj < 2; ++bj) { const v4u r = tr4(t.push, *(const GAS v4u*)(src + off + bj * 128));
                    const f32x4 y0 = (f32x4){bflo(r.x), bfhi(r.x), bflo(r.y), bfhi(r.y)} * ca + acc[ai][bj][m][0] * cb, y1 = (f32x4){bflo(r.z), bfhi(r.z), bflo(r.w), bfhi(r.w)} * ca + acc[ai][bj][m][1] * cb;
                    *(GAS v4u*)(dst + off + bj * 128) = tr4(t.pull, pack8(y0, y1)); } }
        return false;
    }
};

struct EpiGate {
    static constexpr bool PERM = true; static constexpr int NS = 0;
    unsigned char* ws;
    __device__ __forceinline__ bool operator()(AccT& acc, const Unit& u, int wr, int wc, int fr, int fq) const {
        asm volatile("" : "+s"(wr), "+s"(wc), "+v"(fr), "+v"(fq));
        const LaneT t = lane_t(fr, fq);
        const bf16* Gt = (const bf16*)(ws + WS_GT); bf16* mix = (bf16*)(ws + WS_MIX);
        const int n = u.pm / NPANEL, pm = u.pm - n * NPANEL, pn = u.pn & 3;
        const int row0 = pm * 256 + wr * 64 + t.tfr, col0 = pn * 256 + wc * 32 + 8 * t.tfq;
#pragma unroll
        for (int ai = 0; ai < 2; ++ai)
#pragma unroll
            for (int m = 0; m < 4; ++m) { const size_t r = (size_t)(row0 + ai * 128 + m * 16);
#pragma unroll
                for (int bj = 0; bj < 2; ++bj) {
                    const v4u ga = tr4(t.push, *(const GAS v4u*)(Gt + r * (3 * D) + n * D + col0 + bj * 128));
                    float f[8] = {bflo(ga.x), bfhi(ga.x), bflo(ga.y), bfhi(ga.y), bflo(ga.z), bfhi(ga.z), bflo(ga.w), bfhi(ga.w)};
                    if (n < 2) { const v4u gb = tr4(t.push, *(const GAS v4u*)(Gt + r * (3 * D) + (n + 1) * D + col0 + bj * 128));
                        const float h[8] = {bflo(gb.x), bfhi(gb.x), bflo(gb.y), bfhi(gb.y), bflo(gb.z), bfhi(gb.z), bflo(gb.w), bfhi(gb.w)};
#pragma unroll
                        for (int e = 0; e < 8; ++e) f[e] = f[e] * fast_rcp(fmaxf(h[e], 1e-30f)); }
                    f32x4 v0 = acc[ai][bj][m][0], v1 = acc[ai][bj][m][1];
                    v0 = v0 * (f32x4){f[0], f[1], f[2], f[3]}; v1 = v1 * (f32x4){f[4], f[5], f[6], f[7]};
                    acc[ai][bj][m][0] = v0; acc[ai][bj][m][1] = v1;
                    if (n == 2) *(GAS v4u*)(mix + r * D + col0 + bj * 128) = tr4(t.pull, pack8(v0, v1));
                } }
        return n < 2;
    }
};
struct Order3 : pg8::StaticOrder {
    __device__ __forceinline__ bool next(int i, Unit& u) const { Unit t; if (!pg8::StaticOrder::next(i / 3, t)) return false; const int k = i % 3; u.pm = t.pm + k * NPANEL; u.pn = t.pn + 4 * k; return true; }
};

struct SmallOrder {
    int c;
    __device__ __forceinline__ bool next(int i, Unit& u) const { if (i > 0 || c >= 8) return false; u.pm = 256 + (c >> 2); u.pn = c & 3; return true; }
    __device__ __forceinline__ void a_ready(const Unit&) const {}
    __device__ __forceinline__ void done(const Unit&) const {}
};

struct SmallOrderH {
    int c;
    __device__ __forceinline__ bool next(int i, Unit& u) const { if (i > 0 || c >= 16) return false; u.pm = 256 + ((c >> 2) & 1); u.pn = c & 3; return true; }
    __device__ __forceinline__ void a_ready(const Unit&) const {}
    __device__ __forceinline__ void done(const Unit&) const {}
};
struct EpiPart {
    static constexpr bool PERM = true; static constexpr int NS = 16;
    float* part;
    __device__ __forceinline__ bool operator()(AccT& acc, const Unit& u, int wr, int wc, int fr, int fq) const {
        asm volatile("" : "+s"(wr), "+s"(wc), "+v"(fr), "+v"(fq));
        float* p0 = part + (size_t)((u.pm - 256) * 256 + wr * 64 + fr) * D + u.pn * 256 + wc * 32 + 8 * fq;
#pragma unroll
        for (int ai = 0; ai < 2; ++ai)
#pragma unroll
            for (int m = 0; m < 4; ++m)
#pragma unroll
                for (int bj = 0; bj < 2; ++bj)
#pragma unroll
                    for (int n = 0; n < 2; ++n) *(GAS f32x4*)(p0 + (size_t)(ai * 128 + m * 16) * D + bj * 128 + 4 * n) = acc[ai][bj][m][n];
        return false;
    }
};

struct SmallOrder3 {
    int c;
    __device__ __forceinline__ bool next(int i, Unit& u) const { if (i > 2) return false; u.pm = 256 + (c >> 2) + i * NPANEL; u.pn = (c & 3) + 4 * i; return true; }
    __device__ __forceinline__ void a_ready(const Unit&) const {}
    __device__ __forceinline__ void done(const Unit&) const {}
};
struct SmallOrderW {
    int c;
    __device__ __forceinline__ bool next(int i, Unit& u) const { if (i > 0) return false; const int p = c >= 22 ? 1 : 0; u.pm = 256 + p; u.pn = c - 22 * p; return true; }
    __device__ __forceinline__ void a_ready(const Unit&) const {}
    __device__ __forceinline__ void done(const Unit&) const {}
};

struct EpiWin {
    static constexpr bool PERM = true; static constexpr int NS = 16;
    unsigned char* ws; float* out; int layer;
    __device__ __forceinline__ bool operator()(AccT& acc, const Unit& u, int wr, int wc, int fr, int fq) const {
        asm volatile("" : "+s"(wr), "+s"(wc), "+v"(fr), "+v"(fq));
        const LaneT t = lane_t(fr, fq);
        const int pn = u.pn, pm = u.pm, rl0 = wr * 64 + fr, trl0 = wr * 64 + t.tfr;
        if (pn < 4) {
            const bool isk = pn >= 2; bf16* dst = (bf16*)(ws + (isk ? WS_KR : WS_QR)); const float sc = isk ? 0.08838834764831845f : 1.0f;
            const float lgA = ret_lg2(2 * (pn & 1)) * (isk ? -1.f : 1.f), lgB = ret_lg2(2 * (pn & 1) + 1) * (isk ? -1.f : 1.f);
            float invf[4];
#pragma unroll
            for (int e = 0; e < 4; ++e) invf[e] = fast_exp2(-(float)(16 * wc + 4 * fq + e) * (13.287712379549449f / 64.0f)) * 0.15915494309189535f;
#pragma unroll
            for (int ai = 0; ai < 2; ++ai)
#pragma unroll
                for (int mp = 0; mp < 2; ++mp) { unsigned pk1[2][2][2], pk2[2][2][2];
#pragma unroll
                    for (int k = 0; k < 2; ++k) { const int rl = rl0 + ai * 128 + (2 * mp + k) * 16, r = pm * 256 + rl;
                        const float pos = (float)(pm < 256 ? NMETA + (r & (T - 1)) : (pm == 256 ? NMETA + PAST + (rl & (ST - 1)) : rl));
                        const float jp1 = (float)((pm < 256 ? (r & 63) : (pm == 256 ? (rl & (ST - 1)) : rl)) + 1);
                        const float dsc[2] = {sc * fast_exp2(jp1 * lgA), sc * fast_exp2(jp1 * lgB)};
                        f32x4 cs, sn;
#pragma unroll
                        for (int e = 0; e < 4; ++e) { float rev = pos * invf[e]; rev = rev - floorf(rev); cs[e] = __builtin_amdgcn_cosf(rev); sn[e] = __builtin_amdgcn_sinf(rev); }
#pragma unroll
                        for (int bj = 0; bj < 2; ++bj) { const f32x4 x1 = acc[ai][bj][2 * mp + k][0], x2 = acc[ai][bj][2 * mp + k][1];
                            const f32x4 o1 = (x1 * cs - x2 * sn) * dsc[bj], o2 = (x2 * cs + x1 * sn) * dsc[bj];
                            pk1[k][bj][0] = pg8::cvt_pk_bf16(o1[0], o1[1]); pk1[k][bj][1] = pg8::cvt_pk_bf16(o1[2], o1[3]);
                            pk2[k][bj][0] = pg8::cvt_pk_bf16(o2[0], o2[1]); pk2[k][bj][1] = pg8::cvt_pk_bf16(o2[2], o2[3]); } }
                    const size_t srow = (size_t)(pm * 256 + rl0 + ai * 128 + (2 * mp + (fq & 1)) * 16);
#pragma unroll
                    for (int bj = 0; bj < 2; ++bj) { bf16* rowp = dst + srow * 512 + (2 * (pn & 1) + bj) * 128 + 16 * wc + 4 * (fq & 2);
                        { const auto sx = __builtin_amdgcn_permlane16_swap(pk1[0][bj][0], pk1[1][bj][0], false, false), sy = __builtin_amdgcn_permlane16_swap(pk1[0][bj][1], pk1[1][bj][1], false, false);
                          *(GAS v4u*)rowp = (v4u){sx[0], sy[0], sx[1], sy[1]}; }
                        { const auto sx = __builtin_amdgcn_permlane16_swap(pk2[0][bj][0], pk2[1][bj][0], false, false), sy = __builtin_amdgcn_permlane16_swap(pk2[0][bj][1], pk2[1][bj][1], false, false);
                          *(GAS v4u*)(rowp + 64) = (v4u){sx[0], sy[0], sx[1], sy[1]}; } } }
            return false;
        }
        const int seg = (pn - 4) >> 2;
        const int colt = ((pn - 4) & 3) * 256 + wc * 32 + 8 * t.tfq;
        if (seg == 0 || seg == 1 || seg == 2 || seg >= 6) {
            bf16* dst = (bf16*)(ws + (seg == 0 ? WS_VR : seg == 1 ? WS_GR : seg == 2 ? WS_QS : WS_GT)); const int ld = seg >= 6 ? 3 * D : D; const int cofs = seg >= 6 ? (seg - 6) * D : 0;
#pragma unroll
            for (int ai = 0; ai < 2; ++ai)
#pragma unroll
                for (int m = 0; m < 4; ++m) { const size_t r = (size_t)(pm * 256 + trl0 + ai * 128 + m * 16);
#pragma unroll
                    for (int bj = 0; bj < 2; ++bj) { f32x4 v0 = acc[ai][bj][m][0], v1 = acc[ai][bj][m][1];
                        if (seg == 1) {
#pragma unroll
                            for (int e = 0; e < 4; ++e) { v0[e] = siluf_(v0[e]); v1[e] = siluf_(v1[e]); } }
                        else if (seg == 2) { v0 = v0 * (0.08838834764831845f * LOG2E); v1 = v1 * (0.08838834764831845f * LOG2E); }
                        else if (seg >= 6) {
#pragma unroll
                            for (int e = 0; e < 4; ++e) { v0[e] = sigmoidf_(v0[e]); v1[e] = sigmoidf_(v1[e]); } }
                        *(GAS v4u*)(dst + r * ld + cofs + colt + bj * 128) = tr4(t.pull, pack8(v0, v1)); } }
            return false;
        }
        if (seg == 3 || seg == 4) {
            bf16* dst = (bf16*)(ws + (seg == 3 ? WS_KS : WS_VS));
            if (seg == 3 && pm != 256) {
                float mx[2] = {0.f, 0.f};
#pragma unroll
                for (int ai = 0; ai < 2; ++ai)
#pragma unroll
                    for (int m = 0; m < 4; ++m) { const int rl = rl0 + ai * 128 + m * 16; if (pm < 256 || rl < NMETA) {
#pragma unroll
                        for (int bj = 0; bj < 2; ++bj) { const f32x4 a = acc[ai][bj][m][0], b2 = acc[ai][bj][m][1];
                            const float s = (a[0] * a[0] + a[1] * a[1]) + (a[2] * a[2] + a[3] * a[3]) + (b2[0] * b2[0] + b2[1] * b2[1]) + (b2[2] * b2[2] + b2[3] * b2[3]); mx[bj] = fmaxf(mx[bj], s); } } }
#pragma unroll
                for (int bj = 0; bj < 2; ++bj) {
#pragma unroll
                    for (int o = 1; o < 16; o <<= 1) mx[bj] = fmaxf(mx[bj], __shfl_xor(mx[bj], o));
                    if (fr == 0) { const int bidx = pm < 256 ? (pm >> 3) : 32, hh = ((pn - 16) & 3) * 2 + bj;
                        atomicMax((unsigned*)(ws + WS_CTL) + CW_KN + ((layer * 33 + bidx) * 8 + hh) * 16 + wc * 4 + fq, __float_as_uint(mx[bj] * 1.02f)); } }
            }
            float* op = out + (seg == 3 ? O_KP : O_VP) + (size_t)layer * NB * KT_PP * D;
            float* os = out + (seg == 3 ? O_KS : O_VS) + (size_t)layer * SBATCH * ST * D;
#pragma unroll
            for (int ai = 0; ai < 2; ++ai)
#pragma unroll
                for (int m = 0; m < 4; ++m) { const int rl = trl0 + ai * 128 + m * 16; const size_t r = (size_t)(pm * 256 + rl);
#pragma unroll
                    for (int bj = 0; bj < 2; ++bj) { const f32x4 v0 = tr4f(t.pull, acc[ai][bj][m][0]), v1 = tr4f(t.pull, acc[ai][bj][m][1]); const int c = colt + bj * 128;
                        *(GAS v4u*)(dst + r * D + c) = pack8(v0, v1);
                        if (pm < 256) { float* o = op + ((size_t)(r >> 11) * KT_PP + NMETA + (r & (T - 1))) * D + c; *(GAS f32x4*)o = v0; *(GAS f32x4*)(o + 4) = v1; }
                        else if (pm == 256) { float* o = os + (size_t)rl * D + c; *(GAS f32x4*)o = v0; *(GAS f32x4*)(o + 4) = v1; }
                        else if (rl < NMETA) { for (int bb = 0; bb < NB; ++bb) { float* o = op + ((size_t)bb * KT_PP + rl) * D + c; *(GAS f32x4*)o = v0; *(GAS f32x4*)(o + 4) = v1; } }
                    } }
            return false;
        }
        {
            float* op = out + O_PP + (size_t)layer * NB * PBUF * D;
            float* os = out + O_PS + (size_t)layer * SBATCH * PBUF * D;
#pragma unroll
            for (int ai = 0; ai < 2; ++ai)
#pragma unroll
                for (int m = 0; m < 4; ++m) { const int rl = trl0 + ai * 128 + m * 16; const size_t r = (size_t)(pm * 256 + rl);
#pragma unroll
                    for (int bj = 0; bj < 2; ++bj) { const f32x4 v0 = tr4f(t.pull, acc[ai][bj][m][0]), v1 = tr4f(t.pull, acc[ai][bj][m][1]); const int c = colt + bj * 128;
                        *(GAS v4u*)((bf16*)(ws + WS_U) + r * D + c) = pack8(v0, v1);
                        if (pm < 256) { const int tt = (int)(r & (T - 1)); if (tt >= T - PBUF) { float* o = op + ((size_t)(r >> 11) * PBUF + (tt - (T - PBUF))) * D + c; *(GAS f32x4*)o = v0; *(GAS f32x4*)(o + 4) = v1; } }
                        else if (pm == 256) { const int tt = rl & (ST - 1); if (tt >= ST - PBUF) { float* o = os + ((size_t)(rl >> 5) * PBUF + (tt - (ST - PBUF))) * D + c; *(GAS f32x4*)o = v0; *(GAS f32x4*)(o + 4) = v1; } }
                    } }
            return false;
        }
    }
};

__device__ __forceinline__ int grab(const Frame& F, gu32* ctr) {
    __syncthreads();
    if (F.wave == 0 && lane_lo_() == 0u) F.MISC[16] = __hip_atomic_fetch_add(ctr, 1u, RLX_AGENT);
    __syncthreads();
    return (int)F.MISC[16];
}
__device__ __forceinline__ unsigned grab_issue(const Frame& F, gu32* ctr) { return (F.wave == 0 && lane_lo_() == 0u) ? __hip_atomic_fetch_add(ctr, 1u, RLX_AGENT) : 0u; }
__device__ __forceinline__ int grab_publish(const Frame& F, unsigned nxt) {
    __syncthreads();
    if (F.wave == 0 && lane_lo_() == 0u) F.MISC[16] = nxt;
    __syncthreads();
    return (int)F.MISC[16];
}
typedef float f32x4_t __attribute__((ext_vector_type(4)));
#define MFMA16(a, b, c) __builtin_amdgcn_mfma_f32_16x16x32_bf16((a), (b), (c), 0, 0, 0)
__device__ __forceinline__ s16x4 tr16(const LAS unsigned char* p) { typedef short v4i16_t __attribute__((ext_vector_type(4))); return __builtin_bit_cast(s16x4, __builtin_amdgcn_ds_read_tr16_b64_v4i16((LAS v4i16_t*)p)); }

constexpr int RT_QS = 272, RT_VS = 528, RT_AS = 144;
constexpr int RT_Q = 0, RT_K = 64 * RT_QS, RT_V = 2 * 64 * RT_QS, RT_A = RT_V + 64 * RT_VS, RT_END = RT_A + 64 * RT_AS;
static_assert(RT_END <= RING_BYTES && 64 * 256 * 4 <= RT_END, "retention LDS map");
__device__ __forceinline__ float ret_lg2(int h) { return fast_log2(1.0f - fast_exp2(-5.0f - (float)h * (4.0f / 3.0f))); }
__device__ __forceinline__ void ret_unit(const Frame& F, int layer, int uid) {
    const int h = uid & 3; int stream, b;
    if (uid < 128) { stream = 0; b = uid >> 2; } else if (uid < 160) { stream = 1; b = (uid - 128) >> 2; } else { stream = 2; b = 0; }
    const TC tc = thread_coords(F.wave); const int tid = tc.tid, lane = tc.lane, w = tc.wave, l15 = lane & 15, g = lane >> 4, q4 = l15 >> 2, p4 = l15 & 3;
    const float lg2 = ret_lg2(h);
    const int nch = stream == 0 ? 1 + T / 64 : 1;
    f32x4 accS[8][2];
#pragma unroll
    for (int m = 0; m < 8; ++m)
#pragma unroll
        for (int n = 0; n < 2; ++n) accS[m][n] = (f32x4){0.f, 0.f, 0.f, 0.f};
    if (stream == 1) { const float* s0 = in_ptr(IN_SRET) + (((size_t)layer * SBATCH + b) * HRET + h) * DKR * DVR;
#pragma unroll
        for (int m = 0; m < 8; ++m)
#pragma unroll
            for (int n = 0; n < 2; ++n)
#pragma unroll
                for (int r = 0; r < 4; ++r) accS[m][n][r] = s0[(size_t)(16 * m + 4 * g + r) * DVR + 32 * w + 16 * n + l15]; }
    v4u qreg[2], kreg[2], vreg[4];
    const int lrow = tid >> 4, lch = tid & 15, vrow = tid >> 5, vch = tid & 31;
#define RT_CHUNK(c, rb, vl) do { if (stream == 0) { if ((c) == 0) { rb = ROW_M; vl = NMETA; } else { rb = b * T + 64 * ((c) - 1); vl = 64; } } \
        else if (stream == 1) { rb = ROW_S + b * ST; vl = ST; } else { rb = ROW_M; vl = NMETA; } } while (0)
#define RT_LOAD(c) do { int rb_, vl_; RT_CHUNK(c, rb_, vl_); \
        _Pragma("unroll") for (int i_ = 0; i_ < 2; ++i_) { const int r_ = lrow + 32 * i_; qreg[i_] = (v4u){0u, 0u, 0u, 0u}; kreg[i_] = (v4u){0u, 0u, 0u, 0u}; \
            if (r_ < vl_) { const size_t o_ = (size_t)(rb_ + r_) * 512 + h * 128 + lch * 8; qreg[i_] = *(const GAS v4u*)(WSB(F, WS_QR) + o_); kreg[i_] = *(const GAS v4u*)(WSB(F, WS_KR) + o_); } } \
        _Pragma("unroll") for (int i_ = 0; i_ < 4; ++i_) { const int r_ = vrow + 16 * i_; vreg[i_] = (v4u){0u, 0u, 0u, 0u}; \
            if (r_ < vl_) vreg[i_] = *(const GAS v4u*)(WSB(F, WS_VR) + (size_t)(rb_ + r_) * D + h * 256 + vch * 8); } } while (0)
    RT_LOAD(0);
    const LAS unsigned char* Ql = F.lds + RT_Q; const LAS unsigned char* Kl = F.lds + RT_K; const LAS unsigned char* Vl = F.lds + RT_V; const LAS unsigned char* Al = F.lds + RT_A;
    for (int c = 0; c < nch; ++c) {
        int rowbase, valid; RT_CHUNK(c, rowbase, valid);
        const bool write_out = !(stream == 0 && c == 0);
        const float dc = fast_exp2((float)valid * lg2);
        __syncthreads();
#pragma unroll
        for (int i = 0; i < 2; ++i) { *(LAS v4u*)(F.lds + RT_Q + (lrow + 32 * i) * RT_QS + lch * 16) = qreg[i]; *(LAS v4u*)(F.lds + RT_K + (lrow + 32 * i) * RT_QS + lch * 16) = kreg[i]; }
#pragma unroll
        for (int i = 0; i < 4; ++i) *(LAS v4u*)(F.lds + RT_V + (vrow + 16 * i) * RT_VS + vch * 16) = vreg[i];
        __syncthreads();
        if (c + 1 < nch) RT_LOAD(c + 1);
#pragma unroll
        for (int tt = 0; tt < 2; ++tt) { const int id = 2 * w + tt, mt = id >> 2, nt = id & 3;
            f32x4 a4 = (f32x4){0.f, 0.f, 0.f, 0.f};
            if (mt <= nt) {
#pragma unroll
                for (int ks = 0; ks < 4; ++ks) { const bf16x8 A = *(const LAS bf16x8*)(Kl + (16 * mt + l15) * RT_QS + 64 * ks + 16 * g); const bf16x8 B = *(const LAS bf16x8*)(Ql + (16 * nt + l15) * RT_QS + 64 * ks + 16 * g);
                    a4 = MFMA16(A, B, a4); }
#pragma unroll
                for (int r = 0; r < 4; ++r) a4[r] = (16 * mt + 4 * g + r <= 16 * nt + l15) ? a4[r] : 0.f;
            }
            *(LAS v2u*)(F.lds + RT_A + (16 * nt + l15) * RT_AS + (16 * mt + 4 * g) * 2) = (v2u){pg8::cvt_pk_bf16(a4[0], a4[1]), pg8::cvt_pk_bf16(a4[2], a4[3])}; }
        __syncthreads();
        f32x4 accO[4][2];
#pragma unroll
        for (int m = 0; m < 4; ++m)
#pragma unroll
            for (int n = 0; n < 2; ++n) accO[m][n] = (f32x4){0.f, 0.f, 0.f, 0.f};
#pragma unroll
        for (int ks = 0; ks < 4; ++ks) {
            bf16x8 Sf[2];
#pragma unroll
            for (int n = 0; n < 2; ++n) Sf[n] = __builtin_bit_cast(bf16x8, (v4u){pg8::cvt_pk_bf16(accS[2 * ks][n][0], accS[2 * ks][n][1]), pg8::cvt_pk_bf16(accS[2 * ks][n][2], accS[2 * ks][n][3]),
                                                                               pg8::cvt_pk_bf16(accS[2 * ks + 1][n][0], accS[2 * ks + 1][n][1]), pg8::cvt_pk_bf16(accS[2 * ks + 1][n][2], accS[2 * ks + 1][n][3])});
#pragma unroll
            for (int m = 0; m < 4; ++m) { const v2u lo = *(const LAS v2u*)(Ql + (16 * m + l15) * RT_QS + (32 * ks + 4 * g) * 2), hi = *(const LAS v2u*)(Ql + (16 * m + l15) * RT_QS + (32 * ks + 16 + 4 * g) * 2);
                const bf16x8 A = __builtin_bit_cast(bf16x8, (v4u){lo.x, lo.y, hi.x, hi.y});
#pragma unroll
                for (int n = 0; n < 2; ++n) accO[m][n] = MFMA16(A, Sf[n], accO[m][n]); }
        }
        bf16x8 Bv[2][2];
#pragma unroll
        for (int k2 = 0; k2 < 2; ++k2)
#pragma unroll
            for (int n = 0; n < 2; ++n) { const s16x4 lo = tr16(Vl + (32 * k2 + 8 * g + q4) * RT_VS + (32 * w + 16 * n + 4 * p4) * 2), hi = tr16(Vl + (32 * k2 + 8 * g + 4 + q4) * RT_VS + (32 * w + 16 * n + 4 * p4) * 2);
                Bv[k2][n] = __builtin_shufflevector(lo, hi, 0, 1, 2, 3, 4, 5, 6, 7); }
#pragma unroll
        for (int k2 = 0; k2 < 2; ++k2)
#pragma unroll
            for (int m = 0; m < 4; ++m) { const bf16x8 A = *(const LAS bf16x8*)(Al + (16 * m + l15) * RT_AS + (32 * k2 + 8 * g) * 2);
#pragma unroll
                for (int n = 0; n < 2; ++n) accO[m][n] = MFMA16(A, Bv[k2][n], accO[m][n]); }
#pragma unroll
        for (int m = 0; m < 8; ++m)
#pragma unroll
            for (int k2 = 0; k2 < 2; ++k2) { const s16x4 lo = tr16(Kl + (32 * k2 + 8 * g + q4) * RT_QS + (16 * m + 4 * p4) * 2), hi = tr16(Kl + (32 * k2 + 8 * g + 4 + q4) * RT_QS + (16 * m + 4 * p4) * 2);
                const bf16x8 A = __builtin_shufflevector(lo, hi, 0, 1, 2, 3, 4, 5, 6, 7);
#pragma unroll
                for (int n = 0; n < 2; ++n) accS[m][n] = MFMA16(A, Bv[k2][n], accS[m][n]); }
#pragma unroll
        for (int m = 0; m < 8; ++m)
#pragma unroll
            for (int n = 0; n < 2; ++n) accS[m][n] = accS[m][n] * dc;
        if (write_out) {
            __syncthreads();
            LAS float* oL = (LAS float*)F.lds;
#pragma unroll
            for (int m = 0; m < 4; ++m)
#pragma unroll
                for (int n = 0; n < 2; ++n)
#pragma unroll
                    for (int r = 0; r < 4; ++r) oL[(16 * m + 4 * g + r) * 256 + 32 * w + 16 * n + l15] = accO[m][n][r];
            __syncthreads();
            const f32x4 gn = *(const GAS f32x4*)(in_ptr(IN_RETG) + ((size_t)layer * HRET + h) * DVR + lane * 4);
#pragma unroll
            for (int hb2 = 0; hb2 < 2; ++hb2) {
            f32x4 x[4]; v2u gr[4]; float s1[4], s2[4];
#pragma unroll
            for (int tt = 0; tt < 4; ++tt) { const int t = w * 8 + hb2 * 4 + tt; x[tt] = *(const LAS f32x4*)(oL + t * 256 + lane * 4); gr[tt] = *(const GAS v2u*)(WSB(F, WS_GR) + (size_t)(rowbase + t) * D + h * 256 + lane * 4);
                s1[tt] = (x[tt][0] + x[tt][1]) + (x[tt][2] + x[tt][3]); }
#pragma unroll
            for (int o = 1; o < 64; o <<= 1)
#pragma unroll
                for (int tt = 0; tt < 4; ++tt) s1[tt] += __shfl_xor(s1[tt], o);
#pragma unroll
            for (int tt = 0; tt < 4; ++tt) { x[tt] = x[tt] - s1[tt] * (1.f / 256.f); s2[tt] = (x[tt][0] * x[tt][0] + x[tt][1] * x[tt][1]) + (x[tt][2] * x[tt][2] + x[tt][3] * x[tt][3]); }
#pragma unroll
            for (int o = 1; o < 64; o <<= 1)
#pragma unroll
                for (int tt = 0; tt < 4; ++tt) s2[tt] += __shfl_xor(s2[tt], o);
#pragma unroll
            for (int tt = 0; tt < 4; ++tt) { const int t = w * 8 + hb2 * 4 + tt; const float rstd = 1.f / sqrtf(s2[tt] * (1.f / 256.f) + LN_EPS);
                const f32x4 y = x[tt] * rstd * gn * (f32x4){bflo(gr[tt].x), bfhi(gr[tt].x), bflo(gr[tt].y), bfhi(gr[tt].y)};
                if (t < valid) *(GAS v2u*)(WSB(F, WS_BR) + (size_t)(rowbase + t) * D + h * 256 + lane * 4) = (v2u){pk2(y[0], y[1]), pk2(y[2], y[3])}; }
            }
        }
    }
#undef RT_LOAD
#undef RT_CHUNK
    if (stream != 2) { float* d = F.out + (stream == 0 ? O_RP + (((size_t)layer * NB + b) * HRET + h) * DKR * DVR : O_RS + (((size_t)layer * SBATCH + b) * HRET + h) * DKR * DVR);
#pragma unroll
        for (int m = 0; m < 8; ++m)
#pragma unroll
            for (int n = 0; n < 2; ++n)
#pragma unroll
                for (int r = 0; r < 4; ++r) d[(size_t)(16 * m + 4 * g + r) * DVR + 32 * w + 16 * n + l15] = accS[m][n][r]; }
}

constexpr int AT_RS = 272;
constexpr int AT_VOFF = 64 * AT_RS;
constexpr int AT_QOFF = 36864;
static_assert(AT_QOFF >= 2 * 64 * AT_RS && AT_QOFF + 8 * 8 * 1024 <= RING_BYTES, "attention LDS map");
template <bool F32KV> __device__ __forceinline__ void attn_unit(const Frame& F, int layer, int uid) {
    int stream, b, h, qb;
    if (uid < 64) { stream = 1; b = uid >> 3; h = uid & 7; qb = 0; }
    else if (uid < 64 + 2048) { const int idx = uid - 64; qb = 7 - (idx >> 8); b = (idx & 255) >> 3; h = idx & 7; stream = 0; }
    else { stream = 2; b = 0; h = (uid - (64 + 2048)) & 7; qb = 0; }
    const bf16 *k0p = nullptr, *k1p = nullptr, *v0p = nullptr, *v1p = nullptr; const float *k0f = nullptr, *k1f = nullptr, *v0f = nullptr, *v1f = nullptr; int len0, Tq, rowbase;
    if (stream == 0) { k0p = WSB(F, WS_KS) + (size_t)ROW_M * D; v0p = WSB(F, WS_VS) + (size_t)ROW_M * D; len0 = NMETA; k1p = WSB(F, WS_KS) + (size_t)b * T * D; v1p = WSB(F, WS_VS) + (size_t)b * T * D; Tq = T; rowbase = b * T; }
    else if (stream == 1) { k0f = in_ptr(IN_CK) + ((size_t)layer * SBATCH + b) * PAST * D; v0f = in_ptr(IN_CV) + ((size_t)layer * SBATCH + b) * PAST * D; len0 = PAST;
        k1f = F.out + O_KS + ((size_t)layer * SBATCH + b) * ST * D; v1f = F.out + O_VS + ((size_t)layer * SBATCH + b) * ST * D; Tq = ST; rowbase = ROW_S + b * ST; }
    else { k0p = k1p = WSB(F, WS_KS) + (size_t)ROW_M * D; v0p = v1p = WSB(F, WS_VS) + (size_t)ROW_M * D; len0 = 0; Tq = NMETA; rowbase = ROW_M; }
    constexpr int NQ = F32KV ? 1 : 2, QPW = 16 * NQ, QBLK = 8 * QPW;
    const int Stot = len0 + Tq, q0 = qb * QBLK;
    const TC tc = thread_coords(F.wave); const int tid = tc.tid, lane = tc.lane, w = tc.wave, l15 = lane & 15, g = lane >> 4;
    int qi[NQ]; bool valid_q[NQ]; int lim[NQ];
#pragma unroll
    for (int nb = 0; nb < NQ; ++nb) { qi[nb] = q0 + 16 * (NQ == 2 ? (nb == 0 ? w : 15 - w) : w) + l15; valid_q[nb] = qi[nb] < Tq; lim[nb] = len0 + qi[nb]; }
    bf16x8 qf[NQ][4];
#pragma unroll
    for (int nb = 0; nb < NQ; ++nb)
#pragma unroll
    for (int ks = 0; ks < 4; ++ks) { v4u t4 = (v4u){0u, 0u, 0u, 0u}; if (valid_q[nb]) t4 = *(const GAS v4u*)(WSB(F, WS_QS) + (size_t)(rowbase + qi[nb]) * D + h * 128 + 32 * ks + 8 * g); qf[nb][ks] = __builtin_bit_cast(bf16x8, t4); }
    const int qend = (q0 + QBLK < Tq) ? q0 + QBLK : Tq;
    const int kt_max = (len0 + qend - 2) >> 6;
    const int lrow = tid >> 4, lch = tid & 15;
    constexpr int NR = F32KV ? 4 : 2;
    constexpr int DIST = F32KV ? 1 : 2;
    v4u kregA[NR], vregA[NR], kregB[NR], vregB[NR];
#define AT_LOAD(kt, KR, VR) do { _Pragma("unroll") for (int i_ = 0; i_ < 2; ++i_) { int s_ = ((kt) > 0 ? (kt) : 0) * 64 + lrow + 32 * i_; s_ = s_ < Stot ? s_ : Stot - 1; \
        const size_t off_ = (s_ < len0 ? (size_t)s_ : (size_t)(s_ - len0)) * D + h * 128 + lch * 8; \
        if constexpr (F32KV) { const float* kp_ = (s_ < len0 ? k0f : k1f) + off_; const float* vp_ = (s_ < len0 ? v0f : v1f) + off_; \
            asm volatile("global_load_dwordx4 %0, %1, off" : "=&v"(KR[2 * i_]) : "v"(kp_) : "memory"); asm volatile("global_load_dwordx4 %0, %1, off offset:16" : "=&v"(KR[2 * i_ + 1]) : "v"(kp_) : "memory"); \
            asm volatile("global_load_dwordx4 %0, %1, off" : "=&v"(VR[2 * i_]) : "v"(vp_) : "memory"); asm volatile("global_load_dwordx4 %0, %1, off offset:16" : "=&v"(VR[2 * i_ + 1]) : "v"(vp_) : "memory"); } \
        else { const bf16* kp_ = (s_ < len0 ? k0p : k1p) + off_; const bf16* vp_ = (s_ < len0 ? v0p : v1p) + off_; \
            asm volatile("global_load_dwordx4 %0, %1, off" : "=&v"(KR[i_]) : "v"(kp_) : "memory"); asm volatile("global_load_dwordx4 %0, %1, off" : "=&v"(VR[i_]) : "v"(vp_) : "memory"); } } } while (0)
    AT_LOAD(kt_max, kregA, vregA);
    if constexpr (!F32KV) AT_LOAD(kt_max - 1, kregB, vregB);
    float zq[NQ];
#pragma unroll
    for (int nb = 0; nb < NQ; ++nb) zq[nb] = 3.0e38f;
    float kn2 = -1.f;
    if (stream == 0) { const unsigned* kn = (const unsigned*)(F.ws + WS_CTL) + CW_KN + ((layer * 33 + b) * 8 + h) * 16; const unsigned* km = (const unsigned*)(F.ws + WS_CTL) + CW_KN + ((layer * 33 + 32) * 8 + h) * 16;
        kn2 = 0.f;
#pragma unroll
        for (int p = 0; p < 16; ++p) kn2 += fmaxf(__uint_as_float(kn[p]), __uint_as_float(km[p])); }
    if constexpr (F32KV) {
        const int lr_ = tid >> 4, lc_ = tid & 15; float km_ = 0.f;
        for (int s0 = lr_; s0 < Stot; s0 += 128) { f32x4 a_[4][2];
#pragma unroll
            for (int j = 0; j < 4; ++j) { int s_ = s0 + 32 * j; s_ = s_ < Stot ? s_ : Stot - 1; const float* kp_ = (s_ < len0 ? k0f + (size_t)s_ * D : k1f + (size_t)(s_ - len0) * D) + h * 128 + lc_ * 8;
                a_[j][0] = *(const GAS f32x4*)kp_; a_[j][1] = *(const GAS f32x4*)(kp_ + 4); }
#pragma unroll
            for (int j = 0; j < 4; ++j) { const f32x4 x = a_[j][0] * a_[j][0] + a_[j][1] * a_[j][1]; float p = (x[0] + x[1]) + (x[2] + x[3]);
                p += __shfl_xor(p, 1); p += __shfl_xor(p, 2); p += __shfl_xor(p, 4); p += __shfl_xor(p, 8); km_ = fmaxf(km_, p); } }
        km_ = fmaxf(km_, __shfl_xor(km_, 16)); km_ = fmaxf(km_, __shfl_xor(km_, 32));
        __syncthreads();
        if (lane == 0) F.MISC[32 + w] = __float_as_uint(km_);
        __syncthreads();
        kn2 = 0.f;
#pragma unroll
        for (int i = 0; i < 8; ++i) kn2 = fmaxf(kn2, __uint_as_float(F.MISC[32 + i])); }
    if (kn2 >= 0.f) {
#pragma unroll
        for (int nb = 0; nb < NQ; ++nb) { float q2 = 0.f;
#pragma unroll
            for (int ks = 0; ks < 4; ++ks)
#pragma unroll
                for (int e = 0; e < 8; ++e) { const float x = bf2f((unsigned short)qf[nb][ks][e]); q2 += x * x; }
            q2 += __shfl_xor(q2, 16); q2 += __shfl_xor(q2, 32);
            zq[nb] = sqrtf(kn2 * q2) * 1.01f + 150.0f; } }
    f32x4 o[NQ][8];
#pragma unroll
    for (int nb = 0; nb < NQ; ++nb)
#pragma unroll
    for (int i = 0; i < 8; ++i) o[nb][i] = (f32x4){0.f, 0.f, 0.f, 0.f};
    float R[NQ]; bool anyv_ = false;
#pragma unroll
    for (int nb = 0; nb < NQ; ++nb) { R[nb] = 0.f; anyv_ = anyv_ || valid_q[nb]; }
    bool wave_done = __all(!anyv_) != 0;
    const LAS unsigned char* Ql = F.lds + AT_QOFF + w * (NQ * 4096);
#pragma unroll
    for (int nb = 0; nb < NQ; ++nb)
#pragma unroll
        for (int ks = 0; ks < 4; ++ks) *(LAS v4u*)(F.lds + AT_QOFF + w * (NQ * 4096) + ((nb * 4 + ks) * 64 + lane) * 16) = __builtin_bit_cast(v4u, qf[nb][ks]);
    const LAS unsigned char* Kl = F.lds; const LAS unsigned char* Vl = F.lds + AT_VOFF;
    const int q4 = l15 >> 2, p4 = l15 & 3;
#define AT_BODY(NB0_) { \
        f32x4 z[NQ][4]; \
        _Pragma("unroll") \
        for (int mt = 0; mt < 4; ++mt) { _Pragma("unroll") for (int nb = (NB0_); nb < NQ; ++nb) z[nb][mt] = (f32x4){0.f, 0.f, 0.f, 0.f}; } \
        _Pragma("unroll") \
        for (int ks = 0; ks < 4; ++ks) { bf16x8 qa[NQ]; _Pragma("unroll") for (int nb = (NB0_); nb < NQ; ++nb) qa[nb] = *(const LAS bf16x8*)(Ql + ((nb * 4 + ks) * 64 + lane) * 16); \
        _Pragma("unroll") \
            for (int mt = 0; mt < 4; ++mt) { const bf16x8 a = *(const LAS bf16x8*)(Kl + (16 * mt + l15) * AT_RS + 64 * ks + 16 * g); _Pragma("unroll") for (int nb = (NB0_); nb < NQ; ++nb) z[nb][mt] = MFMA16(a, qa[nb], z[nb][mt]); } } \
        bf16x8 pf[NQ][2]; \
        _Pragma("unroll") \
        for (int nb = (NB0_); nb < NQ; ++nb) { \
        bf16x8 triA, triB, ones; \
        _Pragma("unroll") \
        for (int e = 0; e < 8; ++e) { const int jl = 16 * (e >> 2) + 4 * g + (e & 3); triA[e] = (short)(jl >= l15 ? 0x3f80 : 0); triB[e] = (short)(jl >= l15 + 16 ? 0x3f80 : 0); ones[e] = (short)0x3f80; } \
        f32x4 sp[4]; \
        if (need_mask) { \
        _Pragma("unroll") \
            for (int mt = 0; mt < 4; ++mt) \
        _Pragma("unroll") \
                for (int r = 0; r < 4; ++r) { const bool vis = (tb + 16 * mt + 4 * g + r) < lim[nb]; const float zz = fminf(z[nb][mt][r], 80.f); z[nb][mt][r] = vis ? zz : -1.0e30f; \
                    sp[mt][r] = vis ? fast_log2(1.0f + fast_exp2(zz)) : 0.f; } \
        } else { \
        _Pragma("unroll") \
            for (int mt = 0; mt < 4; ++mt) \
        _Pragma("unroll") \
                for (int r = 0; r < 4; ++r) { const float zz = fminf(z[nb][mt][r], 80.f); z[nb][mt][r] = zz; sp[mt][r] = fast_log2(1.0f + fast_exp2(zz)); } \
        } \
        bf16x8 spf[2]; \
        _Pragma("unroll") \
        for (int k2 = 0; k2 < 2; ++k2) spf[k2] = __builtin_bit_cast(bf16x8, (v4u){pg8::cvt_pk_bf16(sp[2 * k2][0], sp[2 * k2][1]), pg8::cvt_pk_bf16(sp[2 * k2][2], sp[2 * k2][3]), \
                                                                                  pg8::cvt_pk_bf16(sp[2 * k2 + 1][0], sp[2 * k2 + 1][1]), pg8::cvt_pk_bf16(sp[2 * k2 + 1][2], sp[2 * k2 + 1][3])}); \
        const f32x4 zero4 = (f32x4){0.f, 0.f, 0.f, 0.f}; \
        f32x4 I0 = MFMA16(triA, spf[0], zero4); I0 = MFMA16(ones, spf[1], I0); \
        f32x4 I1 = MFMA16(triB, spf[0], zero4); I1 = MFMA16(ones, spf[1], I1); \
        f32x4 I2 = MFMA16(triA, spf[1], zero4); \
        f32x4 I3 = MFMA16(triB, spf[1], zero4); \
        f32x4 tot = MFMA16(ones, spf[0], zero4); tot = MFMA16(ones, spf[1], tot); \
        const f32x4 II[4] = {I0, I1, I2, I3}; \
        f32x4 wv[4]; \
        _Pragma("unroll") \
        for (int mt = 0; mt < 4; ++mt) \
        _Pragma("unroll") \
            for (int r = 0; r < 4; ++r) wv[mt][r] = fast_exp2(z[nb][mt][r] - II[mt][r] - R[nb]); \
        _Pragma("unroll") \
        for (int k2 = 0; k2 < 2; ++k2) pf[nb][k2] = __builtin_bit_cast(bf16x8, (v4u){pg8::cvt_pk_bf16(wv[2 * k2][0], wv[2 * k2][1]), pg8::cvt_pk_bf16(wv[2 * k2][2], wv[2 * k2][3]), \
                                                                                 pg8::cvt_pk_bf16(wv[2 * k2 + 1][0], wv[2 * k2 + 1][1]), pg8::cvt_pk_bf16(wv[2 * k2 + 1][2], wv[2 * k2 + 1][3])}); \
        R[nb] += tot[0]; \
        } \
        _Pragma("unroll") \
        for (int mt8 = 0; mt8 < 8; ++mt8) \
        _Pragma("unroll") \
            for (int k2 = 0; k2 < 2; ++k2) { \
                const s16x4 lo = tr16(Vl + (32 * k2 + 4 * g + q4) * AT_RS + (16 * mt8 + 4 * p4) * 2); \
                const s16x4 hi = tr16(Vl + (32 * k2 + 16 + 4 * g + q4) * AT_RS + (16 * mt8 + 4 * p4) * 2); \
                const bf16x8 a = __builtin_shufflevector(lo, hi, 0, 1, 2, 3, 4, 5, 6, 7); \
                _Pragma("unroll") for (int nb = (NB0_); nb < NQ; ++nb) o[nb][mt8] = MFMA16(a, pf[nb][k2], o[nb][mt8]); } \
        }
#define AT_ITER(KT_, KR_, VR_) { const int kt = (KT_); \
        __syncthreads(); \
        if (kt < kt_max) { unsigned allok = 1u; \
        _Pragma("unroll") \
            for (int i = 0; i < 8; ++i) allok &= F.MISC[24 + i]; \
            if (allok) break; } \
        if constexpr (F32KV) asm volatile("s_waitcnt vmcnt(0)" : "+v"(KR_[0]), "+v"(VR_[0]), "+v"(KR_[1]), "+v"(VR_[1]), "+v"(KR_[NR - 2]), "+v"(VR_[NR - 2]), "+v"(KR_[NR - 1]), "+v"(VR_[NR - 1]) :: "memory"); \
        else asm volatile("s_waitcnt vmcnt(4)" : "+v"(KR_[0]), "+v"(VR_[0]), "+v"(KR_[1]), "+v"(VR_[1]) :: "memory");     \
        _Pragma("unroll") \
        for (int i = 0; i < 2; ++i) { const bool in_ = (kt * 64 + lrow + 32 * i) < Stot; const v4u z4_ = (v4u){0u, 0u, 0u, 0u}; v4u kk_, vv_; \
            if constexpr (F32KV) { kk_ = pack8(__builtin_bit_cast(f32x4, KR_[(2 * i) % NR]), __builtin_bit_cast(f32x4, KR_[(2 * i + 1) % NR])); vv_ = pack8(__builtin_bit_cast(f32x4, VR_[(2 * i) % NR]), __builtin_bit_cast(f32x4, VR_[(2 * i + 1) % NR])); } \
            else { kk_ = KR_[i % NR]; vv_ = VR_[i % NR]; } \
            *(LAS v4u*)(F.lds + (lrow + 32 * i) * AT_RS + lch * 16) = in_ ? kk_ : z4_; *(LAS v4u*)(F.lds + AT_VOFF + (lrow + 32 * i) * AT_RS + lch * 16) = in_ ? vv_ : z4_; } \
        __syncthreads(); \
        AT_LOAD(kt - DIST, KR_, VR_); \
        const int tb = kt * 64; \
        const int lim_lo = len0 + q0 + 16 * w, lim_hi = NQ == 2 ? len0 + q0 + 16 * (15 - w) : lim_lo;      \
        const bool act0 = tb < lim_lo + 15, act1 = tb < lim_hi + 15;                                           \
        if (!wave_done && act1) { \
        const bool need_mask = (tb + 64 > (act0 ? lim_lo : lim_hi)); \
        if (NQ == 2 && !act0) AT_BODY(NQ - 1) else AT_BODY(0) \
        { bool dn_ = true; _Pragma("unroll") for (int nb = 0; nb < NQ; ++nb) dn_ = dn_ && ((!valid_q[nb]) || (R[nb] > zq[nb])); wave_done = __all(dn_) != 0; } \
        } \
        if (lane == 0) F.MISC[24 + w] = wave_done ? 1u : 0u; \
    }
    for (int kt2 = kt_max; kt2 >= 0; kt2 -= 2) {
        AT_ITER(kt2, kregA, vregA)
        if (kt2 == 0) break;
        if constexpr (F32KV) { AT_ITER(kt2 - 1, kregA, vregA) } else { AT_ITER(kt2 - 1, kregB, vregB) }
    }
#undef AT_ITER
#undef AT_BODY
    if constexpr (F32KV) asm volatile("s_waitcnt vmcnt(0)" : "+v"(kregA[0]), "+v"(vregA[0]), "+v"(kregA[1]), "+v"(vregA[1]), "+v"(kregA[NR - 2]), "+v"(vregA[NR - 2]), "+v"(kregA[NR - 1]), "+v"(vregA[NR - 1]) :: "memory");
    else asm volatile("s_waitcnt vmcnt(0)" : "+v"(kregA[0]), "+v"(vregA[0]), "+v"(kregA[1]), "+v"(vregA[1]), "+v"(kregB[0]), "+v"(vregB[0]), "+v"(kregB[1]), "+v"(vregB[1]) :: "memory");
#undef AT_LOAD
#pragma unroll
    for (int nb = 0; nb < NQ; ++nb)
    if (valid_q[nb]) { bf16* orow = WSB(F, WS_BR) + (size_t)M_PAD * D + (size_t)(rowbase + qi[nb]) * D + h * 128 + 4 * g;
#pragma unroll
        for (int mt8 = 0; mt8 < 8; ++mt8) *(GAS v2u*)(orow + 16 * mt8) = (v2u){pg8::cvt_pk_bf16(o[nb][mt8][0], o[nb][mt8][1]), pg8::cvt_pk_bf16(o[nb][mt8][2], o[nb][mt8][3])}; }
}

__device__ __forceinline__ void pool_row(const Frame& F, int layer, int stream, int b, int rowbase, int tp, int ch, float (&v)[8]) {
    if (tp >= 0 || stream == 0) { const size_t row = tp >= 0 ? (size_t)(rowbase + tp) : (size_t)(ROW_M + NMETA + tp);
        const v4u x = *(const GAS v4u*)(WSB(F, WS_U) + row * D + ch * 8);
        v[0] = bflo(x.x); v[1] = bfhi(x.x); v[2] = bflo(x.y); v[3] = bfhi(x.y); v[4] = bflo(x.z); v[5] = bfhi(x.z); v[6] = bflo(x.w); v[7] = bfhi(x.w); }
    else if (stream == 1) { const float* sp = in_ptr(IN_SPOOL) + (((size_t)layer * SBATCH + b) * PBUF + (PBUF + tp)) * D + ch * 8;
        const f32x4 a = *(const GAS f32x4*)sp, c = *(const GAS f32x4*)(sp + 4);
        v[0] = a[0]; v[1] = a[1]; v[2] = a[2]; v[3] = a[3]; v[4] = c[0]; v[5] = c[1]; v[6] = c[2]; v[7] = c[3]; }
    else {
#pragma unroll
        for (int e = 0; e < 8; ++e) v[e] = 0.f; }
}
__device__ __forceinline__ void pool_unit(const Frame& F, int layer, int uid) {
    int stream, b, t0, Tlen, rowbase;
    if (uid < 1024) { stream = 0; b = uid >> 5; t0 = (uid & 31) * 64; Tlen = T; rowbase = b * T; }
    else if (uid < 1032) { stream = 1; b = uid - 1024; t0 = 0; Tlen = ST; rowbase = ROW_S + b * ST; }
    else { stream = 2; b = 0; t0 = 0; Tlen = NMETA; rowbase = ROW_M; }
    const TC tc = thread_coords(F.wave); const int ch = tc.tid & 127, tsub = tc.tid >> 7, win = 2 << (ch >> 5);
    const int ts = t0 + tsub * 16; if (ts >= Tlen) return;
    float acc[8];
#pragma unroll
    for (int e = 0; e < 8; ++e) acc[e] = 0.f;
#pragma unroll
    for (int j = 1; j < 16; ++j) if (j < win) { float v[8]; pool_row(F, layer, stream, b, rowbase, ts - j, ch, v);
#pragma unroll
        for (int e = 0; e < 8; ++e) acc[e] += v[e]; }
#pragma unroll 4
    for (int tt = 0; tt < 16; ++tt) {
        const int t = ts + tt;
        float vn[8], vo[8]; pool_row(F, layer, stream, b, rowbase, t, ch, vn);
        if (tt > 0) pool_row(F, layer, stream, b, rowbase, t - win, ch, vo);
#pragma unroll
        for (int e = 0; e < 8; ++e) acc[e] += vn[e] - (tt > 0 ? vo[e] : 0.f);
        const int have = (stream == 2) ? (t + 1 < win ? t + 1 : win) : win;
        const float inv = 1.0f / (float)have;
        float y[8];
#pragma unroll
        for (int e = 0; e < 8; ++e) y[e] = acc[e] * inv - vn[e];
        *(GAS v4u*)(WSB(F, WS_BR) + (size_t)2 * M_PAD * D + (size_t)(rowbase + t) * D + ch * 8) = (v4u){pk2(y[0], y[1]), pk2(y[2], y[3]), pk2(y[4], y[5]), pk2(y[6], y[7])};
    }
}

struct Args { const float* in[19]; float* out; unsigned char* ws; };

__device__ __forceinline__ int opq(int x) { asm volatile("" : "+s"(x)); return x; }

constexpr int CH_TOTAL = 25;
__device__ __forceinline__ int ch_stage(int ci) { return ci < 8 ? 1 : ci < 16 ? 2 : 3; }
__device__ __forceinline__ int ch_first(int s) { return s == 1 ? 0 : s == 2 ? 8 : s == 3 ? 16 : CH_TOTAL; }
__device__ __forceinline__ unsigned ch_cnt(int s) { return s == 0 ? 117u : s == 3 ? 9u : 8u; }
__device__ __forceinline__ void chain_signal(const Frame& F, gu32* ch, int s) {
    asm volatile("s_waitcnt vmcnt(0)" ::: "memory");
    __syncthreads();
    if (F.wave == 0 && lane_lo_() == 0u) {
        __builtin_amdgcn_fence(__ATOMIC_RELEASE, "agent");
        asm volatile("s_waitcnt vmcnt(0)" ::: "memory");
        const unsigned old = __hip_atomic_fetch_add(ch + 64 * (2 + s), 1u, RLX_AGENT);
        if (old + 1u == ch_cnt(s) && s < 3) __hip_atomic_store(ch + 64, (unsigned)ch_first(s + 2), RLX_AGENT);
    }
}
__device__ __forceinline__ void chain_item(const Frame& F, int l, gu32* ch, int ci) {
    const int s = ch_stage(ci);
    if (s == 1) { pg8::Gemm g{WSB(F, WS_BR), lw(F, l, LW_BR), 3 * M_PAD, 3 * D, D}; SmallOrder3 S{ci}; EpiGate E{F.ws};
        pg8::gemm_phase<EpiGate, SmallOrder3, true, true>(F.lds, g, S, E, F.wave); }
    else if (s == 2) { pg8::Gemm g{WSB(F, WS_MIX), lw(F, l, LW_OUT), M_PAD, D, D}; SmallOrder S{ci - 8}; EpiResid E{F.ws, ALPHA, 1.0f};
        pg8::gemm_phase<EpiResid, SmallOrder, true, true>(F.lds, g, S, E, F.wave); }
    else { const int i = ci - 16; ln_rows(F, l * 3 + 1, false, MP + 32 * i, MP + 32 * i + 32, 0, 8); }
    chain_signal(F, ch, s);
}
__device__ __forceinline__ int mq_count(int kq) { return kq == 0 ? 164 : kq == 1 ? 9 : kq == 2 ? 64 : kq == 3 ? 2056 : 1024; }

__global__ void __launch_bounds__(512, 2) mega_fwd(Args args) {
    extern __shared__ __attribute__((aligned(16))) unsigned char lds[];
    Frame F;
    F.lds = (LAS unsigned char*)lds;
    F.MISC = (volatile LAS unsigned*)(F.lds + MISC_OFF);
    F.G = gridDim.x; F.wave = __builtin_amdgcn_readfirstlane((int)threadIdx.x >> 6);
    F.ws = args.ws; F.out = args.out; F.ctl = (gu32*)(args.ws + WS_CTL);
    for (int u = threadIdx.x; u < (LDS_BYTES - LDSCTL_OFF) / 4; u += 512) ((LAS unsigned*)(F.lds + LDSCTL_OFF))[u] = 0u;
    __syncthreads();
    XcdBarrier bar = xcd_barrier_post((unsigned*)(F.ctl + CW_BAR), F.MISC + 8);
#define GRID_BAR() xcd_barrier(bar)

    p0_prologue(F);

    GRID_BAR();

    for (int l = 0; l < DEPTH; ++l) {
        { pg8::Gemm g{WSB(F, WS_HB), lw(F, l, LW_UP1), M_PAD, 2 * DFF, D}; pg8::StaticOrder S; S.init(M_PAD, 2 * DFF, opq(F.G), opq((int)blockIdx.x)); EpiSwiglu E{WSB(F, WS_ACT)};
          pg8::gemm_phase<EpiSwiglu, pg8::StaticOrder, true, true>(F.lds, g, S, E, F.wave); }

        GRID_BAR();
        { pg8::Gemm g{WSB(F, WS_ACT), lw(F, l, LW_DN1), M_PAD, D, DFF}; pg8::StaticOrder S; S.init(MP, D, opq(F.G), opq((int)blockIdx.x));
          EpiResid E{F.ws, ALPHA, 0.5f};
          pg8::gemm_phase<EpiResid, pg8::StaticOrder, true, true>(F.lds, g, S, E, F.wave); }

        GRID_BAR();
        if (blockIdx.x < 16) { const int kh = opq((int)blockIdx.x) >> 3; pg8::Gemm g{WSB(F, WS_ACT) + kh * (DFF / 2), lw(F, l, LW_DN1) + kh * (DFF / 2), M_PAD, D, DFF / 2, DFF}; SmallOrderH S{opq((int)blockIdx.x)};
            EpiPart E{(float*)WSB(F, WS_ACT) + (size_t)kh * 512 * D};
            pg8::gemm_phase<EpiPart, SmallOrderH, true, true>(F.lds, g, S, E, F.wave); }
        else ln_phase(F, l * 3 + 0, false, 0, MP, 16);
        GRID_BAR();
        ln_phase(F, l * 3 + 0, false, MP, M_PAD, 0, true);
        GRID_BAR();
        { pg8::Gemm g{WSB(F, WS_HB), lw(F, l, LW_IN), M_PAD, DIN, D}; pg8::StaticOrder S; S.init(M_PAD, DIN, opq(F.G), opq((int)blockIdx.x));
          EpiWin E{F.ws, F.out, l};
          pg8::gemm_phase<EpiWin, pg8::StaticOrder, true, true>(F.lds, g, S, E, F.wave);
        }

        GRID_BAR();
        { gu32* q = F.ctl + CW_Q + 64 * (l * 8); gu32* ch = F.ctl + CW_CH + 1024 * l;
          int kq = 0, u = __builtin_amdgcn_readfirstlane(grab(F, q)), chain_open = 1;
          for (;;) {
              while (kq < 5 && u >= mq_count(kq)) { ++kq; if (kq < 5) u = __builtin_amdgcn_readfirstlane(grab(F, q + 64 * kq)); }
              unsigned l0_ = lane_lo_(); asm volatile("" : "+v"(l0_));
              const bool t0 = F.wave == 0 && l0_ == 0u;
              unsigned nx = 0u, hd = 0u, rd = 0u;
              if (t0) { if (kq < 5) nx = __hip_atomic_fetch_add(q + 64 * kq, 1u, RLX_AGENT); if (chain_open) { hd = __hip_atomic_load(ch, RLX_AGENT); rd = __hip_atomic_load(ch + 64, RLX_AGENT); } }
              if (kq == 0) { ret_unit(F, l, u < 36 ? 128 + u : u - 36); if (u < 36) chain_signal(F, ch, 0); }
              else if (kq == 1 || kq == 4) { pool_unit(F, l, kq == 1 ? 1024 + u : u); if (kq == 1) chain_signal(F, ch, 0); }
              else if (kq == 2) { attn_unit<true>(F, l, u); chain_signal(F, ch, 0); }
              else if (kq == 3) { attn_unit<false>(F, l, u < 8 ? 64 + 2048 + u : 64 + u - 8); if (u < 8) chain_signal(F, ch, 0); }
              __syncthreads();
              if (t0) { int ci = -1;
                  if (chain_open) {
                      if (kq == 5) { unsigned sp = 0u;
                          for (;;) { hd = __hip_atomic_load(ch, RLX_AGENT); if (hd >= (unsigned)CH_TOTAL) { ci = -2; break; } rd = __hip_atomic_load(ch + 64, RLX_AGENT);
                              if (hd < rd) { unsigned e = hd; if (__hip_atomic_compare_exchange_strong(ch, &e, hd + 1u, __ATOMIC_RELAXED, __ATOMIC_RELAXED, __HIP_MEMORY_SCOPE_AGENT)) { ci = (int)hd; break; } }
                              else { __builtin_amdgcn_s_sleep(2); if ((++sp & 255u) == 0u) { if (xb_ld((unsigned*)(F.ctl + CW_BAR) + XB_TMO)) { ci = -2; break; } if (sp > XB_SPIN_CAP) { atomicAdd((unsigned*)(F.ctl + CW_BAR) + XB_TMO, 1u); ci = -2; break; } } } } }
                      else if (hd >= (unsigned)CH_TOTAL) ci = -3;
                      else if (hd < rd) { unsigned e = hd; if (__hip_atomic_compare_exchange_strong(ch, &e, hd + 1u, __ATOMIC_RELAXED, __ATOMIC_RELAXED, __HIP_MEMORY_SCOPE_AGENT)) ci = (int)hd; }
                      if (ci >= 0) { __builtin_amdgcn_fence(__ATOMIC_ACQUIRE, "agent"); asm volatile("s_waitcnt vmcnt(0)" ::: "memory"); }
                  } else if (kq == 5) ci = -2;
                  F.MISC[16] = nx; F.MISC[17] = (unsigned)ci; }
              __syncthreads();
              u = __builtin_amdgcn_readfirstlane((int)F.MISC[16]); const int ci = __builtin_amdgcn_readfirstlane((int)F.MISC[17]);
              if (ci == -2) break;
              if (ci == -3) chain_open = 0;
              if (ci >= 0) chain_item(F, l, ch, ci);
          }
          __syncthreads(); }
        GRID_BAR();
        { pg8::Gemm g{WSB(F, WS_BR), lw(F, l, LW_BR), 3 * M_PAD, 3 * D, D}; Order3 S; S.init(MP, D, opq(F.G), opq((int)blockIdx.x)); EpiGate E{F.ws};
          pg8::gemm_phase<EpiGate, Order3, true, true>(F.lds, g, S, E, F.wave); }

        GRID_BAR();
        { pg8::Gemm g{WSB(F, WS_MIX), lw(F, l, LW_OUT), M_PAD, D, D}; pg8::StaticOrder S; S.init(MP, D, opq(F.G), opq((int)blockIdx.x));
          EpiResid E{F.ws, ALPHA, 1.0f};
          pg8::gemm_phase<EpiResid, pg8::StaticOrder, true, true>(F.lds, g, S, E, F.wave); }

        GRID_BAR();
        if (blockIdx.x < 44) { pg8::Gemm g{WSB(F, WS_HB), lw(F, l, LW_UP2), M_PAD, 2 * DFF, D}; SmallOrderW S{opq((int)blockIdx.x)}; EpiSwiglu E{WSB(F, WS_ACT)};
            pg8::gemm_phase<EpiSwiglu, SmallOrderW, true, true>(F.lds, g, S, E, F.wave); }
        else ln_phase(F, l * 3 + 1, false, 0, MP, 44);
        GRID_BAR();
        { pg8::Gemm g{WSB(F, WS_HB), lw(F, l, LW_UP2), M_PAD, 2 * DFF, D}; pg8::StaticOrder S; S.init(MP, 2 * DFF, opq(F.G), opq((int)blockIdx.x)); EpiSwiglu E{WSB(F, WS_ACT)};
          pg8::gemm_phase<EpiSwiglu, pg8::StaticOrder, true, true>(F.lds, g, S, E, F.wave); }

        GRID_BAR();
        { pg8::Gemm g{WSB(F, WS_ACT), lw(F, l, LW_DN2), M_PAD, D, DFF}; pg8::StaticOrder S; S.init(MP, D, opq(F.G), opq((int)blockIdx.x));
          EpiResid E{F.ws, ALPHA, 0.5f};
          pg8::gemm_phase<EpiResid, pg8::StaticOrder, true, true>(F.lds, g, S, E, F.wave); }

        GRID_BAR();
        if (blockIdx.x < 16) { const int kh = opq((int)blockIdx.x) >> 3; pg8::Gemm g{WSB(F, WS_ACT) + kh * (DFF / 2), lw(F, l, LW_DN2) + kh * (DFF / 2), M_PAD, D, DFF / 2, DFF}; SmallOrderH S{opq((int)blockIdx.x)};
            EpiPart E{(float*)WSB(F, WS_ACT) + (size_t)kh * 512 * D};
            pg8::gemm_phase<EpiPart, SmallOrderH, true, true>(F.lds, g, S, E, F.wave); }
        else ln_phase(F, l * 3 + 2, l + 1 == DEPTH, 0, MP, 16);
        GRID_BAR();
        ln_phase(F, l * 3 + 2, l + 1 == DEPTH, MP, M_PAD, 0, true);
        if (l + 1 < DEPTH) GRID_BAR();
    }
}

extern "C" void kernel_launch(void* const* d_in, const int* in_sizes, int n_in, void* d_out, int out_size, void* d_ws, size_t ws_size, hipStream_t stream) {
    static int grid = 0;
    if (grid == 0) {
        if (n_in != 19 || (size_t)out_size != O_END || ws_size < WS_END) { fprintf(stderr, "kernel_launch: unexpected sizes (n_in %d out %d ws %zu need %zu)\n", n_in, out_size, ws_size, (size_t)WS_END); grid = -1; return; }
        int dev = 0, cus = 0, per_cu = 0;
        if (hipGetDevice(&dev) != hipSuccess || hipDeviceGetAttribute(&cus, hipDeviceAttributeMultiprocessorCount, dev) != hipSuccess) { grid = -1; return; }
        if (hipFuncSetAttribute((const void*)mega_fwd, hipFuncAttributeMaxDynamicSharedMemorySize, LDS_BYTES) != hipSuccess) { fprintf(stderr, "kernel_launch: hipFuncSetAttribute failed\n"); grid = -1; return; }
        if (hipOccupancyMaxActiveBlocksPerMultiprocessor(&per_cu, (const void*)mega_fwd, 512, LDS_BYTES) != hipSuccess || per_cu < 1) { fprintf(stderr, "kernel_launch: occupancy query says %d\n", per_cu); }
        (void)hipGetLastError();
        grid = cus;
    }
    if (grid < 0) return;
    if (hipMemsetAsync((char*)d_ws + WS_CTL, 0, CTL_ZERO_BYTES, stream) != hipSuccess) return;
    Args a{};
    for (int i = 0; i < 19; ++i) a.in[i] = (const float*)d_in[i];
    a.out = (float*)d_out; a.ws = (unsigned char*)d_ws;
    hipLaunchKernelGGL(mega_fwd, dim3(grid), dim3(512), LDS_BYTES, stream, a);
}
```

```cpp
#include <hip/hip_runtime.h>
#include <cstdio>
#include <cstdint>
__device__ __forceinline__ unsigned lane_lo_() { unsigned l; asm volatile("v_mbcnt_lo_u32_b32 %0, -1, 0" : "=v"(l)); return l; }
__device__ __forceinline__ int lane_id_() { unsigned l; asm volatile("v_mbcnt_lo_u32_b32 %0, -1, 0\n\tv_mbcnt_hi_u32_b32 %0, -1, %0" : "=v"(l)); return (int)l; }
namespace pg8 {
#define PG8_LAS __attribute__((address_space(3)))
typedef unsigned short bf16_t;
typedef short bf16x8 __attribute__((ext_vector_type(8)));
typedef float f32x4 __attribute__((ext_vector_type(4)));
typedef unsigned u32x4 __attribute__((ext_vector_type(4)));
constexpr int BM = 256, BK = 64, HALF = 128, HTB = HALF * BK * 2  , STAGE_BYTES = 8 * HTB, NXCD = 8, WGM = 4;

__host__ __device__ __forceinline__ int lds_byte(int r, int c) { const int st = (r >> 4) * 2 + (c >> 5), rr = r & 15, cc = c & 31, ob = rr * 64 + cc * 2; return st * 1024 + (ob ^ (((ob >> 9) & 1) << 5)); }
__host__ __device__ __forceinline__ void stage_rc(int b, int& R, int& C) { const int st = b / 1024, sb = b % 1024, swz = sb ^ (((sb >> 9) & 1) << 5); R = (st >> 1) * 16 + swz / 64; C = (st & 1) * 32 + (swz % 64) / 2; }
__host__ __device__ __forceinline__ int perm32(int rho) { const int n = rho >> 4, i = rho & 15; return 8 * (i >> 2) + 4 * n + (i & 3); }

struct Unit { int pm, pn; };
struct Gemm { const bf16_t* A; const bf16_t* Bt; int M, N, K; int ld = 0; };

struct StaticOrder {
    int nM, nN, nwg, G, c;
    __host__ __device__ void init(int M, int N, int G_, int c_) { nM = M / BM; nN = N / BM; nwg = nM * nN; G = G_; c = c_; }
    __host__ __device__ bool next(int i, Unit& u) const {
        const long L = (long)i * G + c; if (L >= nwg) return false;
        int wgid = (int)L; { const int q = nwg / NXCD, r = nwg % NXCD, xcd = wgid % NXCD, off = wgid / NXCD; wgid = (xcd < r ? xcd * (q + 1) : r * (q + 1) + (xcd - r) * q) + off; }
        const int nig = WGM * nN, gid = wgid / nig, fm = gid * WGM, gsz = (nM - fm) < WGM ? (nM - fm) : WGM;
        u.pm = fm + ((wgid % nig) % gsz); u.pn = (wgid % nig) / gsz; return true;
    }
    __device__ __forceinline__ void a_ready(const Unit&) const {}
    __device__ __forceinline__ void done(const Unit&) const {}
};

__device__ __forceinline__ unsigned cvt_pk_bf16(float lo, float hi) { unsigned r; asm volatile("v_cvt_pk_bf16_f32 %0, %1, %2" : "=v"(r) : "v"(lo), "v"(hi)); return r; }
template <class Epi, class Sched, bool ALIGN_EPI = false, bool SP2 = false>
__device__ __forceinline__ void gemm_phase(PG8_LAS unsigned char* lds, const Gemm g, const Sched& S, const Epi& E, const int wave_id) {
    int lane_ = lane_id_(); asm volatile("" : "+v"(lane_));
    const int tid = wave_id * 64 + lane_;
    int widq_ = wave_id; asm volatile("" : "+s"(widq_));
    const int wid = widq_, lane = tid & 63, wr = wid >> 2, wc = wid & 3, fr = lane & 15, fq = lane >> 4;
    const int K = g.K, nt = K / BK, LD = g.ld > 0 ? g.ld : K;
    unsigned voffA[2], voffB[2];
#pragma unroll
    for (int i = 0; i < 2; ++i) { int R, C; stage_rc(tid * 16 + i * 8192, R, C); const int Rb = Epi::PERM ? ((R & ~31) + perm32(R & 31)) : R;
        voffA[i] = (unsigned)(R * LD + C) * 2u; voffB[i] = (unsigned)(Rb * LD + C) * 2u; }
    const size_t kstep = (size_t)(BK * 2);
    const size_t hstep = (size_t)HALF * LD * 2;
    const size_t tstep = 2 * hstep;
    const unsigned ldsw = (unsigned)wid * 1024u;
    const int aoff = lds_byte(wr * 64 + fr, fq * 8), boff = lds_byte(wc * 32 + fr, fq * 8);
#define PG8_SA(b, h) (((b) * 2 + (h)) * HTB)
#define PG8_SB(b, h) ((4 + (b) * 2 + (h)) * HTB)
#define PG8_STAGE(bufoff, gbase, voff) do { _Pragma("unroll") for (int _i = 0; _i < 2; ++_i) \
        __builtin_amdgcn_global_load_lds((const unsigned*)((const char*)(gbase) + (voff)[_i]), (PG8_LAS unsigned*)(lds + (bufoff) + ldsw + _i * 8192), 16, 0, 0); } while (0)
#define PG8_LDA(dst, b, h) do { _Pragma("unroll") for (int m = 0; m < 4; ++m) _Pragma("unroll") for (int k = 0; k < 2; ++k) dst[m][k] = *(const PG8_LAS bf16x8*)(lds + PG8_SA(b, h) + aoff + m * 2048 + k * 1024); } while (0)
#define PG8_LDB(dst, b, h) do { _Pragma("unroll") for (int n = 0; n < 2; ++n) _Pragma("unroll") for (int k = 0; k < 2; ++k) dst[n][k] = *(const PG8_LAS bf16x8*)(lds + PG8_SB(b, h) + boff + n * 2048 + k * 1024); } while (0)
#define PG8_MMA(ai, bj, At, Bt) do { __builtin_amdgcn_s_setprio(1); _Pragma("unroll") for (int m = 0; m < 4; ++m) _Pragma("unroll") for (int n = 0; n < 2; ++n) _Pragma("unroll") for (int k = 0; k < 2; ++k) \
        acc[ai][bj][m][n] = __builtin_amdgcn_mfma_f32_16x16x32_bf16(Bt[n][k], At[m][k], acc[ai][bj][m][n], 0, 0, 0); __builtin_amdgcn_s_setprio(0); } while (0)
#define PG8_WAIT_V(n) asm volatile("s_waitcnt vmcnt(" #n ")" ::: "memory")
#define PG8_WAIT_VN(n) asm volatile("s_waitcnt vmcnt(%0)" :: "n"(n) : "memory")
#define PG8_WAIT_L(n) asm volatile("s_waitcnt lgkmcnt(" #n ")" ::: "memory")
#define PG8_BAR __builtin_amdgcn_s_barrier()
#define PG8_SCHED __builtin_amdgcn_sched_barrier(0)
    Unit cur, nxt; int ui = 0;
    if (!S.next(0, cur)) return;
    f32x4 acc[2][2][4][2];
#pragma unroll
    for (int a = 0; a < 2; ++a)
#pragma unroll
        for (int b = 0; b < 2; ++b)
#pragma unroll
            for (int m = 0; m < 4; ++m)
#pragma unroll
                for (int n = 0; n < 2; ++n) acc[a][b][m][n] = (f32x4){0.f, 0.f, 0.f, 0.f};
    bf16x8 At[4][2], B0[2][2], B1[2][2];
    const char* cA = (const char*)g.A + (size_t)cur.pm * tstep; const char* cB = (const char*)g.Bt + (size_t)cur.pn * tstep;
    S.a_ready(cur);
    if constexpr (SP2) {
        PG8_STAGE(PG8_SB(0, 0), cB, voffB); PG8_STAGE(PG8_SB(0, 1), cB + hstep, voffB); PG8_STAGE(PG8_SA(0, 0), cA, voffA); PG8_STAGE(PG8_SA(0, 1), cA + hstep, voffA);
        if (wr == 1) PG8_BAR;
        PG8_WAIT_V(2); PG8_BAR;
        PG8_STAGE(PG8_SB(1, 0), cB + kstep, voffB); PG8_STAGE(PG8_SA(1, 0), cA + kstep, voffA); PG8_STAGE(PG8_SB(1, 1), cB + hstep + kstep, voffB);
        PG8_WAIT_V(6); PG8_BAR;
    } else {
        PG8_STAGE(PG8_SB(0, 0), cB, voffB); PG8_STAGE(PG8_SA(0, 0), cA, voffA); PG8_STAGE(PG8_SB(0, 1), cB + hstep, voffB); PG8_STAGE(PG8_SA(0, 1), cA + hstep, voffA);
        if (wr == 1) PG8_BAR;
        PG8_WAIT_V(4); PG8_BAR;
        PG8_STAGE(PG8_SB(1, 0), cB + kstep, voffB); PG8_STAGE(PG8_SA(1, 0), cA + kstep, voffA); PG8_STAGE(PG8_SB(1, 1), cB + hstep + kstep, voffB);
        PG8_WAIT_V(6); PG8_BAR;
    }
    for (;;) {
        const bool has_next = S.next(ui + 1, nxt);
        const char* nA = has_next ? (const char*)g.A + (size_t)nxt.pm * tstep : cA; const char* nB = has_next ? (const char*)g.Bt + (size_t)nxt.pn * tstep : cB;
        for (int t = 0; t < nt; t += 2) {
            const bool last = (t == nt - 2);
            const char* a1 = cA + (size_t)(t + 1) * kstep;
            const char* a2 = last ? nA : cA + (size_t)(t + 2) * kstep; const char* b2 = last ? nB : cB + (size_t)(t + 2) * kstep;
            const char* a3 = a2 + kstep; const char* b3 = b2 + kstep;
            if (last && has_next) S.a_ready(nxt);
            if constexpr (SP2) {
            int tz_ = __builtin_amdgcn_readfirstlane(t | (ui > 0 ? 0 : 1)); asm volatile("" : "+s"(tz_));
            const bool strict = !(Epi::NS > 0 && tz_ == 0);
            PG8_LDB(B0, 0, 0); PG8_LDB(B1, 0, 1); PG8_SCHED; PG8_LDA(At, 0, 0); PG8_STAGE(PG8_SA(1, 1), a1 + hstep, voffA);
            PG8_WAIT_VN(8 + Epi::NS); if (strict) PG8_WAIT_V(8); PG8_WAIT_L(0); PG8_BAR; PG8_MMA(0, 0, At, B0); PG8_MMA(0, 1, At, B1); PG8_BAR; PG8_SCHED;
            PG8_LDA(At, 0, 1); PG8_STAGE(PG8_SB(0, 0), b2, voffB); PG8_STAGE(PG8_SB(0, 1), b2 + hstep, voffB); PG8_STAGE(PG8_SA(0, 0), a2, voffA);
            PG8_WAIT_VN(8 + Epi::NS); if (strict) PG8_WAIT_V(8); PG8_WAIT_L(0); PG8_BAR; PG8_MMA(1, 0, At, B0); PG8_MMA(1, 1, At, B1); PG8_BAR; PG8_SCHED;
            PG8_LDB(B0, 1, 0); PG8_LDB(B1, 1, 1); PG8_SCHED; PG8_LDA(At, 1, 0); PG8_STAGE(PG8_SA(0, 1), a2 + hstep, voffA);
            PG8_WAIT_V(8); PG8_WAIT_L(0); PG8_BAR; PG8_MMA(0, 0, At, B0); PG8_MMA(0, 1, At, B1); PG8_BAR; PG8_SCHED;
            PG8_LDA(At, 1, 1); PG8_STAGE(PG8_SB(1, 0), b3, voffB); PG8_STAGE(PG8_SB(1, 1), b3 + hstep, voffB); PG8_STAGE(PG8_SA(1, 0), a3, voffA);
            PG8_WAIT_V(8); PG8_WAIT_L(0); PG8_BAR; PG8_MMA(1, 0, At, B0); PG8_MMA(1, 1, At, B1); PG8_BAR; PG8_SCHED;
            } else {
            PG8_LDB(B0, 0, 0); PG8_SCHED; PG8_LDA(At, 0, 0); PG8_STAGE(PG8_SA(1, 1), a1 + hstep, voffA);
            PG8_WAIT_L(8); PG8_BAR; PG8_WAIT_L(0); PG8_MMA(0, 0, At, B0); PG8_BAR; PG8_SCHED;
            PG8_LDB(B1, 0, 1); PG8_STAGE(PG8_SB(0, 0), b2, voffB);
            PG8_BAR; PG8_WAIT_L(0); PG8_MMA(0, 1, At, B1); PG8_BAR;
            PG8_LDA(At, 0, 1); PG8_STAGE(PG8_SA(0, 0), a2, voffA);
            PG8_BAR; PG8_WAIT_L(0); PG8_MMA(1, 0, At, B0); PG8_BAR; PG8_SCHED;
            PG8_STAGE(PG8_SB(0, 1), b2 + hstep, voffB);
            PG8_WAIT_V(6); PG8_BAR; PG8_MMA(1, 1, At, B1); PG8_BAR;
            PG8_LDB(B0, 1, 0); PG8_SCHED; PG8_LDA(At, 1, 0); PG8_STAGE(PG8_SA(0, 1), a2 + hstep, voffA);
            PG8_WAIT_L(8); PG8_BAR; PG8_WAIT_L(0); PG8_MMA(0, 0, At, B0); PG8_BAR; PG8_SCHED;
            PG8_LDB(B1, 1, 1); PG8_STAGE(PG8_SB(1, 0), b3, voffB);
            PG8_BAR; PG8_WAIT_L(0); PG8_MMA(0, 1, At, B1); PG8_BAR;
            PG8_LDA(At, 1, 1); PG8_STAGE(PG8_SA(1, 0), a3, voffA);
            PG8_BAR; PG8_WAIT_L(0); PG8_MMA(1, 0, At, B0); PG8_BAR; PG8_SCHED;
            PG8_STAGE(PG8_SB(1, 1), b3 + hstep, voffB);
            PG8_WAIT_V(6); PG8_BAR; PG8_MMA(1, 1, At, B1); PG8_BAR;
            }
        }
        if constexpr (ALIGN_EPI) { if (wr == 0) PG8_BAR; }
        const bool keep_acc = E(acc, cur, wr, wc, fr, fq);
        if (!has_next) break;
        if (!keep_acc) {
#pragma unroll
        for (int a = 0; a < 2; ++a)
#pragma unroll
            for (int b = 0; b < 2; ++b)
#pragma unroll
                for (int m = 0; m < 4; ++m)
#pragma unroll
                    for (int n = 0; n < 2; ++n) acc[a][b][m][n] = (f32x4){0.f, 0.f, 0.f, 0.f};
        }
        cur = nxt; cA = nA; cB = nB; ++ui;
        if constexpr (ALIGN_EPI) { if (wr == 1) PG8_BAR; }
    }
    PG8_WAIT_V(0);
    if constexpr (!ALIGN_EPI) { if (wr == 0) PG8_BAR; }
    PG8_BAR;
#undef PG8_SA
#undef PG8_SB
#undef PG8_STAGE
#undef PG8_LDA
#undef PG8_LDB
#undef PG8_MMA
#undef PG8_WAIT_V
#undef PG8_WAIT_VN
#undef PG8_WAIT_L
#undef PG8_BAR
#undef PG8_SCHED
}
}

constexpr int D = 1024, NB = 32, T = 2048, DEPTH = 2, SBATCH = 8, ST = 32, PAST = 4096, NMETA = 16;
constexpr int HRET = 4, DKR = 128, DVR = 256, HSB = 8, DSB = 128, DFF = 2816, DIN = 10240, PBUF = 15;
constexpr int MP = NB * T;
constexpr int ROW_S = MP;
constexpr int ROW_M = MP + SBATCH * ST;
constexpr int M_PAD = ROW_M + 256;
constexpr int NPANEL = M_PAD / 256;
constexpr float LN_EPS = 1e-5f;
constexpr float ALPHA = 1.41421356237f;
constexpr float LOG2E = 1.44269504089f;
constexpr int KT_SP = PAST + ST;
constexpr int KT_PP = NMETA + T;

constexpr size_t O_YP = 0;
constexpr size_t O_YS = O_YP + (size_t)NB * T * D;
constexpr size_t O_KP = O_YS + (size_t)SBATCH * ST * D;
constexpr size_t O_VP = O_KP + (size_t)DEPTH * NB * KT_PP * D;
constexpr size_t O_RP = O_VP + (size_t)DEPTH * NB * KT_PP * D;
constexpr size_t O_PP = O_RP + (size_t)DEPTH * NB * HRET * DKR * DVR;
constexpr size_t O_KS = O_PP + (size_t)DEPTH * NB * PBUF * D;
constexpr size_t O_VS = O_KS + (size_t)DEPTH * SBATCH * ST * D;
constexpr size_t O_RS = O_VS + (size_t)DEPTH * SBATCH * ST * D;
constexpr size_t O_PS = O_RS + (size_t)DEPTH * SBATCH * HRET * DKR * DVR;
constexpr size_t O_END = O_PS + (size_t)DEPTH * SBATCH * PBUF * D;
static_assert(O_END == 350666752ull, "output size");

constexpr size_t MiB = 1u << 20;
constexpr size_t AL(size_t x) { return (x + 4095) & ~(size_t)4095; }
constexpr size_t WS_CTL = 0, CTL_ZERO_BYTES = 1 * MiB;
constexpr size_t WS_YB = WS_CTL + CTL_ZERO_BYTES;
constexpr size_t WS_HB = AL(WS_YB + (size_t)M_PAD * D * 2);
constexpr size_t WS_ACT = AL(WS_HB + (size_t)M_PAD * D * 2);
constexpr size_t WS_QR = AL(WS_ACT + (size_t)M_PAD * DFF * 2);
constexpr size_t WS_KR = AL(WS_QR + (size_t)M_PAD * 512 * 2);
constexpr size_t WS_VR = AL(WS_KR + (size_t)M_PAD * 512 * 2);
constexpr size_t WS_GR = AL(WS_VR + (size_t)M_PAD * D * 2);
constexpr size_t WS_QS = AL(WS_GR + (size_t)M_PAD * D * 2);
constexpr size_t WS_KS = AL(WS_QS + (size_t)M_PAD * D * 2);
constexpr size_t WS_VS = AL(WS_KS + (size_t)M_PAD * D * 2);
constexpr size_t WS_U = AL(WS_VS + (size_t)M_PAD * D * 2);
constexpr size_t WS_GT = AL(WS_U + (size_t)M_PAD * D * 2);
constexpr size_t WS_BR = AL(WS_GT + (size_t)M_PAD * 3 * D * 2);
constexpr size_t WS_MIX = AL(WS_BR + (size_t)3 * M_PAD * D * 2);
constexpr size_t WS_W = AL(WS_MIX + (size_t)M_PAD * D * 2);
constexpr size_t LW_UP1 = 0;
constexpr size_t LW_DN1 = LW_UP1 + (size_t)2 * DFF * D * 2;
constexpr size_t LW_IN = LW_DN1 + (size_t)D * DFF * 2;
constexpr size_t LW_BR = LW_IN + (size_t)DIN * D * 2;
constexpr size_t LW_OUT = LW_BR + (size_t)3 * D * D * 2;
constexpr size_t LW_UP2 = LW_OUT + (size_t)D * D * 2;
constexpr size_t LW_DN2 = LW_UP2 + (size_t)2 * DFF * D * 2;
constexpr size_t LW_SIZE = AL(LW_DN2 + (size_t)D * DFF * 2);
constexpr size_t WS_END = WS_W + DEPTH * LW_SIZE;
static_assert(WS_END < (size_t)4000 * MiB, "workspace budget");

constexpr int CW_BAR = 4096;
constexpr int CW_Q = 16384;
constexpr int CW_CH = 24576;
constexpr int CW_DBG = 32768;
constexpr int CW_KN = 65536;
static_assert((CW_KN + DEPTH * 33 * 8 * 16) * 4 <= (int)CTL_ZERO_BYTES, "ctl region");

constexpr int RING_BYTES = 131072;
constexpr int LDSCTL_OFF = RING_BYTES, MISC_OFF = LDSCTL_OFF + 320;
constexpr int LDS_BYTES = 147456;

#define GAS __attribute__((address_space(1)))
#define LAS __attribute__((address_space(3)))
typedef unsigned short bf16;
typedef unsigned v4u __attribute__((ext_vector_type(4)));
typedef unsigned v2u __attribute__((ext_vector_type(2)));
typedef float f32x4 __attribute__((ext_vector_type(4)));
typedef short bf16x8 __attribute__((ext_vector_type(8)));
typedef short s16x4 __attribute__((ext_vector_type(4)));
typedef GAS unsigned gu32;
#define RLX_AGENT __ATOMIC_RELAXED, __HIP_MEMORY_SCOPE_AGENT
__device__ __forceinline__ unsigned f2bf(float f) { unsigned u = __builtin_bit_cast(unsigned, f); return (u + 0x7fffu + ((u >> 16) & 1u)) >> 16; }
__device__ __forceinline__ unsigned pk2(float lo, float hi) { return f2bf(lo) | (f2bf(hi) << 16); }
__device__ __forceinline__ float bf2f(unsigned short b) { return __builtin_bit_cast(float, (unsigned)b << 16); }
__device__ __forceinline__ float bflo(unsigned w) { return __builtin_bit_cast(float, w << 16); }
__device__ __forceinline__ float bfhi(unsigned w) { return __builtin_bit_cast(float, w & 0xffff0000u); }
__device__ __forceinline__ float fast_exp2(float x) { return __builtin_amdgcn_exp2f(x); }
__device__ __forceinline__ float fast_log2(float x) { return __builtin_amdgcn_logf(x); }
__device__ __forceinline__ float fast_rcp(float x) { return __builtin_amdgcn_rcpf(x); }
__device__ __forceinline__ float sigmoidf_(float x) { return fast_rcp(1.0f + fast_exp2(-x * LOG2E)); }
__device__ __forceinline__ float siluf_(float x) { return x * sigmoidf_(x); }
__device__ __forceinline__ float wave_sum(float v) {
#pragma unroll
    for (int o = 1; o < 64; o <<= 1) v += __shfl_xor(v, o);
    return v;
}
#define XB_TMO      128
#define XB_XCNT(j)  (256  + 64 * (j))
#define XB_XSUB(j)  (1280 + 64 * (j))
#define XB_XGEN(j)  (2304 + 64 * (j))
#define XB_TOP      3328
#define XB_TOPGEN   3392
#define XCD_BAR_WORDS 3456
#define XB_SPIN_CAP (1u << 20)

__device__ __forceinline__ unsigned xb_ld(unsigned* p)              { return __hip_atomic_load(p, __ATOMIC_RELAXED, __HIP_MEMORY_SCOPE_AGENT); }
__device__ __forceinline__ unsigned xb_add(unsigned* p, unsigned v) { return __hip_atomic_fetch_add(p, v, __ATOMIC_RELAXED, __HIP_MEMORY_SCOPE_AGENT); }
__device__ __forceinline__ unsigned xb_xcc_id() { return (unsigned)__builtin_amdgcn_s_getreg((3 << 11) | 20) & 0xFu; }
#define XB_SPIN(cond, bar) do { unsigned _sp = 0; while (cond) { __builtin_amdgcn_s_sleep(1); \
    if ((++_sp & 255u) == 0u) { if (xb_ld(&(bar)[XB_TMO])) break; if (_sp > XB_SPIN_CAP) { atomicAdd(&(bar)[XB_TMO], 1u); break; } } } } while (0)

struct XcdBarrier {
    unsigned* bar; unsigned x; unsigned w0;
    volatile LAS unsigned* st;
};

__device__ __forceinline__ XcdBarrier xcd_barrier_post(unsigned* bar, volatile LAS unsigned* st) {
    XcdBarrier b; b.bar = bar; b.x = xb_xcc_id(); b.st = st; b.w0 = (__builtin_amdgcn_readfirstlane((int)threadIdx.x >> 6) == 0) ? 1u : 0u;
    if (threadIdx.x == 0) (void)xb_add(&bar[XB_XCNT(b.x)], 1u);
    return b;
}
__device__ __forceinline__ void xcd_barrier_complete(unsigned* bar, unsigned x, unsigned& nloc, unsigned& nx) {
    const unsigned G = gridDim.x * gridDim.y * gridDim.z;
    unsigned sum, cnt, mine, sp = 0u;
    for (;;) {
        sum = 0u; cnt = 0u; mine = 0u;
#pragma unroll
        for (unsigned j = 0; j < 16; ++j) { const unsigned c = xb_ld(&bar[XB_XCNT(j)]); sum += c; cnt += (c > 0u) ? 1u : 0u; mine = (j == x) ? c : mine; }
        if (sum == G) break;
        __builtin_amdgcn_s_sleep(1);
        if ((++sp & 255u) == 0u) { if (xb_ld(&bar[XB_TMO])) break; if (sp > XB_SPIN_CAP) { atomicAdd(&bar[XB_TMO], 1u); break; } }
    }
    nloc = mine > 0u ? mine : 1u; nx = cnt > 0u ? cnt : 1u;
}

__device__ __forceinline__ void xcd_barrier(const XcdBarrier& b) {
    asm volatile("s_waitcnt vmcnt(0)" ::: "memory");
    __syncthreads();
    if (b.w0 != 0u && lane_lo_() == 0u) {
        unsigned* bar = b.bar; unsigned bx = b.x; asm volatile("" : "+s"(bar), "+s"(bx));
        __builtin_amdgcn_s_waitcnt(0);
        unsigned nloc = b.st[0], nx = b.st[1];
        if (nloc == 0u) { xcd_barrier_complete(bar, bx, nloc, nx); b.st[0] = nloc; b.st[1] = nx; }
        const unsigned old = xb_add(&bar[XB_XSUB(bx)], 1u);
        const unsigned gen = old / nloc;
        if (old + 1u == (gen + 1u) * nloc) {
            __builtin_amdgcn_fence(__ATOMIC_RELEASE, "agent");
            asm volatile("s_waitcnt vmcnt(0)" ::: "memory");
            const unsigned og = xb_add(&bar[XB_TOP], 1u);
            const unsigned tg = og / nx;
            if (og + 1u == (tg + 1u) * nx) xb_add(&bar[XB_TOPGEN], 1u);
            else XB_SPIN(xb_ld(&bar[XB_TOPGEN]) == tg, bar);
            __builtin_amdgcn_fence(__ATOMIC_ACQUIRE, "agent");
            xb_add(&bar[XB_XGEN(bx)], 1u);
            asm volatile("s_waitcnt vmcnt(0)" ::: "memory");
        } else {
            XB_SPIN(xb_ld(&bar[XB_XGEN(bx)]) == gen, bar);
            __builtin_amdgcn_fence(__ATOMIC_ACQUIRE, "agent");
            asm volatile("s_waitcnt vmcnt(0)" ::: "memory");
        }
    }
    __syncthreads();
}

struct Frame {
    LAS unsigned char* lds;
    volatile LAS unsigned* MISC;
    gu32* ctl;
    int G, wave;
    float* out; unsigned char* ws;
};
__device__ __forceinline__ const float* in_ptr(int i) {
    const __attribute__((address_space(4))) char* k = (const __attribute__((address_space(4))) char*)__builtin_amdgcn_kernarg_segment_ptr();
    asm volatile("" : "+s"(k));
    return *(const float* const __attribute__((address_space(4)))*)(k + 8 * i);
}
enum { IN_XP = 0, IN_XS, IN_CK, IN_CV, IN_SRET, IN_SPOOL, IN_META, IN_WIN, IN_RETG, IN_PMIX, IN_PSCALE, IN_WBR, IN_WOUT, IN_UP1, IN_DN1, IN_UP2, IN_DN2, IN_LNG, IN_LNB };
__device__ __forceinline__ unsigned char* wsq(unsigned char* p) { asm volatile("" : "+s"(p)); return p; }
#define WSB(F, off) ((bf16*)(wsq((F).ws) + (off)))
struct TC { int tid, lane, wave; };
__device__ __forceinline__ TC thread_coords(int wave) { TC c; int l = lane_id_(); asm volatile("" : "+v"(l)); c.lane = l; c.wave = wave; c.tid = wave * 64 + l; return c; }
__device__ __forceinline__ bf16* lw(const Frame& F, int l, size_t off) { return (bf16*)(wsq(F.ws) + WS_W + (size_t)l * LW_SIZE + off); }
__device__ __forceinline__ float* yrow(const Frame& F, int m) {
    if (m < MP) return F.out + O_YP + (size_t)m * D;
    if (m < ROW_M) return F.out + O_YS + (size_t)(m - ROW_S) * D;
    return nullptr;
}

__device__ __forceinline__ int srccol(int kind, int n) {
    if (kind == 1) { const int pn = n >> 8, p = n & 255, bj = p >> 7, wc = (p >> 5) & 3, fq = (p >> 3) & 3, nn = (p >> 2) & 1, e = p & 3;
        return (nn ? DFF : 0) + 128 * pn + 64 * bj + 16 * wc + 4 * fq + e; }
    if (kind == 2 && n < 1024) { const int hb_ = n & ~127, p = n & 127, wc = p >> 5, fq = (p >> 3) & 3, nn = (p >> 2) & 1, e = p & 3;
        return hb_ + 16 * wc + 4 * fq + e + 64 * nn; }
    return n;
}
__device__ __forceinline__ void p0_transpose_item(const float* W, int K, int ldw, int N, bf16* WT, int kind, LAS float* scr, int item, int lane) {
    const int nblk = N / 32, kb = item / nblk, nb = item % nblk, k0 = 64 * kb, n0 = 32 * nb;
    const int sc = srccol(kind, n0 + (lane & 31));
    float t_[32];
#pragma unroll
    for (int i = 0; i < 32; ++i) t_[i] = W[(size_t)(k0 + 2 * i + (lane >> 5)) * ldw + sc];
#pragma unroll
    for (int i = 0; i < 32; ++i) scr[(2 * i + (lane >> 5)) * 33 + (lane & 31)] = t_[i];
    asm volatile("s_waitcnt lgkmcnt(0)" ::: "memory");
    const int c = lane & 7;
#pragma unroll
    for (int j = 0; j < 4; ++j) { const int n = (lane >> 3) + 8 * j; const LAS float* s = scr + (8 * c) * 33 + n;
        v4u o; o.x = pk2(s[0 * 33], s[1 * 33]); o.y = pk2(s[2 * 33], s[3 * 33]); o.z = pk2(s[4 * 33], s[5 * 33]); o.w = pk2(s[6 * 33], s[7 * 33]);
        *(GAS v4u*)(WT + (size_t)(n0 + n) * K + k0 + 8 * c) = o; }
    asm volatile("s_waitcnt lgkmcnt(0)" ::: "memory");
}
__device__ __forceinline__ void p0_poolfold_item(const float* mixw  , const float* scale  , const float* wb2  , bf16* WT  , int item, int lane) {
    const int g = item >> 7, r = item & 127, cb = r >> 4, nb = r & 15;
    const int n = nb * 64 + lane, c0 = cb * 32;
    float acc[32];
#pragma unroll
    for (int i = 0; i < 32; ++i) acc[i] = 0.f;
    const float* mw = mixw + ((size_t)g * 256 + c0) * 256;
    for (int d0 = 0; d0 < 256; d0 += 8) {
        float a[8];
#pragma unroll
        for (int j = 0; j < 8; ++j) a[j] = scale[g * 256 + d0 + j] * wb2[(size_t)(g * 256 + d0 + j) * D + n];
#pragma unroll
        for (int i = 0; i < 32; ++i)
#pragma unroll
            for (int j = 0; j < 8; ++j) acc[i] += mw[(size_t)i * 256 + d0 + j] * a[j];
    }
    bf16* dst = WT + (size_t)n * D + g * 256 + c0;
#pragma unroll
    for (int i = 0; i < 32; i += 8) { v4u o; o.x = pk2(acc[i], acc[i + 1]); o.y = pk2(acc[i + 2], acc[i + 3]); o.z = pk2(acc[i + 4], acc[i + 5]); o.w = pk2(acc[i + 6], acc[i + 7]); *(GAS v4u*)(dst + i) = o; }
}
__device__ __forceinline__ void p0_prologue(Frame& F) {
    const TC tc = thread_coords(F.wave); const int gw = blockIdx.x * 8 + tc.wave, NGW = F.G * 8;
    LAS float* scr = (LAS float*)(F.lds + tc.wave * 16384);
    for (int l = 0; l < DEPTH; ++l) {
        constexpr int I_UP = (D / 64) * (2 * DFF / 32), I_DN = (DFF / 64) * (D / 32), I_IN = (D / 64) * (DIN / 32), I_SQ = (D / 64) * (D / 32), I_PF = 4 * 4 * 32;
        constexpr int NIT = 2 * I_UP + 2 * I_DN + I_IN + 3 * I_SQ + I_PF;
        for (int it = (gw + l * (NGW / 2)) % NGW; it < NIT; it += NGW) {
            int r = it;
            if (r < I_UP) { p0_transpose_item(in_ptr(IN_UP1) + (size_t)l * D * 2 * DFF, D, 2 * DFF, 2 * DFF, lw(F, l, LW_UP1), 1, scr, r, tc.lane); continue; } r -= I_UP;
            if (r < I_UP) { p0_transpose_item(in_ptr(IN_UP2) + (size_t)l * D * 2 * DFF, D, 2 * DFF, 2 * DFF, lw(F, l, LW_UP2), 1, scr, r, tc.lane); continue; } r -= I_UP;
            if (r < I_DN) { p0_transpose_item(in_ptr(IN_DN1) + (size_t)l * DFF * D, DFF, D, D, lw(F, l, LW_DN1), 0, scr, r, tc.lane); continue; } r -= I_DN;
            if (r < I_DN) { p0_transpose_item(in_ptr(IN_DN2) + (size_t)l * DFF * D, DFF, D, D, lw(F, l, LW_DN2), 0, scr, r, tc.lane); continue; } r -= I_DN;
            if (r < I_IN) { p0_transpose_item(in_ptr(IN_WIN) + (size_t)l * D * DIN, D, DIN, DIN, lw(F, l, LW_IN), 2, scr, r, tc.lane); continue; } r -= I_IN;
            if (r < I_SQ) { p0_transpose_item(in_ptr(IN_WBR) + (size_t)(l * 3 + 0) * D * D, D, D, D, lw(F, l, LW_BR), 0, scr, r, tc.lane); continue; } r -= I_SQ;
            if (r < I_SQ) { p0_transpose_item(in_ptr(IN_WBR) + (size_t)(l * 3 + 1) * D * D, D, D, D, lw(F, l, LW_BR) + (size_t)D * D, 0, scr, r, tc.lane); continue; } r -= I_SQ;
            if (r < I_SQ) { p0_transpose_item(in_ptr(IN_WOUT) + (size_t)l * D * D, D, D, D, lw(F, l, LW_OUT), 0, scr, r, tc.lane); continue; } r -= I_SQ;
            p0_poolfold_item(in_ptr(IN_PMIX) + (size_t)l * 4 * 256 * 256, in_ptr(IN_PSCALE) + (size_t)l * D, in_ptr(IN_WBR) + (size_t)(l * 3 + 2) * D * D, lw(F, l, LW_BR) + (size_t)2 * D * D, r, tc.lane);
        }
    }
    for (int m0 = gw; m0 < M_PAD; m0 += 2 * NGW) {
        f32x4 v[2][4];
#pragma unroll
        for (int r = 0; r < 2; ++r) { const int m = m0 + r * NGW;
            const float* src = (m < MP) ? in_ptr(IN_XP) + (size_t)m * D : (m < ROW_M) ? in_ptr(IN_XS) + (size_t)(m - ROW_S) * D : (m - ROW_M < NMETA) ? in_ptr(IN_META) + (size_t)(m - ROW_M) * D : nullptr;
#pragma unroll
            for (int j = 0; j < 4; ++j) v[r][j] = (src && m < M_PAD) ? ((const GAS f32x4*)src)[tc.lane + 64 * j] : (f32x4){0.f, 0.f, 0.f, 0.f}; }
#pragma unroll
        for (int r = 0; r < 2; ++r) { const int m = m0 + r * NGW;
            if (m < M_PAD) { GAS v2u* o8 = (GAS v2u*)(WSB(F, WS_HB) + (size_t)m * D) + tc.lane;
#pragma unroll
                for (int j = 0; j < 4; ++j) o8[64 * j] = (v2u){pk2(v[r][j].x, v[r][j].y), pk2(v[r][j].z, v[r][j].w)}; } }
    }
}

__device__ __forceinline__ void ln_rows(const Frame& F, int idx, bool final_out, int row_lo, int row_hi, int gw0, int NGW, bool comb = false) {
    const TC tc = thread_coords(F.wave); const int gw = gw0 + tc.wave;
    const float* g = in_ptr(IN_LNG) + (size_t)idx * D; const float* b = in_ptr(IN_LNB) + (size_t)idx * D;
    f32x4 gv[4], bv[4];
#pragma unroll
    for (int j = 0; j < 2; ++j) { gv[2 * j] = ((const GAS f32x4*)g)[2 * tc.lane + 128 * j]; gv[2 * j + 1] = ((const GAS f32x4*)g)[2 * tc.lane + 128 * j + 1];
                                  bv[2 * j] = ((const GAS f32x4*)b)[2 * tc.lane + 128 * j]; bv[2 * j + 1] = ((const GAS f32x4*)b)[2 * tc.lane + 128 * j + 1]; }
    for (int m0 = row_lo + gw; m0 < row_hi; m0 += 2 * NGW) {
        v4u w[2][2]; const bool two = m0 + NGW < row_hi;
#pragma unroll
        for (int r = 0; r < 2; ++r) { const int m = (r == 0 || two) ? m0 + r * NGW : m0; const GAS v4u* yr = (const GAS v4u*)(WSB(F, comb ? WS_HB : WS_YB) + (size_t)m * D) + tc.lane; w[r][0] = yr[0]; w[r][1] = yr[64]; }
#pragma unroll
        for (int r = 0; r < 2; ++r) { const int m = m0 + r * NGW; if (r == 1 && !two) break;
        f32x4 v[4]; float s = 0.f;
#pragma unroll
        for (int j = 0; j < 2; ++j) { const v4u x = w[r][j]; v[2 * j] = (f32x4){bflo(x.x), bfhi(x.x), bflo(x.y), bfhi(x.y)}; v[2 * j + 1] = (f32x4){bflo(x.z), bfhi(x.z), bflo(x.w), bfhi(x.w)}; }
        if (comb) {
            const GAS f32x4* pa = (const GAS f32x4*)((const float*)WSB(F, WS_ACT) + (size_t)(m - MP) * D) + 2 * tc.lane; const GAS f32x4* pb = pa + (size_t)512 * D / 4;
#pragma unroll
            for (int j = 0; j < 2; ++j) { v[2 * j] = v[2 * j] * ALPHA + (pa[128 * j] + pb[128 * j]) * 0.5f; v[2 * j + 1] = v[2 * j + 1] * ALPHA + (pa[128 * j + 1] + pb[128 * j + 1]) * 0.5f; } }
#pragma unroll
        for (int j = 0; j < 4; ++j) s += (v[j].x + v[j].y) + (v[j].z + v[j].w);
        const float mean = wave_sum(s) * (1.f / D); float s2 = 0.f;
#pragma unroll
        for (int j = 0; j < 4; ++j) { v[j] = v[j] - mean; s2 += (v[j].x * v[j].x + v[j].y * v[j].y) + (v[j].z * v[j].z + v[j].w * v[j].w); }
        const float rstd = 1.f / sqrtf(wave_sum(s2) * (1.f / D) + LN_EPS);
#pragma unroll
        for (int j = 0; j < 4; ++j) v[j] = v[j] * rstd * gv[j] + bv[j];
        if (!final_out) { GAS v4u* o = (GAS v4u*)(WSB(F, WS_HB) + (size_t)m * D) + tc.lane;
#pragma unroll
            for (int j = 0; j < 2; ++j) o[64 * j] = (v4u){pk2(v[2 * j].x, v[2 * j].y), pk2(v[2 * j].z, v[2 * j].w), pk2(v[2 * j + 1].x, v[2 * j + 1].y), pk2(v[2 * j + 1].z, v[2 * j + 1].w)}; }
        else { float* yo = yrow(F, m); if (yo) { GAS f32x4* o = (GAS f32x4*)yo + 2 * tc.lane;
#pragma unroll
            for (int j = 0; j < 2; ++j) { o[128 * j] = v[2 * j]; o[128 * j + 1] = v[2 * j + 1]; } } }
        }
    }
}
__device__ __forceinline__ void ln_phase(const Frame& F, int idx, bool final_out, int row_lo, int row_hi, int cu_lo, bool comb = false) { ln_rows(F, idx, final_out, row_lo, row_hi, ((int)blockIdx.x - cu_lo) * 8, (F.G - cu_lo) * 8, comb); }
__device__ __forceinline__ float ret_lg2(int h);

using pg8::Unit;
typedef f32x4 AccT[2][2][4][2];
#ifndef LANE_TR
#define LANE_TR 1
#endif
struct LaneT { int tfr, tfq, pull, push; };
#if LANE_TR
__device__ __forceinline__ LaneT lane_t(int fr, int fq) { LaneT t; const int L = fq * 16 + fr; t.tfr = L >> 2; t.tfq = L & 3; t.pull = ((t.tfq << 4) + t.tfr) << 2; t.push = ((fr << 2) + fq) << 2; return t; }
__device__ __forceinline__ unsigned bperm(int a, unsigned x) { return (unsigned)__builtin_amdgcn_ds_bpermute(a, (int)x); }
__device__ __forceinline__ v4u tr4(int a, v4u x) { return (v4u){bperm(a, x.x), bperm(a, x.y), bperm(a, x.z), bperm(a, x.w)}; }
__device__ __forceinline__ v2u tr2(int a, v2u x) { return (v2u){bperm(a, x.x), bperm(a, x.y)}; }
#else
__device__ __forceinline__ LaneT lane_t(int fr, int fq) { LaneT t; t.tfr = fr; t.tfq = fq; t.pull = 0; t.push = 0; return t; }
__device__ __forceinline__ v4u tr4(int, v4u x) { return x; }
__device__ __forceinline__ v2u tr2(int, v2u x) { return x; }
#endif
__device__ __forceinline__ f32x4 tr4f(int a, f32x4 x) { return __builtin_bit_cast(f32x4, tr4(a, __builtin_bit_cast(v4u, x))); }
__device__ __forceinline__ v4u pack8(const f32x4& a, const f32x4& b) { return (v4u){pg8::cvt_pk_bf16(a[0], a[1]), pg8::cvt_pk_bf16(a[2], a[3]), pg8::cvt_pk_bf16(b[0], b[1]), pg8::cvt_pk_bf16(b[2], b[3])}; }

struct EpiSwiglu {
    static constexpr bool PERM = true; static constexpr int NS = 8;
    bf16* act;
    __device__ __forceinline__ bool operator()(AccT& acc, const Unit& u, int wr, int wc, int fr, int fq) const {
        asm volatile("" : "+s"(wr), "+s"(wc), "+v"(fr), "+v"(fq));
        const int row0 = u.pm * 256 + wr * 64 + fr + 16 * (fq & 1), col0 = u.pn * 128 + wc * 16 + 4 * (fq & 2);
#pragma unroll
        for (int ai = 0; ai < 2; ++ai)
#pragma unroll
            for (int mp = 0; mp < 2; ++mp) { bf16* rowp = act + (size_t)(row0 + ai * 128 + mp * 32) * DFF + col0;
#pragma unroll
                for (int bj = 0; bj < 2; ++bj) { unsigned pk[2][2];
#pragma unroll
                    for (int k = 0; k < 2; ++k) { const f32x4 g = acc[ai][bj][2 * mp + k][0], up = acc[ai][bj][2 * mp + k][1];
                        pk[k][0] = pg8::cvt_pk_bf16(siluf_(g[0]) * up[0], siluf_(g[1]) * up[1]); pk[k][1] = pg8::cvt_pk_bf16(siluf_(g[2]) * up[2], siluf_(g[3]) * up[3]); }
                    const auto sx = __builtin_amdgcn_permlane16_swap(pk[0][0], pk[1][0], false, false), sy = __builtin_amdgcn_permlane16_swap(pk[0][1], pk[1][1], false, false);
                    *(GAS v4u*)(rowp + bj * 64) = (v4u){sx[0], sy[0], sx[1], sy[1]}; } }
        return false;
    }
};

struct EpiResid {
    static constexpr bool PERM = true; static constexpr int NS = 16;
    unsigned char* ws; float ca, cb;
    __device__ __forceinline__ bool operator()(AccT& acc, const Unit& u, int wr, int wc, int fr, int fq) const {
        asm volatile("" : "+s"(wr), "+s"(wc), "+v"(fr), "+v"(fq));
        const LaneT t = lane_t(fr, fq);
        const bf16* src = (const bf16*)(ws + WS_HB); bf16* dst = (bf16*)(ws + WS_YB);
        const int row0 = u.pm * 256 + wr * 64 + t.tfr, col0 = u.pn * 256 + wc * 32 + 8 * t.tfq;
#pragma unroll
        for (int ai = 0; ai < 2; ++ai)
#pragma unroll
            for (int m = 0; m < 4; ++m) { const size_t off = (size_t)(row0 + ai * 128 + m * 16) * D + col0;
#pragma unroll
                for (int bj = 0; bj < 2; ++bj) { const v4u r = tr4(t.push, *(const GAS v4u*)(src + off + bj * 128));
                    const f32x4 y0 = (f32x4){bflo(r.x), bfhi(r.x), bflo(r.y), bfhi(r.y)} * ca + acc[ai][bj][m][0] * cb, y1 = (f32x4){bflo(r.z), bfhi(r.z), bflo(r.w), bfhi(r.w)} * ca + acc[ai][bj][m][1] * cb;
                    *(GAS v4u*)(dst + off + bj * 128) = tr4(t.pull, pack8(y0, y1)); } }
        return false;
    }
};

struct EpiGate {
    static constexpr bool PERM = true; static constexpr int NS = 0;
    unsigned char* ws;
    __device__ __forceinline__ bool operator()(AccT& acc, const Unit& u, int wr, int wc, int fr, int fq) const {
        asm volatile("" : "+s"(wr), "+s"(wc), "+v"(fr), "+v"(fq));
        const LaneT t = lane_t(fr, fq);
        const bf16* Gt = (const bf16*)(ws + WS_GT); bf16* mix = (bf16*)(ws + WS_MIX);
        const int n = u.pm / NPANEL, pm = u.pm - n * NPANEL, pn = u.pn & 3;
        const int row0 = pm * 256 + wr * 64 + t.tfr, col0 = pn * 256 + wc * 32 + 8 * t.tfq;
#pragma unroll
        for (int ai = 0; ai < 2; ++ai)
#pragma unroll
            for (int m = 0; m < 4; ++m) { const size_t r = (size_t)(row0 + ai * 128 + m * 16);
#pragma unroll
                for (int bj = 0; bj < 2; ++bj) {
                    const v4u ga = tr4(t.push, *(const GAS v4u*)(Gt + r * (3 * D) + n * D + col0 + bj * 128));
                    float f[8] = {bflo(ga.x), bfhi(ga.x), bflo(ga.y), bfhi(ga.y), bflo(ga.z), bfhi(ga.z), bflo(ga.w), bfhi(ga.w)};
                    if (n < 2) { const v4u gb = tr4(t.push, *(const GAS v4u*)(Gt + r * (3 * D) + (n + 1) * D + col0 + bj * 128));
                        const float h[8] = {bflo(gb.x), bfhi(gb.x), bflo(gb.y), bfhi(gb.y), bflo(gb.z), bfhi(gb.z), bflo(gb.w), bfhi(gb.w)};
#pragma unroll
                        for (int e = 0; e < 8; ++e) f[e] = f[e] * fast_rcp(fmaxf(h[e], 1e-30f)); }
                    f32x4 v0 = acc[ai][bj][m][0], v1 = acc[ai][bj][m][1];
                    v0 = v0 * (f32x4){f[0], f[1], f[2], f[3]}; v1 = v1 * (f32x4){f[4], f[5], f[6], f[7]};
                    acc[ai][bj][m][0] = v0; acc[ai][bj][m][1] = v1;
                    if (n == 2) *(GAS v4u*)(mix + r * D + col0 + bj * 128) = tr4(t.pull, pack8(v0, v1));
                } }
        return n < 2;
    }
};
struct Order3 : pg8::StaticOrder {
    __device__ __forceinline__ bool next(int i, Unit& u) const { Unit t; if (!pg8::StaticOrder::next(i / 3, t)) return false; const int k = i % 3; u.pm = t.pm + k * NPANEL; u.pn = t.pn + 4 * k; return true; }
};

struct SmallOrder {
    int c;
    __device__ __forceinline__ bool next(int i, Unit& u) const { if (i > 0 || c >= 8) return false; u.pm = 256 + (c >> 2); u.pn = c & 3; return true; }
    __device__ __forceinline__ void a_ready(const Unit&) const {}
    __device__ __forceinline__ void done(const Unit&) const {}
};

struct SmallOrderH {
    int c;
    __device__ __forceinline__ bool next(int i, Unit& u) const { if (i > 0 || c >= 16) return false; u.pm = 256 + ((c >> 2) & 1); u.pn = c & 3; return true; }
    __device__ __forceinline__ void a_ready(const Unit&) const {}
    __device__ __forceinline__ void done(const Unit&) const {}
};
struct EpiPart {
    static constexpr bool PERM = true; static constexpr int NS = 16;
    float* part;
    __device__ __forceinline__ bool operator()(AccT& acc, const Unit& u, int wr, int wc, int fr, int fq) const {
        asm volatile("" : "+s"(wr), "+s"(wc), "+v"(fr), "+v"(fq));
        float* p0 = part + (size_t)((u.pm - 256) * 256 + wr * 64 + fr) * D + u.pn * 256 + wc * 32 + 8 * fq;
#pragma unroll
        for (int ai = 0; ai < 2; ++ai)
#pragma unroll
            for (int m = 0; m < 4; ++m)
#pragma unroll
                for (int bj = 0; bj < 2; ++bj)
#pragma unroll
                    for (int n = 0; n < 2; ++n) *(GAS f32x4*)(p0 + (size_t)(ai * 128 + m * 16) * D + bj * 128 + 4 * n) = acc[ai][bj][m][n];
        return false;
    }
};

struct SmallOrder3 {
    int c;
    __device__ __forceinline__ bool next(int i, Unit& u) const { if (i > 2) return false; u.pm = 256 + (c >> 2) + i * NPANEL; u.pn = (c & 3) + 4 * i; return true; }
    __device__ __forceinline__ void a_ready(const Unit&) const {}
    __device__ __forceinline__ void done(const Unit&) const {}
};
struct SmallOrderW {
    int c;
    __device__ __forceinline__ bool next(int i, Unit& u) const { if (i > 0) return false; const int p = c >= 22 ? 1 : 0; u.pm = 256 + p; u.pn = c - 22 * p; return true; }
    __device__ __forceinline__ void a_ready(const Unit&) const {}
    __device__ __forceinline__ void done(const Unit&) const {}
};

struct EpiWin {
    static constexpr bool PERM = true; static constexpr int NS = 16;
    unsigned char* ws; float* out; int layer;
    __device__ __forceinline__ bool operator()(AccT& acc, const Unit& u, int wr, int wc, int fr, int fq) const {
        asm volatile("" : "+s"(wr), "+s"(wc), "+v"(fr), "+v"(fq));
        const LaneT t = lane_t(fr, fq);
        const int pn = u.pn, pm = u.pm, rl0 = wr * 64 + fr, trl0 = wr * 64 + t.tfr;
        if (pn < 4) {
            const bool isk = pn >= 2; bf16* dst = (bf16*)(ws + (isk ? WS_KR : WS_QR)); const float sc = isk ? 0.08838834764831845f : 1.0f;
            const float lgA = ret_lg2(2 * (pn & 1)) * (isk ? -1.f : 1.f), lgB = ret_lg2(2 * (pn & 1) + 1) * (isk ? -1.f : 1.f);
            float invf[4];
#pragma unroll
            for (int e = 0; e < 4; ++e) invf[e] = fast_exp2(-(float)(16 * wc + 4 * fq + e) * (13.287712379549449f / 64.0f)) * 0.15915494309189535f;
#pragma unroll
            for (int ai = 0; ai < 2; ++ai)
#pragma unroll
                for (int mp = 0; mp < 2; ++mp) { unsigned pk1[2][2][2], pk2[2][2][2];
#pragma unroll
                    for (int k = 0; k < 2; ++k) { const int rl = rl0 + ai * 128 + (2 * mp + k) * 16, r = pm * 256 + rl;
                        const float pos = (float)(pm < 256 ? NMETA + (r & (T - 1)) : (pm == 256 ? NMETA + PAST + (rl & (ST - 1)) : rl));
                        const float jp1 = (float)((pm < 256 ? (r & 63) : (pm == 256 ? (rl & (ST - 1)) : rl)) + 1);
                        const float dsc[2] = {sc * fast_exp2(jp1 * lgA), sc * fast_exp2(jp1 * lgB)};
                        f32x4 cs, sn;
#pragma unroll
                        for (int e = 0; e < 4; ++e) { float rev = pos * invf[e]; rev = rev - floorf(rev); cs[e] = __builtin_amdgcn_cosf(rev); sn[e] = __builtin_amdgcn_sinf(rev); }
#pragma unroll
                        for (int bj = 0; bj < 2; ++bj) { const f32x4 x1 = acc[ai][bj][2 * mp + k][0], x2 = acc[ai][bj][2 * mp + k][1];
                            const f32x4 o1 = (x1 * cs - x2 * sn) * dsc[bj], o2 = (x2 * cs + x1 * sn) * dsc[bj];
                            pk1[k][bj][0] = pg8::cvt_pk_bf16(o1[0], o1[1]); pk1[k][bj][1] = pg8::cvt_pk_bf16(o1[2], o1[3]);
                            pk2[k][bj][0] = pg8::cvt_pk_bf16(o2[0], o2[1]); pk2[k][bj][1] = pg8::cvt_pk_bf16(o2[2], o2[3]); } }
                    const size_t srow = (size_t)(pm * 256 + rl0 + ai * 128 + (2 * mp + (fq & 1)) * 16);
#pragma unroll
                    for (int bj = 0; bj < 2; ++bj) { bf16* rowp = dst + srow * 512 + (2 * (pn & 1) + bj) * 128 + 16 * wc + 4 * (fq & 2);
                        { const auto sx = __builtin_amdgcn_permlane16_swap(pk1[0][bj][0], pk1[1][bj][0], false, false), sy = __builtin_amdgcn_permlane16_swap(pk1[0][bj][1], pk1[1][bj][1], false, false);
                          *(GAS v4u*)rowp = (v4u){sx[0], sy[0], sx[1], sy[1]}; }
                        { const auto sx = __builtin_amdgcn_permlane16_swap(pk2[0][bj][0], pk2[1][bj][0], false, false), sy = __builtin_amdgcn_permlane16_swap(pk2[0][bj][1], pk2[1][bj][1], false, false);
                          *(GAS v4u*)(rowp + 64) = (v4u){sx[0], sy[0], sx[1], sy[1]}; } } }
            return false;
        }
        const int seg = (pn - 4) >> 2;
        const int colt = ((pn - 4) & 3) * 256 + wc * 32 + 8 * t.tfq;
        if (seg == 0 || seg == 1 || seg == 2 || seg >= 6) {
            bf16* dst = (bf16*)(ws + (seg == 0 ? WS_VR : seg == 1 ? WS_GR : seg == 2 ? WS_QS : WS_GT)); const int ld = seg >= 6 ? 3 * D : D; const int cofs = seg >= 6 ? (seg - 6) * D : 0;
#pragma unroll
            for (int ai = 0; ai < 2; ++ai)
#pragma unroll
                for (int m = 0; m < 4; ++m) { const size_t r = (size_t)(pm * 256 + trl0 + ai * 128 + m * 16);
#pragma unroll
                    for (int bj = 0; bj < 2; ++bj) { f32x4 v0 = acc[ai][bj][m][0], v1 = acc[ai][bj][m][1];
                        if (seg == 1) {
#pragma unroll
                            for (int e = 0; e < 4; ++e) { v0[e] = siluf_(v0[e]); v1[e] = siluf_(v1[e]); } }
                        else if (seg == 2) { v0 = v0 * (0.08838834764831845f * LOG2E); v1 = v1 * (0.08838834764831845f * LOG2E); }
                        else if (seg >= 6) {
#pragma unroll
                            for (int e = 0; e < 4; ++e) { v0[e] = sigmoidf_(v0[e]); v1[e] = sigmoidf_(v1[e]); } }
                        *(GAS v4u*)(dst + r * ld + cofs + colt + bj * 128) = tr4(t.pull, pack8(v0, v1)); } }
            return false;
        }
        if (seg == 3 || seg == 4) {
            bf16* dst = (bf16*)(ws + (seg == 3 ? WS_KS : WS_VS));
            if (seg == 3 && pm != 256) {
                float mx[2] = {0.f, 0.f};
#pragma unroll
                for (int ai = 0; ai < 2; ++ai)
#pragma unroll
                    for (int m = 0; m < 4; ++m) { const int rl = rl0 + ai * 128 + m * 16; if (pm < 256 || rl < NMETA) {
#pragma unroll
                        for (int bj = 0; bj < 2; ++bj) { const f32x4 a = acc[ai][bj][m][0], b2 = acc[ai][bj][m][1];
                            const float s = (a[0] * a[0] + a[1] * a[1]) + (a[2] * a[2] + a[3] * a[3]) + (b2[0] * b2[0] + b2[1] * b2[1]) + (b2[2] * b2[2] + b2[3] * b2[3]); mx[bj] = fmaxf(mx[bj], s); } } }
#pragma unroll
                for (int bj = 0; bj < 2; ++bj) {
#pragma unroll
                    for (int o = 1; o < 16; o <<= 1) mx[bj] = fmaxf(mx[bj], __shfl_xor(mx[bj], o));
                    if (fr == 0) { const int bidx = pm < 256 ? (pm >> 3) : 32, hh = ((pn - 16) & 3) * 2 + bj;
                        atomicMax((unsigned*)(ws + WS_CTL) + CW_KN + ((layer * 33 + bidx) * 8 + hh) * 16 + wc * 4 + fq, __float_as_uint(mx[bj] * 1.02f)); } }
            }
            float* op = out + (seg == 3 ? O_KP : O_VP) + (size_t)layer * NB * KT_PP * D;
            float* os = out + (seg == 3 ? O_KS : O_VS) + (size_t)layer * SBATCH * ST * D;
#pragma unroll
            for (int ai = 0; ai < 2; ++ai)
#pragma unroll
                for (int m = 0; m < 4; ++m) { const int rl = trl0 + ai * 128 + m * 16; const size_t r = (size_t)(pm * 256 + rl);
#pragma unroll
                    for (int bj = 0; bj < 2; ++bj) { const f32x4 v0 = tr4f(t.pull, acc[ai][bj][m][0]), v1 = tr4f(t.pull, acc[ai][bj][m][1]); const int c = colt + bj * 128;
                        *(GAS v4u*)(dst + r * D + c) = pack8(v0, v1);
                        if (pm < 256) { float* o = op + ((size_t)(r >> 11) * KT_PP + NMETA + (r & (T - 1))) * D + c; *(GAS f32x4*)o = v0; *(GAS f32x4*)(o + 4) = v1; }
                        else if (pm == 256) { float* o = os + (size_t)rl * D + c; *(GAS f32x4*)o = v0; *(GAS f32x4*)(o + 4) = v1; }
                        else if (rl < NMETA) { for (int bb = 0; bb < NB; ++bb) { float* o = op + ((size_t)bb * KT_PP + rl) * D + c; *(GAS f32x4*)o = v0; *(GAS f32x4*)(o + 4) = v1; } }
                    } }
            return false;
        }
        {
            float* op = out + O_PP + (size_t)layer * NB * PBUF * D;
            float* os = out + O_PS + (size_t)layer * SBATCH * PBUF * D;
#pragma unroll
            for (int ai = 0; ai < 2; ++ai)
#pragma unroll
                for (int m = 0; m < 4; ++m) { const int rl = trl0 + ai * 128 + m * 16; const size_t r = (size_t)(pm * 256 + rl);
#pragma unroll
                    for (int bj = 0; bj < 2; ++bj) { const f32x4 v0 = tr4f(t.pull, acc[ai][bj][m][0]), v1 = tr4f(t.pull, acc[ai][bj][m][1]); const int c = colt + bj * 128;
                        *(GAS v4u*)((bf16*)(ws + WS_U) + r * D + c) = pack8(v0, v1);
                        if (pm < 256) { const int tt = (int)(r & (T - 1)); if (tt >= T - PBUF) { float* o = op + ((size_t)(r >> 11) * PBUF + (tt - (T - PBUF))) * D + c; *(GAS f32x4*)o = v0; *(GAS f32x4*)(o + 4) = v1; } }
                        else if (pm == 256) { const int tt = rl & (ST - 1); if (tt >= ST - PBUF) { float* o = os + ((size_t)(rl >> 5) * PBUF + (tt - (ST - PBUF))) * D + c; *(GAS f32x4*)o = v0; *(GAS f32x4*)(o + 4) = v1; } }
                    } }
            return false;
        }
    }
};

__device__ __forceinline__ int grab(const Frame& F, gu32* ctr) {
    __syncthreads();
    if (F.wave == 0 && lane_lo_() == 0u) F.MISC[16] = __hip_atomic_fetch_add(ctr, 1u, RLX_AGENT);
    __syncthreads();
    return (int)F.MISC[16];
}
__device__ __forceinline__ unsigned grab_issue(const Frame& F, gu32* ctr) { return (F.wave == 0 && lane_lo_() == 0u) ? __hip_atomic_fetch_add(ctr, 1u, RLX_AGENT) : 0u; }
__device__ __forceinline__ int grab_publish(const Frame& F, unsigned nxt) {
    __syncthreads();
    if (F.wave == 0 && lane_lo_() == 0u) F.MISC[16] = nxt;
    __syncthreads();
    return (int)F.MISC[16];
}
typedef float f32x4_t __attribute__((ext_vector_type(4)));
#define MFMA16(a, b, c) __builtin_amdgcn_mfma_f32_16x16x32_bf16((a), (b), (c), 0, 0, 0)
__device__ __forceinline__ s16x4 tr16(const LAS unsigned char* p) { typedef short v4i16_t __attribute__((ext_vector_type(4))); return __builtin_bit_cast(s16x4, __builtin_amdgcn_ds_read_tr16_b64_v4i16((LAS v4i16_t*)p)); }

constexpr int RT_QS = 272, RT_VS = 528, RT_AS = 144;
constexpr int RT_Q = 0, RT_K = 64 * RT_QS, RT_V = 2 * 64 * RT_QS, RT_A = RT_V + 64 * RT_VS, RT_END = RT_A + 64 * RT_AS;
static_assert(RT_END <= RING_BYTES && 64 * 256 * 4 <= RT_END, "retention LDS map");
__device__ __forceinline__ float ret_lg2(int h) { return fast_log2(1.0f - fast_exp2(-5.0f - (float)h * (4.0f / 3.0f))); }
__device__ __forceinline__ void ret_unit(const Frame& F, int layer, int uid) {
    const int h = uid & 3; int stream, b;
    if (uid < 128) { stream = 0; b = uid >> 2; } else if (uid < 160) { stream = 1; b = (uid - 128) >> 2; } else { stream = 2; b = 0; }
    const TC tc = thread_coords(F.wave); const int tid = tc.tid, lane = tc.lane, w = tc.wave, l15 = lane & 15, g = lane >> 4, q4 = l15 >> 2, p4 = l15 & 3;
    const float lg2 = ret_lg2(h);
    const int nch = stream == 0 ? 1 + T / 64 : 1;
    f32x4 accS[8][2];
#pragma unroll
    for (int m = 0; m < 8; ++m)
#pragma unroll
        for (int n = 0; n < 2; ++n) accS[m][n] = (f32x4){0.f, 0.f, 0.f, 0.f};
    if (stream == 1) { const float* s0 = in_ptr(IN_SRET) + (((size_t)layer * SBATCH + b) * HRET + h) * DKR * DVR;
#pragma unroll
        for (int m = 0; m < 8; ++m)
#pragma unroll
            for (int n = 0; n < 2; ++n)
#pragma unroll
                for (int r = 0; r < 4; ++r) accS[m][n][r] = s0[(size_t)(16 * m + 4 * g + r) * DVR + 32 * w + 16 * n + l15]; }
    v4u qreg[2], kreg[2], vreg[4];
    const int lrow = tid >> 4, lch = tid & 15, vrow = tid >> 5, vch = tid & 31;
#define RT_CHUNK(c, rb, vl) do { if (stream == 0) { if ((c) == 0) { rb = ROW_M; vl = NMETA; } else { rb = b * T + 64 * ((c) - 1); vl = 64; } } \
        else if (stream == 1) { rb = ROW_S + b * ST; vl = ST; } else { rb = ROW_M; vl = NMETA; } } while (0)
#define RT_LOAD(c) do { int rb_, vl_; RT_CHUNK(c, rb_, vl_); \
        _Pragma("unroll") for (int i_ = 0; i_ < 2; ++i_) { const int r_ = lrow + 32 * i_; qreg[i_] = (v4u){0u, 0u, 0u, 0u}; kreg[i_] = (v4u){0u, 0u, 0u, 0u}; \
            if (r_ < vl_) { const size_t o_ = (size_t)(rb_ + r_) * 512 + h * 128 + lch * 8; qreg[i_] = *(const GAS v4u*)(WSB(F, WS_QR) + o_); kreg[i_] = *(const GAS v4u*)(WSB(F, WS_KR) + o_); } } \
        _Pragma("unroll") for (int i_ = 0; i_ < 4; ++i_) { const int r_ = vrow + 16 * i_; vreg[i_] = (v4u){0u, 0u, 0u, 0u}; \
            if (r_ < vl_) vreg[i_] = *(const GAS v4u*)(WSB(F, WS_VR) + (size_t)(rb_ + r_) * D + h * 256 + vch * 8); } } while (0)
    RT_LOAD(0);
    const LAS unsigned char* Ql = F.lds + RT_Q; const LAS unsigned char* Kl = F.lds + RT_K; const LAS unsigned char* Vl = F.lds + RT_V; const LAS unsigned char* Al = F.lds + RT_A;
    for (int c = 0; c < nch; ++c) {
        int rowbase, valid; RT_CHUNK(c, rowbase, valid);
        const bool write_out = !(stream == 0 && c == 0);
        const float dc = fast_exp2((float)valid * lg2);
        __syncthreads();
#pragma unroll
        for (int i = 0; i < 2; ++i) { *(LAS v4u*)(F.lds + RT_Q + (lrow + 32 * i) * RT_QS + lch * 16) = qreg[i]; *(LAS v4u*)(F.lds + RT_K + (lrow + 32 * i) * RT_QS + lch * 16) = kreg[i]; }
#pragma unroll
        for (int i = 0; i < 4; ++i) *(LAS v4u*)(F.lds + RT_V + (vrow + 16 * i) * RT_VS + vch * 16) = vreg[i];
        __syncthreads();
        if (c + 1 < nch) RT_LOAD(c + 1);
#pragma unroll
        for (int tt = 0; tt < 2; ++tt) { const int id = 2 * w + tt, mt = id >> 2, nt = id & 3;
            f32x4 a4 = (f32x4){0.f, 0.f, 0.f, 0.f};
            if (mt <= nt) {
#pragma unroll
                for (int ks = 0; ks < 4; ++ks) { const bf16x8 A = *(const LAS bf16x8*)(Kl + (16 * mt + l15) * RT_QS + 64 * ks + 16 * g); const bf16x8 B = *(const LAS bf16x8*)(Ql + (16 * nt + l15) * RT_QS + 64 * ks + 16 * g);
                    a4 = MFMA16(A, B, a4); }
#pragma unroll
                for (int r = 0; r < 4; ++r) a4[r] = (16 * mt + 4 * g + r <= 16 * nt + l15) ? a4[r] : 0.f;
            }
            *(LAS v2u*)(F.lds + RT_A + (16 * nt + l15) * RT_AS + (16 * mt + 4 * g) * 2) = (v2u){pg8::cvt_pk_bf16(a4[0], a4[1]), pg8::cvt_pk_bf16(a4[2], a4[3])}; }
        __syncthreads();
        f32x4 accO[4][2];
#pragma unroll
        for (int m = 0; m < 4; ++m)
#pragma unroll
            for (int n = 0; n < 2; ++n) accO[m][n] = (f32x4){0.f, 0.f, 0.f, 0.f};
#pragma unroll
        for (int ks = 0; ks < 4; ++ks) {
            bf16x8 Sf[2];
#pragma unroll
            for (int n = 0; n < 2; ++n) Sf[n] = __builtin_bit_cast(bf16x8, (v4u){pg8::cvt_pk_bf16(accS[2 * ks][n][0], accS[2 * ks][n][1]), pg8::cvt_pk_bf16(accS[2 * ks][n][2], accS[2 * ks][n][3]),
                                                                               pg8::cvt_pk_bf16(accS[2 * ks + 1][n][0], accS[2 * ks + 1][n][1]), pg8::cvt_pk_bf16(accS[2 * ks + 1][n][2], accS[2 * ks + 1][n][3])});
#pragma unroll
            for (int m = 0; m < 4; ++m) { const v2u lo = *(const LAS v2u*)(Ql + (16 * m + l15) * RT_QS + (32 * ks + 4 * g) * 2), hi = *(const LAS v2u*)(Ql + (16 * m + l15) * RT_QS + (32 * ks + 16 + 4 * g) * 2);
                const bf16x8 A = __builtin_bit_cast(bf16x8, (v4u){lo.x, lo.y, hi.x, hi.y});
#pragma unroll
                for (int n = 0; n < 2; ++n) accO[m][n] = MFMA16(A, Sf[n], accO[m][n]); }
        }
        bf16x8 Bv[2][2];
#pragma unroll
        for (int k2 = 0; k2 < 2; ++k2)
#pragma unroll
            for (int n = 0; n < 2; ++n) { const s16x4 lo = tr16(Vl + (32 * k2 + 8 * g + q4) * RT_VS + (32 * w + 16 * n + 4 * p4) * 2), hi = tr16(Vl + (32 * k2 + 8 * g + 4 + q4) * RT_VS + (32 * w + 16 * n + 4 * p4) * 2);
                Bv[k2][n] = __builtin_shufflevector(lo, hi, 0, 1, 2, 3, 4, 5, 6, 7); }
#pragma unroll
        for (int k2 = 0; k2 < 2; ++k2)
#pragma unroll
            for (int m = 0; m < 4; ++m) { const bf16x8 A = *(const LAS bf16x8*)(Al + (16 * m + l15) * RT_AS + (32 * k2 + 8 * g) * 2);
#pragma unroll
                for (int n = 0; n < 2; ++n) accO[m][n] = MFMA16(A, Bv[k2][n], accO[m][n]); }
#pragma unroll
        for (int m = 0; m < 8; ++m)
#pragma unroll
            for (int k2 = 0; k2 < 2; ++k2) { const s16x4 lo = tr16(Kl + (32 * k2 + 8 * g + q4) * RT_QS + (16 * m + 4 * p4) * 2), hi = tr16(Kl + (32 * k2 + 8 * g + 4 + q4) * RT_QS + (16 * m + 4 * p4) * 2);
                const bf16x8 A = __builtin_shufflevector(lo, hi, 0, 1, 2, 3, 4, 5, 6, 7);
#pragma unroll
                for (int n = 0; n < 2; ++n) accS[m][n] = MFMA16(A, Bv[k2][n], accS[m][n]); }
#pragma unroll
        for (int m = 0; m < 8; ++m)
#pragma unroll
            for (int n = 0; n < 2; ++n) accS[m][n] = accS[m][n] * dc;
        if (write_out) {
            __syncthreads();
            LAS float* oL = (LAS float*)F.lds;
#pragma unroll
            for (int m = 0; m < 4; ++m)
#pragma unroll
                for (int n = 0; n < 2; ++n)
#pragma unroll
                    for (int r = 0; r < 4; ++r) oL[(16 * m + 4 * g + r) * 256 + 32 * w + 16 * n + l15] = accO[m][n][r];
            __syncthreads();
            const f32x4 gn = *(const GAS f32x4*)(in_ptr(IN_RETG) + ((size_t)layer * HRET + h) * DVR + lane * 4);
#pragma unroll
            for (int hb2 = 0; hb2 < 2; ++hb2) {
            f32x4 x[4]; v2u gr[4]; float s1[4], s2[4];
#pragma unroll
            for (int tt = 0; tt < 4; ++tt) { const int t = w * 8 + hb2 * 4 + tt; x[tt] = *(const LAS f32x4*)(oL + t * 256 + lane * 4); gr[tt] = *(const GAS v2u*)(WSB(F, WS_GR) + (size_t)(rowbase + t) * D + h * 256 + lane * 4);
                s1[tt] = (x[tt][0] + x[tt][1]) + (x[tt][2] + x[tt][3]); }
#pragma unroll
            for (int o = 1; o < 64; o <<= 1)
#pragma unroll
                for (int tt = 0; tt < 4; ++tt) s1[tt] += __shfl_xor(s1[tt], o);
#pragma unroll
            for (int tt = 0; tt < 4; ++tt) { x[tt] = x[tt] - s1[tt] * (1.f / 256.f); s2[tt] = (x[tt][0] * x[tt][0] + x[tt][1] * x[tt][1]) + (x[tt][2] * x[tt][2] + x[tt][3] * x[tt][3]); }
#pragma unroll
            for (int o = 1; o < 64; o <<= 1)
#pragma unroll
                for (int tt = 0; tt < 4; ++tt) s2[tt] += __shfl_xor(s2[tt], o);
#pragma unroll
            for (int tt = 0; tt < 4; ++tt) { const int t = w * 8 + hb2 * 4 + tt; const float rstd = 1.f / sqrtf(s2[tt] * (1.f / 256.f) + LN_EPS);
                const f32x4 y = x[tt] * rstd * gn * (f32x4){bflo(gr[tt].x), bfhi(gr[tt].x), bflo(gr[tt].y), bfhi(gr[tt].y)};
                if (t < valid) *(GAS v2u*)(WSB(F, WS_BR) + (size_t)(rowbase + t) * D + h * 256 + lane * 4) = (v2u){pk2(y[0], y[1]), pk2(y[2], y[3])}; }
            }
        }
    }
#undef RT_LOAD
#undef RT_CHUNK
    if (stream != 2) { float* d = F.out + (stream == 0 ? O_RP + (((size_t)layer * NB + b) * HRET + h) * DKR * DVR : O_RS + (((size_t)layer * SBATCH + b) * HRET + h) * DKR * DVR);
#pragma unroll
        for (int m = 0; m < 8; ++m)
#pragma unroll
            for (int n = 0; n < 2; ++n)
#pragma unroll
                for (int r = 0; r < 4; ++r) d[(size_t)(16 * m + 4 * g + r) * DVR + 32 * w + 16 * n + l15] = accS[m][n][r]; }
}

constexpr int AT_RS = 272;
constexpr int AT_VOFF = 64 * AT_RS;
constexpr int AT_QOFF = 36864;
static_assert(AT_QOFF >= 2 * 64 * AT_RS && AT_QOFF + 8 * 8 * 1024 <= RING_BYTES, "attention LDS map");
template <bool F32KV> __device__ __forceinline__ void attn_unit(const Frame& F, int layer, int uid) {
    int stream, b, h, qb;
    if (uid < 64) { stream = 1; b = uid >> 3; h = uid & 7; qb = 0; }
    else if (uid < 64 + 2048) { const int idx = uid - 64; qb = 7 - (idx >> 8); b = (idx & 255) >> 3; h = idx & 7; stream = 0; }
    else { stream = 2; b = 0; h = (uid - (64 + 2048)) & 7; qb = 0; }
    const bf16 *k0p = nullptr, *k1p = nullptr, *v0p = nullptr, *v1p = nullptr; const float *k0f = nullptr, *k1f = nullptr, *v0f = nullptr, *v1f = nullptr; int len0, Tq, rowbase;
    if (stream == 0) { k0p = WSB(F, WS_KS) + (size_t)ROW_M * D; v0p = WSB(F, WS_VS) + (size_t)ROW_M * D; len0 = NMETA; k1p = WSB(F, WS_KS) + (size_t)b * T * D; v1p = WSB(F, WS_VS) + (size_t)b * T * D; Tq = T; rowbase = b * T; }
    else if (stream == 1) { k0f = in_ptr(IN_CK) + ((size_t)layer * SBATCH + b) * PAST * D; v0f = in_ptr(IN_CV) + ((size_t)layer * SBATCH + b) * PAST * D; len0 = PAST;
        k1f = F.out + O_KS + ((size_t)layer * SBATCH + b) * ST * D; v1f = F.out + O_VS + ((size_t)layer * SBATCH + b) * ST * D; Tq = ST; rowbase = ROW_S + b * ST; }
    else { k0p = k1p = WSB(F, WS_KS) + (size_t)ROW_M * D; v0p = v1p = WSB(F, WS_VS) + (size_t)ROW_M * D; len0 = 0; Tq = NMETA; rowbase = ROW_M; }
    constexpr int NQ = F32KV ? 1 : 2, QPW = 16 * NQ, QBLK = 8 * QPW;
    const int Stot = len0 + Tq, q0 = qb * QBLK;
    const TC tc = thread_coords(F.wave); const int tid = tc.tid, lane = tc.lane, w = tc.wave, l15 = lane & 15, g = lane >> 4;
    int qi[NQ]; bool valid_q[NQ]; int lim[NQ];
#pragma unroll
    for (int nb = 0; nb < NQ; ++nb) { qi[nb] = q0 + 16 * (NQ == 2 ? (nb == 0 ? w : 15 - w) : w) + l15; valid_q[nb] = qi[nb] < Tq; lim[nb] = len0 + qi[nb]; }
    bf16x8 qf[NQ][4];
#pragma unroll
    for (int nb = 0; nb < NQ; ++nb)
#pragma unroll
    for (int ks = 0; ks < 4; ++ks) { v4u t4 = (v4u){0u, 0u, 0u, 0u}; if (valid_q[nb]) t4 = *(const GAS v4u*)(WSB(F, WS_QS) + (size_t)(rowbase + qi[nb]) * D + h * 128 + 32 * ks + 8 * g); qf[nb][ks] = __builtin_bit_cast(bf16x8, t4); }
    float zq[NQ];
#pragma unroll
    for (int nb = 0; nb < NQ; ++nb) zq[nb] = 3.0e38f;
    float kn2 = -1.f;
    if (stream == 0) { const unsigned* kn = (const unsigned*)(F.ws + WS_CTL) + CW_KN + ((layer * 33 + b) * 8 + h) * 16; const unsigned* km = (const unsigned*)(F.ws + WS_CTL) + CW_KN + ((layer * 33 + 32) * 8 + h) * 16;
        kn2 = 0.f;
#pragma unroll
        for (int p = 0; p < 16; ++p) kn2 += fmaxf(__uint_as_float(kn[p]), __uint_as_float(km[p])); }
    if constexpr (F32KV) {
        const int lr_ = tid >> 4, lc_ = tid & 15; float km_ = 0.f;
        for (int s0 = lr_; s0 < Stot; s0 += 128) { f32x4 a_[4][2];
#pragma unroll
            for (int j = 0; j < 4; ++j) { int s_ = s0 + 32 * j; s_ = s_ < Stot ? s_ : Stot - 1; const float* kp_ = (s_ < len0 ? k0f + (size_t)s_ * D : k1f + (size_t)(s_ - len0) * D) + h * 128 + lc_ * 8;
                a_[j][0] = *(const GAS f32x4*)kp_; a_[j][1] = *(const GAS f32x4*)(kp_ + 4); }
#pragma unroll
            for (int j = 0; j < 4; ++j) { const f32x4 x = a_[j][0] * a_[j][0] + a_[j][1] * a_[j][1]; float p = (x[0] + x[1]) + (x[2] + x[3]);
                p += __shfl_xor(p, 1); p += __shfl_xor(p, 2); p += __shfl_xor(p, 4); p += __shfl_xor(p, 8); km_ = fmaxf(km_, p); } }
        km_ = fmaxf(km_, __shfl_xor(km_, 16)); km_ = fmaxf(km_, __shfl_xor(km_, 32));
        __syncthreads();
        if (lane == 0) F.MISC[32 + w] = __float_as_uint(km_);
        __syncthreads();
        kn2 = 0.f;
#pragma unroll
        for (int i = 0; i < 8; ++i) kn2 = fmaxf(kn2, __uint_as_float(F.MISC[32 + i])); }
    if (kn2 >= 0.f) {
#pragma unroll
        for (int nb = 0; nb < NQ; ++nb) { float q2 = 0.f;
#pragma unroll
            for (int ks = 0; ks < 4; ++ks)
#pragma unroll
                for (int e = 0; e < 8; ++e) { const float x = bf2f((unsigned short)qf[nb][ks][e]); q2 += x * x; }
            q2 += __shfl_xor(q2, 16); q2 += __shfl_xor(q2, 32);
            zq[nb] = sqrtf(kn2 * q2) * 1.01f + 150.0f; } }
    f32x4 o[NQ][8];
#pragma unroll
    for (int nb = 0; nb < NQ; ++nb)
#pragma unroll
    for (int i = 0; i < 8; ++i) o[nb][i] = (f32x4){0.f, 0.f, 0.f, 0.f};
    float R[NQ]; bool anyv_ = false;
#pragma unroll
    for (int nb = 0; nb < NQ; ++nb) { R[nb] = 0.f; anyv_ = anyv_ || valid_q[nb]; }
    bool wave_done = __all(!anyv_) != 0;
    const int qend = (q0 + QBLK < Tq) ? q0 + QBLK : Tq;
    const int kt_max = (len0 + qend - 2) >> 6;
    const int lrow = tid >> 4, lch = tid & 15;
    constexpr int NR = F32KV ? 4 : 2;
    constexpr int DIST = F32KV ? 1 : 2;
    v4u kregA[NR], vregA[NR], kregB[NR], vregB[NR];
#define AT_LOAD(kt, KR, VR) do { _Pragma("unroll") for (int i_ = 0; i_ < 2; ++i_) { int s_ = ((kt) > 0 ? (kt) : 0) * 64 + lrow + 32 * i_; s_ = s_ < Stot ? s_ : Stot - 1; \
        const size_t off_ = (s_ < len0 ? (size_t)s_ : (size_t)(s_ - len0)) * D + h * 128 + lch * 8; \
        if constexpr (F32KV) { const float* kp_ = (s_ < len0 ? k0f : k1f) + off_; const float* vp_ = (s_ < len0 ? v0f : v1f) + off_; \
            asm volatile("global_load_dwordx4 %0, %1, off" : "=&v"(KR[2 * i_]) : "v"(kp_) : "memory"); asm volatile("global_load_dwordx4 %0, %1, off offset:16" : "=&v"(KR[2 * i_ + 1]) : "v"(kp_) : "memory"); \
            asm volatile("global_load_dwordx4 %0, %1, off" : "=&v"(VR[2 * i_]) : "v"(vp_) : "memory"); asm volatile("global_load_dwordx4 %0, %1, off offset:16" : "=&v"(VR[2 * i_ + 1]) : "v"(vp_) : "memory"); } \
        else { const bf16* kp_ = (s_ < len0 ? k0p : k1p) + off_; const bf16* vp_ = (s_ < len0 ? v0p : v1p) + off_; \
            asm volatile("global_load_dwordx4 %0, %1, off" : "=&v"(KR[i_]) : "v"(kp_) : "memory"); asm volatile("global_load_dwordx4 %0, %1, off" : "=&v"(VR[i_]) : "v"(vp_) : "memory"); } } } while (0)
    AT_LOAD(kt_max, kregA, vregA);
    if constexpr (!F32KV) AT_LOAD(kt_max - 1, kregB, vregB);
    const LAS unsigned char* Ql = F.lds + AT_QOFF + w * (NQ * 4096);
#pragma unroll
    for (int nb = 0; nb < NQ; ++nb)
#pragma unroll
        for (int ks = 0; ks < 4; ++ks) *(LAS v4u*)(F.lds + AT_QOFF + w * (NQ * 4096) + ((nb * 4 + ks) * 64 + lane) * 16) = __builtin_bit_cast(v4u, qf[nb][ks]);
    const LAS unsigned char* Kl = F.lds; const LAS unsigned char* Vl = F.lds + AT_VOFF;
    const int q4 = l15 >> 2, p4 = l15 & 3;
#define AT_BODY(NB0_) { \
        f32x4 z[NQ][4]; \
        _Pragma("unroll") \
        for (int mt = 0; mt < 4; ++mt) { _Pragma("unroll") for (int nb = (NB0_); nb < NQ; ++nb) z[nb][mt] = (f32x4){0.f, 0.f, 0.f, 0.f}; } \
        _Pragma("unroll") \
        for (int ks = 0; ks < 4; ++ks) { bf16x8 qa[NQ]; _Pragma("unroll") for (int nb = (NB0_); nb < NQ; ++nb) qa[nb] = *(const LAS bf16x8*)(Ql + ((nb * 4 + ks) * 64 + lane) * 16); \
        _Pragma("unroll") \
            for (int mt = 0; mt < 4; ++mt) { const bf16x8 a = *(const LAS bf16x8*)(Kl + (16 * mt + l15) * AT_RS + 64 * ks + 16 * g); _Pragma("unroll") for (int nb = (NB0_); nb < NQ; ++nb) z[nb][mt] = MFMA16(a, qa[nb], z[nb][mt]); } } \
        bf16x8 pf[NQ][2]; \
        _Pragma("unroll") \
        for (int nb = (NB0_); nb < NQ; ++nb) { \
        bf16x8 triA, triB, ones; \
        _Pragma("unroll") \
        for (int e = 0; e < 8; ++e) { const int jl = 16 * (e >> 2) + 4 * g + (e & 3); triA[e] = (short)(jl >= l15 ? 0x3f80 : 0); triB[e] = (short)(jl >= l15 + 16 ? 0x3f80 : 0); ones[e] = (short)0x3f80; } \
        f32x4 sp[4]; \
        if (need_mask) { \
        _Pragma("unroll") \
            for (int mt = 0; mt < 4; ++mt) \
        _Pragma("unroll") \
                for (int r = 0; r < 4; ++r) { const bool vis = (tb + 16 * mt + 4 * g + r) < lim[nb]; const float zz = fminf(z[nb][mt][r], 80.f); z[nb][mt][r] = vis ? zz : -1.0e30f; \
                    sp[mt][r] = vis ? fast_log2(1.0f + fast_exp2(zz)) : 0.f; } \
        } else { \
        _Pragma("unroll") \
            for (int mt = 0; mt < 4; ++mt) \
        _Pragma("unroll") \
                for (int r = 0; r < 4; ++r) { const float zz = fminf(z[nb][mt][r], 80.f); z[nb][mt][r] = zz; sp[mt][r] = fast_log2(1.0f + fast_exp2(zz)); } \
        } \
        bf16x8 spf[2]; \
        _Pragma("unroll") \
        for (int k2 = 0; k2 < 2; ++k2) spf[k2] = __builtin_bit_cast(bf16x8, (v4u){pg8::cvt_pk_bf16(sp[2 * k2][0], sp[2 * k2][1]), pg8::cvt_pk_bf16(sp[2 * k2][2], sp[2 * k2][3]), \
                                                                                  pg8::cvt_pk_bf16(sp[2 * k2 + 1][0], sp[2 * k2 + 1][1]), pg8::cvt_pk_bf16(sp[2 * k2 + 1][2], sp[2 * k2 + 1][3])}); \
        const f32x4 zero4 = (f32x4){0.f, 0.f, 0.f, 0.f}; \
        const f32x4 r4 = (f32x4){R[nb], R[nb], R[nb], R[nb]};                  \
        f32x4 I0 = MFMA16(triA, spf[0], r4); I0 = MFMA16(ones, spf[1], I0); \
        f32x4 I1 = MFMA16(triB, spf[0], r4); I1 = MFMA16(ones, spf[1], I1); \
        f32x4 I2 = MFMA16(triA, spf[1], r4); \
        f32x4 I3 = MFMA16(triB, spf[1], r4); \
        f32x4 tot = MFMA16(ones, spf[0], zero4); tot = MFMA16(ones, spf[1], tot); \
        const f32x4 II[4] = {I0, I1, I2, I3}; \
        f32x4 wv[4]; \
        _Pragma("unroll") \
        for (int mt = 0; mt < 4; ++mt) \
        _Pragma("unroll") \
            for (int r = 0; r < 4; ++r) wv[mt][r] = fast_exp2(z[nb][mt][r] - II[mt][r]); \
        _Pragma("unroll") \
        for (int k2 = 0; k2 < 2; ++k2) pf[nb][k2] = __builtin_bit_cast(bf16x8, (v4u){pg8::cvt_pk_bf16(wv[2 * k2][0], wv[2 * k2][1]), pg8::cvt_pk_bf16(wv[2 * k2][2], wv[2 * k2][3]), \
                                                                                 pg8::cvt_pk_bf16(wv[2 * k2 + 1][0], wv[2 * k2 + 1][1]), pg8::cvt_pk_bf16(wv[2 * k2 + 1][2], wv[2 * k2 + 1][3])}); \
        R[nb] += tot[0]; \
        } \
        _Pragma("unroll") \
        for (int mt8 = 0; mt8 < 8; ++mt8) \
        _Pragma("unroll") \
            for (int k2 = 0; k2 < 2; ++k2) { \
                const s16x4 lo = tr16(Vl + (32 * k2 + 4 * g + q4) * AT_RS + (16 * mt8 + 4 * p4) * 2); \
                const s16x4 hi = tr16(Vl + (32 * k2 + 16 + 4 * g + q4) * AT_RS + (16 * mt8 + 4 * p4) * 2); \
                const bf16x8 a = __builtin_shufflevector(lo, hi, 0, 1, 2, 3, 4, 5, 6, 7); \
                _Pragma("unroll") for (int nb = (NB0_); nb < NQ; ++nb) o[nb][mt8] = MFMA16(a, pf[nb][k2], o[nb][mt8]); } \
        }
#define AT_ITER(KT_, KR_, VR_) { const int kt = (KT_); \
        __syncthreads(); \
        if (kt < kt_max) { unsigned allok = 1u; \
        _Pragma("unroll") \
            for (int i = 0; i < 8; ++i) allok &= F.MISC[24 + i]; \
            if (allok) break; } \
        if constexpr (F32KV) asm volatile("s_waitcnt vmcnt(0)" : "+v"(KR_[0]), "+v"(VR_[0]), "+v"(KR_[1]), "+v"(VR_[1]), "+v"(KR_[NR - 2]), "+v"(VR_[NR - 2]), "+v"(KR_[NR - 1]), "+v"(VR_[NR - 1]) :: "memory"); \
        else asm volatile("s_waitcnt vmcnt(4)" : "+v"(KR_[0]), "+v"(VR_[0]), "+v"(KR_[1]), "+v"(VR_[1]) :: "memory");     \
        _Pragma("unroll") \
        for (int i = 0; i < 2; ++i) { const bool in_ = (kt * 64 + lrow + 32 * i) < Stot; const v4u z4_ = (v4u){0u, 0u, 0u, 0u}; v4u kk_, vv_; \
            if constexpr (F32KV) { kk_ = pack8(__builtin_bit_cast(f32x4, KR_[(2 * i) % NR]), __builtin_bit_cast(f32x4, KR_[(2 * i + 1) % NR])); vv_ = pack8(__builtin_bit_cast(f32x4, VR_[(2 * i) % NR]), __builtin_bit_cast(f32x4, VR_[(2 * i + 1) % NR])); } \
            else { kk_ = KR_[i % NR]; vv_ = VR_[i % NR]; } \
            *(LAS v4u*)(F.lds + (lrow + 32 * i) * AT_RS + lch * 16) = in_ ? kk_ : z4_; *(LAS v4u*)(F.lds + AT_VOFF + (lrow + 32 * i) * AT_RS + lch * 16) = in_ ? vv_ : z4_; } \
        __syncthreads(); \
        AT_LOAD(kt - DIST, KR_, VR_); \
        const int tb = kt * 64; \
        const int lim_lo = len0 + q0 + 16 * w, lim_hi = NQ == 2 ? len0 + q0 + 16 * (15 - w) : lim_lo;      \
        const bool act0 = tb < lim_lo + 15, act1 = tb < lim_hi + 15;                                           \
        if (!wave_done && act1) { \
        const bool need_mask = (tb + 64 > (act0 ? lim_lo : lim_hi)); \
        if (NQ == 2 && !act0) AT_BODY(NQ - 1) else AT_BODY(0) \
        { bool dn_ = true; _Pragma("unroll") for (int nb = 0; nb < NQ; ++nb) dn_ = dn_ && ((!valid_q[nb]) || (R[nb] > zq[nb])); wave_done = __all(dn_) != 0; } \
        } \
        if (lane == 0) F.MISC[24 + w] = wave_done ? 1u : 0u; \
    }
    for (int kt2 = kt_max; kt2 >= 0; kt2 -= 2) {
        AT_ITER(kt2, kregA, vregA)
        if (kt2 == 0) break;
        if constexpr (F32KV) { AT_ITER(kt2 - 1, kregA, vregA) } else { AT_ITER(kt2 - 1, kregB, vregB) }
    }
#undef AT_ITER
#undef AT_BODY
    if constexpr (F32KV) asm volatile("s_waitcnt vmcnt(0)" : "+v"(kregA[0]), "+v"(vregA[0]), "+v"(kregA[1]), "+v"(vregA[1]), "+v"(kregA[NR - 2]), "+v"(vregA[NR - 2]), "+v"(kregA[NR - 1]), "+v"(vregA[NR - 1]) :: "memory");
    else asm volatile("s_waitcnt vmcnt(0)" : "+v"(kregA[0]), "+v"(vregA[0]), "+v"(kregA[1]), "+v"(vregA[1]), "+v"(kregB[0]), "+v"(vregB[0]), "+v"(kregB[1]), "+v"(vregB[1]) :: "memory");
#undef AT_LOAD
#pragma unroll
    for (int nb = 0; nb < NQ; ++nb)
    if (valid_q[nb]) { bf16* orow = WSB(F, WS_BR) + (size_t)M_PAD * D + (size_t)(rowbase + qi[nb]) * D + h * 128 + 4 * g;
#pragma unroll
        for (int mt8 = 0; mt8 < 8; ++mt8) *(GAS v2u*)(orow + 16 * mt8) = (v2u){pg8::cvt_pk_bf16(o[nb][mt8][0], o[nb][mt8][1]), pg8::cvt_pk_bf16(o[nb][mt8][2], o[nb][mt8][3])}; }
}

__device__ __forceinline__ void pool_row(const Frame& F, int layer, int stream, int b, int rowbase, int tp, int ch, float (&v)[8]) {
    if (tp >= 0 || stream == 0) { const size_t row = tp >= 0 ? (size_t)(rowbase + tp) : (size_t)(ROW_M + NMETA + tp);
        const v4u x = *(const GAS v4u*)(WSB(F, WS_U) + row * D + ch * 8);
        v[0] = bflo(x.x); v[1] = bfhi(x.x); v[2] = bflo(x.y); v[3] = bfhi(x.y); v[4] = bflo(x.z); v[5] = bfhi(x.z); v[6] = bflo(x.w); v[7] = bfhi(x.w); }
    else if (stream == 1) { const float* sp = in_ptr(IN_SPOOL) + (((size_t)layer * SBATCH + b) * PBUF + (PBUF + tp)) * D + ch * 8;
        const f32x4 a = *(const GAS f32x4*)sp, c = *(const GAS f32x4*)(sp + 4);
        v[0] = a[0]; v[1] = a[1]; v[2] = a[2]; v[3] = a[3]; v[4] = c[0]; v[5] = c[1]; v[6] = c[2]; v[7] = c[3]; }
    else {
#pragma unroll
        for (int e = 0; e < 8; ++e) v[e] = 0.f; }
}
__device__ __forceinline__ void pool_unit(const Frame& F, int layer, int uid) {
    int stream, b, t0, Tlen, rowbase;
    if (uid < 1024) { stream = 0; b = uid >> 5; t0 = (uid & 31) * 64; Tlen = T; rowbase = b * T; }
    else if (uid < 1032) { stream = 1; b = uid - 1024; t0 = 0; Tlen = ST; rowbase = ROW_S + b * ST; }
    else { stream = 2; b = 0; t0 = 0; Tlen = NMETA; rowbase = ROW_M; }
    const TC tc = thread_coords(F.wave); const int ch = tc.tid & 127, tsub = tc.tid >> 7, win = 2 << (ch >> 5);
    const int ts = t0 + tsub * 16; if (ts >= Tlen) return;
    float acc[8];
#pragma unroll
    for (int e = 0; e < 8; ++e) acc[e] = 0.f;
#pragma unroll
    for (int j = 1; j < 16; ++j) if (j < win) { float v[8]; pool_row(F, layer, stream, b, rowbase, ts - j, ch, v);
#pragma unroll
        for (int e = 0; e < 8; ++e) acc[e] += v[e]; }
#pragma unroll 4
    for (int tt = 0; tt < 16; ++tt) {
        const int t = ts + tt;
        float vn[8], vo[8]; pool_row(F, layer, stream, b, rowbase, t, ch, vn);
        if (tt > 0) pool_row(F, layer, stream, b, rowbase, t - win, ch, vo);
#pragma unroll
        for (int e = 0; e < 8; ++e) acc[e] += vn[e] - (tt > 0 ? vo[e] : 0.f);
        const int have = (stream == 2) ? (t + 1 < win ? t + 1 : win) : win;
        const float inv = 1.0f / (float)have;
        float y[8];
#pragma unroll
        for (int e = 0; e < 8; ++e) y[e] = acc[e] * inv - vn[e];
        *(GAS v4u*)(WSB(F, WS_BR) + (size_t)2 * M_PAD * D + (size_t)(rowbase + t) * D + ch * 8) = (v4u){pk2(y[0], y[1]), pk2(y[2], y[3]), pk2(y[4], y[5]), pk2(y[6], y[7])};
    }
}

struct Args { const float* in[19]; float* out; unsigned char* ws; };

__device__ __forceinline__ int opq(int x) { asm volatile("" : "+s"(x)); return x; }

constexpr int CH_TOTAL = 25;
__device__ __forceinline__ int ch_stage(int ci) { return ci < 8 ? 1 : ci < 16 ? 2 : 3; }
__device__ __forceinline__ int ch_first(int s) { return s == 1 ? 0 : s == 2 ? 8 : s == 3 ? 16 : CH_TOTAL; }
__device__ __forceinline__ unsigned ch_cnt(int s) { return s == 0 ? 117u : s == 3 ? 9u : 8u; }
__device__ __forceinline__ void chain_signal(const Frame& F, gu32* ch, int s) {
    asm volatile("s_waitcnt vmcnt(0)" ::: "memory");
    __syncthreads();
    if (F.wave == 0 && lane_lo_() == 0u) {
        __builtin_amdgcn_fence(__ATOMIC_RELEASE, "agent");
        asm volatile("s_waitcnt vmcnt(0)" ::: "memory");
        const unsigned old = __hip_atomic_fetch_add(ch + 64 * (2 + s), 1u, RLX_AGENT);
        if (old + 1u == ch_cnt(s) && s < 3) __hip_atomic_store(ch + 64, (unsigned)ch_first(s + 2), RLX_AGENT);
    }
}
__device__ __forceinline__ void chain_item(const Frame& F, int l, gu32* ch, int ci) {
    const int s = ch_stage(ci);
    if (s == 1) { pg8::Gemm g{WSB(F, WS_BR), lw(F, l, LW_BR), 3 * M_PAD, 3 * D, D}; SmallOrder3 S{ci}; EpiGate E{F.ws};
        pg8::gemm_phase<EpiGate, SmallOrder3, true, true>(F.lds, g, S, E, F.wave); }
    else if (s == 2) { pg8::Gemm g{WSB(F, WS_MIX), lw(F, l, LW_OUT), M_PAD, D, D}; SmallOrder S{ci - 8}; EpiResid E{F.ws, ALPHA, 1.0f};
        pg8::gemm_phase<EpiResid, SmallOrder, true, true>(F.lds, g, S, E, F.wave); }
    else { const int i = ci - 16; ln_rows(F, l * 3 + 1, false, MP + 32 * i, MP + 32 * i + 32, 0, 8); }
    chain_signal(F, ch, s);
}
__device__ __forceinline__ int mq_count(int kq) { return kq == 0 ? 164 : kq == 1 ? 9 : kq == 2 ? 64 : kq == 3 ? 2056 : 1024; }

__global__ void __launch_bounds__(512, 2) mega_fwd(Args args) {
    extern __shared__ __attribute__((aligned(16))) unsigned char lds[];
    Frame F;
    F.lds = (LAS unsigned char*)lds;
    F.MISC = (volatile LAS unsigned*)(F.lds + MISC_OFF);
    F.G = gridDim.x; F.wave = __builtin_amdgcn_readfirstlane((int)threadIdx.x >> 6);
    F.ws = args.ws; F.out = args.out; F.ctl = (gu32*)(args.ws + WS_CTL);
    for (int u = threadIdx.x; u < (LDS_BYTES - LDSCTL_OFF) / 4; u += 512) ((LAS unsigned*)(F.lds + LDSCTL_OFF))[u] = 0u;
    __syncthreads();
    XcdBarrier bar = xcd_barrier_post((unsigned*)(F.ctl + CW_BAR), F.MISC + 8);
#define GRID_BAR() xcd_barrier(bar)

    p0_prologue(F);

    GRID_BAR();

    for (int l = 0; l < DEPTH; ++l) {
        { pg8::Gemm g{WSB(F, WS_HB), lw(F, l, LW_UP1), M_PAD, 2 * DFF, D}; pg8::StaticOrder S; S.init(M_PAD, 2 * DFF, opq(F.G), opq((int)blockIdx.x)); EpiSwiglu E{WSB(F, WS_ACT)};
          pg8::gemm_phase<EpiSwiglu, pg8::StaticOrder, true, true>(F.lds, g, S, E, F.wave); }

        GRID_BAR();
        { pg8::Gemm g{WSB(F, WS_ACT), lw(F, l, LW_DN1), M_PAD, D, DFF}; pg8::StaticOrder S; S.init(MP, D, opq(F.G), opq((int)blockIdx.x));
          EpiResid E{F.ws, ALPHA, 0.5f};
          pg8::gemm_phase<EpiResid, pg8::StaticOrder, true, true>(F.lds, g, S, E, F.wave); }

        GRID_BAR();
        if (blockIdx.x < 16) { const int kh = opq((int)blockIdx.x) >> 3; pg8::Gemm g{WSB(F, WS_ACT) + kh * (DFF / 2), lw(F, l, LW_DN1) + kh * (DFF / 2), M_PAD, D, DFF / 2, DFF}; SmallOrderH S{opq((int)blockIdx.x)};
            EpiPart E{(float*)WSB(F, WS_ACT) + (size_t)kh * 512 * D};
            pg8::gemm_phase<EpiPart, SmallOrderH, true, true>(F.lds, g, S, E, F.wave); }
        else ln_phase(F, l * 3 + 0, false, 0, MP, 16);
        GRID_BAR();
        ln_phase(F, l * 3 + 0, false, MP, M_PAD, 0, true);
        GRID_BAR();
        { pg8::Gemm g{WSB(F, WS_HB), lw(F, l, LW_IN), M_PAD, DIN, D}; pg8::StaticOrder S; S.init(M_PAD, DIN, opq(F.G), opq((int)blockIdx.x));
          EpiWin E{F.ws, F.out, l};
          pg8::gemm_phase<EpiWin, pg8::StaticOrder, true, true>(F.lds, g, S, E, F.wave);
        }

        GRID_BAR();
        { gu32* q = F.ctl + CW_Q + 64 * (l * 8); gu32* ch = F.ctl + CW_CH + 1024 * l;
          int kq = 0, u = __builtin_amdgcn_readfirstlane(grab(F, q)), chain_open = 1;
          for (;;) {
              while (kq < 5 && u >= mq_count(kq)) { ++kq; if (kq < 5) u = __builtin_amdgcn_readfirstlane(grab(F, q + 64 * kq)); }
              unsigned l0_ = lane_lo_(); asm volatile("" : "+v"(l0_));
              const bool t0 = F.wave == 0 && l0_ == 0u;
              unsigned nx = 0u, hd = 0u, rd = 0u;
              if (t0) { if (kq < 5) nx = __hip_atomic_fetch_add(q + 64 * kq, 1u, RLX_AGENT); if (chain_open) { hd = __hip_atomic_load(ch, RLX_AGENT); rd = __hip_atomic_load(ch + 64, RLX_AGENT); } }
              if (kq == 0) { ret_unit(F, l, u < 36 ? 128 + u : u - 36); if (u < 36) chain_signal(F, ch, 0); }
              else if (kq == 1 || kq == 4) { pool_unit(F, l, kq == 1 ? 1024 + u : u); if (kq == 1) chain_signal(F, ch, 0); }
              else if (kq == 2) { attn_unit<true>(F, l, u); chain_signal(F, ch, 0); }
              else if (kq == 3) { attn_unit<false>(F, l, u < 8 ? 64 + 2048 + u : 64 + u - 8); if (u < 8) chain_signal(F, ch, 0); }
              __syncthreads();
              if (t0) { int ci = -1;
                  if (chain_open) {
                      if (kq == 5) { unsigned sp = 0u;
                          for (;;) { hd = __hip_atomic_load(ch, RLX_AGENT); if (hd >= (unsigned)CH_TOTAL) { ci = -2; break; } rd = __hip_atomic_load(ch + 64, RLX_AGENT);
                              if (hd < rd) { unsigned e = hd; if (__hip_atomic_compare_exchange_strong(ch, &e, hd + 1u, __ATOMIC_RELAXED, __ATOMIC_RELAXED, __HIP_MEMORY_SCOPE_AGENT)) { ci = (int)hd; break; } }
                              else { __builtin_amdgcn_s_sleep(2); if ((++sp & 255u) == 0u) { if (xb_ld((unsigned*)(F.ctl + CW_BAR) + XB_TMO)) { ci = -2; break; } if (sp > XB_SPIN_CAP) { atomicAdd((unsigned*)(F.ctl + CW_BAR) + XB_TMO, 1u); ci = -2; break; } } } } }
                      else if (hd >= (unsigned)CH_TOTAL) ci = -3;
                      else if (hd < rd) { unsigned e = hd; if (__hip_atomic_compare_exchange_strong(ch, &e, hd + 1u, __ATOMIC_RELAXED, __ATOMIC_RELAXED, __HIP_MEMORY_SCOPE_AGENT)) ci = (int)hd; }
                      if (ci >= 0) { __builtin_amdgcn_fence(__ATOMIC_ACQUIRE, "agent"); asm volatile("s_waitcnt vmcnt(0)" ::: "memory"); }
                  } else if (kq == 5) ci = -2;
                  F.MISC[16] = nx; F.MISC[17] = (unsigned)ci; }
              __syncthreads();
              u = __builtin_amdgcn_readfirstlane((int)F.MISC[16]); const int ci = __builtin_amdgcn_readfirstlane((int)F.MISC[17]);
              if (ci == -2) break;
              if (ci == -3) chain_open = 0;
              if (ci >= 0) chain_item(F, l, ch, ci);
          }
          __syncthreads(); }
        GRID_BAR();
        { pg8::Gemm g{WSB(F, WS_BR), lw(F, l, LW_BR), 3 * M_PAD, 3 * D, D}; Order3 S; S.init(MP, D, opq(F.G), opq((int)blockIdx.x)); EpiGate E{F.ws};
          pg8::gemm_phase<EpiGate, Order3, true, true>(F.lds, g, S, E, F.wave); }

        GRID_BAR();
        { pg8::Gemm g{WSB(F, WS_MIX), lw(F, l, LW_OUT), M_PAD, D, D}; pg8::StaticOrder S; S.init(MP, D, opq(F.G), opq((int)blockIdx.x));
          EpiResid E{F.ws, ALPHA, 1.0f};
          pg8::gemm_phase<EpiResid, pg8::StaticOrder, true, true>(F.lds, g, S, E, F.wave); }

        GRID_BAR();
        if (blockIdx.x < 44) { pg8::Gemm g{WSB(F, WS_HB), lw(F, l, LW_UP2), M_PAD, 2 * DFF, D}; SmallOrderW S{opq((int)blockIdx.x)}; EpiSwiglu E{WSB(F, WS_ACT)};
            pg8::gemm_phase<EpiSwiglu, SmallOrderW, true, true>(F.lds, g, S, E, F.wave); }
        else ln_phase(F, l * 3 + 1, false, 0, MP, 44);
        GRID_BAR();
        { pg8::Gemm g{WSB(F, WS_HB), lw(F, l, LW_UP2), M_PAD, 2 * DFF, D}; pg8::StaticOrder S; S.init(MP, 2 * DFF, opq(F.G), opq((int)blockIdx.x)); EpiSwiglu E{WSB(F, WS_ACT)};
          pg8::gemm_phase<EpiSwiglu, pg8::StaticOrder, true, true>(F.lds, g, S, E, F.wave); }

        GRID_BAR();
        { pg8::Gemm g{WSB(F, WS_ACT), lw(F, l, LW_DN2), M_PAD, D, DFF}; pg8::StaticOrder S; S.init(MP, D, opq(F.G), opq((int)blockIdx.x));
          EpiResid E{F.ws, ALPHA, 0.5f};
          pg8::gemm_phase<EpiResid, pg8::StaticOrder, true, true>(F.lds, g, S, E, F.wave); }

        GRID_BAR();
        if (blockIdx.x < 16) { const int kh = opq((int)blockIdx.x) >> 3; pg8::Gemm g{WSB(F, WS_ACT) + kh * (DFF / 2), lw(F, l, LW_DN2) + kh * (DFF / 2), M_PAD, D, DFF / 2, DFF}; SmallOrderH S{opq((int)blockIdx.x)};
            EpiPart E{(float*)WSB(F, WS_ACT) + (size_t)kh * 512 * D};
            pg8::gemm_phase<EpiPart, SmallOrderH, true, true>(F.lds, g, S, E, F.wave); }
        else ln_phase(F, l * 3 + 2, l + 1 == DEPTH, 0, MP, 16);
        GRID_BAR();
        ln_phase(F, l * 3 + 2, l + 1 == DEPTH, MP, M_PAD, 0, true);
        if (l + 1 < DEPTH) GRID_BAR();
    }
}

extern "C" void kernel_launch(void* const* d_in, const int* in_sizes, int n_in, void* d_out, int out_size, void* d_ws, size_t ws_size, hipStream_t stream) {
    static int grid = 0;
    if (grid == 0) {
        if (n_in != 19 || (size_t)out_size != O_END || ws_size < WS_END) { fprintf(stderr, "kernel_launch: unexpected sizes (n_in %d out %d ws %zu need %zu)\n", n_in, out_size, ws_size, (size_t)WS_END); grid = -1; return; }
        int dev = 0, cus = 0, per_cu = 0;
        if (hipGetDevice(&dev) != hipSuccess || hipDeviceGetAttribute(&cus, hipDeviceAttributeMultiprocessorCount, dev) != hipSuccess) { grid = -1; return; }
        if (hipFuncSetAttribute((const void*)mega_fwd, hipFuncAttributeMaxDynamicSharedMemorySize, LDS_BYTES) != hipSuccess) { fprintf(stderr, "kernel_launch: hipFuncSetAttribute failed\n"); grid = -1; return; }
        if (hipOccupancyMaxActiveBlocksPerMultiprocessor(&per_cu, (const void*)mega_fwd, 512, LDS_BYTES) != hipSuccess || per_cu < 1) { fprintf(stderr, "kernel_launch: occupancy query says %d\n", per_cu); }
        (void)hipGetLastError();
        grid = cus;
    }
    if (grid < 0) return;
    if (hipMemsetAsync((char*)d_ws + WS_CTL, 0, CTL_ZERO_BYTES, stream) != hipSuccess) return;
    Args a{};
    for (int i = 0; i < 19; ++i) a.in[i] = (const float*)d_in[i];
    a.out = (float*)d_out; a.ws = (unsigned char*)d_ws;
    hipLaunchKernelGGL(mega_fwd, dim3(grid), dim3(512), LDS_BYTES, stream, a);
}
```

```cpp
#include <hip/hip_runtime.h>
#include <cstdio>
#include <cstdint>
__device__ __forceinline__ unsigned lane_lo_() { unsigned l; asm volatile("v_mbcnt_lo_u32_b32 %0, -1, 0" : "=v"(l)); return l; }
__device__ __forceinline__ int lane_id_() { unsigned l; asm volatile("v_mbcnt_lo_u32_b32 %0, -1, 0\n\tv_mbcnt_hi_u32_b32 %0, -1, %0" : "=v"(l)); return (int)l; }
namespace pg8 {
#define PG8_LAS __attribute__((address_space(3)))
typedef unsigned short bf16_t;
typedef short bf16x8 __attribute__((ext_vector_type(8)));
typedef float f32x4 __attribute__((ext_vector_type(4)));
typedef unsigned u32x4 __attribute__((ext_vector_type(4)));
constexpr int BM = 256, BK = 64, HALF = 128, HTB = HALF * BK * 2  , STAGE_BYTES = 8 * HTB, NXCD = 8, WGM = 4;

__host__ __device__ __forceinline__ int lds_byte(int r, int c) { const int st = (r >> 4) * 2 + (c >> 5), rr = r & 15, cc = c & 31, ob = rr * 64 + cc * 2; return st * 1024 + (ob ^ (((ob >> 9) & 1) << 5)); }
__host__ __device__ __forceinline__ void stage_rc(int b, int& R, int& C) { const int st = b / 1024, sb = b % 1024, swz = sb ^ (((sb >> 9) & 1) << 5); R = (st >> 1) * 16 + swz / 64; C = (st & 1) * 32 + (swz % 64) / 2; }
__host__ __device__ __forceinline__ int perm32(int rho) { const int n = rho >> 4, i = rho & 15; return 8 * (i >> 2) + 4 * n + (i & 3); }

struct Unit { int pm, pn; };
struct Gemm { const bf16_t* A; const bf16_t* Bt; int M, N, K; int ld = 0; };

struct StaticOrder {
    int nM, nN, nwg, G, c;
    __host__ __device__ void init(int M, int N, int G_, int c_) { nM = M / BM; nN = N / BM; nwg = nM * nN; G = G_; c = c_; }
    __host__ __device__ bool next(int i, Unit& u) const {
        const long L = (long)i * G + c; if (L >= nwg) return false;
        int wgid = (int)L; { const int q = nwg / NXCD, r = nwg % NXCD, xcd = wgid % NXCD, off = wgid / NXCD; wgid = (xcd < r ? xcd * (q + 1) : r * (q + 1) + (xcd - r) * q) + off; }
        const int nig = WGM * nN, gid = wgid / nig, fm = gid * WGM, gsz = (nM - fm) < WGM ? (nM - fm) : WGM;
        u.pm = fm + ((wgid % nig) % gsz); u.pn = (wgid % nig) / gsz; return true;
    }
    __device__ __forceinline__ void a_ready(const Unit&) const {}
    __device__ __forceinline__ void done(const Unit&) const {}
};

__device__ __forceinline__ unsigned cvt_pk_bf16(float lo, float hi) { unsigned r; asm volatile("v_cvt_pk_bf16_f32 %0, %1, %2" : "=v"(r) : "v"(lo), "v"(hi)); return r; }
template <class Epi, class Sched, bool ALIGN_EPI = false, bool SP2 = false>
__device__ __forceinline__ void gemm_phase(PG8_LAS unsigned char* lds, const Gemm g, const Sched& S, const Epi& E, const int wave_id) {
    int lane_ = lane_id_(); asm volatile("" : "+v"(lane_));
    const int tid = wave_id * 64 + lane_;
    int widq_ = wave_id; asm volatile("" : "+s"(widq_));
    const int wid = widq_, lane = tid & 63, wr = wid >> 2, wc = wid & 3, fr = lane & 15, fq = lane >> 4;
    const int K = g.K, nt = K / BK, LD = g.ld > 0 ? g.ld : K;
    unsigned voffA[2], voffB[2];
#pragma unroll
    for (int i = 0; i < 2; ++i) { int R, C; stage_rc(tid * 16 + i * 8192, R, C); const int Rb = Epi::PERM ? ((R & ~31) + perm32(R & 31)) : R;
        voffA[i] = (unsigned)(R * LD + C) * 2u; voffB[i] = (unsigned)(Rb * LD + C) * 2u; }
    const size_t kstep = (size_t)(BK * 2);
    const size_t hstep = (size_t)HALF * LD * 2;
    const size_t tstep = 2 * hstep;
    const unsigned ldsw = (unsigned)wid * 1024u;
    const int aoff = lds_byte(wr * 64 + fr, fq * 8), boff = lds_byte(wc * 32 + fr, fq * 8);
#define PG8_SA(b, h) (((b) * 2 + (h)) * HTB)
#define PG8_SB(b, h) ((4 + (b) * 2 + (h)) * HTB)
#define PG8_STAGE(bufoff, gbase, voff) do { _Pragma("unroll") for (int _i = 0; _i < 2; ++_i) \
        __builtin_amdgcn_global_load_lds((const unsigned*)((const char*)(gbase) + (voff)[_i]), (PG8_LAS unsigned*)(lds + (bufoff) + ldsw + _i * 8192), 16, 0, 0); } while (0)
#define PG8_LDA(dst, b, h) do { _Pragma("unroll") for (int m = 0; m < 4; ++m) _Pragma("unroll") for (int k = 0; k < 2; ++k) dst[m][k] = *(const PG8_LAS bf16x8*)(lds + PG8_SA(b, h) + aoff + m * 2048 + k * 1024); } while (0)
#define PG8_LDB(dst, b, h) do { _Pragma("unroll") for (int n = 0; n < 2; ++n) _Pragma("unroll") for (int k = 0; k < 2; ++k) dst[n][k] = *(const PG8_LAS bf16x8*)(lds + PG8_SB(b, h) + boff + n * 2048 + k * 1024); } while (0)
#define PG8_MMA(ai, bj, At, Bt) do { __builtin_amdgcn_s_setprio(1); _Pragma("unroll") for (int m = 0; m < 4; ++m) _Pragma("unroll") for (int n = 0; n < 2; ++n) _Pragma("unroll") for (int k = 0; k < 2; ++k) \
        acc[ai][bj][m][n] = __builtin_amdgcn_mfma_f32_16x16x32_bf16(Bt[n][k], At[m][k], acc[ai][bj][m][n], 0, 0, 0); __builtin_amdgcn_s_setprio(0); } while (0)
#define PG8_WAIT_V(n) asm volatile("s_waitcnt vmcnt(" #n ")" ::: "memory")
#define PG8_WAIT_VN(n) asm volatile("s_waitcnt vmcnt(%0)" :: "n"(n) : "memory")
#define PG8_WAIT_L(n) asm volatile("s_waitcnt lgkmcnt(" #n ")" ::: "memory")
#define PG8_BAR __builtin_amdgcn_s_barrier()
#define PG8_SCHED __builtin_amdgcn_sched_barrier(0)
    Unit cur, nxt; int ui = 0;
    if (!S.next(0, cur)) return;
    f32x4 acc[2][2][4][2];
#pragma unroll
    for (int a = 0; a < 2; ++a)
#pragma unroll
        for (int b = 0; b < 2; ++b)
#pragma unroll
            for (int m = 0; m < 4; ++m)
#pragma unroll
                for (int n = 0; n < 2; ++n) acc[a][b][m][n] = (f32x4){0.f, 0.f, 0.f, 0.f};
    bf16x8 At[4][2], B0[2][2], B1[2][2];
    const char* cA = (const char*)g.A + (size_t)cur.pm * tstep; const char* cB = (const char*)g.Bt + (size_t)cur.pn * tstep;
    S.a_ready(cur);
    if constexpr (SP2) {
        PG8_STAGE(PG8_SB(0, 0), cB, voffB); PG8_STAGE(PG8_SB(0, 1), cB + hstep, voffB); PG8_STAGE(PG8_SA(0, 0), cA, voffA); PG8_STAGE(PG8_SA(0, 1), cA + hstep, voffA);
        if (wr == 1) PG8_BAR;
        PG8_WAIT_V(2); PG8_BAR;
        PG8_STAGE(PG8_SB(1, 0), cB + kstep, voffB); PG8_STAGE(PG8_SA(1, 0), cA + kstep, voffA); PG8_STAGE(PG8_SB(1, 1), cB + hstep + kstep, voffB);
        PG8_WAIT_V(6); PG8_BAR;
    } else {
        PG8_STAGE(PG8_SB(0, 0), cB, voffB); PG8_STAGE(PG8_SA(0, 0), cA, voffA); PG8_STAGE(PG8_SB(0, 1), cB + hstep, voffB); PG8_STAGE(PG8_SA(0, 1), cA + hstep, voffA);
        if (wr == 1) PG8_BAR;
        PG8_WAIT_V(4); PG8_BAR;
        PG8_STAGE(PG8_SB(1, 0), cB + kstep, voffB); PG8_STAGE(PG8_SA(1, 0), cA + kstep, voffA); PG8_STAGE(PG8_SB(1, 1), cB + hstep + kstep, voffB);
        PG8_WAIT_V(6); PG8_BAR;
    }
    for (;;) {
        const bool has_next = S.next(ui + 1, nxt);
        const char* nA = has_next ? (const char*)g.A + (size_t)nxt.pm * tstep : cA; const char* nB = has_next ? (const char*)g.Bt + (size_t)nxt.pn * tstep : cB;
        for (int t = 0; t < nt; t += 2) {
            const bool last = (t == nt - 2);
            const char* a1 = cA + (size_t)(t + 1) * kstep;
            const char* a2 = last ? nA : cA + (size_t)(t + 2) * kstep; const char* b2 = last ? nB : cB + (size_t)(t + 2) * kstep;
            const char* a3 = a2 + kstep; const char* b3 = b2 + kstep;
            if (last && has_next) S.a_ready(nxt);
            if constexpr (SP2) {
            int tz_ = __builtin_amdgcn_readfirstlane(t | (ui > 0 ? 0 : 1)); asm volatile("" : "+s"(tz_));
            const bool strict = !(Epi::NS > 0 && tz_ == 0);
            PG8_LDB(B0, 0, 0); PG8_LDB(B1, 0, 1); PG8_SCHED; PG8_LDA(At, 0, 0); PG8_STAGE(PG8_SA(1, 1), a1 + hstep, voffA);
            PG8_WAIT_VN(8 + Epi::NS); if (strict) PG8_WAIT_V(8); PG8_WAIT_L(0); PG8_BAR; PG8_MMA(0, 0, At, B0); PG8_MMA(0, 1, At, B1); PG8_BAR; PG8_SCHED;
            PG8_LDA(At, 0, 1); PG8_STAGE(PG8_SB(0, 0), b2, voffB); PG8_STAGE(PG8_SB(0, 1), b2 + hstep, voffB); PG8_STAGE(PG8_SA(0, 0), a2, voffA);
            PG8_WAIT_VN(8 + Epi::NS); if (strict) PG8_WAIT_V(8); PG8_WAIT_L(0); PG8_BAR; PG8_MMA(1, 0, At, B0); PG8_MMA(1, 1, At, B1); PG8_BAR; PG8_SCHED;
            PG8_LDB(B0, 1, 0); PG8_LDB(B1, 1, 1); PG8_SCHED; PG8_LDA(At, 1, 0); PG8_STAGE(PG8_SA(0, 1), a2 + hstep, voffA);
            PG8_WAIT_V(8); PG8_WAIT_L(0); PG8_BAR; PG8_MMA(0, 0, At, B0); PG8_MMA(0, 1, At, B1); PG8_BAR; PG8_SCHED;
            PG8_LDA(At, 1, 1); PG8_STAGE(PG8_SB(1, 0), b3, voffB); PG8_STAGE(PG8_SB(1, 1), b3 + hstep, voffB); PG8_STAGE(PG8_SA(1, 0), a3, voffA);
            PG8_WAIT_V(8); PG8_WAIT_L(0); PG8_BAR; PG8_MMA(1, 0, At, B0); PG8_MMA(1, 1, At, B1); PG8_BAR; PG8_SCHED;
            } else {
            PG8_LDB(B0, 0, 0); PG8_SCHED; PG8_LDA(At, 0, 0); PG8_STAGE(PG8_SA(1, 1), a1 + hstep, voffA);
            PG8_WAIT_L(8); PG8_BAR; PG8_WAIT_L(0); PG8_MMA(0, 0, At, B0); PG8_BAR; PG8_SCHED;
            PG8_LDB(B1, 0, 1); PG8_STAGE(PG8_SB(0, 0), b2, voffB);
            PG8_BAR; PG8_WAIT_L(0); PG8_MMA(0, 1, At, B1); PG8_BAR;
            PG8_LDA(At, 0, 1); PG8_STAGE(PG8_SA(0, 0), a2, voffA);
            PG8_BAR; PG8_WAIT_L(0); PG8_MMA(1, 0, At, B0); PG8_BAR; PG8_SCHED;
            PG8_STAGE(PG8_SB(0, 1), b2 + hstep, voffB);
            PG8_WAIT_V(6); PG8_BAR; PG8_MMA(1, 1, At, B1); PG8_BAR;
            PG8_LDB(B0, 1, 0); PG8_SCHED; PG8_LDA(At, 1, 0); PG8_STAGE(PG8_SA(0, 1), a2 + hstep, voffA);
            PG8_WAIT_L(8); PG8_BAR; PG8_WAIT_L(0); PG8_MMA(0, 0, At, B0); PG8_BAR; PG8_SCHED;
            PG8_LDB(B1, 1, 1); PG8_STAGE(PG8_SB(1, 0), b3, voffB);
            PG8_BAR; PG8_WAIT_L(0); PG8_MMA(0, 1, At, B1); PG8_BAR;
            PG8_LDA(At, 1, 1); PG8_STAGE(PG8_SA(1, 0), a3, voffA);
            PG8_BAR; PG8_WAIT_L(0); PG8_MMA(1, 0, At, B0); PG8_BAR; PG8_SCHED;
            PG8_STAGE(PG8_SB(1, 1), b3 + hstep, voffB);
            PG8_WAIT_V(6); PG8_BAR; PG8_MMA(1, 1, At, B1); PG8_BAR;
            }
        }
        if constexpr (ALIGN_EPI) { if (wr == 0) PG8_BAR; }
        const bool keep_acc = E(acc, cur, wr, wc, fr, fq);
        if (!has_next) break;
        if (!keep_acc) {
#pragma unroll
        for (int a = 0; a < 2; ++a)
#pragma unroll
            for (int b = 0; b < 2; ++b)
#pragma unroll
                for (int m = 0; m < 4; ++m)
#pragma unroll
                    for (int n = 0; n < 2; ++n) acc[a][b][m][n] = (f32x4){0.f, 0.f, 0.f, 0.f};
        }
        cur = nxt; cA = nA; cB = nB; ++ui;
        if constexpr (ALIGN_EPI) { if (wr == 1) PG8_BAR; }
    }
    PG8_WAIT_V(0);
    if constexpr (!ALIGN_EPI) { if (wr == 0) PG8_BAR; }
    PG8_BAR;
#undef PG8_SA
#undef PG8_SB
#undef PG8_STAGE
#undef PG8_LDA
#undef PG8_LDB
#undef PG8_MMA
#undef PG8_WAIT_V
#undef PG8_WAIT_VN
#undef PG8_WAIT_L
#undef PG8_BAR
#undef PG8_SCHED
}
}

constexpr int D = 1024, NB = 32, T = 2048, DEPTH = 2, SBATCH = 8, ST = 32, PAST = 4096, NMETA = 16;
constexpr int HRET = 4, DKR = 128, DVR = 256, HSB = 8, DSB = 128, DFF = 2816, DIN = 10240, PBUF = 15;
constexpr int MP = NB * T;
constexpr int ROW_S = MP;
constexpr int ROW_M = MP + SBATCH * ST;
constexpr int M_PAD = ROW_M + 256;
constexpr int NPANEL = M_PAD / 256;
constexpr float LN_EPS = 1e-5f;
constexpr float ALPHA = 1.41421356237f;
constexpr float LOG2E = 1.44269504089f;
constexpr int KT_SP = PAST + ST;
constexpr int KT_PP = NMETA + T;

constexpr size_t O_YP = 0;
constexpr size_t O_YS = O_YP + (size_t)NB * T * D;
constexpr size_t O_KP = O_YS + (size_t)SBATCH * ST * D;
constexpr size_t O_VP = O_KP + (size_t)DEPTH * NB * KT_PP * D;
constexpr size_t O_RP = O_VP + (size_t)DEPTH * NB * KT_PP * D;
constexpr size_t O_PP = O_RP + (size_t)DEPTH * NB * HRET * DKR * DVR;
constexpr size_t O_KS = O_PP + (size_t)DEPTH * NB * PBUF * D;
constexpr size_t O_VS = O_KS + (size_t)DEPTH * SBATCH * ST * D;
constexpr size_t O_RS = O_VS + (size_t)DEPTH * SBATCH * ST * D;
constexpr size_t O_PS = O_RS + (size_t)DEPTH * SBATCH * HRET * DKR * DVR;
constexpr size_t O_END = O_PS + (size_t)DEPTH * SBATCH * PBUF * D;
static_assert(O_END == 350666752ull, "output size");

constexpr size_t MiB = 1u << 20;
constexpr size_t AL(size_t x) { return (x + 4095) & ~(size_t)4095; }
constexpr size_t WS_CTL = 0, CTL_ZERO_BYTES = 1 * MiB;
constexpr size_t WS_YB = WS_CTL + CTL_ZERO_BYTES;
constexpr size_t WS_HB = AL(WS_YB + (size_t)M_PAD * D * 2);
constexpr size_t WS_ACT = AL(WS_HB + (size_t)M_PAD * D * 2);
constexpr size_t WS_QR = AL(WS_ACT + (size_t)M_PAD * DFF * 2);
constexpr size_t WS_KR = AL(WS_QR + (size_t)M_PAD * 512 * 2);
constexpr size_t WS_VR = AL(WS_KR + (size_t)M_PAD * 512 * 2);
constexpr size_t WS_GR = AL(WS_VR + (size_t)M_PAD * D * 2);
constexpr size_t WS_QS = AL(WS_GR + (size_t)M_PAD * D * 2);
constexpr size_t WS_KS = AL(WS_QS + (size_t)M_PAD * D * 2);
constexpr size_t WS_VS = AL(WS_KS + (size_t)M_PAD * D * 2);
constexpr size_t WS_U = AL(WS_VS + (size_t)M_PAD * D * 2);
constexpr size_t WS_GT = AL(WS_U + (size_t)M_PAD * D * 2);
constexpr size_t WS_BR = AL(WS_GT + (size_t)M_PAD * 3 * D * 2);
constexpr size_t WS_MIX = AL(WS_BR + (size_t)3 * M_PAD * D * 2);
constexpr size_t WS_W = AL(WS_MIX + (size_t)M_PAD * D * 2);
constexpr size_t LW_UP1 = 0;
constexpr size_t LW_DN1 = LW_UP1 + (size_t)2 * DFF * D * 2;
constexpr size_t LW_IN = LW_DN1 + (size_t)D * DFF * 2;
constexpr size_t LW_BR = LW_IN + (size_t)DIN * D * 2;
constexpr size_t LW_OUT = LW_BR + (size_t)3 * D * D * 2;
constexpr size_t LW_UP2 = LW_OUT + (size_t)D * D * 2;
constexpr size_t LW_DN2 = LW_UP2 + (size_t)2 * DFF * D * 2;
constexpr size_t LW_SIZE = AL(LW_DN2 + (size_t)D * DFF * 2);
constexpr size_t WS_END = WS_W + DEPTH * LW_SIZE;
static_assert(WS_END < (size_t)4000 * MiB, "workspace budget");

constexpr int CW_BAR = 4096;
constexpr int CW_Q = 16384;
constexpr int CW_CH = 24576;
constexpr int CW_DBG = 32768;
constexpr int CW_KN = 65536;
static_assert((CW_KN + DEPTH * 33 * 8 * 16) * 4 <= (int)CTL_ZERO_BYTES, "ctl region");

constexpr int RING_BYTES = 131072;
constexpr int LDSCTL_OFF = RING_BYTES, MISC_OFF = LDSCTL_OFF + 320;
constexpr int LDS_BYTES = 147456;

#define GAS __attribute__((address_space(1)))
#define LAS __attribute__((address_space(3)))
typedef unsigned short bf16;
typedef unsigned v4u __attribute__((ext_vector_type(4)));
typedef unsigned v2u __attribute__((ext_vector_type(2)));
typedef float f32x4 __attribute__((ext_vector_type(4)));
typedef short bf16x8 __attribute__((ext_vector_type(8)));
typedef short s16x4 __attribute__((ext_vector_type(4)));
typedef GAS unsigned gu32;
#define RLX_AGENT __ATOMIC_RELAXED, __HIP_MEMORY_SCOPE_AGENT
__device__ __forceinline__ unsigned f2bf(float f) { unsigned u = __builtin_bit_cast(unsigned, f); return (u + 0x7fffu + ((u >> 16) & 1u)) >> 16; }
__device__ __forceinline__ unsigned pk2(float lo, float hi) { return f2bf(lo) | (f2bf(hi) << 16); }
__device__ __forceinline__ float bf2f(unsigned short b) { return __builtin_bit_cast(float, (unsigned)b << 16); }
__device__ __forceinline__ float bflo(unsigned w) { return __builtin_bit_cast(float, w << 16); }
__device__ __forceinline__ float bfhi(unsigned w) { return __builtin_bit_cast(float, w & 0xffff0000u); }
__device__ __forceinline__ float fast_exp2(float x) { return __builtin_amdgcn_exp2f(x); }
__device__ __forceinline__ float fast_log2(float x) { return __builtin_amdgcn_logf(x); }
__device__ __forceinline__ float fast_rcp(float x) { return __builtin_amdgcn_rcpf(x); }
__device__ __forceinline__ float sigmoidf_(float x) { return fast_rcp(1.0f + fast_exp2(-x * LOG2E)); }
__device__ __forceinline__ float siluf_(float x) { return x * sigmoidf_(x); }
__device__ __forceinline__ float wave_sum(float v) {
#pragma unroll
    for (int o = 1; o < 64; o <<= 1) v += __shfl_xor(v, o);
    return v;
}
#define XB_TMO      128
#define XB_XCNT(j)  (256  + 64 * (j))
#define XB_XSUB(j)  (1280 + 64 * (j))
#define XB_XGEN(j)  (2304 + 64 * (j))
#define XB_TOP      3328
#define XB_TOPGEN   3392
#define XCD_BAR_WORDS 3456
#define XB_SPIN_CAP (1u << 20)

__device__ __forceinline__ unsigned xb_ld(unsigned* p)              { return __hip_atomic_load(p, __ATOMIC_RELAXED, __HIP_MEMORY_SCOPE_AGENT); }
__device__ __forceinline__ unsigned xb_add(unsigned* p, unsigned v) { return __hip_atomic_fetch_add(p, v, __ATOMIC_RELAXED, __HIP_MEMORY_SCOPE_AGENT); }
__device__ __forceinline__ unsigned xb_xcc_id() { return (unsigned)__builtin_amdgcn_s_getreg((3 << 11) | 20) & 0xFu; }
#define XB_SPIN(cond, bar) do { unsigned _sp = 0; while (cond) { __builtin_amdgcn_s_sleep(1); \
    if ((++_sp & 255u) == 0u) { if (xb_ld(&(bar)[XB_TMO])) break; if (_sp > XB_SPIN_CAP) { atomicAdd(&(bar)[XB_TMO], 1u); break; } } } } while (0)

struct XcdBarrier {
    unsigned* bar; unsigned x; unsigned w0;
    volatile LAS unsigned* st;
};

__device__ __forceinline__ XcdBarrier xcd_barrier_post(unsigned* bar, volatile LAS unsigned* st) {
    XcdBarrier b; b.bar = bar; b.x = xb_xcc_id(); b.st = st; b.w0 = (__builtin_amdgcn_readfirstlane((int)threadIdx.x >> 6) == 0) ? 1u : 0u;
    if (threadIdx.x == 0) (void)xb_add(&bar[XB_XCNT(b.x)], 1u);
    return b;
}
__device__ __forceinline__ void xcd_barrier_complete(unsigned* bar, unsigned x, unsigned& nloc, unsigned& nx) {
    const unsigned G = gridDim.x * gridDim.y * gridDim.z;
    unsigned sum, cnt, mine, sp = 0u;
    for (;;) {
        sum = 0u; cnt = 0u; mine = 0u;
#pragma unroll
        for (unsigned j = 0; j < 16; ++j) { const unsigned c = xb_ld(&bar[XB_XCNT(j)]); sum += c; cnt += (c > 0u) ? 1u : 0u; mine = (j == x) ? c : mine; }
        if (sum == G) break;
        __builtin_amdgcn_s_sleep(1);
        if ((++sp & 255u) == 0u) { if (xb_ld(&bar[XB_TMO])) break; if (sp > XB_SPIN_CAP) { atomicAdd(&bar[XB_TMO], 1u); break; } }
    }
    nloc = mine > 0u ? mine : 1u; nx = cnt > 0u ? cnt : 1u;
}

__device__ __forceinline__ void xcd_barrier(const XcdBarrier& b) {
    asm volatile("s_waitcnt vmcnt(0)" ::: "memory");
    __syncthreads();
    if (b.w0 != 0u && lane_lo_() == 0u) {
        unsigned* bar = b.bar; unsigned bx = b.x; asm volatile("" : "+s"(bar), "+s"(bx));
        __builtin_amdgcn_s_waitcnt(0);
        unsigned nloc = b.st[0], nx = b.st[1];
        if (nloc == 0u) { xcd_barrier_complete(bar, bx, nloc, nx); b.st[0] = nloc; b.st[1] = nx; }
        const unsigned old = xb_add(&bar[XB_XSUB(bx)], 1u);
        const unsigned gen = old / nloc;
        if (old + 1u == (gen + 1u) * nloc) {
            __builtin_amdgcn_fence(__ATOMIC_RELEASE, "agent");
            asm volatile("s_waitcnt vmcnt(0)" ::: "memory");
            const unsigned og = xb_add(&bar[XB_TOP], 1u);
            const unsigned tg = og / nx;
            if (og + 1u == (tg + 1u) * nx) xb_add(&bar[XB_TOPGEN], 1u);
            else XB_SPIN(xb_ld(&bar[XB_TOPGEN]) == tg, bar);
            __builtin_amdgcn_fence(__ATOMIC_ACQUIRE, "agent");
            xb_add(&bar[XB_XGEN(bx)], 1u);
            asm volatile("s_waitcnt vmcnt(0)" ::: "memory");
        } else {
            XB_SPIN(xb_ld(&bar[XB_XGEN(bx)]) == gen, bar);
            __builtin_amdgcn_fence(__ATOMIC_ACQUIRE, "agent");
            asm volatile("s_waitcnt vmcnt(0)" ::: "memory");
        }
    }
    __syncthreads();
}

struct Frame {
    LAS unsigned char* lds;
    volatile LAS unsigned* MISC;
    gu32* ctl;
    int G, wave;
    float* out; unsigned char* ws;
};
__device__ __forceinline__ const float* in_ptr(int i) {
    const __attribute__((address_space(4))) char* k = (const __attribute__((address_space(4))) char*)__builtin_amdgcn_kernarg_segment_ptr();
    asm volatile("" : "+s"(k));
    return *(const float* const __attribute__((address_space(4)))*)(k + 8 * i);
}
enum { IN_XP = 0, IN_XS, IN_CK, IN_CV, IN_SRET, IN_SPOOL, IN_META, IN_WIN, IN_RETG, IN_PMIX, IN_PSCALE, IN_WBR, IN_WOUT, IN_UP1, IN_DN1, IN_UP2, IN_DN2, IN_LNG, IN_LNB };
__device__ __forceinline__ unsigned char* wsq(unsigned char* p) { asm volatile("" : "+s"(p)); return p; }
#define WSB(F, off) ((bf16*)(wsq((F).ws) + (off)))
struct TC { int tid, lane, wave; };
__device__ __forceinline__ TC thread_coords(int wave) { TC c; int l = lane_id_(); asm volatile("" : "+v"(l)); c.lane = l; c.wave = wave; c.tid = wave * 64 + l; return c; }
__device__ __forceinline__ bf16* lw(const Frame& F, int l, size_t off) { return (bf16*)(wsq(F.ws) + WS_W + (size_t)l * LW_SIZE + off); }
__device__ __forceinline__ float* yrow(const Frame& F, int m) {
    if (m < MP) return F.out + O_YP + (size_t)m * D;
    if (m < ROW_M) return F.out + O_YS + (size_t)(m - ROW_S) * D;
    return nullptr;
}

__device__ __forceinline__ int srccol(int kind, int n) {
    if (kind == 1) { const int pn = n >> 8, p = n & 255, bj = p >> 7, wc = (p >> 5) & 3, fq = (p >> 3) & 3, nn = (p >> 2) & 1, e = p & 3;
        return (nn ? DFF : 0) + 128 * pn + 64 * bj + 16 * wc + 4 * fq + e; }
    if (kind == 2 && n < 1024) { const int hb_ = n & ~127, p = n & 127, wc = p >> 5, fq = (p >> 3) & 3, nn = (p >> 2) & 1, e = p & 3;
        return hb_ + 16 * wc + 4 * fq + e + 64 * nn; }
    return n;
}
__device__ __forceinline__ void p0_transpose_item(const float* W, int K, int ldw, int N, bf16* WT, int kind, LAS float* scr, int item, int lane) {
    const int nblk = N / 32, kb = item / nblk, nb = item % nblk, k0 = 64 * kb, n0 = 32 * nb;
    const int sc = srccol(kind, n0 + (lane & 31));
    float t_[32];
#pragma unroll
    for (int i = 0; i < 32; ++i) t_[i] = W[(size_t)(k0 + 2 * i + (lane >> 5)) * ldw + sc];
#pragma unroll
    for (int i = 0; i < 32; ++i) scr[(2 * i + (lane >> 5)) * 33 + (lane & 31)] = t_[i];
    asm volatile("s_waitcnt lgkmcnt(0)" ::: "memory");
    const int c = lane & 7;
#pragma unroll
    for (int j = 0; j < 4; ++j) { const int n = (lane >> 3) + 8 * j; const LAS float* s = scr + (8 * c) * 33 + n;
        v4u o; o.x = pk2(s[0 * 33], s[1 * 33]); o.y = pk2(s[2 * 33], s[3 * 33]); o.z = pk2(s[4 * 33], s[5 * 33]); o.w = pk2(s[6 * 33], s[7 * 33]);
        *(GAS v4u*)(WT + (size_t)(n0 + n) * K + k0 + 8 * c) = o; }
    asm volatile("s_waitcnt lgkmcnt(0)" ::: "memory");
}
__device__ __forceinline__ void p0_poolfold_item(const float* mixw  , const float* scale  , const float* wb2  , bf16* WT  , int item, int lane) {
    const int g = item >> 7, r = item & 127, cb = r >> 4, nb = r & 15;
    const int n = nb * 64 + lane, c0 = cb * 32;
    float acc[32];
#pragma unroll
    for (int i = 0; i < 32; ++i) acc[i] = 0.f;
    const float* mw = mixw + ((size_t)g * 256 + c0) * 256;
    for (int d0 = 0; d0 < 256; d0 += 8) {
        float a[8];
#pragma unroll
        for (int j = 0; j < 8; ++j) a[j] = scale[g * 256 + d0 + j] * wb2[(size_t)(g * 256 + d0 + j) * D + n];
#pragma unroll
        for (int i = 0; i < 32; ++i)
#pragma unroll
            for (int j = 0; j < 8; ++j) acc[i] += mw[(size_t)i * 256 + d0 + j] * a[j];
    }
    bf16* dst = WT + (size_t)n * D + g * 256 + c0;
#pragma unroll
    for (int i = 0; i < 32; i += 8) { v4u o; o.x = pk2(acc[i], acc[i + 1]); o.y = pk2(acc[i + 2], acc[i + 3]); o.z = pk2(acc[i + 4], acc[i + 5]); o.w = pk2(acc[i + 6], acc[i + 7]); *(GAS v4u*)(dst + i) = o; }
}
__device__ __forceinline__ void p0_prologue(Frame& F) {
    const TC tc = thread_coords(F.wave); const int gw = blockIdx.x * 8 + tc.wave, NGW = F.G * 8;
    LAS float* scr = (LAS float*)(F.lds + tc.wave * 16384);
    for (int l = 0; l < DEPTH; ++l) {
        constexpr int I_UP = (D / 64) * (2 * DFF / 32), I_DN = (DFF / 64) * (D / 32), I_IN = (D / 64) * (DIN / 32), I_SQ = (D / 64) * (D / 32), I_PF = 4 * 4 * 32;
        constexpr int NIT = 2 * I_UP + 2 * I_DN + I_IN + 3 * I_SQ + I_PF;
        for (int it = (gw + l * (NGW / 2)) % NGW; it < NIT; it += NGW) {
            int r = it;
            if (r < I_UP) { p0_transpose_item(in_ptr(IN_UP1) + (size_t)l * D * 2 * DFF, D, 2 * DFF, 2 * DFF, lw(F, l, LW_UP1), 1, scr, r, tc.lane); continue; } r -= I_UP;
            if (r < I_UP) { p0_transpose_item(in_ptr(IN_UP2) + (size_t)l * D * 2 * DFF, D, 2 * DFF, 2 * DFF, lw(F, l, LW_UP2), 1, scr, r, tc.lane); continue; } r -= I_UP;
            if (r < I_DN) { p0_transpose_item(in_ptr(IN_DN1) + (size_t)l * DFF * D, DFF, D, D, lw(F, l, LW_DN1), 0, scr, r, tc.lane); continue; } r -= I_DN;
            if (r < I_DN) { p0_transpose_item(in_ptr(IN_DN2) + (size_t)l * DFF * D, DFF, D, D, lw(F, l, LW_DN2), 0, scr, r, tc.lane); continue; } r -= I_DN;
            if (r < I_IN) { p0_transpose_item(in_ptr(IN_WIN) + (size_t)l * D * DIN, D, DIN, DIN, lw(F, l, LW_IN), 2, scr, r, tc.lane); continue; } r -= I_IN;
            if (r < I_SQ) { p0_transpose_item(in_ptr(IN_WBR) + (size_t)(l * 3 + 0) * D * D, D, D, D, lw(F, l, LW_BR), 0, scr, r, tc.lane); continue; } r -= I_SQ;
            if (r < I_SQ) { p0_transpose_item(in_ptr(IN_WBR) + (size_t)(l * 3 + 1) * D * D, D, D, D, lw(F, l, LW_BR) + (size_t)D * D, 0, scr, r, tc.lane); continue; } r -= I_SQ;
            if (r < I_SQ) { p0_transpose_item(in_ptr(IN_WOUT) + (size_t)l * D * D, D, D, D, lw(F, l, LW_OUT), 0, scr, r, tc.lane); continue; } r -= I_SQ;
            p0_poolfold_item(in_ptr(IN_PMIX) + (size_t)l * 4 * 256 * 256, in_ptr(IN_PSCALE) + (size_t)l * D, in_ptr(IN_WBR) + (size_t)(l * 3 + 2) * D * D, lw(F, l, LW_BR) + (size_t)2 * D * D, r, tc.lane);
        }
    }
    for (int m0 = gw; m0 < M_PAD; m0 += 2 * NGW) {
        f32x4 v[2][4];
#pragma unroll
        for (int r = 0; r < 2; ++r) { const int m = m0 + r * NGW;
            const float* src = (m < MP) ? in_ptr(IN_XP) + (size_t)m * D : (m < ROW_M) ? in_ptr(IN_XS) + (size_t)(m - ROW_S) * D : (m - ROW_M < NMETA) ? in_ptr(IN_META) + (size_t)(m - ROW_M) * D : nullptr;
#pragma unroll
            for (int j = 0; j < 4; ++j) v[r][j] = (src && m < M_PAD) ? ((const GAS f32x4*)src)[tc.lane + 64 * j] : (f32x4){0.f, 0.f, 0.f, 0.f}; }
#pragma unroll
        for (int r = 0; r < 2; ++r) { const int m = m0 + r * NGW;
            if (m < M_PAD) { GAS v2u* o8 = (GAS v2u*)(WSB(F, WS_HB) + (size_t)m * D) + tc.lane;
#pragma unroll
                for (int j = 0; j < 4; ++j) o8[64 * j] = (v2u){pk2(v[r][j].x, v[r][j].y), pk2(v[r][j].z, v[r][j].w)}; } }
    }
}

__device__ __forceinline__ void ln_rows(const Frame& F, int idx, bool final_out, int row_lo, int row_hi, int gw0, int NGW, bool comb = false) {
    const TC tc = thread_coords(F.wave); const int gw = gw0 + tc.wave;
    const float* g = in_ptr(IN_LNG) + (size_t)idx * D; const float* b = in_ptr(IN_LNB) + (size_t)idx * D;
    f32x4 gv[4], bv[4];
#pragma unroll
    for (int j = 0; j < 2; ++j) { gv[2 * j] = ((const GAS f32x4*)g)[2 * tc.lane + 128 * j]; gv[2 * j + 1] = ((const GAS f32x4*)g)[2 * tc.lane + 128 * j + 1];
                                  bv[2 * j] = ((const GAS f32x4*)b)[2 * tc.lane + 128 * j]; bv[2 * j + 1] = ((const GAS f32x4*)b)[2 * tc.lane + 128 * j + 1]; }
    for (int m0 = row_lo + gw; m0 < row_hi; m0 += 2 * NGW) {
        v4u w[2][2]; const bool two = m0 + NGW < row_hi;
#pragma unroll
        for (int r = 0; r < 2; ++r) { const int m = (r == 0 || two) ? m0 + r * NGW : m0; const GAS v4u* yr = (const GAS v4u*)(WSB(F, comb ? WS_HB : WS_YB) + (size_t)m * D) + tc.lane; w[r][0] = yr[0]; w[r][1] = yr[64]; }
#pragma unroll
        for (int r = 0; r < 2; ++r) { const int m = m0 + r * NGW; if (r == 1 && !two) break;
        f32x4 v[4]; float s = 0.f;
#pragma unroll
        for (int j = 0; j < 2; ++j) { const v4u x = w[r][j]; v[2 * j] = (f32x4){bflo(x.x), bfhi(x.x), bflo(x.y), bfhi(x.y)}; v[2 * j + 1] = (f32x4){bflo(x.z), bfhi(x.z), bflo(x.w), bfhi(x.w)}; }
        if (comb) {
            const GAS f32x4* pa = (const GAS f32x4*)((const float*)WSB(F, WS_ACT) + (size_t)(m - MP) * D) + 2 * tc.lane; const GAS f32x4* pb = pa + (size_t)512 * D / 4;
#pragma unroll
            for (int j = 0; j < 2; ++j) { v[2 * j] = v[2 * j] * ALPHA + (pa[128 * j] + pb[128 * j]) * 0.5f; v[2 * j + 1] = v[2 * j + 1] * ALPHA + (pa[128 * j + 1] + pb[128 * j + 1]) * 0.5f; } }
#pragma unroll
        for (int j = 0; j < 4; ++j) s += (v[j].x + v[j].y) + (v[j].z + v[j].w);
        const float mean = wave_sum(s) * (1.f / D); float s2 = 0.f;
#pragma unroll
        for (int j = 0; j < 4; ++j) { v[j] = v[j] - mean; s2 += (v[j].x * v[j].x + v[j].y * v[j].y) + (v[j].z * v[j].z + v[j].w * v[j].w); }
        const float rstd = 1.f / sqrtf(wave_sum(s2) * (1.f / D) + LN_EPS);
#pragma unroll
        for (int j = 0; j < 4; ++j) v[j] = v[j] * rstd * gv[j] + bv[j];
        if (!final_out) { GAS v4u* o = (GAS v4u*)(WSB(F, WS_HB) + (size_t)m * D) + tc.lane;
#pragma unroll
            for (int j = 0; j < 2; ++j) o[64 * j] = (v4u){pk2(v[2 * j].x, v[2 * j].y), pk2(v[2 * j].z, v[2 * j].w), pk2(v[2 * j + 1].x, v[2 * j + 1].y), pk2(v[2 * j + 1].z, v[2 * j + 1].w)}; }
        else { float* yo = yrow(F, m); if (yo) { GAS f32x4* o = (GAS f32x4*)yo + 2 * tc.lane;
#pragma unroll
            for (int j = 0; j < 2; ++j) { o[128 * j] = v[2 * j]; o[128 * j + 1] = v[2 * j + 1]; } } }
        }
    }
}
__device__ __forceinline__ void ln_phase(const Frame& F, int idx, bool final_out, int row_lo, int row_hi, int cu_lo, bool comb = false) { ln_rows(F, idx, final_out, row_lo, row_hi, ((int)blockIdx.x - cu_lo) * 8, (F.G - cu_lo) * 8, comb); }
__device__ __forceinline__ float ret_lg2(int h);

using pg8::Unit;
typedef f32x4 AccT[2][2][4][2];
#ifndef LANE_TR
#define LANE_TR 1
#endif
struct LaneT { int tfr, tfq, pull, push; };
#if LANE_TR
__device__ __forceinline__ LaneT lane_t(int fr, int fq) { LaneT t; const int L = fq * 16 + fr; t.tfr = L >> 2; t.tfq = L & 3; t.pull = ((t.tfq << 4) + t.tfr) << 2; t.push = ((fr << 2) + fq) << 2; return t; }
__device__ __forceinline__ unsigned bperm(int a, unsigned x) { return (unsigned)__builtin_amdgcn_ds_bpermute(a, (int)x); }
__device__ __forceinline__ v4u tr4(int a, v4u x) { return (v4u){bperm(a, x.x), bperm(a, x.y), bperm(a, x.z), bperm(a, x.w)}; }
__device__ __forceinline__ v2u tr2(int a, v2u x) { return (v2u){bperm(a, x.x), bperm(a, x.y)}; }
#else
__device__ __forceinline__ LaneT lane_t(int fr, int fq) { LaneT t; t.tfr = fr; t.tfq = fq; t.pull = 0; t.push = 0; return t; }
__device__ __forceinline__ v4u tr4(int, v4u x) { return x; }
__device__ __forceinline__ v2u tr2(int, v2u x) { return x; }
#endif
__device__ __forceinline__ f32x4 tr4f(int a, f32x4 x) { return __builtin_bit_cast(f32x4, tr4(a, __builtin_bit_cast(v4u, x))); }
__device__ __forceinline__ v4u pack8(const f32x4& a, const f32x4& b) { return (v4u){pg8::cvt_pk_bf16(a[0], a[1]), pg8::cvt_pk_bf16(a[2], a[3]), pg8::cvt_pk_bf16(b[0], b[1]), pg8::cvt_pk_bf16(b[2], b[3])}; }

struct EpiSwiglu {
    static constexpr bool PERM = true; static constexpr int NS = 8;
    bf16* act;
    __device__ __forceinline__ bool operator()(AccT& acc, const Unit& u, int wr, int wc, int fr, int fq) const {
        asm volatile("" : "+s"(wr), "+s"(wc), "+v"(fr), "+v"(fq));
        const int row0 = u.pm * 256 + wr * 64 + fr + 16 * (fq & 1), col0 = u.pn * 128 + wc * 16 + 4 * (fq & 2);
#pragma unroll
        for (int ai = 0; ai < 2; ++ai)
#pragma unroll
            for (int mp = 0; mp < 2; ++mp) { bf16* rowp = act + (size_t)(row0 + ai * 128 + mp * 32) * DFF + col0;
#pragma unroll
                for (int bj = 0; bj < 2; ++bj) { unsigned pk[2][2];
#pragma unroll
                    for (int k = 0; k < 2; ++k) { const f32x4 g = acc[ai][bj][2 * mp + k][0], up = acc[ai][bj][2 * mp + k][1];
                        pk[k][0] = pg8::cvt_pk_bf16(siluf_(g[0]) * up[0], siluf_(g[1]) * up[1]); pk[k][1] = pg8::cvt_pk_bf16(siluf_(g[2]) * up[2], siluf_(g[3]) * up[3]); }
                    const auto sx = __builtin_amdgcn_permlane16_swap(pk[0][0], pk[1][0], false, false), sy = __builtin_amdgcn_permlane16_swap(pk[0][1], pk[1][1], false, false);
                    *(GAS v4u*)(rowp + bj * 64) = (v4u){sx[0], sy[0], sx[1], sy[1]}; } }
        return false;
    }
};

struct EpiResid {
    static constexpr bool PERM = true; static constexpr int NS = 16;
    unsigned char* ws; float ca, cb;
    __device__ __forceinline__ bool operator()(AccT& acc, const Unit& u, int wr, int wc, int fr, int fq) const {
        asm volatile("" : "+s"(wr), "+s"(wc), "+v"(fr), "+v"(fq));
        const LaneT t = lane_t(fr, fq);
        const bf16* src = (const bf16*)(ws + WS_HB); bf16* dst = (bf16*)(ws + WS_YB);
        const int row0 = u.pm * 256 + wr * 64 + t.tfr, col0 = u.pn * 256 + wc * 32 + 8 * t.tfq;
#pragma unroll
        for (int ai = 0; ai < 2; ++ai)
#pragma unroll
            for (int m = 0; m < 4; ++m) { const size_t off = (size_t)(row0 + ai * 128 + m * 16) * D + col0;
#pragma unroll
                for (int bj = 0; bj < 2; ++bj) { const v4u r = tr4(t.push, *(const GAS v4u*)(src + off + bj * 128));
                    const f32x4 y0 = (f32x4){bflo(r.x), bfhi(r.x), bflo(r.y), bfhi(r.y)} * ca + acc[ai][bj][m][0] * cb, y1 = (f32x4){bflo(r.z), bfhi(r.z), bflo(r.w), bfhi(r.w)} * ca + acc[ai][bj][m][1] * cb;
                    *(GAS v4u*)(dst + off + bj * 128) = tr4(t.pull, pack8(y0, y1)); } }
        return false;
    }
};

struct EpiGate {
    static constexpr bool PERM = true; static constexpr int NS = 0;
    unsigned char* ws;
    __device__ __forceinline__ bool operator()(AccT& acc, const Unit& u, int wr, int wc, int fr, int fq) const {
        asm volatile("" : "+s"(wr), "+s"(wc), "+v"(fr), "+v"(fq));
        const LaneT t = lane_t(fr, fq);
        const bf16* Gt = (const bf16*)(ws + WS_GT); bf16* mix = (bf16*)(ws + WS_MIX);
        const int n = u.pm / NPANEL, pm = u.pm - n * NPANEL, pn = u.pn & 3;
        const int row0 = pm * 256 + wr * 64 + t.tfr, col0 = pn * 256 + wc * 32 + 8 * t.tfq;
#pragma unroll
        for (int ai = 0; ai < 2; ++ai)
#pragma unroll
            for (int m = 0; m < 4; ++m) { const size_t r = (size_t)(row0 + ai * 128 + m * 16);
#pragma unroll
                for (int bj = 0; bj < 2; ++bj) {
                    const v4u ga = tr4(t.push, *(const GAS v4u*)(Gt + r * (3 * D) + n * D + col0 + bj * 128));
                    float f[8] = {bflo(ga.x), bfhi(ga.x), bflo(ga.y), bfhi(ga.y), bflo(ga.z), bfhi(ga.z), bflo(ga.w), bfhi(ga.w)};
                    if (n < 2) { const v4u gb = tr4(t.push, *(const GAS v4u*)(Gt + r * (3 * D) + (n + 1) * D + col0 + bj * 128));
                        const float h[8] = {bflo(gb.x), bfhi(gb.x), bflo(gb.y), bfhi(gb.y), bflo(gb.z), bfhi(gb.z), bflo(gb.w), bfhi(gb.w)};
#pragma unroll
                        for (int e = 0; e < 8; ++e) f[e] = f[e] * fast_rcp(fmaxf(h[e], 1e-30f)); }
                    f32x4 v0 = acc[ai][bj][m][0], v1 = acc[ai][bj][m][1];
                    v0 = v0 * (f32x4){f[0], f[1], f[2], f[3]}; v1 = v1 * (f32x4){f[4], f[5], f[6], f[7]};
                    acc[ai][bj][m][0] = v0; acc[ai][bj][m][1] = v1;
                    if (n == 2) *(GAS v4u*)(mix + r * D + col0 + bj * 128) = tr4(t.pull, pack8(v0, v1));
                } }
        return n < 2;
    }
};
struct Order3 : pg8::StaticOrder {
    __device__ __forceinline__ bool next(int i, Unit& u) const { Unit t; if (!pg8::StaticOrder::next(i / 3, t)) return false; const int k = i % 3; u.pm = t.pm + k * NPANEL; u.pn = t.pn + 4 * k; return true; }
};

struct SmallOrder {
    int c;
    __device__ __forceinline__ bool next(int i, Unit& u) const { if (i > 0 || c >= 8) return false; u.pm = 256 + (c >> 2); u.pn = c & 3; return true; }
    __device__ __forceinline__ void a_ready(const Unit&) const {}
    __device__ __forceinline__ void done(const Unit&) const {}
};

struct SmallOrderH {
    int c;
    __device__ __forceinline__ bool next(int i, Unit& u) const { if (i > 0 || c >= 16) return false; u.pm = 256 + ((c >> 2) & 1); u.pn = c & 3; return true; }
    __device__ __forceinline__ void a_ready(const Unit&) const {}
    __device__ __forceinline__ void done(const Unit&) const {}
};
struct EpiPart {
    static constexpr bool PERM = true; static constexpr int NS = 16;
    float* part;
    __device__ __forceinline__ bool operator()(AccT& acc, const Unit& u, int wr, int wc, int fr, int fq) const {
        asm volatile("" : "+s"(wr), "+s"(wc), "+v"(fr), "+v"(fq));
        float* p0 = part + (size_t)((u.pm - 256) * 256 + wr * 64 + fr) * D + u.pn * 256 + wc * 32 + 8 * fq;
#pragma unroll
        for (int ai = 0; ai < 2; ++ai)
#pragma unroll
            for (int m = 0; m < 4; ++m)
#pragma unroll
                for (int bj = 0; bj < 2; ++bj)
#pragma unroll
                    for (int n = 0; n < 2; ++n) *(GAS f32x4*)(p0 + (size_t)(ai * 128 + m * 16) * D + bj * 128 + 4 * n) = acc[ai][bj][m][n];
        return false;
    }
};

struct SmallOrder3 {
    int c;
    __device__ __forceinline__ bool next(int i, Unit& u) const { if (i > 2) return false; u.pm = 256 + (c >> 2) + i * NPANEL; u.pn = (c & 3) + 4 * i; return true; }
    __device__ __forceinline__ void a_ready(const Unit&) const {}
    __device__ __forceinline__ void done(const Unit&) const {}
};
struct SmallOrderW {
    int c;
    __device__ __forceinline__ bool next(int i, Unit& u) const { if (i > 0) return false; const int p = c >= 22 ? 1 : 0; u.pm = 256 + p; u.pn = c - 22 * p; return true; }
    __device__ __forceinline__ void a_ready(const Unit&) const {}
    __device__ __forceinline__ void done(const Unit&) const {}
};

struct EpiWin {
    static constexpr bool PERM = true; static constexpr int NS = 16;
    unsigned char* ws; float* out; int layer;
    __device__ __forceinline__ bool operator()(AccT& acc, const Unit& u, int wr, int wc, int fr, int fq) const {
        asm volatile("" : "+s"(wr), "+s"(wc), "+v"(fr), "+v"(fq));
        const LaneT t = lane_t(fr, fq);
        const int pn = u.pn, pm = u.pm, rl0 = wr * 64 + fr, trl0 = wr * 64 + t.tfr;
        if (pn < 4) {
            const bool isk = pn >= 2; bf16* dst = (bf16*)(ws + (isk ? WS_KR : WS_QR)); const float sc = isk ? 0.08838834764831845f : 1.0f;
            const float lgA = ret_lg2(2 * (pn & 1)) * (isk ? -1.f : 1.f), lgB = ret_lg2(2 * (pn & 1) + 1) * (isk ? -1.f : 1.f);
            float invf[4];
#pragma unroll
            for (int e = 0; e < 4; ++e) invf[e] = fast_exp2(-(float)(16 * wc + 4 * fq + e) * (13.287712379549449f / 64.0f)) * 0.15915494309189535f;
#pragma unroll
            for (int ai = 0; ai < 2; ++ai)
#pragma unroll
                for (int mp = 0; mp < 2; ++mp) { unsigned pk1[2][2][2], pk2[2][2][2];
#pragma unroll
                    for (int k = 0; k < 2; ++k) { const int rl = rl0 + ai * 128 + (2 * mp + k) * 16, r = pm * 256 + rl;
                        const float pos = (float)(pm < 256 ? NMETA + (r & (T - 1)) : (pm == 256 ? NMETA + PAST + (rl & (ST - 1)) : rl));
                        const float jp1 = (float)((pm < 256 ? (r & 63) : (pm == 256 ? (rl & (ST - 1)) : rl)) + 1);
                        const float dsc[2] = {sc * fast_exp2(jp1 * lgA), sc * fast_exp2(jp1 * lgB)};
                        f32x4 cs, sn;
#pragma unroll
                        for (int e = 0; e < 4; ++e) { float rev = pos * invf[e]; rev = rev - floorf(rev); cs[e] = __builtin_amdgcn_cosf(rev); sn[e] = __builtin_amdgcn_sinf(rev); }
#pragma unroll
                        for (int bj = 0; bj < 2; ++bj) { const f32x4 x1 = acc[ai][bj][2 * mp + k][0], x2 = acc[ai][bj][2 * mp + k][1];
                            const f32x4 o1 = (x1 * cs - x2 * sn) * dsc[bj], o2 = (x2 * cs + x1 * sn) * dsc[bj];
                            pk1[k][bj][0] = pg8::cvt_pk_bf16(o1[0], o1[1]); pk1[k][bj][1] = pg8::cvt_pk_bf16(o1[2], o1[3]);
                            pk2[k][bj][0] = pg8::cvt_pk_bf16(o2[0], o2[1]); pk2[k][bj][1] = pg8::cvt_pk_bf16(o2[2], o2[3]); } }
                    const size_t srow = (size_t)(pm * 256 + rl0 + ai * 128 + (2 * mp + (fq & 1)) * 16);
#pragma unroll
                    for (int bj = 0; bj < 2; ++bj) { bf16* rowp = dst + srow * 512 + (2 * (pn & 1) + bj) * 128 + 16 * wc + 4 * (fq & 2);
                        { const auto sx = __builtin_amdgcn_permlane16_swap(pk1[0][bj][0], pk1[1][bj][0], false, false), sy = __builtin_amdgcn_permlane16_swap(pk1[0][bj][1], pk1[1][bj][1], false, false);
                          *(GAS v4u*)rowp = (v4u){sx[0], sy[0], sx[1], sy[1]}; }
                        { const auto sx = __builtin_amdgcn_permlane16_swap(pk2[0][bj][0], pk2[1][bj][0], false, false), sy = __builtin_amdgcn_permlane16_swap(pk2[0][bj][1], pk2[1][bj][1], false, false);
                          *(GAS v4u*)(rowp + 64) = (v4u){sx[0], sy[0], sx[1], sy[1]}; } } }
            return false;
        }
        const int seg = (pn - 4) >> 2;
        const int colt = ((pn - 4) & 3) * 256 + wc * 32 + 8 * t.tfq;
        if (seg == 0 || seg == 1 || seg == 2 || seg >= 6) {
            bf16* dst = (bf16*)(ws + (seg == 0 ? WS_VR : seg == 1 ? WS_GR : seg == 2 ? WS_QS : WS_GT)); const int ld = seg >= 6 ? 3 * D : D; const int cofs = seg >= 6 ? (seg - 6) * D : 0;
#pragma unroll
            for (int ai = 0; ai < 2; ++ai)
#pragma unroll
                for (int m = 0; m < 4; ++m) { const size_t r = (size_t)(pm * 256 + trl0 + ai * 128 + m * 16);
#pragma unroll
                    for (int bj = 0; bj < 2; ++bj) { f32x4 v0 = acc[ai][bj][m][0], v1 = acc[ai][bj][m][1];
                        if (seg == 1) {
#pragma unroll
                            for (int e = 0; e < 4; ++e) { v0[e] = siluf_(v0[e]); v1[e] = siluf_(v1[e]); } }
                        else if (seg == 2) { v0 = v0 * (0.08838834764831845f * LOG2E); v1 = v1 * (0.08838834764831845f * LOG2E); }
                        else if (seg >= 6) {
#pragma unroll
                            for (int e = 0; e < 4; ++e) { v0[e] = sigmoidf_(v0[e]); v1[e] = sigmoidf_(v1[e]); } }
                        *(GAS v4u*)(dst + r * ld + cofs + colt + bj * 128) = tr4(t.pull, pack8(v0, v1)); } }
            return false;
        }
        if (seg == 3 || seg == 4) {
            bf16* dst = (bf16*)(ws + (seg == 3 ? WS_KS : WS_VS));
            if (seg == 3 && pm != 256) {
                float mx[2] = {0.f, 0.f};
#pragma unroll
                for (int ai = 0; ai < 2; ++ai)
#pragma unroll
                    for (int m = 0; m < 4; ++m) { const int rl = rl0 + ai * 128 + m * 16; if (pm < 256 || rl < NMETA) {
#pragma unroll
                        for (int bj = 0; bj < 2; ++bj) { const f32x4 a = acc[ai][bj][m][0], b2 = acc[ai][bj][m][1];
                            const float s = (a[0] * a[0] + a[1] * a[1]) + (a[2] * a[2] + a[3] * a[3]) + (b2[0] * b2[0] + b2[1] * b2[1]) + (b2[2] * b2[2] + b2[3] * b2[3]); mx[bj] = fmaxf(mx[bj], s); } } }
#pragma unroll
                for (int bj = 0; bj < 2; ++bj) {
#pragma unroll
                    for (int o = 1; o < 16; o <<= 1) mx[bj] = fmaxf(mx[bj], __shfl_xor(mx[bj], o));
                    if (fr == 0) { const int bidx = pm < 256 ? (pm >> 3) : 32, hh = ((pn - 16) & 3) * 2 + bj;
                        atomicMax((unsigned*)(ws + WS_CTL) + CW_KN + ((layer * 33 + bidx) * 8 + hh) * 16 + wc * 4 + fq, __float_as_uint(mx[bj] * 1.02f)); } }
            }
            float* op = out + (seg == 3 ? O_KP : O_VP) + (size_t)layer * NB * KT_PP * D;
            float* os = out + (seg == 3 ? O_KS : O_VS) + (size_t)layer * SBATCH * ST * D;
#pragma unroll
            for (int ai = 0; ai < 2; ++ai)
#pragma unroll
                for (int m = 0; m < 4; ++m) { const int rl = trl0 + ai * 128 + m * 16; const size_t r = (size_t)(pm * 256 + rl);
#pragma unroll
                    for (int bj = 0; bj < 2; ++bj) { const f32x4 v0 = tr4f(t.pull, acc[ai][bj][m][0]), v1 = tr4f(t.pull, acc[ai][bj][m][1]); const int c = colt + bj * 128;
                        *(GAS v4u*)(dst + r * D + c) = pack8(v0, v1);
                        if (pm < 256) { float* o = op + ((size_t)(r >> 11) * KT_PP + NMETA + (r & (T - 1))) * D + c; *(GAS f32x4*)o = v0; *(GAS f32x4*)(o + 4) = v1; }
                        else if (pm == 256) { float* o = os + (size_t)rl * D + c; *(GAS f32x4*)o = v0; *(GAS f32x4*)(o + 4) = v1; }
                        else if (rl < NMETA) { for (int bb = 0; bb < NB; ++bb) { float* o = op + ((size_t)bb * KT_PP + rl) * D + c; *(GAS f32x4*)o = v0; *(GAS f32x4*)(o + 4) = v1; } }
                    } }
            return false;
        }
        {
            float* op = out + O_PP + (size_t)layer * NB * PBUF * D;
            float* os = out + O_PS + (size_t)layer * SBATCH * PBUF * D;
#pragma unroll
            for (int ai = 0; ai < 2; ++ai)
#pragma unroll
                for (int m = 0; m < 4; ++m) { const int rl = trl0 + ai * 128 + m * 16; const size_t r = (size_t)(pm * 256 + rl);
#pragma unroll
                    for (int bj = 0; bj < 2; ++bj) { const f32x4 v0 = tr4f(t.pull, acc[ai][bj][m][0]), v1 = tr4f(t.pull, acc[ai][bj][m][1]); const int c = colt + bj * 128;
                        *(GAS v4u*)((bf16*)(ws + WS_U) + r * D + c) = pack8(v0, v1);
                        if (pm < 256) { const int tt = (int)(r & (T - 1)); if (tt >= T - PBUF) { float* o = op + ((size_t)(r >> 11) * PBUF + (tt - (T - PBUF))) * D + c; *(GAS f32x4*)o = v0; *(GAS f32x4*)(o + 4) = v1; } }
                        else if (pm == 256) { const int tt = rl & (ST - 1); if (tt >= ST - PBUF) { float* o = os + ((size_t)(rl >> 5) * PBUF + (tt - (ST - PBUF))) * D + c; *(GAS f32x4*)o = v0; *(GAS f32x4*)(o + 4) = v1; } }
                    } }
            return false;
        }
    }
};

__device__ __forceinline__ int grab(const Frame& F, gu32* ctr) {
    __syncthreads();
    if (F.wave == 0 && lane_lo_() == 0u) F.MISC[16] = __hip_atomic_fetch_add(ctr, 1u, RLX_AGENT);
    __syncthreads();
    return (int)F.MISC[16];
}
__device__ __forceinline__ unsigned grab_issue(const Frame& F, gu32* ctr) { return (F.wave == 0 && lane_lo_() == 0u) ? __hip_atomic_fetch_add(ctr, 1u, RLX_AGENT) : 0u; }
__device__ __forceinline__ int grab_publish(const Frame& F, unsigned nxt) {
    __syncthreads();
    if (F.wave == 0 && lane_lo_() == 0u) F.MISC[16] = nxt;
    __syncthreads();
    return (int)F.MISC[16];
}
typedef float f32x4_t __attribute__((ext_vector_type(4)));
#define MFMA16(a, b, c) __builtin_amdgcn_mfma_f32_16x16x32_bf16((a), (b), (c), 0, 0, 0)
__device__ __forceinline__ s16x4 tr16(const LAS unsigned char* p) { typedef short v4i16_t __attribute__((ext_vector_type(4))); return __builtin_bit_cast(s16x4, __builtin_amdgcn_ds_read_tr16_b64_v4i16((LAS v4i16_t*)p)); }

constexpr int RT_QS = 272, RT_VS = 528, RT_AS = 144;
constexpr int RT_Q = 0, RT_K = 64 * RT_QS, RT_V = 2 * 64 * RT_QS, RT_A = RT_V + 64 * RT_VS, RT_END = RT_A + 64 * RT_AS;
static_assert(RT_END <= RING_BYTES && 64 * 256 * 4 <= RT_END, "retention LDS map");
__device__ __forceinline__ float ret_lg2(int h) { return fast_log2(1.0f - fast_exp2(-5.0f - (float)h * (4.0f / 3.0f))); }
__device__ __forceinline__ void ret_unit(const Frame& F, int layer, int uid) {
    const int h = uid & 3; int stream, b;
    if (uid < 128) { stream = 0; b = uid >> 2; } else if (uid < 160) { stream = 1; b = (uid - 128) >> 2; } else { stream = 2; b = 0; }
    const TC tc = thread_coords(F.wave); const int tid = tc.tid, lane = tc.lane, w = tc.wave, l15 = lane & 15, g = lane >> 4, q4 = l15 >> 2, p4 = l15 & 3;
    const float lg2 = ret_lg2(h);
    const int nch = stream == 0 ? 1 + T / 64 : 1;
    f32x4 accS[8][2];
#pragma unroll
    for (int m = 0; m < 8; ++m)
#pragma unroll
        for (int n = 0; n < 2; ++n) accS[m][n] = (f32x4){0.f, 0.f, 0.f, 0.f};
    if (stream == 1) { const float* s0 = in_ptr(IN_SRET) + (((size_t)layer * SBATCH + b) * HRET + h) * DKR * DVR;
#pragma unroll
        for (int m = 0; m < 8; ++m)
#pragma unroll
            for (int n = 0; n < 2; ++n)
#pragma unroll
                for (int r = 0; r < 4; ++r) accS[m][n][r] = s0[(size_t)(16 * m + 4 * g + r) * DVR + 32 * w + 16 * n + l15]; }
    v4u qreg[2], kreg[2], vreg[4];
    const int lrow = tid >> 4, lch = tid & 15, vrow = tid >> 5, vch = tid & 31;
#define RT_CHUNK(c, rb, vl) do { if (stream == 0) { if ((c) == 0) { rb = ROW_M; vl = NMETA; } else { rb = b * T + 64 * ((c) - 1); vl = 64; } } \
        else if (stream == 1) { rb = ROW_S + b * ST; vl = ST; } else { rb = ROW_M; vl = NMETA; } } while (0)
#define RT_LOAD(c) do { int rb_, vl_; RT_CHUNK(c, rb_, vl_); \
        _Pragma("unroll") for (int i_ = 0; i_ < 2; ++i_) { const int r_ = lrow + 32 * i_; qreg[i_] = (v4u){0u, 0u, 0u, 0u}; kreg[i_] = (v4u){0u, 0u, 0u, 0u}; \
            if (r_ < vl_) { const size_t o_ = (size_t)(rb_ + r_) * 512 + h * 128 + lch * 8; qreg[i_] = *(const GAS v4u*)(WSB(F, WS_QR) + o_); kreg[i_] = *(const GAS v4u*)(WSB(F, WS_KR) + o_); } } \
        _Pragma("unroll") for (int i_ = 0; i_ < 4; ++i_) { const int r_ = vrow + 16 * i_; vreg[i_] = (v4u){0u, 0u, 0u, 0u}; \
            if (r_ < vl_) vreg[i_] = *(const GAS v4u*)(WSB(F, WS_VR) + (size_t)(rb_ + r_) * D + h * 256 + vch * 8); } } while (0)
    RT_LOAD(0);
    const LAS unsigned char* Ql = F.lds + RT_Q; const LAS unsigned char* Kl = F.lds + RT_K; const LAS unsigned char* Vl = F.lds + RT_V; const LAS unsigned char* Al = F.lds + RT_A;
    if (w >= 4) __builtin_amdgcn_s_setprio(1);
    for (int c = 0; c < nch; ++c) {
        int rowbase, valid; RT_CHUNK(c, rowbase, valid);
        const bool write_out = !(stream == 0 && c == 0);
        const float dc = fast_exp2((float)valid * lg2);
        __syncthreads();
#pragma unroll
        for (int i = 0; i < 2; ++i) { *(LAS v4u*)(F.lds + RT_Q + (lrow + 32 * i) * RT_QS + lch * 16) = qreg[i]; *(LAS v4u*)(F.lds + RT_K + (lrow + 32 * i) * RT_QS + lch * 16) = kreg[i]; }
#pragma unroll
        for (int i = 0; i < 4; ++i) *(LAS v4u*)(F.lds + RT_V + (vrow + 16 * i) * RT_VS + vch * 16) = vreg[i];
        __syncthreads();
        if (c + 1 < nch) RT_LOAD(c + 1);
#pragma unroll
        for (int tt = 0; tt < 2; ++tt) { const int id = 2 * w + tt, mt = id >> 2, nt = id & 3;
            f32x4 a4 = (f32x4){0.f, 0.f, 0.f, 0.f};
            if (mt <= nt) {
#pragma unroll
                for (int ks = 0; ks < 4; ++ks) { const bf16x8 A = *(const LAS bf16x8*)(Kl + (16 * mt + l15) * RT_QS + 64 * ks + 16 * g); const bf16x8 B = *(const LAS bf16x8*)(Ql + (16 * nt + l15) * RT_QS + 64 * ks + 16 * g);
                    a4 = MFMA16(A, B, a4); }
#pragma unroll
                for (int r = 0; r < 4; ++r) a4[r] = (16 * mt + 4 * g + r <= 16 * nt + l15) ? a4[r] : 0.f;
            }
            *(LAS v2u*)(F.lds + RT_A + (16 * nt + l15) * RT_AS + (16 * mt + 4 * g) * 2) = (v2u){pg8::cvt_pk_bf16(a4[0], a4[1]), pg8::cvt_pk_bf16(a4[2], a4[3])}; }
        __syncthreads();
        f32x4 accO[4][2];
#pragma unroll
        for (int m = 0; m < 4; ++m)
#pragma unroll
            for (int n = 0; n < 2; ++n) accO[m][n] = (f32x4){0.f, 0.f, 0.f, 0.f};
#pragma unroll
        for (int ks = 0; ks < 4; ++ks) {
            bf16x8 Sf[2];
#pragma unroll
            for (int n = 0; n < 2; ++n) Sf[n] = __builtin_bit_cast(bf16x8, (v4u){pg8::cvt_pk_bf16(accS[2 * ks][n][0], accS[2 * ks][n][1]), pg8::cvt_pk_bf16(accS[2 * ks][n][2], accS[2 * ks][n][3]),
                                                                               pg8::cvt_pk_bf16(accS[2 * ks + 1][n][0], accS[2 * ks + 1][n][1]), pg8::cvt_pk_bf16(accS[2 * ks + 1][n][2], accS[2 * ks + 1][n][3])});
#pragma unroll
            for (int m = 0; m < 4; ++m) { const v2u lo = *(const LAS v2u*)(Ql + (16 * m + l15) * RT_QS + (32 * ks + 4 * g) * 2), hi = *(const LAS v2u*)(Ql + (16 * m + l15) * RT_QS + (32 * ks + 16 + 4 * g) * 2);
                const bf16x8 A = __builtin_bit_cast(bf16x8, (v4u){lo.x, lo.y, hi.x, hi.y});
#pragma unroll
                for (int n = 0; n < 2; ++n) accO[m][n] = MFMA16(A, Sf[n], accO[m][n]); }
        }
        bf16x8 Bv[2][2];
#pragma unroll
        for (int k2 = 0; k2 < 2; ++k2)
#pragma unroll
            for (int n = 0; n < 2; ++n) { const s16x4 lo = tr16(Vl + (32 * k2 + 8 * g + q4) * RT_VS + (32 * w + 16 * n + 4 * p4) * 2), hi = tr16(Vl + (32 * k2 + 8 * g + 4 + q4) * RT_VS + (32 * w + 16 * n + 4 * p4) * 2);
                Bv[k2][n] = __builtin_shufflevector(lo, hi, 0, 1, 2, 3, 4, 5, 6, 7); }
#pragma unroll
        for (int k2 = 0; k2 < 2; ++k2)
#pragma unroll
            for (int m = 0; m < 4; ++m) { const bf16x8 A = *(const LAS bf16x8*)(Al + (16 * m + l15) * RT_AS + (32 * k2 + 8 * g) * 2);
#pragma unroll
                for (int n = 0; n < 2; ++n) accO[m][n] = MFMA16(A, Bv[k2][n], accO[m][n]); }
#pragma unroll
        for (int m = 0; m < 8; ++m)
#pragma unroll
            for (int k2 = 0; k2 < 2; ++k2) { const s16x4 lo = tr16(Kl + (32 * k2 + 8 * g + q4) * RT_QS + (16 * m + 4 * p4) * 2), hi = tr16(Kl + (32 * k2 + 8 * g + 4 + q4) * RT_QS + (16 * m + 4 * p4) * 2);
                const bf16x8 A = __builtin_shufflevector(lo, hi, 0, 1, 2, 3, 4, 5, 6, 7);
#pragma unroll
                for (int n = 0; n < 2; ++n) accS[m][n] = MFMA16(A, Bv[k2][n], accS[m][n]); }
#pragma unroll
        for (int m = 0; m < 8; ++m)
#pragma unroll
            for (int n = 0; n < 2; ++n) accS[m][n] = accS[m][n] * dc;
        if (write_out) {
            __syncthreads();
            LAS float* oL = (LAS float*)F.lds;
#pragma unroll
            for (int m = 0; m < 4; ++m)
#pragma unroll
                for (int n = 0; n < 2; ++n)
#pragma unroll
                    for (int r = 0; r < 4; ++r) oL[(16 * m + 4 * g + r) * 256 + 32 * w + 16 * n + l15] = accO[m][n][r];
            __syncthreads();
            const f32x4 gn = *(const GAS f32x4*)(in_ptr(IN_RETG) + ((size_t)layer * HRET + h) * DVR + lane * 4);
#pragma unroll
            for (int hb2 = 0; hb2 < 2; ++hb2) {
            f32x4 x[4]; v2u gr[4]; float s1[4], s2[4];
#pragma unroll
            for (int tt = 0; tt < 4; ++tt) { const int t = w * 8 + hb2 * 4 + tt; x[tt] = *(const LAS f32x4*)(oL + t * 256 + lane * 4); gr[tt] = *(const GAS v2u*)(WSB(F, WS_GR) + (size_t)(rowbase + t) * D + h * 256 + lane * 4);
                s1[tt] = (x[tt][0] + x[tt][1]) + (x[tt][2] + x[tt][3]); }
#pragma unroll
            for (int o = 1; o < 64; o <<= 1)
#pragma unroll
                for (int tt = 0; tt < 4; ++tt) s1[tt] += __shfl_xor(s1[tt], o);
#pragma unroll
            for (int tt = 0; tt < 4; ++tt) { x[tt] = x[tt] - s1[tt] * (1.f / 256.f); s2[tt] = (x[tt][0] * x[tt][0] + x[tt][1] * x[tt][1]) + (x[tt][2] * x[tt][2] + x[tt][3] * x[tt][3]); }
#pragma unroll
            for (int o = 1; o < 64; o <<= 1)
#pragma unroll
                for (int tt = 0; tt < 4; ++tt) s2[tt] += __shfl_xor(s2[tt], o);
#pragma unroll
            for (int tt = 0; tt < 4; ++tt) { const int t = w * 8 + hb2 * 4 + tt; const float rstd = 1.f / sqrtf(s2[tt] * (1.f / 256.f) + LN_EPS);
                const f32x4 y = x[tt] * rstd * gn * (f32x4){bflo(gr[tt].x), bfhi(gr[tt].x), bflo(gr[tt].y), bfhi(gr[tt].y)};
                if (t < valid) *(GAS v2u*)(WSB(F, WS_BR) + (size_t)(rowbase + t) * D + h * 256 + lane * 4) = (v2u){pk2(y[0], y[1]), pk2(y[2], y[3])}; }
            }
        }
    }
#undef RT_LOAD
#undef RT_CHUNK
    __builtin_amdgcn_s_setprio(0);
    if (stream != 2) { float* d = F.out + (stream == 0 ? O_RP + (((size_t)layer * NB + b) * HRET + h) * DKR * DVR : O_RS + (((size_t)layer * SBATCH + b) * HRET + h) * DKR * DVR);
#pragma unroll
        for (int m = 0; m < 8; ++m)
#pragma unroll
            for (int n = 0; n < 2; ++n)
#pragma unroll
                for (int r = 0; r < 4; ++r) d[(size_t)(16 * m + 4 * g + r) * DVR + 32 * w + 16 * n + l15] = accS[m][n][r]; }
}

constexpr int AT_RS = 272;
constexpr int AT_VOFF = 64 * AT_RS;
constexpr int AT_QOFF = 36864;
static_assert(AT_QOFF >= 2 * 64 * AT_RS && AT_QOFF + 8 * 8 * 1024 <= RING_BYTES, "attention LDS map");
template <bool F32KV> __device__ __forceinline__ void attn_unit(const Frame& F, int layer, int uid) {
    int stream, b, h, qb;
    if (uid < 64) { stream = 1; b = uid >> 3; h = uid & 7; qb = 0; }
    else if (uid < 64 + 2048) { const int idx = uid - 64; qb = 7 - (idx >> 8); b = (idx & 255) >> 3; h = idx & 7; stream = 0; }
    else { stream = 2; b = 0; h = (uid - (64 + 2048)) & 7; qb = 0; }
    const bf16 *k0p = nullptr, *k1p = nullptr, *v0p = nullptr, *v1p = nullptr; const float *k0f = nullptr, *k1f = nullptr, *v0f = nullptr, *v1f = nullptr; int len0, Tq, rowbase;
    if (stream == 0) { k0p = WSB(F, WS_KS) + (size_t)ROW_M * D; v0p = WSB(F, WS_VS) + (size_t)ROW_M * D; len0 = NMETA; k1p = WSB(F, WS_KS) + (size_t)b * T * D; v1p = WSB(F, WS_VS) + (size_t)b * T * D; Tq = T; rowbase = b * T; }
    else if (stream == 1) { k0f = in_ptr(IN_CK) + ((size_t)layer * SBATCH + b) * PAST * D; v0f = in_ptr(IN_CV) + ((size_t)layer * SBATCH + b) * PAST * D; len0 = PAST;
        k1f = F.out + O_KS + ((size_t)layer * SBATCH + b) * ST * D; v1f = F.out + O_VS + ((size_t)layer * SBATCH + b) * ST * D; Tq = ST; rowbase = ROW_S + b * ST; }
    else { k0p = k1p = WSB(F, WS_KS) + (size_t)ROW_M * D; v0p = v1p = WSB(F, WS_VS) + (size_t)ROW_M * D; len0 = 0; Tq = NMETA; rowbase = ROW_M; }
    constexpr int NQ = F32KV ? 1 : 2, QPW = 16 * NQ, QBLK = 8 * QPW;
    const int Stot = len0 + Tq, q0 = qb * QBLK;
    const TC tc = thread_coords(F.wave); const int tid = tc.tid, lane = tc.lane, w = tc.wave, l15 = lane & 15, g = lane >> 4;
    int qi[NQ]; bool valid_q[NQ]; int lim[NQ];
#pragma unroll
    for (int nb = 0; nb < NQ; ++nb) { qi[nb] = q0 + 16 * (NQ == 2 ? (nb == 0 ? w : 15 - w) : w) + l15; valid_q[nb] = qi[nb] < Tq; lim[nb] = len0 + qi[nb]; }
    bf16x8 qf[NQ][4];
#pragma unroll
    for (int nb = 0; nb < NQ; ++nb)
#pragma unroll
    for (int ks = 0; ks < 4; ++ks) { v4u t4 = (v4u){0u, 0u, 0u, 0u}; if (valid_q[nb]) t4 = *(const GAS v4u*)(WSB(F, WS_QS) + (size_t)(rowbase + qi[nb]) * D + h * 128 + 32 * ks + 8 * g); qf[nb][ks] = __builtin_bit_cast(bf16x8, t4); }
    float zq[NQ];
#pragma unroll
    for (int nb = 0; nb < NQ; ++nb) zq[nb] = 3.0e38f;
    float kn2 = -1.f;
    if (stream == 0) { const unsigned* kn = (const unsigned*)(F.ws + WS_CTL) + CW_KN + ((layer * 33 + b) * 8 + h) * 16; const unsigned* km = (const unsigned*)(F.ws + WS_CTL) + CW_KN + ((layer * 33 + 32) * 8 + h) * 16;
        kn2 = 0.f;
#pragma unroll
        for (int p = 0; p < 16; ++p) kn2 += fmaxf(__uint_as_float(kn[p]), __uint_as_float(km[p])); }
    if constexpr (F32KV) {
        const int lr_ = tid >> 4, lc_ = tid & 15; float km_ = 0.f;
        for (int s0 = lr_; s0 < Stot; s0 += 128) { f32x4 a_[4][2];
#pragma unroll
            for (int j = 0; j < 4; ++j) { int s_ = s0 + 32 * j; s_ = s_ < Stot ? s_ : Stot - 1; const float* kp_ = (s_ < len0 ? k0f + (size_t)s_ * D : k1f + (size_t)(s_ - len0) * D) + h * 128 + lc_ * 8;
                a_[j][0] = *(const GAS f32x4*)kp_; a_[j][1] = *(const GAS f32x4*)(kp_ + 4); }
#pragma unroll
            for (int j = 0; j < 4; ++j) { const f32x4 x = a_[j][0] * a_[j][0] + a_[j][1] * a_[j][1]; float p = (x[0] + x[1]) + (x[2] + x[3]);
                p += __shfl_xor(p, 1); p += __shfl_xor(p, 2); p += __shfl_xor(p, 4); p += __shfl_xor(p, 8); km_ = fmaxf(km_, p); } }
        km_ = fmaxf(km_, __shfl_xor(km_, 16)); km_ = fmaxf(km_, __shfl_xor(km_, 32));
        __syncthreads();
        if (lane == 0) F.MISC[32 + w] = __float_as_uint(km_);
        __syncthreads();
        kn2 = 0.f;
#pragma unroll
        for (int i = 0; i < 8; ++i) kn2 = fmaxf(kn2, __uint_as_float(F.MISC[32 + i])); }
    if (kn2 >= 0.f) {
#pragma unroll
        for (int nb = 0; nb < NQ; ++nb) { float q2 = 0.f;
#pragma unroll
            for (int ks = 0; ks < 4; ++ks)
#pragma unroll
                for (int e = 0; e < 8; ++e) { const float x = bf2f((unsigned short)qf[nb][ks][e]); q2 += x * x; }
            q2 += __shfl_xor(q2, 16); q2 += __shfl_xor(q2, 32);
            zq[nb] = sqrtf(kn2 * q2) * 1.01f + 150.0f; } }
    f32x4 o[NQ][8];
#pragma unroll
    for (int nb = 0; nb < NQ; ++nb)
#pragma unroll
    for (int i = 0; i < 8; ++i) o[nb][i] = (f32x4){0.f, 0.f, 0.f, 0.f};
    float R[NQ]; bool anyv_ = false;
#pragma unroll
    for (int nb = 0; nb < NQ; ++nb) { R[nb] = 0.f; anyv_ = anyv_ || valid_q[nb]; }
    bool wave_done = __all(!anyv_) != 0;
    const int qend = (q0 + QBLK < Tq) ? q0 + QBLK : Tq;
    const int kt_max = (len0 + qend - 2) >> 6;
    const int lrow = tid >> 4, lch = tid & 15;
    constexpr int NR = F32KV ? 4 : 2;
    constexpr int DIST = F32KV ? 1 : 2;
    v4u kregA[NR], vregA[NR], kregB[NR], vregB[NR];
#define AT_LOAD(kt, KR, VR) do { _Pragma("unroll") for (int i_ = 0; i_ < 2; ++i_) { int s_ = ((kt) > 0 ? (kt) : 0) * 64 + lrow + 32 * i_; s_ = s_ < Stot ? s_ : Stot - 1; \
        const size_t off_ = (s_ < len0 ? (size_t)s_ : (size_t)(s_ - len0)) * D + h * 128 + lch * 8; \
        if constexpr (F32KV) { const float* kp_ = (s_ < len0 ? k0f : k1f) + off_; const float* vp_ = (s_ < len0 ? v0f : v1f) + off_; \
            asm volatile("global_load_dwordx4 %0, %1, off" : "=&v"(KR[2 * i_]) : "v"(kp_) : "memory"); asm volatile("global_load_dwordx4 %0, %1, off offset:16" : "=&v"(KR[2 * i_ + 1]) : "v"(kp_) : "memory"); \
            asm volatile("global_load_dwordx4 %0, %1, off" : "=&v"(VR[2 * i_]) : "v"(vp_) : "memory"); asm volatile("global_load_dwordx4 %0, %1, off offset:16" : "=&v"(VR[2 * i_ + 1]) : "v"(vp_) : "memory"); } \
        else { const bf16* kp_ = (s_ < len0 ? k0p : k1p) + off_; const bf16* vp_ = (s_ < len0 ? v0p : v1p) + off_; \
            asm volatile("global_load_dwordx4 %0, %1, off" : "=&v"(KR[i_]) : "v"(kp_) : "memory"); asm volatile("global_load_dwordx4 %0, %1, off" : "=&v"(VR[i_]) : "v"(vp_) : "memory"); } } } while (0)
    AT_LOAD(kt_max, kregA, vregA);
    if constexpr (!F32KV) AT_LOAD(kt_max - 1, kregB, vregB);
    const LAS unsigned char* Ql = F.lds + AT_QOFF + w * (NQ * 4096);
#pragma unroll
    for (int nb = 0; nb < NQ; ++nb)
#pragma unroll
        for (int ks = 0; ks < 4; ++ks) *(LAS v4u*)(F.lds + AT_QOFF + w * (NQ * 4096) + ((nb * 4 + ks) * 64 + lane) * 16) = __builtin_bit_cast(v4u, qf[nb][ks]);
    const LAS unsigned char* Kl = F.lds; const LAS unsigned char* Vl = F.lds + AT_VOFF;
    const int q4 = l15 >> 2, p4 = l15 & 3;
#define AT_BODY(NB0_) { \
        f32x4 z[NQ][4]; \
        _Pragma("unroll") \
        for (int mt = 0; mt < 4; ++mt) { _Pragma("unroll") for (int nb = (NB0_); nb < NQ; ++nb) z[nb][mt] = (f32x4){0.f, 0.f, 0.f, 0.f}; } \
        _Pragma("unroll") \
        for (int ks = 0; ks < 4; ++ks) { bf16x8 qa[NQ]; _Pragma("unroll") for (int nb = (NB0_); nb < NQ; ++nb) qa[nb] = *(const LAS bf16x8*)(Ql + ((nb * 4 + ks) * 64 + lane) * 16); \
        _Pragma("unroll") \
            for (int mt = 0; mt < 4; ++mt) { const bf16x8 a = *(const LAS bf16x8*)(Kl + (16 * mt + l15) * AT_RS + 64 * ks + 16 * g); _Pragma("unroll") for (int nb = (NB0_); nb < NQ; ++nb) z[nb][mt] = MFMA16(a, qa[nb], z[nb][mt]); } } \
        bf16x8 pf[NQ][2]; \
        _Pragma("unroll") \
        for (int nb = (NB0_); nb < NQ; ++nb) { \
        bf16x8 triA, triB, ones; \
        _Pragma("unroll") \
        for (int e = 0; e < 8; ++e) { const int jl = 16 * (e >> 2) + 4 * g + (e & 3); triA[e] = (short)(jl >= l15 ? 0x3f80 : 0); triB[e] = (short)(jl >= l15 + 16 ? 0x3f80 : 0); ones[e] = (short)0x3f80; } \
        f32x4 sp[4]; \
        if (need_mask) { \
        _Pragma("unroll") \
            for (int mt = 0; mt < 4; ++mt) \
        _Pragma("unroll") \
                for (int r = 0; r < 4; ++r) { const bool vis = (tb + 16 * mt + 4 * g + r) < lim[nb]; const float zz = fminf(z[nb][mt][r], 80.f); z[nb][mt][r] = vis ? zz : -1.0e30f; \
                    sp[mt][r] = vis ? fast_log2(1.0f + fast_exp2(zz)) : 0.f; } \
        } else { \
        _Pragma("unroll") \
            for (int mt = 0; mt < 4; ++mt) \
        _Pragma("unroll") \
                for (int r = 0; r < 4; ++r) { const float zz = fminf(z[nb][mt][r], 80.f); z[nb][mt][r] = zz; sp[mt][r] = fast_log2(1.0f + fast_exp2(zz)); } \
        } \
        bf16x8 spf[2]; \
        _Pragma("unroll") \
        for (int k2 = 0; k2 < 2; ++k2) spf[k2] = __builtin_bit_cast(bf16x8, (v4u){pg8::cvt_pk_bf16(sp[2 * k2][0], sp[2 * k2][1]), pg8::cvt_pk_bf16(sp[2 * k2][2], sp[2 * k2][3]), \
                                                                                  pg8::cvt_pk_bf16(sp[2 * k2 + 1][0], sp[2 * k2 + 1][1]), pg8::cvt_pk_bf16(sp[2 * k2 + 1][2], sp[2 * k2 + 1][3])}); \
        const f32x4 zero4 = (f32x4){0.f, 0.f, 0.f, 0.f}; \
        f32x4 I0 = MFMA16(triA, spf[0], zero4); I0 = MFMA16(ones, spf[1], I0); \
        f32x4 I1 = MFMA16(triB, spf[0], zero4); I1 = MFMA16(ones, spf[1], I1); \
        f32x4 I2 = MFMA16(triA, spf[1], zero4); \
        f32x4 I3 = MFMA16(triB, spf[1], zero4); \
        f32x4 tot = MFMA16(ones, spf[0], zero4); tot = MFMA16(ones, spf[1], tot); \
        const f32x4 II[4] = {I0, I1, I2, I3}; \
        f32x4 wv[4]; \
        _Pragma("unroll") \
        for (int mt = 0; mt < 4; ++mt) \
        _Pragma("unroll") \
            for (int r = 0; r < 4; ++r) wv[mt][r] = fast_exp2(z[nb][mt][r] - II[mt][r] - R[nb]); \
        _Pragma("unroll") \
        for (int k2 = 0; k2 < 2; ++k2) pf[nb][k2] = __builtin_bit_cast(bf16x8, (v4u){pg8::cvt_pk_bf16(wv[2 * k2][0], wv[2 * k2][1]), pg8::cvt_pk_bf16(wv[2 * k2][2], wv[2 * k2][3]), \
                                                                                 pg8::cvt_pk_bf16(wv[2 * k2 + 1][0], wv[2 * k2 + 1][1]), pg8::cvt_pk_bf16(wv[2 * k2 + 1][2], wv[2 * k2 + 1][3])}); \
        R[nb] += tot[0]; \
        } \
        _Pragma("unroll") \
        for (int mt8 = 0; mt8 < 8; ++mt8) \
        _Pragma("unroll") \
            for (int k2 = 0; k2 < 2; ++k2) { \
                const s16x4 lo = tr16(Vl + (32 * k2 + 4 * g + q4) * AT_RS + (16 * mt8 + 4 * p4) * 2); \
                const s16x4 hi = tr16(Vl + (32 * k2 + 16 + 4 * g + q4) * AT_RS + (16 * mt8 + 4 * p4) * 2); \
                const bf16x8 a = __builtin_shufflevector(lo, hi, 0, 1, 2, 3, 4, 5, 6, 7); \
                _Pragma("unroll") for (int nb = (NB0_); nb < NQ; ++nb) o[nb][mt8] = MFMA16(a, pf[nb][k2], o[nb][mt8]); } \
        }
#define AT_ITER(KT_, KR_, VR_) { const int kt = (KT_); \
        __syncthreads(); \
        if (kt < kt_max) { unsigned allok = 1u; \
        _Pragma("unroll") \
            for (int i = 0; i < 8; ++i) allok &= F.MISC[24 + i]; \
            if (allok) break; } \
        if constexpr (F32KV) asm volatile("s_waitcnt vmcnt(0)" : "+v"(KR_[0]), "+v"(VR_[0]), "+v"(KR_[1]), "+v"(VR_[1]), "+v"(KR_[NR - 2]), "+v"(VR_[NR - 2]), "+v"(KR_[NR - 1]), "+v"(VR_[NR - 1]) :: "memory"); \
        else asm volatile("s_waitcnt vmcnt(4)" : "+v"(KR_[0]), "+v"(VR_[0]), "+v"(KR_[1]), "+v"(VR_[1]) :: "memory");     \
        _Pragma("unroll") \
        for (int i = 0; i < 2; ++i) { const bool in_ = (kt * 64 + lrow + 32 * i) < Stot; const v4u z4_ = (v4u){0u, 0u, 0u, 0u}; v4u kk_, vv_; \
            if constexpr (F32KV) { kk_ = pack8(__builtin_bit_cast(f32x4, KR_[(2 * i) % NR]), __builtin_bit_cast(f32x4, KR_[(2 * i + 1) % NR])); vv_ = pack8(__builtin_bit_cast(f32x4, VR_[(2 * i) % NR]), __builtin_bit_cast(f32x4, VR_[(2 * i + 1) % NR])); } \
            else { kk_ = KR_[i % NR]; vv_ = VR_[i % NR]; } \
            *(LAS v4u*)(F.lds + (lrow + 32 * i) * AT_RS + lch * 16) = in_ ? kk_ : z4_; *(LAS v4u*)(F.lds + AT_VOFF + (lrow + 32 * i) * AT_RS + lch * 16) = in_ ? vv_ : z4_; } \
        __syncthreads(); \
        AT_LOAD(kt - DIST, KR_, VR_); \
        const int tb = kt * 64; \
        const int lim_lo = len0 + q0 + 16 * w, lim_hi = NQ == 2 ? len0 + q0 + 16 * (15 - w) : lim_lo;      \
        const bool act0 = tb < lim_lo + 15, act1 = tb < lim_hi + 15;                                           \
        if (!wave_done && act1) { \
        const bool need_mask = (tb + 64 > (act0 ? lim_lo : lim_hi)); \
        if (NQ == 2 && !act0) AT_BODY(NQ - 1) else AT_BODY(0) \
        { bool dn_ = true; _Pragma("unroll") for (int nb = 0; nb < NQ; ++nb) dn_ = dn_ && ((!valid_q[nb]) || (R[nb] > zq[nb])); wave_done = __all(dn_) != 0; } \
        } \
        if (lane == 0) F.MISC[24 + w] = wave_done ? 1u : 0u; \
    }
    if (w >= 4) __builtin_amdgcn_s_setprio(1);
    for (int kt2 = kt_max; kt2 >= 0; kt2 -= 2) {
        AT_ITER(kt2, kregA, vregA)
        if (kt2 == 0) break;
        if constexpr (F32KV) { AT_ITER(kt2 - 1, kregA, vregA) } else { AT_ITER(kt2 - 1, kregB, vregB) }
    }
#undef AT_ITER
#undef AT_BODY
    __builtin_amdgcn_s_setprio(0);
    if constexpr (F32KV) asm volatile("s_waitcnt vmcnt(0)" : "+v"(kregA[0]), "+v"(vregA[0]), "+v"(kregA[1]), "+v"(vregA[1]), "+v"(kregA[NR - 2]), "+v"(vregA[NR - 2]), "+v"(kregA[NR - 1]), "+v"(vregA[NR - 1]) :: "memory");
    else asm volatile("s_waitcnt vmcnt(0)" : "+v"(kregA[0]), "+v"(vregA[0]), "+v"(kregA[1]), "+v"(vregA[1]), "+v"(kregB[0]), "+v"(vregB[0]), "+v"(kregB[1]), "+v"(vregB[1]) :: "memory");
#undef AT_LOAD
#pragma unroll
    for (int nb = 0; nb < NQ; ++nb)
    if (valid_q[nb]) { bf16* orow = WSB(F, WS_BR) + (size_t)M_PAD * D + (size_t)(rowbase + qi[nb]) * D + h * 128 + 4 * g;
#pragma unroll
        for (int mt8 = 0; mt8 < 8; ++mt8) *(GAS v2u*)(orow + 16 * mt8) = (v2u){pg8::cvt_pk_bf16(o[nb][mt8][0], o[nb][mt8][1]), pg8::cvt_pk_bf16(o[nb][mt8][2], o[nb][mt8][3])}; }
}

__device__ __forceinline__ void pool_row(const Frame& F, int layer, int stream, int b, int rowbase, int tp, int ch, float (&v)[8]) {
    if (tp >= 0 || stream == 0) { const size_t row = tp >= 0 ? (size_t)(rowbase + tp) : (size_t)(ROW_M + NMETA + tp);
        const v4u x = *(const GAS v4u*)(WSB(F, WS_U) + row * D + ch * 8);
        v[0] = bflo(x.x); v[1] = bfhi(x.x); v[2] = bflo(x.y); v[3] = bfhi(x.y); v[4] = bflo(x.z); v[5] = bfhi(x.z); v[6] = bflo(x.w); v[7] = bfhi(x.w); }
    else if (stream == 1) { const float* sp = in_ptr(IN_SPOOL) + (((size_t)layer * SBATCH + b) * PBUF + (PBUF + tp)) * D + ch * 8;
        const f32x4 a = *(const GAS f32x4*)sp, c = *(const GAS f32x4*)(sp + 4);
        v[0] = a[0]; v[1] = a[1]; v[2] = a[2]; v[3] = a[3]; v[4] = c[0]; v[5] = c[1]; v[6] = c[2]; v[7] = c[3]; }
    else {
#pragma unroll
        for (int e = 0; e < 8; ++e) v[e] = 0.f; }
}
__device__ __forceinline__ void pool_unit(const Frame& F, int layer, int uid) {
    int stream, b, t0, Tlen, rowbase;
    if (uid < 1024) { stream = 0; b = uid >> 5; t0 = (uid & 31) * 64; Tlen = T; rowbase = b * T; }
    else if (uid < 1032) { stream = 1; b = uid - 1024; t0 = 0; Tlen = ST; rowbase = ROW_S + b * ST; }
    else { stream = 2; b = 0; t0 = 0; Tlen = NMETA; rowbase = ROW_M; }
    const TC tc = thread_coords(F.wave); const int ch = tc.tid & 127, tsub = tc.tid >> 7, win = 2 << (ch >> 5);
    const int ts = t0 + tsub * 16; if (ts >= Tlen) return;
    float acc[8];
#pragma unroll
    for (int e = 0; e < 8; ++e) acc[e] = 0.f;
#pragma unroll
    for (int j = 1; j < 16; ++j) if (j < win) { float v[8]; pool_row(F, layer, stream, b, rowbase, ts - j, ch, v);
#pragma unroll
        for (int e = 0; e < 8; ++e) acc[e] += v[e]; }
#pragma unroll 4
    for (int tt = 0; tt < 16; ++tt) {
        const int t = ts + tt;
        float vn[8], vo[8]; pool_row(F, layer, stream, b, rowbase, t, ch, vn);
        if (tt > 0) pool_row(F, layer, stream, b, rowbase, t - win, ch, vo);
#pragma unroll
        for (int e = 0; e < 8; ++e) acc[e] += vn[e] - (tt > 0 ? vo[e] : 0.f);
        const int have = (stream == 2) ? (t + 1 < win ? t + 1 : win) : win;
        const float inv = 1.0f / (float)have;
        float y[8];
#pragma unroll
        for (int e = 0; e < 8; ++e) y[e] = acc[e] * inv - vn[e];
        *(GAS v4u*)(WSB(F, WS_BR) + (size_t)2 * M_PAD * D + (size_t)(rowbase + t) * D + ch * 8) = (v4u){pk2(y[0], y[1]), pk2(y[2], y[3]), pk2(y[4], y[5]), pk2(y[6], y[7])};
    }
}

struct Args { const float* in[19]; float* out; unsigned char* ws; };

__device__ __forceinline__ int opq(int x) { asm volatile("" : "+s"(x)); return x; }

constexpr int CH_TOTAL = 25;
__device__ __forceinline__ int ch_stage(int ci) { return ci < 8 ? 1 : ci < 16 ? 2 : 3; }
__device__ __forceinline__ int ch_first(int s) { return s == 1 ? 0 : s == 2 ? 8 : s == 3 ? 16 : CH_TOTAL; }
__device__ __forceinline__ unsigned ch_cnt(int s) { return s == 0 ? 117u : s == 3 ? 9u : 8u; }
__device__ __forceinline__ void chain_signal(const Frame& F, gu32* ch, int s) {
    asm volatile("s_waitcnt vmcnt(0)" ::: "memory");
    __syncthreads();
    if (F.wave == 0 && lane_lo_() == 0u) {
        __builtin_amdgcn_fence(__ATOMIC_RELEASE, "agent");
        asm volatile("s_waitcnt vmcnt(0)" ::: "memory");
        const unsigned old = __hip_atomic_fetch_add(ch + 64 * (2 + s), 1u, RLX_AGENT);
        if (old + 1u == ch_cnt(s) && s < 3) __hip_atomic_store(ch + 64, (unsigned)ch_first(s + 2), RLX_AGENT);
    }
}
__device__ __forceinline__ void chain_item(const Frame& F, int l, gu32* ch, int ci) {
    const int s = ch_stage(ci);
    if (s == 1) { pg8::Gemm g{WSB(F, WS_BR), lw(F, l, LW_BR), 3 * M_PAD, 3 * D, D}; SmallOrder3 S{ci}; EpiGate E{F.ws};
        pg8::gemm_phase<EpiGate, SmallOrder3, true, true>(F.lds, g, S, E, F.wave); }
    else if (s == 2) { pg8::Gemm g{WSB(F, WS_MIX), lw(F, l, LW_OUT), M_PAD, D, D}; SmallOrder S{ci - 8}; EpiResid E{F.ws, ALPHA, 1.0f};
        pg8::gemm_phase<EpiResid, SmallOrder, true, true>(F.lds, g, S, E, F.wave); }
    else { const int i = ci - 16; ln_rows(F, l * 3 + 1, false, MP + 32 * i, MP + 32 * i + 32, 0, 8); }
    chain_signal(F, ch, s);
}
__device__ __forceinline__ int mq_count(int kq) { return kq == 0 ? 164 : kq == 1 ? 9 : kq == 2 ? 64 : kq == 3 ? 2056 : 1024; }

__global__ void __launch_bounds__(512, 2) mega_fwd(Args args) {
    extern __shared__ __attribute__((aligned(16))) unsigned char lds[];
    Frame F;
    F.lds = (LAS unsigned char*)lds;
    F.MISC = (volatile LAS unsigned*)(F.lds + MISC_OFF);
    F.G = gridDim.x; F.wave = __builtin_amdgcn_readfirstlane((int)threadIdx.x >> 6);
    F.ws = args.ws; F.out = args.out; F.ctl = (gu32*)(args.ws + WS_CTL);
    for (int u = threadIdx.x; u < (LDS_BYTES - LDSCTL_OFF) / 4; u += 512) ((LAS unsigned*)(F.lds + LDSCTL_OFF))[u] = 0u;
    __syncthreads();
    XcdBarrier bar = xcd_barrier_post((unsigned*)(F.ctl + CW_BAR), F.MISC + 8);
#define GRID_BAR() xcd_barrier(bar)

    p0_prologue(F);

    GRID_BAR();

    for (int l = 0; l < DEPTH; ++l) {
        { pg8::Gemm g{WSB(F, WS_HB), lw(F, l, LW_UP1), M_PAD, 2 * DFF, D}; pg8::StaticOrder S; S.init(M_PAD, 2 * DFF, opq(F.G), opq((int)blockIdx.x)); EpiSwiglu E{WSB(F, WS_ACT)};
          pg8::gemm_phase<EpiSwiglu, pg8::StaticOrder, true, true>(F.lds, g, S, E, F.wave); }

        GRID_BAR();
        { pg8::Gemm g{WSB(F, WS_ACT), lw(F, l, LW_DN1), M_PAD, D, DFF}; pg8::StaticOrder S; S.init(MP, D, opq(F.G), opq((int)blockIdx.x));
          EpiResid E{F.ws, ALPHA, 0.5f};
          pg8::gemm_phase<EpiResid, pg8::StaticOrder, true, true>(F.lds, g, S, E, F.wave); }

        GRID_BAR();
        if (blockIdx.x < 16) { const int kh = opq((int)blockIdx.x) >> 3; pg8::Gemm g{WSB(F, WS_ACT) + kh * (DFF / 2), lw(F, l, LW_DN1) + kh * (DFF / 2), M_PAD, D, DFF / 2, DFF}; SmallOrderH S{opq((int)blockIdx.x)};
            EpiPart E{(float*)WSB(F, WS_ACT) + (size_t)kh * 512 * D};
            pg8::gemm_phase<EpiPart, SmallOrderH, true, true>(F.lds, g, S, E, F.wave); }
        else ln_phase(F, l * 3 + 0, false, 0, MP, 16);
        GRID_BAR();
        ln_phase(F, l * 3 + 0, false, MP, M_PAD, 0, true);
        GRID_BAR();
        { pg8::Gemm g{WSB(F, WS_HB), lw(F, l, LW_IN), M_PAD, DIN, D}; pg8::StaticOrder S; S.init(M_PAD, DIN, opq(F.G), opq((int)blockIdx.x));
          EpiWin E{F.ws, F.out, l};
          pg8::gemm_phase<EpiWin, pg8::StaticOrder, true, true>(F.lds, g, S, E, F.wave);
        }

        GRID_BAR();
        { gu32* q = F.ctl + CW_Q + 64 * (l * 8); gu32* ch = F.ctl + CW_CH + 1024 * l;
          int kq = 0, u = __builtin_amdgcn_readfirstlane(grab(F, q)), chain_open = 1;
          for (;;) {
              while (kq < 5 && u >= mq_count(kq)) { ++kq; if (kq < 5) u = __builtin_amdgcn_readfirstlane(grab(F, q + 64 * kq)); }
              unsigned l0_ = lane_lo_(); asm volatile("" : "+v"(l0_));
              const bool t0 = F.wave == 0 && l0_ == 0u;
              unsigned nx = 0u, hd = 0u, rd = 0u;
              if (t0) { if (kq < 5) nx = __hip_atomic_fetch_add(q + 64 * kq, 1u, RLX_AGENT); if (chain_open) { hd = __hip_atomic_load(ch, RLX_AGENT); rd = __hip_atomic_load(ch + 64, RLX_AGENT); } }
              if (kq == 0) { ret_unit(F, l, u < 36 ? 128 + u : u - 36); if (u < 36) chain_signal(F, ch, 0); }
              else if (kq == 1 || kq == 4) { pool_unit(F, l, kq == 1 ? 1024 + u : u); if (kq == 1) chain_signal(F, ch, 0); }
              else if (kq == 2) { attn_unit<true>(F, l, u); chain_signal(F, ch, 0); }
              else if (kq == 3) { attn_unit<false>(F, l, u < 8 ? 64 + 2048 + u : 64 + u - 8); if (u < 8) chain_signal(F, ch, 0); }
              __syncthreads();
              if (t0) { int ci = -1;
                  if (chain_open) {
                      if (kq == 5) { unsigned sp = 0u;
                          for (;;) { hd = __hip_atomic_load(ch, RLX_AGENT); if (hd >= (unsigned)CH_TOTAL) { ci = -2; break; } rd = __hip_atomic_load(ch + 64, RLX_AGENT);
                              if (hd < rd) { unsigned e = hd; if (__hip_atomic_compare_exchange_strong(ch, &e, hd + 1u, __ATOMIC_RELAXED, __ATOMIC_RELAXED, __HIP_MEMORY_SCOPE_AGENT)) { ci = (int)hd; break; } }
                              else { __builtin_amdgcn_s_sleep(2); if ((++sp & 255u) == 0u) { if (xb_ld((unsigned*)(F.ctl + CW_BAR) + XB_TMO)) { ci = -2; break; } if (sp > XB_SPIN_CAP) { atomicAdd((unsigned*)(F.ctl + CW_BAR) + XB_TMO, 1u); ci = -2; break; } } } } }
                      else if (hd >= (unsigned)CH_TOTAL) ci = -3;
                      else if (hd < rd) { unsigned e = hd; if (__hip_atomic_compare_exchange_strong(ch, &e, hd + 1u, __ATOMIC_RELAXED, __ATOMIC_RELAXED, __HIP_MEMORY_SCOPE_AGENT)) ci = (int)hd; }
                      if (ci >= 0) { __builtin_amdgcn_fence(__ATOMIC_ACQUIRE, "agent"); asm volatile("s_waitcnt vmcnt(0)" ::: "memory"); }
                  } else if (kq == 5) ci = -2;
                  F.MISC[16] = nx; F.MISC[17] = (unsigned)ci; }
              __syncthreads();
              u = __builtin_amdgcn_readfirstlane((int)F.MISC[16]); const int ci = __builtin_amdgcn_readfirstlane((int)F.MISC[17]);
              if (ci == -2) break;
              if (ci == -3) chain_open = 0;
              if (ci >= 0) chain_item(F, l, ch, ci);
          }
          __syncthreads(); }
        GRID_BAR();
        { pg8::Gemm g{WSB(F, WS_BR), lw(F, l, LW_BR), 3 * M_PAD, 3 * D, D}; Order3 S; S.init(MP, D, opq(F.G), opq((int)blockIdx.x)); EpiGate E{F.ws};
          pg8::gemm_phase<EpiGate, Order3, true, true>(F.lds, g, S, E, F.wave); }

        GRID_BAR();
        { pg8::Gemm g{WSB(F, WS_MIX), lw(F, l, LW_OUT), M_PAD, D, D}; pg8::StaticOrder S; S.init(MP, D, opq(F.G), opq((int)blockIdx.x));
          EpiResid E{F.ws, ALPHA, 1.0f};
          pg8::gemm_phase<EpiResid, pg8::StaticOrder, true, true>(F.lds, g, S, E, F.wave); }

        GRID_BAR();
        if (blockIdx.x < 44) { pg8::Gemm g{WSB(F, WS_HB), lw(F, l, LW_UP2), M_PAD, 2 * DFF, D}; SmallOrderW S{opq((int)blockIdx.x)}; EpiSwiglu E{WSB(F, WS_ACT)};
            pg8::gemm_phase<EpiSwiglu, SmallOrderW, true, true>(F.lds, g, S, E, F.wave); }
        else ln_phase(F, l * 3 + 1, false, 0, MP, 44);
        GRID_BAR();
        { pg8::Gemm g{WSB(F, WS_HB), lw(F, l, LW_UP2), M_PAD, 2 * DFF, D}; pg8::StaticOrder S; S.init(MP, 2 * DFF, opq(F.G), opq((int)blockIdx.x)); EpiSwiglu E{WSB(F, WS_ACT)};
          pg8::gemm_phase<EpiSwiglu, pg8::StaticOrder, true, true>(F.lds, g, S, E, F.wave); }

        GRID_BAR();
        { pg8::Gemm g{WSB(F, WS_ACT), lw(F, l, LW_DN2), M_PAD, D, DFF}; pg8::StaticOrder S; S.init(MP, D, opq(F.G), opq((int)blockIdx.x));
          EpiResid E{F.ws, ALPHA, 0.5f};
          pg8::gemm_phase<EpiResid, pg8::StaticOrder, true, true>(F.lds, g, S, E, F.wave); }

        GRID_BAR();
        if (blockIdx.x < 16) { const int kh = opq((int)blockIdx.x) >> 3; pg8::Gemm g{WSB(F, WS_ACT) + kh * (DFF / 2), lw(F, l, LW_DN2) + kh * (DFF / 2), M_PAD, D, DFF / 2, DFF}; SmallOrderH S{opq((int)blockIdx.x)};
            EpiPart E{(float*)WSB(F, WS_ACT) + (size_t)kh * 512 * D};
            pg8::gemm_phase<EpiPart, SmallOrderH, true, true>(F.lds, g, S, E, F.wave); }
        else ln_phase(F, l * 3 + 2, l + 1 == DEPTH, 0, MP, 16);
        GRID_BAR();
        ln_phase(F, l * 3 + 2, l + 1 == DEPTH, MP, M_PAD, 0, true);
        if (l + 1 < DEPTH) GRID_BAR();
    }
}

extern "C" void kernel_launch(void* const* d_in, const int* in_sizes, int n_in, void* d_out, int out_size, void* d_ws, size_t ws_size, hipStream_t stream) {
    static int grid = 0;
    if (grid == 0) {
        if (n_in != 19 || (size_t)out_size != O_END || ws_size < WS_END) { fprintf(stderr, "kernel_launch: unexpected sizes (n_in %d out %d ws %zu need %zu)\n", n_in, out_size, ws_size, (size_t)WS_END); grid = -1; return; }
        int dev = 0, cus = 0, per_cu = 0;
        if (hipGetDevice(&dev) != hipSuccess || hipDeviceGetAttribute(&cus, hipDeviceAttributeMultiprocessorCount, dev) != hipSuccess) { grid = -1; return; }
        if (hipFuncSetAttribute((const void*)mega_fwd, hipFuncAttributeMaxDynamicSharedMemorySize, LDS_BYTES) != hipSuccess) { fprintf(stderr, "kernel_launch: hipFuncSetAttribute failed\n"); grid = -1; return; }
        if (hipOccupancyMaxActiveBlocksPerMultiprocessor(&per_cu, (const void*)mega_fwd, 512, LDS_BYTES) != hipSuccess || per_cu < 1) { fprintf(stderr, "kernel_launch: occupancy query says %d\n", per_cu); }
        (void)hipGetLastError();
        grid = cus;
    }
    if (grid < 0) return;
    if (hipMemsetAsync((char*)d_ws + WS_CTL, 0, CTL_ZERO_BYTES, stream) != hipSuccess) return;
    Args a{};
    for (int i = 0; i < 19; ++i) a.in[i] = (const float*)d_in[i];
    a.out = (float*)d_out; a.ws = (unsigned char*)d_ws;
    hipLaunchKernelGGL(mega_fwd, dim3(grid), dim3(512), LDS_BYTES, stream, a);
}
```

```cpp
#include <hip/hip_runtime.h>
#include <cstdio>
#include <cstdint>
__device__ __forceinline__ unsigned lane_lo_() { unsigned l; asm volatile("v_mbcnt_lo_u32_b32 %0, -1, 0" : "=v"(l)); return l; }
__device__ __forceinline__ int lane_id_() { unsigned l; asm volatile("v_mbcnt_lo_u32_b32 %0, -1, 0\n\tv_mbcnt_hi_u32_b32 %0, -1, %0" : "=v"(l)); return (int)l; }
namespace pg8 {
#define PG8_LAS __attribute__((address_space(3)))
typedef unsigned short bf16_t;
typedef short bf16x8 __attribute__((ext_vector_type(8)));
typedef float f32x4 __attribute__((ext_vector_type(4)));
typedef unsigned u32x4 __attribute__((ext_vector_type(4)));
constexpr int BM = 256, BK = 64, HALF = 128, HTB = HALF * BK * 2  , STAGE_BYTES = 8 * HTB, NXCD = 8, WGM = 4;

__host__ __device__ __forceinline__ int lds_byte(int r, int c) { const int st = (r >> 4) * 2 + (c >> 5), rr = r & 15, cc = c & 31, ob = rr * 64 + cc * 2; return st * 1024 + (ob ^ (((ob >> 9) & 1) << 5)); }
__host__ __device__ __forceinline__ void stage_rc(int b, int& R, int& C) { const int st = b / 1024, sb = b % 1024, swz = sb ^ (((sb >> 9) & 1) << 5); R = (st >> 1) * 16 + swz / 64; C = (st & 1) * 32 + (swz % 64) / 2; }
__host__ __device__ __forceinline__ int perm32(int rho) { const int n = rho >> 4, i = rho & 15; return 8 * (i >> 2) + 4 * n + (i & 3); }

struct Unit { int pm, pn; };
struct Gemm { const bf16_t* A; const bf16_t* Bt; int M, N, K; int ld = 0; };

struct StaticOrder {
    int nM, nN, nwg, G, c;
    __host__ __device__ void init(int M, int N, int G_, int c_) { nM = M / BM; nN = N / BM; nwg = nM * nN; G = G_; c = c_; }
    __host__ __device__ bool next(int i, Unit& u) const {
        const long L = (long)i * G + c; if (L >= nwg) return false;
        int wgid = (int)L; { const int q = nwg / NXCD, r = nwg % NXCD, xcd = wgid % NXCD, off = wgid / NXCD; wgid = (xcd < r ? xcd * (q + 1) : r * (q + 1) + (xcd - r) * q) + off; }
        const int nig = WGM * nN, gid = wgid / nig, fm = gid * WGM, gsz = (nM - fm) < WGM ? (nM - fm) : WGM;
        u.pm = fm + ((wgid % nig) % gsz); u.pn = (wgid % nig) / gsz; return true;
    }
    __device__ __forceinline__ void a_ready(const Unit&) const {}
    __device__ __forceinline__ void done(const Unit&) const {}
};

__device__ __forceinline__ unsigned cvt_pk_bf16(float lo, float hi) { unsigned r; asm volatile("v_cvt_pk_bf16_f32 %0, %1, %2" : "=v"(r) : "v"(lo), "v"(hi)); return r; }
template <class Epi, class Sched, bool ALIGN_EPI = false, bool SP2 = false>
__device__ __forceinline__ void gemm_phase(PG8_LAS unsigned char* lds, const Gemm g, const Sched& S, const Epi& E, const int wave_id) {
    int lane_ = lane_id_(); asm volatile("" : "+v"(lane_));
    const int tid = wave_id * 64 + lane_;
    int widq_ = wave_id; asm volatile("" : "+s"(widq_));
    const int wid = widq_, lane = tid & 63, wr = wid >> 2, wc = wid & 3, fr = lane & 15, fq = lane >> 4;
    const int K = g.K, nt = K / BK, LD = g.ld > 0 ? g.ld : K;
    unsigned voffA[2], voffB[2];
#pragma unroll
    for (int i = 0; i < 2; ++i) { int R, C; stage_rc(tid * 16 + i * 8192, R, C); const int Rb = Epi::PERM ? ((R & ~31) + perm32(R & 31)) : R;
        voffA[i] = (unsigned)(R * LD + C) * 2u; voffB[i] = (unsigned)(Rb * LD + C) * 2u; }
    const size_t kstep = (size_t)(BK * 2);
    const size_t hstep = (size_t)HALF * LD * 2;
    const size_t tstep = 2 * hstep;
    const unsigned ldsw = (unsigned)wid * 1024u;
    const int aoff = lds_byte(wr * 64 + fr, fq * 8), boff = lds_byte(wc * 32 + fr, fq * 8);
#define PG8_SA(b, h) (((b) * 2 + (h)) * HTB)
#define PG8_SB(b, h) ((4 + (b) * 2 + (h)) * HTB)
#define PG8_STAGE(bufoff, gbase, voff) do { _Pragma("unroll") for (int _i = 0; _i < 2; ++_i) \
        __builtin_amdgcn_global_load_lds((const unsigned*)((const char*)(gbase) + (voff)[_i]), (PG8_LAS unsigned*)(lds + (bufoff) + ldsw + _i * 8192), 16, 0, 0); } while (0)
#define PG8_LDA(dst, b, h) do { _Pragma("unroll") for (int m = 0; m < 4; ++m) _Pragma("unroll") for (int k = 0; k < 2; ++k) dst[m][k] = *(const PG8_LAS bf16x8*)(lds + PG8_SA(b, h) + aoff + m * 2048 + k * 1024); } while (0)
#define PG8_LDB(dst, b, h) do { _Pragma("unroll") for (int n = 0; n < 2; ++n) _Pragma("unroll") for (int k = 0; k < 2; ++k) dst[n][k] = *(const PG8_LAS bf16x8*)(lds + PG8_SB(b, h) + boff + n * 2048 + k * 1024); } while (0)
#define PG8_MMA(ai, bj, At, Bt) do { __builtin_amdgcn_s_setprio(1); _Pragma("unroll") for (int m = 0; m < 4; ++m) _Pragma("unroll") for (int n = 0; n < 2; ++n) _Pragma("unroll") for (int k = 0; k < 2; ++k) \
        acc[ai][bj][m][n] = __builtin_amdgcn_mfma_f32_16x16x32_bf16(Bt[n][k], At[m][k], acc[ai][bj][m][n], 0, 0, 0); __builtin_amdgcn_s_setprio(0); } while (0)
#define PG8_WAIT_V(n) asm volatile("s_waitcnt vmcnt(" #n ")" ::: "memory")
#define PG8_WAIT_VN(n) asm volatile("s_waitcnt vmcnt(%0)" :: "n"(n) : "memory")
#define PG8_WAIT_L(n) asm volatile("s_waitcnt lgkmcnt(" #n ")" ::: "memory")
#define PG8_BAR __builtin_amdgcn_s_barrier()
#define PG8_SCHED __builtin_amdgcn_sched_barrier(0)
    Unit cur, nxt; int ui = 0;
    if (!S.next(0, cur)) return;
    f32x4 acc[2][2][4][2];
#pragma unroll
    for (int a = 0; a < 2; ++a)
#pragma unroll
        for (int b = 0; b < 2; ++b)
#pragma unroll
            for (int m = 0; m < 4; ++m)
#pragma unroll
                for (int n = 0; n < 2; ++n) acc[a][b][m][n] = (f32x4){0.f, 0.f, 0.f, 0.f};
    bf16x8 At[4][2], B0[2][2], B1[2][2];
    const char* cA = (const char*)g.A + (size_t)cur.pm * tstep; const char* cB = (const char*)g.Bt + (size_t)cur.pn * tstep;
    S.a_ready(cur);
    if constexpr (SP2) {
        PG8_STAGE(PG8_SB(0, 0), cB, voffB); PG8_STAGE(PG8_SB(0, 1), cB + hstep, voffB); PG8_STAGE(PG8_SA(0, 0), cA, voffA); PG8_STAGE(PG8_SA(0, 1), cA + hstep, voffA);
        if (wr == 1) PG8_BAR;
        PG8_WAIT_V(2); PG8_BAR;
        PG8_STAGE(PG8_SB(1, 0), cB + kstep, voffB); PG8_STAGE(PG8_SA(1, 0), cA + kstep, voffA); PG8_STAGE(PG8_SB(1, 1), cB + hstep + kstep, voffB);
        PG8_WAIT_V(6); PG8_BAR;
    } else {
        PG8_STAGE(PG8_SB(0, 0), cB, voffB); PG8_STAGE(PG8_SA(0, 0), cA, voffA); PG8_STAGE(PG8_SB(0, 1), cB + hstep, voffB); PG8_STAGE(PG8_SA(0, 1), cA + hstep, voffA);
        if (wr == 1) PG8_BAR;
        PG8_WAIT_V(4); PG8_BAR;
        PG8_STAGE(PG8_SB(1, 0), cB + kstep, voffB); PG8_STAGE(PG8_SA(1, 0), cA + kstep, voffA); PG8_STAGE(PG8_SB(1, 1), cB + hstep + kstep, voffB);
        PG8_WAIT_V(6); PG8_BAR;
    }
    for (;;) {
        const bool has_next = S.next(ui + 1, nxt);
        const char* nA = has_next ? (const char*)g.A + (size_t)nxt.pm * tstep : cA; const char* nB = has_next ? (const char*)g.Bt + (size_t)nxt.pn * tstep : cB;
        for (int t = 0; t < nt; t += 2) {
            const bool last = (t == nt - 2);
            const char* a1 = cA + (size_t)(t + 1) * kstep;
            const char* a2 = last ? nA : cA + (size_t)(t + 2) * kstep; const char* b2 = last ? nB : cB + (size_t)(t + 2) * kstep;
            const char* a3 = a2 + kstep; const char* b3 = b2 + kstep;
            if (last && has_next) S.a_ready(nxt);
            if constexpr (SP2) {
            int tz_ = __builtin_amdgcn_readfirstlane(t | (ui > 0 ? 0 : 1)); asm volatile("" : "+s"(tz_));
            const bool strict = !(Epi::NS > 0 && tz_ == 0);
            PG8_LDB(B0, 0, 0); PG8_LDB(B1, 0, 1); PG8_SCHED; PG8_LDA(At, 0, 0); PG8_STAGE(PG8_SA(1, 1), a1 + hstep, voffA);
            PG8_WAIT_VN(8 + Epi::NS); if (strict) PG8_WAIT_V(8); PG8_WAIT_L(0); PG8_BAR; PG8_MMA(0, 0, At, B0); PG8_MMA(0, 1, At, B1); PG8_BAR; PG8_SCHED;
            PG8_LDA(At, 0, 1); PG8_STAGE(PG8_SB(0, 0), b2, voffB); PG8_STAGE(PG8_SB(0, 1), b2 + hstep, voffB); PG8_STAGE(PG8_SA(0, 0), a2, voffA);
            PG8_WAIT_VN(8 + Epi::NS); if (strict) PG8_WAIT_V(8); PG8_WAIT_L(0); PG8_BAR; PG8_MMA(1, 0, At, B0); PG8_MMA(1, 1, At, B1); PG8_BAR; PG8_SCHED;
            PG8_LDB(B0, 1, 0); PG8_LDB(B1, 1, 1); PG8_SCHED; PG8_LDA(At, 1, 0); PG8_STAGE(PG8_SA(0, 1), a2 + hstep, voffA);
            PG8_WAIT_V(8); PG8_WAIT_L(0); PG8_BAR; PG8_MMA(0, 0, At, B0); PG8_MMA(0, 1, At, B1); PG8_BAR; PG8_SCHED;
            PG8_LDA(At, 1, 1); PG8_STAGE(PG8_SB(1, 0), b3, voffB); PG8_STAGE(PG8_SB(1, 1), b3 + hstep, voffB); PG8_STAGE(PG8_SA(1, 0), a3, voffA);
            PG8_WAIT_V(8); PG8_WAIT_L(0); PG8_BAR; PG8_MMA(1, 0, At, B0); PG8_MMA(1, 1, At, B1); PG8_BAR; PG8_SCHED;
            } else {
            PG8_LDB(B0, 0, 0); PG8_SCHED; PG8_LDA(At, 0, 0); PG8_STAGE(PG8_SA(1, 1), a1 + hstep, voffA);
            PG8_WAIT_L(8); PG8_BAR; PG8_WAIT_L(0); PG8_MMA(0, 0, At, B0); PG8_BAR; PG8_SCHED;
            PG8_LDB(B1, 0, 1); PG8_STAGE(PG8_SB(0, 0), b2, voffB);
            PG8_BAR; PG8_WAIT_L(0); PG8_MMA(0, 1, At, B1); PG8_BAR;
            PG8_LDA(At, 0, 1); PG8_STAGE(PG8_SA(0, 0), a2, voffA);
            PG8_BAR; PG8_WAIT_L(0); PG8_MMA(1, 0, At, B0); PG8_BAR; PG8_SCHED;
            PG8_STAGE(PG8_SB(0, 1), b2 + hstep, voffB);
            PG8_WAIT_V(6); PG8_BAR; PG8_MMA(1, 1, At, B1); PG8_BAR;
            PG8_LDB(B0, 1, 0); PG8_SCHED; PG8_LDA(At, 1, 0); PG8_STAGE(PG8_SA(0, 1), a2 + hstep, voffA);
            PG8_WAIT_L(8); PG8_BAR; PG8_WAIT_L(0); PG8_MMA(0, 0, At, B0); PG8_BAR; PG8_SCHED;
            PG8_LDB(B1, 1, 1); PG8_STAGE(PG8_SB(1, 0), b3, voffB);
            PG8_BAR; PG8_WAIT_L(0); PG8_MMA(0, 1, At, B1); PG8_BAR;
            PG8_LDA(At, 1, 1); PG8_STAGE(PG8_SA(1, 0), a3, voffA);
            PG8_BAR; PG8_WAIT_L(0); PG8_MMA(1, 0, At, B0); PG8_BAR; PG8_SCHED;
            PG8_STAGE(PG8_SB(1, 1), b3 + hstep, voffB);
            PG8_WAIT_V(6); PG8_BAR; PG8_MMA(1, 1, At, B1); PG8_BAR;
            }
        }
        if constexpr (ALIGN_EPI) { if (wr == 0) PG8_BAR; }
        const bool keep_acc = E(acc, cur, wr, wc, fr, fq);
        if (!has_next) break;
        if (!keep_acc) {
#pragma unroll
        for (int a = 0; a < 2; ++a)
#pragma unroll
            for (int b = 0; b < 2; ++b)
#pragma unroll
                for (int m = 0; m < 4; ++m)
#pragma unroll
                    for (int n = 0; n < 2; ++n) acc[a][b][m][n] = (f32x4){0.f, 0.f, 0.f, 0.f};
        }
        cur = nxt; cA = nA; cB = nB; ++ui;
        if constexpr (ALIGN_EPI) { if (wr == 1) PG8_BAR; }
    }
    PG8_WAIT_V(0);
    if constexpr (!ALIGN_EPI) { if (wr == 0) PG8_BAR; }
    PG8_BAR;
#undef PG8_SA
#undef PG8_SB
#undef PG8_STAGE
#undef PG8_LDA
#undef PG8_LDB
#undef PG8_MMA
#undef PG8_WAIT_V
#undef PG8_WAIT_VN
#undef PG8_WAIT_L
#undef PG8_BAR
#undef PG8_SCHED
}
}

constexpr int D = 1024, NB = 32, T = 2048, DEPTH = 2, SBATCH = 8, ST = 32, PAST = 4096, NMETA = 16;
constexpr int HRET = 4, DKR = 128, DVR = 256, HSB = 8, DSB = 128, DFF = 2816, DIN = 10240, PBUF = 15;
constexpr int MP = NB * T;
constexpr int ROW_S = MP;
constexpr int ROW_M = MP + SBATCH * ST;
constexpr int M_PAD = ROW_M + 256;
constexpr int NPANEL = M_PAD / 256;
constexpr float LN_EPS = 1e-5f;
constexpr float ALPHA = 1.41421356237f;
constexpr float LOG2E = 1.44269504089f;
constexpr int KT_SP = PAST + ST;
constexpr int KT_PP = NMETA + T;

constexpr size_t O_YP = 0;
constexpr size_t O_YS = O_YP + (size_t)NB * T * D;
constexpr size_t O_KP = O_YS + (size_t)SBATCH * ST * D;
constexpr size_t O_VP = O_KP + (size_t)DEPTH * NB * KT_PP * D;
constexpr size_t O_RP = O_VP + (size_t)DEPTH * NB * KT_PP * D;
constexpr size_t O_PP = O_RP + (size_t)DEPTH * NB * HRET * DKR * DVR;
constexpr size_t O_KS = O_PP + (size_t)DEPTH * NB * PBUF * D;
constexpr size_t O_VS = O_KS + (size_t)DEPTH * SBATCH * ST * D;
constexpr size_t O_RS = O_VS + (size_t)DEPTH * SBATCH * ST * D;
constexpr size_t O_PS = O_RS + (size_t)DEPTH * SBATCH * HRET * DKR * DVR;
constexpr size_t O_END = O_PS + (size_t)DEPTH * SBATCH * PBUF * D;
static_assert(O_END == 350666752ull, "output size");

constexpr size_t MiB = 1u << 20;
constexpr size_t AL(size_t x) { return (x + 4095) & ~(size_t)4095; }
constexpr size_t WS_CTL = 0, CTL_ZERO_BYTES = 1 * MiB;
constexpr size_t WS_YB = WS_CTL + CTL_ZERO_BYTES;
constexpr size_t WS_HB = AL(WS_YB + (size_t)M_PAD * D * 2);
constexpr size_t WS_ACT = AL(WS_HB + (size_t)M_PAD * D * 2);
constexpr size_t WS_QR = AL(WS_ACT + (size_t)M_PAD * DFF * 2);
constexpr size_t WS_KR = AL(WS_QR + (size_t)M_PAD * 512 * 2);
constexpr size_t WS_VR = AL(WS_KR + (size_t)M_PAD * 512 * 2);
constexpr size_t WS_GR = AL(WS_VR + (size_t)M_PAD * D * 2);
constexpr size_t WS_QS = AL(WS_GR + (size_t)M_PAD * D * 2);
constexpr size_t WS_KS = AL(WS_QS + (size_t)M_PAD * D * 2);
constexpr size_t WS_VS = AL(WS_KS + (size_t)M_PAD * D * 2);
constexpr size_t WS_U = AL(WS_VS + (size_t)M_PAD * D * 2);
constexpr size_t WS_GT = AL(WS_U + (size_t)M_PAD * D * 2);
constexpr size_t WS_BR = AL(WS_GT + (size_t)M_PAD * 3 * D * 2);
constexpr size_t WS_MIX = AL(WS_BR + (size_t)3 * M_PAD * D * 2);
constexpr size_t WS_W = AL(WS_MIX + (size_t)M_PAD * D * 2);
constexpr size_t LW_UP1 = 0;
constexpr size_t LW_DN1 = LW_UP1 + (size_t)2 * DFF * D * 2;
constexpr size_t LW_IN = LW_DN1 + (size_t)D * DFF * 2;
constexpr size_t LW_BR = LW_IN + (size_t)DIN * D * 2;
constexpr size_t LW_OUT = LW_BR + (size_t)3 * D * D * 2;
constexpr size_t LW_UP2 = LW_OUT + (size_t)D * D * 2;
constexpr size_t LW_DN2 = LW_UP2 + (size_t)2 * DFF * D * 2;
constexpr size_t LW_SIZE = AL(LW_DN2 + (size_t)D * DFF * 2);
constexpr size_t WS_END = WS_W + DEPTH * LW_SIZE;
static_assert(WS_END < (size_t)4000 * MiB, "workspace budget");

constexpr int CW_BAR = 4096;
constexpr int CW_Q = 16384;
constexpr int CW_CH = 24576;
constexpr int CW_DBG = 32768;
constexpr int CW_KN = 65536;
static_assert((CW_KN + DEPTH * 33 * 8 * 16) * 4 <= (int)CTL_ZERO_BYTES, "ctl region");

constexpr int RING_BYTES = 131072;
constexpr int LDSCTL_OFF = RING_BYTES, MISC_OFF = LDSCTL_OFF + 320;
constexpr int LDS_BYTES = 147456;

#define GAS __attribute__((address_space(1)))
#define LAS __attribute__((address_space(3)))
typedef unsigned short bf16;
typedef unsigned v4u __attribute__((ext_vector_type(4)));
typedef unsigned v2u __attribute__((ext_vector_type(2)));
typedef float f32x4 __attribute__((ext_vector_type(4)));
typedef short bf16x8 __attribute__((ext_vector_type(8)));
typedef short s16x4 __attribute__((ext_vector_type(4)));
typedef GAS unsigned gu32;
#define RLX_AGENT __ATOMIC_RELAXED, __HIP_MEMORY_SCOPE_AGENT
__device__ __forceinline__ unsigned f2bf(float f) { unsigned u = __builtin_bit_cast(unsigned, f); return (u + 0x7fffu + ((u >> 16) & 1u)) >> 16; }
__device__ __forceinline__ unsigned pk2(float lo, float hi) { return f2bf(lo) | (f2bf(hi) << 16); }
__device__ __forceinline__ float bf2f(unsigned short b) { return __builtin_bit_cast(float, (unsigned)b << 16); }
__device__ __forceinline__ float bflo(unsigned w) { return __builtin_bit_cast(float, w << 16); }
__device__ __forceinline__ float bfhi(unsigned w) { return __builtin_bit_cast(float, w & 0xffff0000u); }
__device__ __forceinline__ float fast_exp2(float x) { return __builtin_amdgcn_exp2f(x); }
__device__ __forceinline__ float fast_log2(float x) { return __builtin_amdgcn_logf(x); }
__device__ __forceinline__ float fast_rcp(float x) { return __builtin_amdgcn_rcpf(x); }
__device__ __forceinline__ float sigmoidf_(float x) { return fast_rcp(1.0f + fast_exp2(-x * LOG2E)); }
__device__ __forceinline__ float siluf_(float x) { return x * sigmoidf_(x); }
__device__ __forceinline__ float wave_sum(float v) {
#pragma unroll
    for (int o = 1; o < 64; o <<= 1) v += __shfl_xor(v, o);
    return v;
}
#define XB_TMO      128
#define XB_XCNT(j)  (256  + 64 * (j))
#define XB_XSUB(j)  (1280 + 64 * (j))
#define XB_XGEN(j)  (2304 + 64 * (j))
#define XB_TOP      3328
#define XB_TOPGEN   3392
#define XCD_BAR_WORDS 3456
#define XB_SPIN_CAP (1u << 20)

__device__ __forceinline__ unsigned xb_ld(unsigned* p)              { return __hip_atomic_load(p, __ATOMIC_RELAXED, __HIP_MEMORY_SCOPE_AGENT); }
__device__ __forceinline__ unsigned xb_add(unsigned* p, unsigned v) { return __hip_atomic_fetch_add(p, v, __ATOMIC_RELAXED, __HIP_MEMORY_SCOPE_AGENT); }
__device__ __forceinline__ unsigned xb_xcc_id() { return (unsigned)__builtin_amdgcn_s_getreg((3 << 11) | 20) & 0xFu; }
#define XB_SPIN(cond, bar) do { unsigned _sp = 0; while (cond) { __builtin_amdgcn_s_sleep(1); \
    if ((++_sp & 255u) == 0u) { if (xb_ld(&(bar)[XB_TMO])) break; if (_sp > XB_SPIN_CAP) { atomicAdd(&(bar)[XB_TMO], 1u); break; } } } } while (0)

struct XcdBarrier {
    unsigned* bar; unsigned x; unsigned w0;
    volatile LAS unsigned* st;
};

__device__ __forceinline__ XcdBarrier xcd_barrier_post(unsigned* bar, volatile LAS unsigned* st) {
    XcdBarrier b; b.bar = bar; b.x = xb_xcc_id(); b.st = st; b.w0 = (__builtin_amdgcn_readfirstlane((int)threadIdx.x >> 6) == 0) ? 1u : 0u;
    if (threadIdx.x == 0) (void)xb_add(&bar[XB_XCNT(b.x)], 1u);
    return b;
}
__device__ __forceinline__ void xcd_barrier_complete(unsigned* bar, unsigned x, unsigned& nloc, unsigned& nx) {
    const unsigned G = gridDim.x * gridDim.y * gridDim.z;
    unsigned sum, cnt, mine, sp = 0u;
    for (;;) {
        sum = 0u; cnt = 0u; mine = 0u;
#pragma unroll
        for (unsigned j = 0; j < 16; ++j) { const unsigned c = xb_ld(&bar[XB_XCNT(j)]); sum += c; cnt += (c > 0u) ? 1u : 0u; mine = (j == x) ? c : mine; }
        if (sum == G) break;
        __builtin_amdgcn_s_sleep(1);
        if ((++sp & 255u) == 0u) { if (xb_ld(&bar[XB_TMO])) break; if (sp > XB_SPIN_CAP) { atomicAdd(&bar[XB_TMO], 1u); break; } }
    }
    nloc = mine > 0u ? mine : 1u; nx = cnt > 0u ? cnt : 1u;
}

__device__ __forceinline__ void xcd_barrier(const XcdBarrier& b) {
    asm volatile("s_waitcnt vmcnt(0)" ::: "memory");
    __syncthreads();
    if (b.w0 != 0u && lane_lo_() == 0u) {
        unsigned* bar = b.bar; unsigned bx = b.x; asm volatile("" : "+s"(bar), "+s"(bx));
        __builtin_amdgcn_s_waitcnt(0);
        unsigned nloc = b.st[0], nx = b.st[1];
        if (nloc == 0u) { xcd_barrier_complete(bar, bx, nloc, nx); b.st[0] = nloc; b.st[1] = nx; }
        const unsigned old = xb_add(&bar[XB_XSUB(bx)], 1u);
        const unsigned gen = old / nloc;
        if (old + 1u == (gen + 1u) * nloc) {
            __builtin_amdgcn_fence(__ATOMIC_RELEASE, "agent");
            asm volatile("s_waitcnt vmcnt(0)" ::: "memory");
            const unsigned og = xb_add(&bar[XB_TOP], 1u);
            const unsigned tg = og / nx;
            if (og + 1u == (tg + 1u) * nx) xb_add(&bar[XB_TOPGEN], 1u);
            else XB_SPIN(xb_ld(&bar[XB_TOPGEN]) == tg, bar);
            __builtin_amdgcn_fence(__ATOMIC_ACQUIRE, "agent");
            xb_add(&bar[XB_XGEN(bx)], 1u);
            asm volatile("s_waitcnt vmcnt(0)" ::: "memory");
        } else {
            XB_SPIN(xb_ld(&bar[XB_XGEN(bx)]) == gen, bar);
            __builtin_amdgcn_fence(__ATOMIC_ACQUIRE, "agent");
            asm volatile("s_waitcnt vmcnt(0)" ::: "memory");
        }
    }
    __syncthreads();
}

struct Frame {
    LAS unsigned char* lds;
    volatile LAS unsigned* MISC;
    gu32* ctl;
    int G, wave;
    float* out; unsigned char* ws;
};
__device__ __forceinline__ const float* in_ptr(int i) {
    const __attribute__((address_space(4))) char* k = (const __attribute__((address_space(4))) char*)__builtin_amdgcn_kernarg_segment_ptr();
    asm volatile("" : "+s"(k));
    return *(const float* const __attribute__((address_space(4)))*)(k + 8 * i);
}
enum { IN_XP = 0, IN_XS, IN_CK, IN_CV, IN_SRET, IN_SPOOL, IN_META, IN_WIN, IN_RETG, IN_PMIX, IN_PSCALE, IN_WBR, IN_WOUT, IN_UP1, IN_DN1, IN_UP2, IN_DN2, IN_LNG, IN_LNB };
__device__ __forceinline__ unsigned char* wsq(unsigned char* p) { asm volatile("" : "+s"(p)); return p; }
#define WSB(F, off) ((bf16*)(wsq((F).ws) + (off)))
struct TC { int tid, lane, wave; };
__device__ __forceinline__ TC thread_coords(int wave) { TC c; int l = lane_id_(); asm volatile("" : "+v"(l)); c.lane = l; c.wave = wave; c.tid = wave * 64 + l; return c; }
__device__ __forceinline__ bf16* lw(const Frame& F, int l, size_t off) { return (bf16*)(wsq(F.ws) + WS_W + (size_t)l * LW_SIZE + off); }
__device__ __forceinline__ float* yrow(const Frame& F, int m) {
    if (m < MP) return F.out + O_YP + (size_t)m * D;
    if (m < ROW_M) return F.out + O_YS + (size_t)(m - ROW_S) * D;
    return nullptr;
}

__device__ __forceinline__ int srccol(int kind, int n) {
    if (kind == 1) { const int pn = n >> 8, p = n & 255, bj = p >> 7, wc = (p >> 5) & 3, fq = (p >> 3) & 3, nn = (p >> 2) & 1, e = p & 3;
        return (nn ? DFF : 0) + 128 * pn + 64 * bj + 16 * wc + 4 * fq + e; }
    if (kind == 2 && n < 1024) { const int hb_ = n & ~127, p = n & 127, wc = p >> 5, fq = (p >> 3) & 3, nn = (p >> 2) & 1, e = p & 3;
        return hb_ + 16 * wc + 4 * fq + e + 64 * nn; }
    return n;
}
__device__ __forceinline__ void p0_transpose_item(const float* W, int K, int ldw, int N, bf16* WT, int kind, LAS float* scr, int item, int lane) {
    const int nblk = N / 32, blk = item >> 3, wv = item & 7, kb = 2 * (blk / (nblk >> 2)) + (wv >> 2), nb = 4 * (blk % (nblk >> 2)) + (wv & 3), k0 = 64 * kb, n0 = 32 * nb;
    const int sc = srccol(kind, n0 + (lane & 31));
    float t_[32];
#pragma unroll
    for (int i = 0; i < 32; ++i) t_[i] = W[(size_t)(k0 + 2 * i + (lane >> 5)) * ldw + sc];
#pragma unroll
    for (int i = 0; i < 32; ++i) scr[(2 * i + (lane >> 5)) * 33 + (lane & 31)] = t_[i];
    asm volatile("s_waitcnt lgkmcnt(0)" ::: "memory");
    const int c = lane & 7;
#pragma unroll
    for (int j = 0; j < 4; ++j) { const int n = (lane >> 3) + 8 * j; const LAS float* s = scr + (8 * c) * 33 + n;
        v4u o; o.x = pk2(s[0 * 33], s[1 * 33]); o.y = pk2(s[2 * 33], s[3 * 33]); o.z = pk2(s[4 * 33], s[5 * 33]); o.w = pk2(s[6 * 33], s[7 * 33]);
        *(GAS v4u*)(WT + (size_t)(n0 + n) * K + k0 + 8 * c) = o; }
    asm volatile("s_waitcnt lgkmcnt(0)" ::: "memory");
}
__device__ __forceinline__ void p0_poolfold_item(const float* mixw  , const float* scale  , const float* wb2  , bf16* WT  , int item, int lane) {
    const int g = item >> 7, r = item & 127, cb = r >> 4, nb = r & 15;
    const int n = nb * 64 + lane, c0 = cb * 32;
    float acc[32];
#pragma unroll
    for (int i = 0; i < 32; ++i) acc[i] = 0.f;
    const float* mw = mixw + ((size_t)g * 256 + c0) * 256;
    for (int d0 = 0; d0 < 256; d0 += 8) {
        float a[8];
#pragma unroll
        for (int j = 0; j < 8; ++j) a[j] = scale[g * 256 + d0 + j] * wb2[(size_t)(g * 256 + d0 + j) * D + n];
#pragma unroll
        for (int i = 0; i < 32; ++i)
#pragma unroll
            for (int j = 0; j < 8; ++j) acc[i] += mw[(size_t)i * 256 + d0 + j] * a[j];
    }
    bf16* dst = WT + (size_t)n * D + g * 256 + c0;
#pragma unroll
    for (int i = 0; i < 32; i += 8) { v4u o; o.x = pk2(acc[i], acc[i + 1]); o.y = pk2(acc[i + 2], acc[i + 3]); o.z = pk2(acc[i + 4], acc[i + 5]); o.w = pk2(acc[i + 6], acc[i + 7]); *(GAS v4u*)(dst + i) = o; }
}
__device__ __forceinline__ void p0_prologue(Frame& F) {
    const TC tc = thread_coords(F.wave); const int gw = blockIdx.x * 8 + tc.wave, NGW = F.G * 8;
    LAS float* scr = (LAS float*)(F.lds + tc.wave * 16384);
    for (int l = 0; l < DEPTH; ++l) {
        constexpr int I_UP = (D / 64) * (2 * DFF / 32), I_DN = (DFF / 64) * (D / 32), I_IN = (D / 64) * (DIN / 32), I_SQ = (D / 64) * (D / 32), I_PF = 4 * 4 * 32;
        constexpr int NIT = 2 * I_UP + 2 * I_DN + I_IN + 3 * I_SQ + I_PF;
        for (int it = (gw + l * (NGW / 2)) % NGW; it < NIT; it += NGW) {
            int r = it;
            if (r < I_UP) { p0_transpose_item(in_ptr(IN_UP1) + (size_t)l * D * 2 * DFF, D, 2 * DFF, 2 * DFF, lw(F, l, LW_UP1), 1, scr, r, tc.lane); continue; } r -= I_UP;
            if (r < I_UP) { p0_transpose_item(in_ptr(IN_UP2) + (size_t)l * D * 2 * DFF, D, 2 * DFF, 2 * DFF, lw(F, l, LW_UP2), 1, scr, r, tc.lane); continue; } r -= I_UP;
            if (r < I_DN) { p0_transpose_item(in_ptr(IN_DN1) + (size_t)l * DFF * D, DFF, D, D, lw(F, l, LW_DN1), 0, scr, r, tc.lane); continue; } r -= I_DN;
            if (r < I_DN) { p0_transpose_item(in_ptr(IN_DN2) + (size_t)l * DFF * D, DFF, D, D, lw(F, l, LW_DN2), 0, scr, r, tc.lane); continue; } r -= I_DN;
            if (r < I_IN) { p0_transpose_item(in_ptr(IN_WIN) + (size_t)l * D * DIN, D, DIN, DIN, lw(F, l, LW_IN), 2, scr, r, tc.lane); continue; } r -= I_IN;
            if (r < I_SQ) { p0_transpose_item(in_ptr(IN_WBR) + (size_t)(l * 3 + 0) * D * D, D, D, D, lw(F, l, LW_BR), 0, scr, r, tc.lane); continue; } r -= I_SQ;
            if (r < I_SQ) { p0_transpose_item(in_ptr(IN_WBR) + (size_t)(l * 3 + 1) * D * D, D, D, D, lw(F, l, LW_BR) + (size_t)D * D, 0, scr, r, tc.lane); continue; } r -= I_SQ;
            if (r < I_SQ) { p0_transpose_item(in_ptr(IN_WOUT) + (size_t)l * D * D, D, D, D, lw(F, l, LW_OUT), 0, scr, r, tc.lane); continue; } r -= I_SQ;
            p0_poolfold_item(in_ptr(IN_PMIX) + (size_t)l * 4 * 256 * 256, in_ptr(IN_PSCALE) + (size_t)l * D, in_ptr(IN_WBR) + (size_t)(l * 3 + 2) * D * D, lw(F, l, LW_BR) + (size_t)2 * D * D, r, tc.lane);
        }
    }
    for (int m0 = gw; m0 < M_PAD; m0 += 2 * NGW) {
        f32x4 v[2][4];
#pragma unroll
        for (int r = 0; r < 2; ++r) { const int m = m0 + r * NGW;
            const float* src = (m < MP) ? in_ptr(IN_XP) + (size_t)m * D : (m < ROW_M) ? in_ptr(IN_XS) + (size_t)(m - ROW_S) * D : (m - ROW_M < NMETA) ? in_ptr(IN_META) + (size_t)(m - ROW_M) * D : nullptr;
#pragma unroll
            for (int j = 0; j < 4; ++j) v[r][j] = (src && m < M_PAD) ? ((const GAS f32x4*)src)[tc.lane + 64 * j] : (f32x4){0.f, 0.f, 0.f, 0.f}; }
#pragma unroll
        for (int r = 0; r < 2; ++r) { const int m = m0 + r * NGW;
            if (m < M_PAD) { GAS v2u* o8 = (GAS v2u*)(WSB(F, WS_HB) + (size_t)m * D) + tc.lane;
#pragma unroll
                for (int j = 0; j < 4; ++j) o8[64 * j] = (v2u){pk2(v[r][j].x, v[r][j].y), pk2(v[r][j].z, v[r][j].w)}; } }
    }
}

__device__ __forceinline__ void ln_rows(const Frame& F, int idx, bool final_out, int row_lo, int row_hi, int gw0, int NGW, bool comb = false) {
    const TC tc = thread_coords(F.wave); const int gw = gw0 + tc.wave;
    const float* g = in_ptr(IN_LNG) + (size_t)idx * D; const float* b = in_ptr(IN_LNB) + (size_t)idx * D;
    f32x4 gv[4], bv[4];
#pragma unroll
    for (int j = 0; j < 2; ++j) { gv[2 * j] = ((const GAS f32x4*)g)[2 * tc.lane + 128 * j]; gv[2 * j + 1] = ((const GAS f32x4*)g)[2 * tc.lane + 128 * j + 1];
                                  bv[2 * j] = ((const GAS f32x4*)b)[2 * tc.lane + 128 * j]; bv[2 * j + 1] = ((const GAS f32x4*)b)[2 * tc.lane + 128 * j + 1]; }
    for (int m0 = row_lo + gw; m0 < row_hi; m0 += 2 * NGW) {
        v4u w[2][2]; const bool two = m0 + NGW < row_hi;
#pragma unroll
        for (int r = 0; r < 2; ++r) { const int m = (r == 0 || two) ? m0 + r * NGW : m0; const GAS v4u* yr = (const GAS v4u*)(WSB(F, comb ? WS_HB : WS_YB) + (size_t)m * D) + tc.lane; w[r][0] = yr[0]; w[r][1] = yr[64]; }
#pragma unroll
        for (int r = 0; r < 2; ++r) { const int m = m0 + r * NGW; if (r == 1 && !two) break;
        f32x4 v[4]; float s = 0.f;
#pragma unroll
        for (int j = 0; j < 2; ++j) { const v4u x = w[r][j]; v[2 * j] = (f32x4){bflo(x.x), bfhi(x.x), bflo(x.y), bfhi(x.y)}; v[2 * j + 1] = (f32x4){bflo(x.z), bfhi(x.z), bflo(x.w), bfhi(x.w)}; }
        if (comb) {
            const GAS f32x4* pa = (const GAS f32x4*)((const float*)WSB(F, WS_ACT) + (size_t)(m - MP) * D) + 2 * tc.lane; const GAS f32x4* pb = pa + (size_t)512 * D / 4;
#pragma unroll
            for (int j = 0; j < 2; ++j) { v[2 * j] = v[2 * j] * ALPHA + (pa[128 * j] + pb[128 * j]) * 0.5f; v[2 * j + 1] = v[2 * j + 1] * ALPHA + (pa[128 * j + 1] + pb[128 * j + 1]) * 0.5f; } }
#pragma unroll
        for (int j = 0; j < 4; ++j) s += (v[j].x + v[j].y) + (v[j].z + v[j].w);
        const float mean = wave_sum(s) * (1.f / D); float s2 = 0.f;
#pragma unroll
        for (int j = 0; j < 4; ++j) { v[j] = v[j] - mean; s2 += (v[j].x * v[j].x + v[j].y * v[j].y) + (v[j].z * v[j].z + v[j].w * v[j].w); }
        const float rstd = 1.f / sqrtf(wave_sum(s2) * (1.f / D) + LN_EPS);
#pragma unroll
        for (int j = 0; j < 4; ++j) v[j] = v[j] * rstd * gv[j] + bv[j];
        if (!final_out) { GAS v4u* o = (GAS v4u*)(WSB(F, WS_HB) + (size_t)m * D) + tc.lane;
#pragma unroll
            for (int j = 0; j < 2; ++j) o[64 * j] = (v4u){pk2(v[2 * j].x, v[2 * j].y), pk2(v[2 * j].z, v[2 * j].w), pk2(v[2 * j + 1].x, v[2 * j + 1].y), pk2(v[2 * j + 1].z, v[2 * j + 1].w)}; }
        else { float* yo = yrow(F, m); if (yo) { GAS f32x4* o = (GAS f32x4*)yo + 2 * tc.lane;
#pragma unroll
            for (int j = 0; j < 2; ++j) { o[128 * j] = v[2 * j]; o[128 * j + 1] = v[2 * j + 1]; } } }
        }
    }
}
__device__ __forceinline__ void ln_phase(const Frame& F, int idx, bool final_out, int row_lo, int row_hi, int cu_lo, bool comb = false) { ln_rows(F, idx, final_out, row_lo, row_hi, ((int)blockIdx.x - cu_lo) * 8, (F.G - cu_lo) * 8, comb); }
__device__ __forceinline__ float ret_lg2(int h);

using pg8::Unit;
typedef f32x4 AccT[2][2][4][2];
#ifndef LANE_TR
#define LANE_TR 1
#endif
struct LaneT { int tfr, tfq, pull, push; };
#if LANE_TR
__device__ __forceinline__ LaneT lane_t(int fr, int fq) { LaneT t; const int L = fq * 16 + fr; t.tfr = L >> 2; t.tfq = L & 3; t.pull = ((t.tfq << 4) + t.tfr) << 2; t.push = ((fr << 2) + fq) << 2; return t; }
__device__ __forceinline__ unsigned bperm(int a, unsigned x) { return (unsigned)__builtin_amdgcn_ds_bpermute(a, (int)x); }
__device__ __forceinline__ v4u tr4(int a, v4u x) { return (v4u){bperm(a, x.x), bperm(a, x.y), bperm(a, x.z), bperm(a, x.w)}; }
__device__ __forceinline__ v2u tr2(int a, v2u x) { return (v2u){bperm(a, x.x), bperm(a, x.y)}; }
#else
__device__ __forceinline__ LaneT lane_t(int fr, int fq) { LaneT t; t.tfr = fr; t.tfq = fq; t.pull = 0; t.push = 0; return t; }
__device__ __forceinline__ v4u tr4(int, v4u x) { return x; }
__device__ __forceinline__ v2u tr2(int, v2u x) { return x; }
#endif
__device__ __forceinline__ f32x4 tr4f(int a, f32x4 x) { return __builtin_bit_cast(f32x4, tr4(a, __builtin_bit_cast(v4u, x))); }
__device__ __forceinline__ v4u pack8(const f32x4& a, const f32x4& b) { return (v4u){pg8::cvt_pk_bf16(a[0], a[1]), pg8::cvt_pk_bf16(a[2], a[3]), pg8::cvt_pk_bf16(b[0], b[1]), pg8::cvt_pk_bf16(b[2], b[3])}; }

struct EpiSwiglu {
    static constexpr bool PERM = true; static constexpr int NS = 8;
    bf16* act;
    __device__ __forceinline__ bool operator()(AccT& acc, const Unit& u, int wr, int wc, int fr, int fq) const {
        asm volatile("" : "+s"(wr), "+s"(wc), "+v"(fr), "+v"(fq));
        const int row0 = u.pm * 256 + wr * 64 + fr + 16 * (fq & 1), col0 = u.pn * 128 + wc * 16 + 4 * (fq & 2);
#pragma unroll
        for (int ai = 0; ai < 2; ++ai)
#pragma unroll
            for (int mp = 0; mp < 2; ++mp) { bf16* rowp = act + (size_t)(row0 + ai * 128 + mp * 32) * DFF + col0;
#pragma unroll
                for (int bj = 0; bj < 2; ++bj) { unsigned pk[2][2];
#pragma unroll
                    for (int k = 0; k < 2; ++k) { const f32x4 g = acc[ai][bj][2 * mp + k][0], up = acc[ai][bj][2 * mp + k][1];
                        pk[k][0] = pg8::cvt_pk_bf16(siluf_(g[0]) * up[0], siluf_(g[1]) * up[1]); pk[k][1] = pg8::cvt_pk_bf16(siluf_(g[2]) * up[2], siluf_(g[3]) * up[3]); }
                    const auto sx = __builtin_amdgcn_permlane16_swap(pk[0][0], pk[1][0], false, false), sy = __builtin_amdgcn_permlane16_swap(pk[0][1], pk[1][1], false, false);
                    *(GAS v4u*)(rowp + bj * 64) = (v4u){sx[0], sy[0], sx[1], sy[1]}; } }
        return false;
    }
};

struct EpiResid {
    static constexpr bool PERM = true; static constexpr int NS = 16;
    unsigned char* ws; float ca, cb;
    __device__ __forceinline__ bool operator()(AccT& acc, const Unit& u, int wr, int wc, int fr, int fq) const {
        asm volatile("" : "+s"(wr), "+s"(wc), "+v"(fr), "+v"(fq));
        const LaneT t = lane_t(fr, fq);
        const bf16* src = (const bf16*)(ws + WS_HB); bf16* dst = (bf16*)(ws + WS_YB);
        const int row0 = u.pm * 256 + wr * 64 + t.tfr, col0 = u.pn * 256 + wc * 32 + 8 * t.tfq;
#pragma unroll
        for (int ai = 0; ai < 2; ++ai)
#pragma unroll
            for (int m = 0; m < 4; ++m) { const size_t off = (size_t)(row0 + ai * 128 + m * 16) * D + col0;
#pragma unroll
                for (int bj = 0; bj < 2; ++bj) { const v4u r = tr4(t.push, *(const GAS v4u*)(src + off + bj * 128));
                    const f32x4 y0 = (f32x4){bflo(r.x), bfhi(r.x), bflo(r.y), bfhi(r.y)} * ca + acc[ai][bj][m][0] * cb, y1 = (f32x4){bflo(r.z), bfhi(r.z), bflo(r.w), bfhi(r.w)} * ca + acc[ai][bj][m][1] * cb;
                    *(GAS v4u*)(dst + off + bj * 128) = tr4(t.pull, pack8(y0, y1)); } }
        return false;
    }
};

struct EpiGate {
    static constexpr bool PERM = true; static constexpr int NS = 0;
    unsigned char* ws;
    __device__ __forceinline__ bool operator()(AccT& acc, const Unit& u, int wr, int wc, int fr, int fq) const {
        asm volatile("" : "+s"(wr), "+s"(wc), "+v"(fr), "+v"(fq));
        const LaneT t = lane_t(fr, fq);
        const bf16* Gt = (const bf16*)(ws + WS_GT); bf16* mix = (bf16*)(ws + WS_MIX);
        const int n = u.pm / NPANEL, pm = u.pm - n * NPANEL, pn = u.pn & 3;
        const int row0 = pm * 256 + wr * 64 + t.tfr, col0 = pn * 256 + wc * 32 + 8 * t.tfq;
#pragma unroll
        for (int ai = 0; ai < 2; ++ai)
#pragma unroll
            for (int m = 0; m < 4; ++m) { const size_t r = (size_t)(row0 + ai * 128 + m * 16);
#pragma unroll
                for (int bj = 0; bj < 2; ++bj) {
                    const v4u ga = tr4(t.push, *(const GAS v4u*)(Gt + r * (3 * D) + n * D + col0 + bj * 128));
                    float f[8] = {bflo(ga.x), bfhi(ga.x), bflo(ga.y), bfhi(ga.y), bflo(ga.z), bfhi(ga.z), bflo(ga.w), bfhi(ga.w)};
                    if (n < 2) { const v4u gb = tr4(t.push, *(const GAS v4u*)(Gt + r * (3 * D) + (n + 1) * D + col0 + bj * 128));
                        const float h[8] = {bflo(gb.x), bfhi(gb.x), bflo(gb.y), bfhi(gb.y), bflo(gb.z), bfhi(gb.z), bflo(gb.w), bfhi(gb.w)};
#pragma unroll
                        for (int e = 0; e < 8; ++e) f[e] = f[e] * fast_rcp(fmaxf(h[e], 1e-30f)); }
                    f32x4 v0 = acc[ai][bj][m][0], v1 = acc[ai][bj][m][1];
                    v0 = v0 * (f32x4){f[0], f[1], f[2], f[3]}; v1 = v1 * (f32x4){f[4], f[5], f[6], f[7]};
                    acc[ai][bj][m][0] = v0; acc[ai][bj][m][1] = v1;
                    if (n == 2) *(GAS v4u*)(mix + r * D + col0 + bj * 128) = tr4(t.pull, pack8(v0, v1));
                } }
        return n < 2;
    }
};
struct Order3 : pg8::StaticOrder {
    __device__ __forceinline__ bool next(int i, Unit& u) const { Unit t; if (!pg8::StaticOrder::next(i / 3, t)) return false; const int k = i % 3; u.pm = t.pm + k * NPANEL; u.pn = t.pn + 4 * k; return true; }
};

struct SmallOrder {
    int c;
    __device__ __forceinline__ bool next(int i, Unit& u) const { if (i > 0 || c >= 8) return false; u.pm = 256 + (c >> 2); u.pn = c & 3; return true; }
    __device__ __forceinline__ void a_ready(const Unit&) const {}
    __device__ __forceinline__ void done(const Unit&) const {}
};

struct SmallOrderH {
    int c;
    __device__ __forceinline__ bool next(int i, Unit& u) const { if (i > 0 || c >= 16) return false; u.pm = 256 + ((c >> 2) & 1); u.pn = c & 3; return true; }
    __device__ __forceinline__ void a_ready(const Unit&) const {}
    __device__ __forceinline__ void done(const Unit&) const {}
};
struct EpiPart {
    static constexpr bool PERM = true; static constexpr int NS = 16;
    float* part;
    __device__ __forceinline__ bool operator()(AccT& acc, const Unit& u, int wr, int wc, int fr, int fq) const {
        asm volatile("" : "+s"(wr), "+s"(wc), "+v"(fr), "+v"(fq));
        float* p0 = part + (size_t)((u.pm - 256) * 256 + wr * 64 + fr) * D + u.pn * 256 + wc * 32 + 8 * fq;
#pragma unroll
        for (int ai = 0; ai < 2; ++ai)
#pragma unroll
            for (int m = 0; m < 4; ++m)
#pragma unroll
                for (int bj = 0; bj < 2; ++bj)
#pragma unroll
                    for (int n = 0; n < 2; ++n) *(GAS f32x4*)(p0 + (size_t)(ai * 128 + m * 16) * D + bj * 128 + 4 * n) = acc[ai][bj][m][n];
        return false;
    }
};

struct SmallOrder3 {
    int c;
    __device__ __forceinline__ bool next(int i, Unit& u) const { if (i > 2) return false; u.pm = 256 + (c >> 2) + i * NPANEL; u.pn = (c & 3) + 4 * i; return true; }
    __device__ __forceinline__ void a_ready(const Unit&) const {}
    __device__ __forceinline__ void done(const Unit&) const {}
};
struct SmallOrderW {
    int c;
    __device__ __forceinline__ bool next(int i, Unit& u) const { if (i > 0) return false; const int p = c >= 22 ? 1 : 0; u.pm = 256 + p; u.pn = c - 22 * p; return true; }
    __device__ __forceinline__ void a_ready(const Unit&) const {}
    __device__ __forceinline__ void done(const Unit&) const {}
};

struct EpiWin {
    static constexpr bool PERM = true; static constexpr int NS = 16;
    unsigned char* ws; float* out; int layer;
    __device__ __forceinline__ bool operator()(AccT& acc, const Unit& u, int wr, int wc, int fr, int fq) const {
        asm volatile("" : "+s"(wr), "+s"(wc), "+v"(fr), "+v"(fq));
        const LaneT t = lane_t(fr, fq);
        const int pn = u.pn, pm = u.pm, rl0 = wr * 64 + fr, trl0 = wr * 64 + t.tfr;
        if (pn < 4) {
            const bool isk = pn >= 2; bf16* dst = (bf16*)(ws + (isk ? WS_KR : WS_QR)); const float sc = isk ? 0.08838834764831845f : 1.0f;
            const float lgA = ret_lg2(2 * (pn & 1)) * (isk ? -1.f : 1.f), lgB = ret_lg2(2 * (pn & 1) + 1) * (isk ? -1.f : 1.f);
            float invf[4];
#pragma unroll
            for (int e = 0; e < 4; ++e) invf[e] = fast_exp2(-(float)(16 * wc + 4 * fq + e) * (13.287712379549449f / 64.0f)) * 0.15915494309189535f;
#pragma unroll
            for (int ai = 0; ai < 2; ++ai)
#pragma unroll
                for (int mp = 0; mp < 2; ++mp) { unsigned pk1[2][2][2], pk2[2][2][2];
#pragma unroll
                    for (int k = 0; k < 2; ++k) { const int rl = rl0 + ai * 128 + (2 * mp + k) * 16, r = pm * 256 + rl;
                        const float pos = (float)(pm < 256 ? NMETA + (r & (T - 1)) : (pm == 256 ? NMETA + PAST + (rl & (ST - 1)) : rl));
                        const float jp1 = (float)((pm < 256 ? (r & 63) : (pm == 256 ? (rl & (ST - 1)) : rl)) + 1);
                        const float dsc[2] = {sc * fast_exp2(jp1 * lgA), sc * fast_exp2(jp1 * lgB)};
                        f32x4 cs, sn;
#pragma unroll
                        for (int e = 0; e < 4; ++e) { float rev = pos * invf[e]; rev = rev - floorf(rev); cs[e] = __builtin_amdgcn_cosf(rev); sn[e] = __builtin_amdgcn_sinf(rev); }
#pragma unroll
                        for (int bj = 0; bj < 2; ++bj) { const f32x4 x1 = acc[ai][bj][2 * mp + k][0], x2 = acc[ai][bj][2 * mp + k][1];
                            const f32x4 o1 = (x1 * cs - x2 * sn) * dsc[bj], o2 = (x2 * cs + x1 * sn) * dsc[bj];
                            pk1[k][bj][0] = pg8::cvt_pk_bf16(o1[0], o1[1]); pk1[k][bj][1] = pg8::cvt_pk_bf16(o1[2], o1[3]);
                            pk2[k][bj][0] = pg8::cvt_pk_bf16(o2[0], o2[1]); pk2[k][bj][1] = pg8::cvt_pk_bf16(o2[2], o2[3]); } }
                    const size_t srow = (size_t)(pm * 256 + rl0 + ai * 128 + (2 * mp + (fq & 1)) * 16);
#pragma unroll
                    for (int bj = 0; bj < 2; ++bj) { bf16* rowp = dst + srow * 512 + (2 * (pn & 1) + bj) * 128 + 16 * wc + 4 * (fq & 2);
                        { const auto sx = __builtin_amdgcn_permlane16_swap(pk1[0][bj][0], pk1[1][bj][0], false, false), sy = __builtin_amdgcn_permlane16_swap(pk1[0][bj][1], pk1[1][bj][1], false, false);
                          *(GAS v4u*)rowp = (v4u){sx[0], sy[0], sx[1], sy[1]}; }
                        { const auto sx = __builtin_amdgcn_permlane16_swap(pk2[0][bj][0], pk2[1][bj][0], false, false), sy = __builtin_amdgcn_permlane16_swap(pk2[0][bj][1], pk2[1][bj][1], false, false);
                          *(GAS v4u*)(rowp + 64) = (v4u){sx[0], sy[0], sx[1], sy[1]}; } } }
            return false;
        }
        const int seg = (pn - 4) >> 2;
        const int colt = ((pn - 4) & 3) * 256 + wc * 32 + 8 * t.tfq;
        if (seg == 0 || seg == 1 || seg == 2 || seg >= 6) {
            bf16* dst = (bf16*)(ws + (seg == 0 ? WS_VR : seg == 1 ? WS_GR : seg == 2 ? WS_QS : WS_GT)); const int ld = seg >= 6 ? 3 * D : D; const int cofs = seg >= 6 ? (seg - 6) * D : 0;
#pragma unroll
            for (int ai = 0; ai < 2; ++ai)
#pragma unroll
                for (int m = 0; m < 4; ++m) { const size_t r = (size_t)(pm * 256 + trl0 + ai * 128 + m * 16);
#pragma unroll
                    for (int bj = 0; bj < 2; ++bj) { f32x4 v0 = acc[ai][bj][m][0], v1 = acc[ai][bj][m][1];
                        if (seg == 1) {
#pragma unroll
                            for (int e = 0; e < 4; ++e) { v0[e] = siluf_(v0[e]); v1[e] = siluf_(v1[e]); } }
                        else if (seg == 2) { v0 = v0 * (0.08838834764831845f * LOG2E); v1 = v1 * (0.08838834764831845f * LOG2E); }
                        else if (seg >= 6) {
#pragma unroll
                            for (int e = 0; e < 4; ++e) { v0[e] = sigmoidf_(v0[e]); v1[e] = sigmoidf_(v1[e]); } }
                        *(GAS v4u*)(dst + r * ld + cofs + colt + bj * 128) = tr4(t.pull, pack8(v0, v1)); } }
            return false;
        }
        if (seg == 3 || seg == 4) {
            bf16* dst = (bf16*)(ws + (seg == 3 ? WS_KS : WS_VS));
            if (seg == 3 && pm != 256) {
                float mx[2] = {0.f, 0.f};
#pragma unroll
                for (int ai = 0; ai < 2; ++ai)
#pragma unroll
                    for (int m = 0; m < 4; ++m) { const int rl = rl0 + ai * 128 + m * 16; if (pm < 256 || rl < NMETA) {
#pragma unroll
                        for (int bj = 0; bj < 2; ++bj) { const f32x4 a = acc[ai][bj][m][0], b2 = acc[ai][bj][m][1];
                            const float s = (a[0] * a[0] + a[1] * a[1]) + (a[2] * a[2] + a[3] * a[3]) + (b2[0] * b2[0] + b2[1] * b2[1]) + (b2[2] * b2[2] + b2[3] * b2[3]); mx[bj] = fmaxf(mx[bj], s); } } }
#pragma unroll
                for (int bj = 0; bj < 2; ++bj) {
#pragma unroll
                    for (int o = 1; o < 16; o <<= 1) mx[bj] = fmaxf(mx[bj], __shfl_xor(mx[bj], o));
                    if (fr == 0) { const int bidx = pm < 256 ? (pm >> 3) : 32, hh = ((pn - 16) & 3) * 2 + bj;
                        atomicMax((unsigned*)(ws + WS_CTL) + CW_KN + ((layer * 33 + bidx) * 8 + hh) * 16 + wc * 4 + fq, __float_as_uint(mx[bj] * 1.02f)); } }
            }
            float* op = out + (seg == 3 ? O_KP : O_VP) + (size_t)layer * NB * KT_PP * D;
            float* os = out + (seg == 3 ? O_KS : O_VS) + (size_t)layer * SBATCH * ST * D;
#pragma unroll
            for (int ai = 0; ai < 2; ++ai)
#pragma unroll
                for (int m = 0; m < 4; ++m) { const int rl = trl0 + ai * 128 + m * 16; const size_t r = (size_t)(pm * 256 + rl);
#pragma unroll
                    for (int bj = 0; bj < 2; ++bj) { const f32x4 v0 = tr4f(t.pull, acc[ai][bj][m][0]), v1 = tr4f(t.pull, acc[ai][bj][m][1]); const int c = colt + bj * 128;
                        *(GAS v4u*)(dst + r * D + c) = pack8(v0, v1);
                        if (pm < 256) { float* o = op + ((size_t)(r >> 11) * KT_PP + NMETA + (r & (T - 1))) * D + c; *(GAS f32x4*)o = v0; *(GAS f32x4*)(o + 4) = v1; }
                        else if (pm == 256) { float* o = os + (size_t)rl * D + c; *(GAS f32x4*)o = v0; *(GAS f32x4*)(o + 4) = v1; }
                        else if (rl < NMETA) { for (int bb = 0; bb < NB; ++bb) { float* o = op + ((size_t)bb * KT_PP + rl) * D + c; *(GAS f32x4*)o = v0; *(GAS f32x4*)(o + 4) = v1; } }
                    } }
            return false;
        }
        {
            float* op = out + O_PP + (size_t)layer * NB * PBUF * D;
            float* os = out + O_PS + (size_t)layer * SBATCH * PBUF * D;
#pragma unroll
            for (int ai = 0; ai < 2; ++ai)
#pragma unroll
                for (int m = 0; m < 4; ++m) { const int rl = trl0 + ai * 128 + m * 16; const size_t r = (size_t)(pm * 256 + rl);
#pragma unroll
                    for (int bj = 0; bj < 2; ++bj) { const f32x4 v0 = tr4f(t.pull, acc[ai][bj][m][0]), v1 = tr4f(t.pull, acc[ai][bj][m][1]); const int c = colt + bj * 128;
                        *(GAS v4u*)((bf16*)(ws + WS_U) + r * D + c) = pack8(v0, v1);
                        if (pm < 256) { const int tt = (int)(r & (T - 1)); if (tt >= T - PBUF) { float* o = op + ((size_t)(r >> 11) * PBUF + (tt - (T - PBUF))) * D + c; *(GAS f32x4*)o = v0; *(GAS f32x4*)(o + 4) = v1; } }
                        else if (pm == 256) { const int tt = rl & (ST - 1); if (tt >= ST - PBUF) { float* o = os + ((size_t)(rl >> 5) * PBUF + (tt - (ST - PBUF))) * D + c; *(GAS f32x4*)o = v0; *(GAS f32x4*)(o + 4) = v1; } }
                    } }
            return false;
        }
    }
};

__device__ __forceinline__ int grab(const Frame& F, gu32* ctr) {
    __syncthreads();
    if (F.wave == 0 && lane_lo_() == 0u) F.MISC[16] = __hip_atomic_fetch_add(ctr, 1u, RLX_AGENT);
    __syncthreads();
    return (int)F.MISC[16];
}
__device__ __forceinline__ unsigned grab_issue(const Frame& F, gu32* ctr) { return (F.wave == 0 && lane_lo_() == 0u) ? __hip_atomic_fetch_add(ctr, 1u, RLX_AGENT) : 0u; }
__device__ __forceinline__ int grab_publish(const Frame& F, unsigned nxt) {
    __syncthreads();
    if (F.wave == 0 && lane_lo_() == 0u) F.MISC[16] = nxt;
    __syncthreads();
    return (int)F.MISC[16];
}
typedef float f32x4_t __attribute__((ext_vector_type(4)));
#define MFMA16(a, b, c) __builtin_amdgcn_mfma_f32_16x16x32_bf16((a), (b), (c), 0, 0, 0)
__device__ __forceinline__ s16x4 tr16(const LAS unsigned char* p) { typedef short v4i16_t __attribute__((ext_vector_type(4))); return __builtin_bit_cast(s16x4, __builtin_amdgcn_ds_read_tr16_b64_v4i16((LAS v4i16_t*)p)); }

constexpr int RT_QS = 272, RT_VS = 528, RT_AS = 144;
constexpr int RT_Q = 0, RT_K = 64 * RT_QS, RT_V = 2 * 64 * RT_QS, RT_A = RT_V + 64 * RT_VS, RT_END = RT_A + 64 * RT_AS;
static_assert(RT_END <= RING_BYTES && 64 * 256 * 4 <= RT_END, "retention LDS map");
__device__ __forceinline__ float ret_lg2(int h) { return fast_log2(1.0f - fast_exp2(-5.0f - (float)h * (4.0f / 3.0f))); }
__device__ __forceinline__ void ret_unit(const Frame& F, int layer, int uid) {
    const int h = uid & 3; int stream, b;
    if (uid < 128) { stream = 0; b = uid >> 2; } else if (uid < 160) { stream = 1; b = (uid - 128) >> 2; } else { stream = 2; b = 0; }
    const TC tc = thread_coords(F.wave); const int tid = tc.tid, lane = tc.lane, w = tc.wave, l15 = lane & 15, g = lane >> 4, q4 = l15 >> 2, p4 = l15 & 3;
    const float lg2 = ret_lg2(h);
    const int nch = stream == 0 ? 1 + T / 64 : 1;
    f32x4 accS[8][2];
#pragma unroll
    for (int m = 0; m < 8; ++m)
#pragma unroll
        for (int n = 0; n < 2; ++n) accS[m][n] = (f32x4){0.f, 0.f, 0.f, 0.f};
    if (stream == 1) { const float* s0 = in_ptr(IN_SRET) + (((size_t)layer * SBATCH + b) * HRET + h) * DKR * DVR;
#pragma unroll
        for (int m = 0; m < 8; ++m)
#pragma unroll
            for (int n = 0; n < 2; ++n)
#pragma unroll
                for (int r = 0; r < 4; ++r) accS[m][n][r] = s0[(size_t)(16 * m + 4 * g + r) * DVR + 32 * w + 16 * n + l15]; }
    v4u qreg[2], kreg[2], vreg[4];
    const int lrow = tid >> 4, lch = tid & 15, vrow = tid >> 5, vch = tid & 31;
#define RT_CHUNK(c, rb, vl) do { if (stream == 0) { if ((c) == 0) { rb = ROW_M; vl = NMETA; } else { rb = b * T + 64 * ((c) - 1); vl = 64; } } \
        else if (stream == 1) { rb = ROW_S + b * ST; vl = ST; } else { rb = ROW_M; vl = NMETA; } } while (0)
#define RT_LOAD(c) do { int rb_, vl_; RT_CHUNK(c, rb_, vl_); \
        _Pragma("unroll") for (int i_ = 0; i_ < 2; ++i_) { const int r_ = lrow + 32 * i_; qreg[i_] = (v4u){0u, 0u, 0u, 0u}; kreg[i_] = (v4u){0u, 0u, 0u, 0u}; \
            if (r_ < vl_) { const size_t o_ = (size_t)(rb_ + r_) * 512 + h * 128 + lch * 8; qreg[i_] = *(const GAS v4u*)(WSB(F, WS_QR) + o_); kreg[i_] = *(const GAS v4u*)(WSB(F, WS_KR) + o_); } } \
        _Pragma("unroll") for (int i_ = 0; i_ < 4; ++i_) { const int r_ = vrow + 16 * i_; vreg[i_] = (v4u){0u, 0u, 0u, 0u}; \
            if (r_ < vl_) vreg[i_] = *(const GAS v4u*)(WSB(F, WS_VR) + (size_t)(rb_ + r_) * D + h * 256 + vch * 8); } } while (0)
    RT_LOAD(0);
    const LAS unsigned char* Ql = F.lds + RT_Q; const LAS unsigned char* Kl = F.lds + RT_K; const LAS unsigned char* Vl = F.lds + RT_V; const LAS unsigned char* Al = F.lds + RT_A;
    for (int c = 0; c < nch; ++c) {
        int rowbase, valid; RT_CHUNK(c, rowbase, valid);
        const bool write_out = !(stream == 0 && c == 0);
        const float dc = fast_exp2((float)valid * lg2);
        __syncthreads();
#pragma unroll
        for (int i = 0; i < 2; ++i) { *(LAS v4u*)(F.lds + RT_Q + (lrow + 32 * i) * RT_QS + lch * 16) = qreg[i]; *(LAS v4u*)(F.lds + RT_K + (lrow + 32 * i) * RT_QS + lch * 16) = kreg[i]; }
#pragma unroll
        for (int i = 0; i < 4; ++i) *(LAS v4u*)(F.lds + RT_V + (vrow + 16 * i) * RT_VS + vch * 16) = vreg[i];
        __syncthreads();
        if (c + 1 < nch) RT_LOAD(c + 1);
#pragma unroll
        for (int tt = 0; tt < 2; ++tt) { const int id = 2 * w + tt, mt = id >> 2, nt = id & 3;
            f32x4 a4 = (f32x4){0.f, 0.f, 0.f, 0.f};
            if (mt <= nt) {
#pragma unroll
                for (int ks = 0; ks < 4; ++ks) { const bf16x8 A = *(const LAS bf16x8*)(Kl + (16 * mt + l15) * RT_QS + 64 * ks + 16 * g); const bf16x8 B = *(const LAS bf16x8*)(Ql + (16 * nt + l15) * RT_QS + 64 * ks + 16 * g);
                    a4 = MFMA16(A, B, a4); }
#pragma unroll
                for (int r = 0; r < 4; ++r) a4[r] = (16 * mt + 4 * g + r <= 16 * nt + l15) ? a4[r] : 0.f;
            }
            *(LAS v2u*)(F.lds + RT_A + (16 * nt + l15) * RT_AS + (16 * mt + 4 * g) * 2) = (v2u){pg8::cvt_pk_bf16(a4[0], a4[1]), pg8::cvt_pk_bf16(a4[2], a4[3])}; }
        __syncthreads();
        f32x4 accO[4][2];
#pragma unroll
        for (int m = 0; m < 4; ++m)
#pragma unroll
            for (int n = 0; n < 2; ++n) accO[m][n] = (f32x4){0.f, 0.f, 0.f, 0.f};
#pragma unroll
        for (int ks = 0; ks < 4; ++ks) {
            bf16x8 Sf[2];
#pragma unroll
            for (int n = 0; n < 2; ++n) Sf[n] = __builtin_bit_cast(bf16x8, (v4u){pg8::cvt_pk_bf16(accS[2 * ks][n][0], accS[2 * ks][n][1]), pg8::cvt_pk_bf16(accS[2 * ks][n][2], accS[2 * ks][n][3]),
                                                                               pg8::cvt_pk_bf16(accS[2 * ks + 1][n][0], accS[2 * ks + 1][n][1]), pg8::cvt_pk_bf16(accS[2 * ks + 1][n][2], accS[2 * ks + 1][n][3])});
#pragma unroll
            for (int m = 0; m < 4; ++m) { const v2u lo = *(const LAS v2u*)(Ql + (16 * m + l15) * RT_QS + (32 * ks + 4 * g) * 2), hi = *(const LAS v2u*)(Ql + (16 * m + l15) * RT_QS + (32 * ks + 16 + 4 * g) * 2);
                const bf16x8 A = __builtin_bit_cast(bf16x8, (v4u){lo.x, lo.y, hi.x, hi.y});
#pragma unroll
                for (int n = 0; n < 2; ++n) accO[m][n] = MFMA16(A, Sf[n], accO[m][n]); }
        }
        bf16x8 Bv[2][2];
#pragma unroll
        for (int k2 = 0; k2 < 2; ++k2)
#pragma unroll
            for (int n = 0; n < 2; ++n) { const s16x4 lo = tr16(Vl + (32 * k2 + 8 * g + q4) * RT_VS + (32 * w + 16 * n + 4 * p4) * 2), hi = tr16(Vl + (32 * k2 + 8 * g + 4 + q4) * RT_VS + (32 * w + 16 * n + 4 * p4) * 2);
                Bv[k2][n] = __builtin_shufflevector(lo, hi, 0, 1, 2, 3, 4, 5, 6, 7); }
#pragma unroll
        for (int k2 = 0; k2 < 2; ++k2)
#pragma unroll
            for (int m = 0; m < 4; ++m) { const bf16x8 A = *(const LAS bf16x8*)(Al + (16 * m + l15) * RT_AS + (32 * k2 + 8 * g) * 2);
#pragma unroll
                for (int n = 0; n < 2; ++n) accO[m][n] = MFMA16(A, Bv[k2][n], accO[m][n]); }
#pragma unroll
        for (int m = 0; m < 8; ++m)
#pragma unroll
            for (int k2 = 0; k2 < 2; ++k2) { const s16x4 lo = tr16(Kl + (32 * k2 + 8 * g + q4) * RT_QS + (16 * m + 4 * p4) * 2), hi = tr16(Kl + (32 * k2 + 8 * g + 4 + q4) * RT_QS + (16 * m + 4 * p4) * 2);
                const bf16x8 A = __builtin_shufflevector(lo, hi, 0, 1, 2, 3, 4, 5, 6, 7);
#pragma unroll
                for (int n = 0; n < 2; ++n) accS[m][n] = MFMA16(A, Bv[k2][n], accS[m][n]); }
#pragma unroll
        for (int m = 0; m < 8; ++m)
#pragma unroll
            for (int n = 0; n < 2; ++n) accS[m][n] = accS[m][n] * dc;
        if (write_out) {
            __syncthreads();
            LAS float* oL = (LAS float*)F.lds;
#pragma unroll
            for (int m = 0; m < 4; ++m)
#pragma unroll
                for (int n = 0; n < 2; ++n)
#pragma unroll
                    for (int r = 0; r < 4; ++r) oL[(16 * m + 4 * g + r) * 256 + 32 * w + 16 * n + l15] = accO[m][n][r];
            __syncthreads();
            const f32x4 gn = *(const GAS f32x4*)(in_ptr(IN_RETG) + ((size_t)layer * HRET + h) * DVR + lane * 4);
#pragma unroll
            for (int hb2 = 0; hb2 < 2; ++hb2) {
            f32x4 x[4]; v2u gr[4]; float s1[4], s2[4];
#pragma unroll
            for (int tt = 0; tt < 4; ++tt) { const int t = w * 8 + hb2 * 4 + tt; x[tt] = *(const LAS f32x4*)(oL + t * 256 + lane * 4); gr[tt] = *(const GAS v2u*)(WSB(F, WS_GR) + (size_t)(rowbase + t) * D + h * 256 + lane * 4);
                s1[tt] = (x[tt][0] + x[tt][1]) + (x[tt][2] + x[tt][3]); }
#pragma unroll
            for (int o = 1; o < 64; o <<= 1)
#pragma unroll
                for (int tt = 0; tt < 4; ++tt) s1[tt] += __shfl_xor(s1[tt], o);
#pragma unroll
            for (int tt = 0; tt < 4; ++tt) { x[tt] = x[tt] - s1[tt] * (1.f / 256.f); s2[tt] = (x[tt][0] * x[tt][0] + x[tt][1] * x[tt][1]) + (x[tt][2] * x[tt][2] + x[tt][3] * x[tt][3]); }
#pragma unroll
            for (int o = 1; o < 64; o <<= 1)
#pragma unroll
                for (int tt = 0; tt < 4; ++tt) s2[tt] += __shfl_xor(s2[tt], o);
#pragma unroll
            for (int tt = 0; tt < 4; ++tt) { const int t = w * 8 + hb2 * 4 + tt; const float rstd = 1.f / sqrtf(s2[tt] * (1.f / 256.f) + LN_EPS);
                const f32x4 y = x[tt] * rstd * gn * (f32x4){bflo(gr[tt].x), bfhi(gr[tt].x), bflo(gr[tt].y), bfhi(gr[tt].y)};
                if (t < valid) *(GAS v2u*)(WSB(F, WS_BR) + (size_t)(rowbase + t) * D + h * 256 + lane * 4) = (v2u){pk2(y[0], y[1]), pk2(y[2], y[3])}; }
            }
        }
    }
#undef RT_LOAD
#undef RT_CHUNK
    if (stream != 2) { float* d = F.out + (stream == 0 ? O_RP + (((size_t)layer * NB + b) * HRET + h) * DKR * DVR : O_RS + (((size_t)layer * SBATCH + b) * HRET + h) * DKR * DVR);
#pragma unroll
        for (int m = 0; m < 8; ++m)
#pragma unroll
            for (int n = 0; n < 2; ++n)
#pragma unroll
                for (int r = 0; r < 4; ++r) d[(size_t)(16 * m + 4 * g + r) * DVR + 32 * w + 16 * n + l15] = accS[m][n][r]; }
}

constexpr int AT_RS = 272;
constexpr int AT_VOFF = 64 * AT_RS;
constexpr int AT_QOFF = 36864;
static_assert(AT_QOFF >= 2 * 64 * AT_RS && AT_QOFF + 8 * 8 * 1024 <= RING_BYTES, "attention LDS map");
template <bool F32KV> __device__ __forceinline__ void attn_unit(const Frame& F, int layer, int uid) {
    int stream, b, h, qb;
    if (uid < 64) { stream = 1; b = uid >> 3; h = uid & 7; qb = 0; }
    else if (uid < 64 + 2048) { const int idx = uid - 64; qb = 7 - (idx >> 8); b = (idx & 255) >> 3; h = idx & 7; stream = 0; }
    else { stream = 2; b = 0; h = (uid - (64 + 2048)) & 7; qb = 0; }
    const bf16 *k0p = nullptr, *k1p = nullptr, *v0p = nullptr, *v1p = nullptr; const float *k0f = nullptr, *k1f = nullptr, *v0f = nullptr, *v1f = nullptr; int len0, Tq, rowbase;
    if (stream == 0) { k0p = WSB(F, WS_KS) + (size_t)ROW_M * D; v0p = WSB(F, WS_VS) + (size_t)ROW_M * D; len0 = NMETA; k1p = WSB(F, WS_KS) + (size_t)b * T * D; v1p = WSB(F, WS_VS) + (size_t)b * T * D; Tq = T; rowbase = b * T; }
    else if (stream == 1) { k0f = in_ptr(IN_CK) + ((size_t)layer * SBATCH + b) * PAST * D; v0f = in_ptr(IN_CV) + ((size_t)layer * SBATCH + b) * PAST * D; len0 = PAST;
        k1f = F.out + O_KS + ((size_t)layer * SBATCH + b) * ST * D; v1f = F.out + O_VS + ((size_t)layer * SBATCH + b) * ST * D; Tq = ST; rowbase = ROW_S + b * ST; }
    else { k0p = k1p = WSB(F, WS_KS) + (size_t)ROW_M * D; v0p = v1p = WSB(F, WS_VS) + (size_t)ROW_M * D; len0 = 0; Tq = NMETA; rowbase = ROW_M; }
    constexpr int NQ = F32KV ? 1 : 2, QPW = 16 * NQ, QBLK = 8 * QPW;
    const int Stot = len0 + Tq, q0 = qb * QBLK;
    const TC tc = thread_coords(F.wave); const int tid = tc.tid, lane = tc.lane, w = tc.wave, l15 = lane & 15, g = lane >> 4;
    int qi[NQ]; bool valid_q[NQ]; int lim[NQ];
#pragma unroll
    for (int nb = 0; nb < NQ; ++nb) { qi[nb] = q0 + 16 * (NQ == 2 ? (nb == 0 ? w : 15 - w) : w) + l15; valid_q[nb] = qi[nb] < Tq; lim[nb] = len0 + qi[nb]; }
    bf16x8 qf[NQ][4];
#pragma unroll
    for (int nb = 0; nb < NQ; ++nb)
#pragma unroll
    for (int ks = 0; ks < 4; ++ks) { v4u t4 = (v4u){0u, 0u, 0u, 0u}; if (valid_q[nb]) t4 = *(const GAS v4u*)(WSB(F, WS_QS) + (size_t)(rowbase + qi[nb]) * D + h * 128 + 32 * ks + 8 * g); qf[nb][ks] = __builtin_bit_cast(bf16x8, t4); }
    float zq[NQ];
#pragma unroll
    for (int nb = 0; nb < NQ; ++nb) zq[nb] = 3.0e38f;
    float kn2 = -1.f;
    if (stream == 0) { const unsigned* kn = (const unsigned*)(F.ws + WS_CTL) + CW_KN + ((layer * 33 + b) * 8 + h) * 16; const unsigned* km = (const unsigned*)(F.ws + WS_CTL) + CW_KN + ((layer * 33 + 32) * 8 + h) * 16;
        kn2 = 0.f;
#pragma unroll
        for (int p = 0; p < 16; ++p) kn2 += fmaxf(__uint_as_float(kn[p]), __uint_as_float(km[p])); }
    if constexpr (F32KV) {
        const int lr_ = tid >> 4, lc_ = tid & 15; float km_ = 0.f;
        for (int s0 = lr_; s0 < Stot; s0 += 128) { f32x4 a_[4][2];
#pragma unroll
            for (int j = 0; j < 4; ++j) { int s_ = s0 + 32 * j; s_ = s_ < Stot ? s_ : Stot - 1; const float* kp_ = (s_ < len0 ? k0f + (size_t)s_ * D : k1f + (size_t)(s_ - len0) * D) + h * 128 + lc_ * 8;
                a_[j][0] = *(const GAS f32x4*)kp_; a_[j][1] = *(const GAS f32x4*)(kp_ + 4); }
#pragma unroll
            for (int j = 0; j < 4; ++j) { const f32x4 x = a_[j][0] * a_[j][0] + a_[j][1] * a_[j][1]; float p = (x[0] + x[1]) + (x[2] + x[3]);
                p += __shfl_xor(p, 1); p += __shfl_xor(p, 2); p += __shfl_xor(p, 4); p += __shfl_xor(p, 8); km_ = fmaxf(km_, p); } }
        km_ = fmaxf(km_, __shfl_xor(km_, 16)); km_ = fmaxf(km_, __shfl_xor(km_, 32));
        __syncthreads();
        if (lane == 0) F.MISC[32 + w] = __float_as_uint(km_);
        __syncthreads();
        kn2 = 0.f;
#pragma unroll
        for (int i = 0; i < 8; ++i) kn2 = fmaxf(kn2, __uint_as_float(F.MISC[32 + i])); }
    if (kn2 >= 0.f) {
#pragma unroll
        for (int nb = 0; nb < NQ; ++nb) { float q2 = 0.f;
#pragma unroll
            for (int ks = 0; ks < 4; ++ks)
#pragma unroll
                for (int e = 0; e < 8; ++e) { const float x = bf2f((unsigned short)qf[nb][ks][e]); q2 += x * x; }
            q2 += __shfl_xor(q2, 16); q2 += __shfl_xor(q2, 32);
            zq[nb] = sqrtf(kn2 * q2) * 1.01f + 150.0f; } }
    f32x4 o[NQ][8];
#pragma unroll
    for (int nb = 0; nb < NQ; ++nb)
#pragma unroll
    for (int i = 0; i < 8; ++i) o[nb][i] = (f32x4){0.f, 0.f, 0.f, 0.f};
    float R[NQ]; bool anyv_ = false;
#pragma unroll
    for (int nb = 0; nb < NQ; ++nb) { R[nb] = 0.f; anyv_ = anyv_ || valid_q[nb]; }
    bool wave_done = __all(!anyv_) != 0;
    const int qend = (q0 + QBLK < Tq) ? q0 + QBLK : Tq;
    const int kt_max = (len0 + qend - 2) >> 6;
    const int lrow = tid >> 4, lch = tid & 15;
    constexpr int NR = F32KV ? 4 : 2;
    constexpr int DIST = F32KV ? 1 : 2;
    v4u kregA[NR], vregA[NR], kregB[NR], vregB[NR];
#define AT_LOAD(kt, KR, VR) do { _Pragma("unroll") for (int i_ = 0; i_ < 2; ++i_) { int s_ = ((kt) > 0 ? (kt) : 0) * 64 + lrow + 32 * i_; s_ = s_ < Stot ? s_ : Stot - 1; \
        const size_t off_ = (s_ < len0 ? (size_t)s_ : (size_t)(s_ - len0)) * D + h * 128 + lch * 8; \
        if constexpr (F32KV) { const float* kp_ = (s_ < len0 ? k0f : k1f) + off_; const float* vp_ = (s_ < len0 ? v0f : v1f) + off_; \
            asm volatile("global_load_dwordx4 %0, %1, off" : "=&v"(KR[2 * i_]) : "v"(kp_) : "memory"); asm volatile("global_load_dwordx4 %0, %1, off offset:16" : "=&v"(KR[2 * i_ + 1]) : "v"(kp_) : "memory"); \
            asm volatile("global_load_dwordx4 %0, %1, off" : "=&v"(VR[2 * i_]) : "v"(vp_) : "memory"); asm volatile("global_load_dwordx4 %0, %1, off offset:16" : "=&v"(VR[2 * i_ + 1]) : "v"(vp_) : "memory"); } \
        else { const bf16* kp_ = (s_ < len0 ? k0p : k1p) + off_; const bf16* vp_ = (s_ < len0 ? v0p : v1p) + off_; \
            asm volatile("global_load_dwordx4 %0, %1, off" : "=&v"(KR[i_]) : "v"(kp_) : "memory"); asm volatile("global_load_dwordx4 %0, %1, off" : "=&v"(VR[i_]) : "v"(vp_) : "memory"); } } } while (0)
    AT_LOAD(kt_max, kregA, vregA);
    if constexpr (!F32KV) AT_LOAD(kt_max - 1, kregB, vregB);
    const LAS unsigned char* Ql = F.lds + AT_QOFF + w * (NQ * 4096);
#pragma unroll
    for (int nb = 0; nb < NQ; ++nb)
#pragma unroll
        for (int ks = 0; ks < 4; ++ks) *(LAS v4u*)(F.lds + AT_QOFF + w * (NQ * 4096) + ((nb * 4 + ks) * 64 + lane) * 16) = __builtin_bit_cast(v4u, qf[nb][ks]);
    const LAS unsigned char* Kl = F.lds; const LAS unsigned char* Vl = F.lds + AT_VOFF;
    const int q4 = l15 >> 2, p4 = l15 & 3;
#define AT_BODY(NB0_) { \
        f32x4 z[NQ][4]; \
        _Pragma("unroll") \
        for (int mt = 0; mt < 4; ++mt) { _Pragma("unroll") for (int nb = (NB0_); nb < NQ; ++nb) z[nb][mt] = (f32x4){0.f, 0.f, 0.f, 0.f}; } \
        _Pragma("unroll") \
        for (int ks = 0; ks < 4; ++ks) { bf16x8 qa[NQ]; _Pragma("unroll") for (int nb = (NB0_); nb < NQ; ++nb) qa[nb] = *(const LAS bf16x8*)(Ql + ((nb * 4 + ks) * 64 + lane) * 16); \
        _Pragma("unroll") \
            for (int mt = 0; mt < 4; ++mt) { const bf16x8 a = *(const LAS bf16x8*)(Kl + (16 * mt + l15) * AT_RS + 64 * ks + 16 * g); _Pragma("unroll") for (int nb = (NB0_); nb < NQ; ++nb) z[nb][mt] = MFMA16(a, qa[nb], z[nb][mt]); } } \
        bf16x8 pf[NQ][2]; \
        _Pragma("unroll") \
        for (int nb = (NB0_); nb < NQ; ++nb) { \
        bf16x8 triA, triB, ones; \
        _Pragma("unroll") \
        for (int e = 0; e < 8; ++e) { const int jl = 16 * (e >> 2) + 4 * g + (e & 3); triA[e] = (short)(jl >= l15 ? 0x3f80 : 0); triB[e] = (short)(jl >= l15 + 16 ? 0x3f80 : 0); ones[e] = (short)0x3f80; } \
        f32x4 sp[4]; \
        if (need_mask) { \
        _Pragma("unroll") \
            for (int mt = 0; mt < 4; ++mt) \
        _Pragma("unroll") \
                for (int r = 0; r < 4; ++r) { const bool vis = (tb + 16 * mt + 4 * g + r) < lim[nb]; const float zz = fminf(z[nb][mt][r], 80.f); z[nb][mt][r] = vis ? zz : -1.0e30f; \
                    sp[mt][r] = vis ? fast_log2(1.0f + fast_exp2(zz)) : 0.f; } \
        } else { \
        _Pragma("unroll") \
            for (int mt = 0; mt < 4; ++mt) \
        _Pragma("unroll") \
                for (int r = 0; r < 4; ++r) { const float zz = fminf(z[nb][mt][r], 80.f); z[nb][mt][r] = zz; sp[mt][r] = fast_log2(1.0f + fast_exp2(zz)); } \
        } \
        bf16x8 spf[2]; \
        _Pragma("unroll") \
        for (int k2 = 0; k2 < 2; ++k2) spf[k2] = __builtin_bit_cast(bf16x8, (v4u){pg8::cvt_pk_bf16(sp[2 * k2][0], sp[2 * k2][1]), pg8::cvt_pk_bf16(sp[2 * k2][2], sp[2 * k2][3]), \
                                                                                  pg8::cvt_pk_bf16(sp[2 * k2 + 1][0], sp[2 * k2 + 1][1]), pg8::cvt_pk_bf16(sp[2 * k2 + 1][2], sp[2 * k2 + 1][3])}); \
        const f32x4 zero4 = (f32x4){0.f, 0.f, 0.f, 0.f}; \
        f32x4 I0 = MFMA16(triA, spf[0], zero4); I0 = MFMA16(ones, spf[1], I0); \
        f32x4 I1 = MFMA16(triB, spf[0], zero4); I1 = MFMA16(ones, spf[1], I1); \
        f32x4 I2 = MFMA16(triA, spf[1], zero4); \
        f32x4 I3 = MFMA16(triB, spf[1], zero4); \
        f32x4 tot = MFMA16(ones, spf[0], zero4); tot = MFMA16(ones, spf[1], tot); \
        const f32x4 II[4] = {I0, I1, I2, I3}; \
        f32x4 wv[4]; \
        _Pragma("unroll") \
        for (int mt = 0; mt < 4; ++mt) \
        _Pragma("unroll") \
            for (int r = 0; r < 4; ++r) wv[mt][r] = fast_exp2(z[nb][mt][r] - II[mt][r] - R[nb]); \
        _Pragma("unroll") \
        for (int k2 = 0; k2 < 2; ++k2) pf[nb][k2] = __builtin_bit_cast(bf16x8, (v4u){pg8::cvt_pk_bf16(wv[2 * k2][0], wv[2 * k2][1]), pg8::cvt_pk_bf16(wv[2 * k2][2], wv[2 * k2][3]), \
                                                                                 pg8::cvt_pk_bf16(wv[2 * k2 + 1][0], wv[2 * k2 + 1][1]), pg8::cvt_pk_bf16(wv[2 * k2 + 1][2], wv[2 * k2 + 1][3])}); \
        R[nb] += tot[0]; \
        } \
        _Pragma("unroll") \
        for (int mt8 = 0; mt8 < 8; ++mt8) \
        _Pragma("unroll") \
            for (int k2 = 0; k2 < 2; ++k2) { \
                const s16x4 lo = tr16(Vl + (32 * k2 + 4 * g + q4) * AT_RS + (16 * mt8 + 4 * p4) * 2); \
                const s16x4 hi = tr16(Vl + (32 * k2 + 16 + 4 * g + q4) * AT_RS + (16 * mt8 + 4 * p4) * 2); \
                const bf16x8 a = __builtin_shufflevector(lo, hi, 0, 1, 2, 3, 4, 5, 6, 7); \
                _Pragma("unroll") for (int nb = (NB0_); nb < NQ; ++nb) o[nb][mt8] = MFMA16(a, pf[nb][k2], o[nb][mt8]); } \
        }
#define AT_ITER(KT_, KR_, VR_) { const int kt = (KT_); \
        __syncthreads(); \
        if (kt < kt_max) { unsigned allok = 1u; \
        _Pragma("unroll") \
            for (int i = 0; i < 8; ++i) allok &= F.MISC[24 + i]; \
            if (allok) break; } \
        if constexpr (F32KV) asm volatile("s_waitcnt vmcnt(0)" : "+v"(KR_[0]), "+v"(VR_[0]), "+v"(KR_[1]), "+v"(VR_[1]), "+v"(KR_[NR - 2]), "+v"(VR_[NR - 2]), "+v"(KR_[NR - 1]), "+v"(VR_[NR - 1]) :: "memory"); \
        else asm volatile("s_waitcnt vmcnt(4)" : "+v"(KR_[0]), "+v"(VR_[0]), "+v"(KR_[1]), "+v"(VR_[1]) :: "memory");     \
        _Pragma("unroll") \
        for (int i = 0; i < 2; ++i) { const bool in_ = (kt * 64 + lrow + 32 * i) < Stot; const v4u z4_ = (v4u){0u, 0u, 0u, 0u}; v4u kk_, vv_; \
            if constexpr (F32KV) { kk_ = pack8(__builtin_bit_cast(f32x4, KR_[(2 * i) % NR]), __builtin_bit_cast(f32x4, KR_[(2 * i + 1) % NR])); vv_ = pack8(__builtin_bit_cast(f32x4, VR_[(2 * i) % NR]), __builtin_bit_cast(f32x4, VR_[(2 * i + 1) % NR])); } \
            else { kk_ = KR_[i % NR]; vv_ = VR_[i % NR]; } \
            *(LAS v4u*)(F.lds + (lrow + 32 * i) * AT_RS + lch * 16) = in_ ? kk_ : z4_; *(LAS v4u*)(F.lds + AT_VOFF + (lrow + 32 * i) * AT_RS + lch * 16) = in_ ? vv_ : z4_; } \
        __syncthreads(); \
        AT_LOAD(kt - DIST, KR_, VR_); \
        const int tb = kt * 64; \
        const int lim_lo = len0 + q0 + 16 * w, lim_hi = NQ == 2 ? len0 + q0 + 16 * (15 - w) : lim_lo;      \
        const bool act0 = tb < lim_lo + 15, act1 = tb < lim_hi + 15;                                           \
        if (!wave_done && act1) { \
        const bool need_mask = (tb + 64 > (act0 ? lim_lo : lim_hi)); \
        if (NQ == 2 && !act0) AT_BODY(NQ - 1) else AT_BODY(0) \
        { bool dn_ = true; _Pragma("unroll") for (int nb = 0; nb < NQ; ++nb) dn_ = dn_ && ((!valid_q[nb]) || (R[nb] > zq[nb])); wave_done = __all(dn_) != 0; } \
        } \
        if (lane == 0) F.MISC[24 + w] = wave_done ? 1u : 0u; \
    }
    for (int kt2 = kt_max; kt2 >= 0; kt2 -= 2) {
        AT_ITER(kt2, kregA, vregA)
        if (kt2 == 0) break;
        if constexpr (F32KV) { AT_ITER(kt2 - 1, kregA, vregA) } else { AT_ITER(kt2 - 1, kregB, vregB) }
    }
#undef AT_ITER
#undef AT_BODY
    if constexpr (F32KV) asm volatile("s_waitcnt vmcnt(0)" : "+v"(kregA[0]), "+v"(vregA[0]), "+v"(kregA[1]), "+v"(vregA[1]), "+v"(kregA[NR - 2]), "+v"(vregA[NR - 2]), "+v"(kregA[NR - 1]), "+v"(vregA[NR - 1]) :: "memory");
    else asm volatile("s_waitcnt vmcnt(0)" : "+v"(kregA[0]), "+v"(vregA[0]), "+v"(kregA[1]), "+v"(vregA[1]), "+v"(kregB[0]), "+v"(vregB[0]), "+v"(kregB[1]), "+v"(vregB[1]) :: "memory");
#undef AT_LOAD
#pragma unroll
    for (int nb = 0; nb < NQ; ++nb)
    if (valid_q[nb]) { bf16* orow = WSB(F, WS_BR) + (size_t)M_PAD * D + (size_t)(rowbase + qi[nb]) * D + h * 128 + 4 * g;
#pragma unroll
        for (int mt8 = 0; mt8 < 8; ++mt8) *(GAS v2u*)(orow + 16 * mt8) = (v2u){pg8::cvt_pk_bf16(o[nb][mt8][0], o[nb][mt8][1]), pg8::cvt_pk_bf16(o[nb][mt8][2], o[nb][mt8][3])}; }
}

__device__ __forceinline__ void pool_row(const Frame& F, int layer, int stream, int b, int rowbase, int tp, int ch, float (&v)[8]) {
    if (tp >= 0 || stream == 0) { const size_t row = tp >= 0 ? (size_t)(rowbase + tp) : (size_t)(ROW_M + NMETA + tp);
        const v4u x = *(const GAS v4u*)(WSB(F, WS_U) + row * D + ch * 8);
        v[0] = bflo(x.x); v[1] = bfhi(x.x); v[2] = bflo(x.y); v[3] = bfhi(x.y); v[4] = bflo(x.z); v[5] = bfhi(x.z); v[6] = bflo(x.w); v[7] = bfhi(x.w); }
    else if (stream == 1) { const float* sp = in_ptr(IN_SPOOL) + (((size_t)layer * SBATCH + b) * PBUF + (PBUF + tp)) * D + ch * 8;
        const f32x4 a = *(const GAS f32x4*)sp, c = *(const GAS f32x4*)(sp + 4);
        v[0] = a[0]; v[1] = a[1]; v[2] = a[2]; v[3] = a[3]; v[4] = c[0]; v[5] = c[1]; v[6] = c[2]; v[7] = c[3]; }
    else {
#pragma unroll
        for (int e = 0; e < 8; ++e) v[e] = 0.f; }
}
__device__ __forceinline__ void pool_unit(const Frame& F, int layer, int uid) {
    int stream, b, t0, Tlen, rowbase;
    if (uid < 1024) { stream = 0; b = uid >> 5; t0 = (uid & 31) * 64; Tlen = T; rowbase = b * T; }
    else if (uid < 1032) { stream = 1; b = uid - 1024; t0 = 0; Tlen = ST; rowbase = ROW_S + b * ST; }
    else { stream = 2; b = 0; t0 = 0; Tlen = NMETA; rowbase = ROW_M; }
    const TC tc = thread_coords(F.wave); const int ch = tc.tid & 127, tsub = tc.tid >> 7, win = 2 << (ch >> 5);
    const int ts = t0 + tsub * 16; if (ts >= Tlen) return;
    float acc[8];
#pragma unroll
    for (int e = 0; e < 8; ++e) acc[e] = 0.f;
#pragma unroll
    for (int j = 1; j < 16; ++j) if (j < win) { float v[8]; pool_row(F, layer, stream, b, rowbase, ts - j, ch, v);
#pragma unroll
        for (int e = 0; e < 8; ++e) acc[e] += v[e]; }
#pragma unroll 4
    for (int tt = 0; tt < 16; ++tt) {
        const int t = ts + tt;
        float vn[8], vo[8]; pool_row(F, layer, stream, b, rowbase, t, ch, vn);
        if (tt > 0) pool_row(F, layer, stream, b, rowbase, t - win, ch, vo);
#pragma unroll
        for (int e = 0; e < 8; ++e) acc[e] += vn[e] - (tt > 0 ? vo[e] : 0.f);
        const int have = (stream == 2) ? (t + 1 < win ? t + 1 : win) : win;
        const float inv = 1.0f / (float)have;
        float y[8];
#pragma unroll
        for (int e = 0; e < 8; ++e) y[e] = acc[e] * inv - vn[e];
        *(GAS v4u*)(WSB(F, WS_BR) + (size_t)2 * M_PAD * D + (size_t)(rowbase + t) * D + ch * 8) = (v4u){pk2(y[0], y[1]), pk2(y[2], y[3]), pk2(y[4], y[5]), pk2(y[6], y[7])};
    }
}

struct Args { const float* in[19]; float* out; unsigned char* ws; };

__device__ __forceinline__ int opq(int x) { asm volatile("" : "+s"(x)); return x; }

constexpr int CH_TOTAL = 25;
__device__ __forceinline__ int ch_stage(int ci) { return ci < 8 ? 1 : ci < 16 ? 2 : 3; }
__device__ __forceinline__ int ch_first(int s) { return s == 1 ? 0 : s == 2 ? 8 : s == 3 ? 16 : CH_TOTAL; }
__device__ __forceinline__ unsigned ch_cnt(int s) { return s == 0 ? 117u : s == 3 ? 9u : 8u; }
__device__ __forceinline__ void chain_signal(const Frame& F, gu32* ch, int s) {
    asm volatile("s_waitcnt vmcnt(0)" ::: "memory");
    __syncthreads();
    if (F.wave == 0 && lane_lo_() == 0u) {
        __builtin_amdgcn_fence(__ATOMIC_RELEASE, "agent");
        asm volatile("s_waitcnt vmcnt(0)" ::: "memory");
        const unsigned old = __hip_atomic_fetch_add(ch + 64 * (2 + s), 1u, RLX_AGENT);
        if (old + 1u == ch_cnt(s) && s < 3) __hip_atomic_store(ch + 64, (unsigned)ch_first(s + 2), RLX_AGENT);
    }
}
__device__ __forceinline__ void chain_item(const Frame& F, int l, gu32* ch, int ci) {
    const int s = ch_stage(ci);
    if (s == 1) { pg8::Gemm g{WSB(F, WS_BR), lw(F, l, LW_BR), 3 * M_PAD, 3 * D, D}; SmallOrder3 S{ci}; EpiGate E{F.ws};
        pg8::gemm_phase<EpiGate, SmallOrder3, true, true>(F.lds, g, S, E, F.wave); }
    else if (s == 2) { pg8::Gemm g{WSB(F, WS_MIX), lw(F, l, LW_OUT), M_PAD, D, D}; SmallOrder S{ci - 8}; EpiResid E{F.ws, ALPHA, 1.0f};
        pg8::gemm_phase<EpiResid, SmallOrder, true, true>(F.lds, g, S, E, F.wave); }
    else { const int i = ci - 16; ln_rows(F, l * 3 + 1, false, MP + 32 * i, MP + 32 * i + 32, 0, 8); }
    chain_signal(F, ch, s);
}
__device__ __forceinline__ int mq_count(int kq) { return kq == 0 ? 164 : kq == 1 ? 9 : kq == 2 ? 64 : kq == 3 ? 2056 : 1024; }

__global__ void __launch_bounds__(512, 2) mega_fwd(Args args) {
    extern __shared__ __attribute__((aligned(16))) unsigned char lds[];
    Frame F;
    F.lds = (LAS unsigned char*)lds;
    F.MISC = (volatile LAS unsigned*)(F.lds + MISC_OFF);
    F.G = gridDim.x; F.wave = __builtin_amdgcn_readfirstlane((int)threadIdx.x >> 6);
    F.ws = args.ws; F.out = args.out; F.ctl = (gu32*)(args.ws + WS_CTL);
    for (int u = threadIdx.x; u < (LDS_BYTES - LDSCTL_OFF) / 4; u += 512) ((LAS unsigned*)(F.lds + LDSCTL_OFF))[u] = 0u;
    __syncthreads();
    XcdBarrier bar = xcd_barrier_post((unsigned*)(F.ctl + CW_BAR), F.MISC + 8);
#define GRID_BAR() xcd_barrier(bar)

    p0_prologue(F);

    GRID_BAR();

    for (int l = 0; l < DEPTH; ++l) {
        { pg8::Gemm g{WSB(F, WS_HB), lw(F, l, LW_UP1), M_PAD, 2 * DFF, D}; pg8::StaticOrder S; S.init(M_PAD, 2 * DFF, opq(F.G), opq((int)blockIdx.x)); EpiSwiglu E{WSB(F, WS_ACT)};
          pg8::gemm_phase<EpiSwiglu, pg8::StaticOrder, true, true>(F.lds, g, S, E, F.wave); }

        GRID_BAR();
        { pg8::Gemm g{WSB(F, WS_ACT), lw(F, l, LW_DN1), M_PAD, D, DFF}; pg8::StaticOrder S; S.init(MP, D, opq(F.G), opq((int)blockIdx.x));
          EpiResid E{F.ws, ALPHA, 0.5f};
          pg8::gemm_phase<EpiResid, pg8::StaticOrder, true, true>(F.lds, g, S, E, F.wave); }

        GRID_BAR();
        if (blockIdx.x < 16) { const int kh = opq((int)blockIdx.x) >> 3; pg8::Gemm g{WSB(F, WS_ACT) + kh * (DFF / 2), lw(F, l, LW_DN1) + kh * (DFF / 2), M_PAD, D, DFF / 2, DFF}; SmallOrderH S{opq((int)blockIdx.x)};
            EpiPart E{(float*)WSB(F, WS_ACT) + (size_t)kh * 512 * D};
            pg8::gemm_phase<EpiPart, SmallOrderH, true, true>(F.lds, g, S, E, F.wave); }
        else ln_phase(F, l * 3 + 0, false, 0, MP, 16);
        GRID_BAR();
        ln_phase(F, l * 3 + 0, false, MP, M_PAD, 0, true);
        GRID_BAR();
        { pg8::Gemm g{WSB(F, WS_HB), lw(F, l, LW_IN), M_PAD, DIN, D}; pg8::StaticOrder S; S.init(M_PAD, DIN, opq(F.G), opq((int)blockIdx.x));
          EpiWin E{F.ws, F.out, l};
          pg8::gemm_phase<EpiWin, pg8::StaticOrder, true, true>(F.lds, g, S, E, F.wave);
        }

        GRID_BAR();
        { gu32* q = F.ctl + CW_Q + 64 * (l * 8); gu32* ch = F.ctl + CW_CH + 1024 * l;
          int kq = 0, u = __builtin_amdgcn_readfirstlane(grab(F, q)), chain_open = 1;
          for (;;) {
              while (kq < 5 && u >= mq_count(kq)) { ++kq; if (kq < 5) u = __builtin_amdgcn_readfirstlane(grab(F, q + 64 * kq)); }
              unsigned l0_ = lane_lo_(); asm volatile("" : "+v"(l0_));
              const bool t0 = F.wave == 0 && l0_ == 0u;
              unsigned nx = 0u, hd = 0u, rd = 0u;
              if (t0) { if (kq < 5) nx = __hip_atomic_fetch_add(q + 64 * kq, 1u, RLX_AGENT); if (chain_open) { hd = __hip_atomic_load(ch, RLX_AGENT); rd = __hip_atomic_load(ch + 64, RLX_AGENT); } }
              if (kq == 0) { ret_unit(F, l, u < 36 ? 128 + u : u - 36); if (u < 36) chain_signal(F, ch, 0); }
              else if (kq == 1 || kq == 4) { pool_unit(F, l, kq == 1 ? 1024 + u : u); if (kq == 1) chain_signal(F, ch, 0); }
              else if (kq == 2) { attn_unit<true>(F, l, u); chain_signal(F, ch, 0); }
              else if (kq == 3) { attn_unit<false>(F, l, u < 8 ? 64 + 2048 + u : 64 + u - 8); if (u < 8) chain_signal(F, ch, 0); }
              __syncthreads();
              if (t0) { int ci = -1;
                  if (chain_open) {
                      if (kq == 5) { unsigned sp = 0u;
                          for (;;) { hd = __hip_atomic_load(ch, RLX_AGENT); if (hd >= (unsigned)CH_TOTAL) { ci = -2; break; } rd = __hip_atomic_load(ch + 64, RLX_AGENT);
                              if (hd < rd) { unsigned e = hd; if (__hip_atomic_compare_exchange_strong(ch, &e, hd + 1u, __ATOMIC_RELAXED, __ATOMIC_RELAXED, __HIP_MEMORY_SCOPE_AGENT)) { ci = (int)hd; break; } }
                              else { __builtin_amdgcn_s_sleep(2); if ((++sp & 255u) == 0u) { if (xb_ld((unsigned*)(F.ctl + CW_BAR) + XB_TMO)) { ci = -2; break; } if (sp > XB_SPIN_CAP) { atomicAdd((unsigned*)(F.ctl + CW_BAR) + XB_TMO, 1u); ci = -2; break; } } } } }
                      else if (hd >= (unsigned)CH_TOTAL) ci = -3;
                      else if (hd < rd) { unsigned e = hd; if (__hip_atomic_compare_exchange_strong(ch, &e, hd + 1u, __ATOMIC_RELAXED, __ATOMIC_RELAXED, __HIP_MEMORY_SCOPE_AGENT)) ci = (int)hd; }
                      if (ci >= 0) { __builtin_amdgcn_fence(__ATOMIC_ACQUIRE, "agent"); asm volatile("s_waitcnt vmcnt(0)" ::: "memory"); }
                  } else if (kq == 5) ci = -2;
                  F.MISC[16] = nx; F.MISC[17] = (unsigned)ci; }
              __syncthreads();
              u = __builtin_amdgcn_readfirstlane((int)F.MISC[16]); const int ci = __builtin_amdgcn_readfirstlane((int)F.MISC[17]);
              if (ci == -2) break;
              if (ci == -3) chain_open = 0;
              if (ci >= 0) chain_item(F, l, ch, ci);
          }
          __syncthreads(); }
        GRID_BAR();
        { pg8::Gemm g{WSB(F, WS_BR), lw(F, l, LW_BR), 3 * M_PAD, 3 * D, D}; Order3 S; S.init(MP, D, opq(F.G), opq((int)blockIdx.x)); EpiGate E{F.ws};
          pg8::gemm_phase<EpiGate, Order3, true, true>(F.lds, g, S, E, F.wave); }

        GRID_BAR();
        { pg8::Gemm g{WSB(F, WS_MIX), lw(F, l, LW_OUT), M_PAD, D, D}; pg8::StaticOrder S; S.init(MP, D, opq(F.G), opq((int)blockIdx.x));
          EpiResid E{F.ws, ALPHA, 1.0f};
          pg8::gemm_phase<EpiResid, pg8::StaticOrder, true, true>(F.lds, g, S, E, F.wave); }

        GRID_BAR();
        if (blockIdx.x < 44) { pg8::Gemm g{WSB(F, WS_HB), lw(F, l, LW_UP2), M_PAD, 2 * DFF, D}; SmallOrderW S{opq((int)blockIdx.x)}; EpiSwiglu E{WSB(F, WS_ACT)};
            pg8::gemm_phase<EpiSwiglu, SmallOrderW, true, true>(F.lds, g, S, E, F.wave); }
        else ln_phase(F, l * 3 + 1, false, 0, MP, 44);
        GRID_BAR();
        { pg8::Gemm g{WSB(F, WS_HB), lw(F, l, LW_UP2), M_PAD, 2 * DFF, D}; pg8::StaticOrder S; S.init(MP, 2 * DFF, opq(F.G), opq((int)blockIdx.x)); EpiSwiglu E{WSB(F, WS_ACT)};
          pg8::gemm_phase<EpiSwiglu, pg8::StaticOrder, true, true>(F.lds, g, S, E, F.wave); }

        GRID_BAR();
        { pg8::Gemm g{WSB(F, WS_ACT), lw(F, l, LW_DN2), M_PAD, D, DFF}; pg8::StaticOrder S; S.init(MP, D, opq(F.G), opq((int)blockIdx.x));
          EpiResid E{F.ws, ALPHA, 0.5f};
          pg8::gemm_phase<EpiResid, pg8::StaticOrder, true, true>(F.lds, g, S, E, F.wave); }

        GRID_BAR();
        if (blockIdx.x < 16) { const int kh = opq((int)blockIdx.x) >> 3; pg8::Gemm g{WSB(F, WS_ACT) + kh * (DFF / 2), lw(F, l, LW_DN2) + kh * (DFF / 2), M_PAD, D, DFF / 2, DFF}; SmallOrderH S{opq((int)blockIdx.x)};
            EpiPart E{(float*)WSB(F, WS_ACT) + (size_t)kh * 512 * D};
            pg8::gemm_phase<EpiPart, SmallOrderH, true, true>(F.lds, g, S, E, F.wave); }
        else ln_phase(F, l * 3 + 2, l + 1 == DEPTH, 0, MP, 16);
        GRID_BAR();
        ln_phase(F, l * 3 + 2, l + 1 == DEPTH, MP, M_PAD, 0, true);
        if (l + 1 < DEPTH) GRID_BAR();
    }
}

extern "C" void kernel_launch(void* const* d_in, const int* in_sizes, int n_in, void* d_out, int out_size, void* d_ws, size_t ws_size, hipStream_t stream) {
    static int grid = 0;
    if (grid == 0) {
        if (n_in != 19 || (size_t)out_size != O_END || ws_size < WS_END) { fprintf(stderr, "kernel_launch: unexpected sizes (n_in %d out %d ws %zu need %zu)\n", n_in, out_size, ws_size, (size_t)WS_END); grid = -1; return; }
        int dev = 0, cus = 0, per_cu = 0;
        if (hipGetDevice(&dev) != hipSuccess || hipDeviceGetAttribute(&cus, hipDeviceAttributeMultiprocessorCount, dev) != hipSuccess) { grid = -1; return; }
        if (hipFuncSetAttribute((const void*)mega_fwd, hipFuncAttributeMaxDynamicSharedMemorySize, LDS_BYTES) != hipSuccess) { fprintf(stderr, "kernel_launch: hipFuncSetAttribute failed\n"); grid = -1; return; }
        if (hipOccupancyMaxActiveBlocksPerMultiprocessor(&per_cu, (const void*)mega_fwd, 512, LDS_BYTES) != hipSuccess || per_cu < 1) { fprintf(stderr, "kernel_launch: occupancy query says %d\n", per_cu); }
        (void)hipGetLastError();
        grid = cus;
    }
    if (grid < 0) return;
    if (hipMemsetAsync((char*)d_ws + WS_CTL, 0, CTL_ZERO_BYTES, stream) != hipSuccess) return;
    Args a{};
    for (int i = 0; i < 19; ++i) a.in[i] = (const float*)d_in[i];
    a.out = (float*)d_out; a.ws = (unsigned char*)d_ws;
    hipLaunchKernelGGL(mega_fwd, dim3(grid), dim3(512), LDS_BYTES, stream, a);
}
```

```cpp
#include <hip/hip_runtime.h>
#include <cstdio>
#include <cstdint>
__device__ __forceinline__ unsigned lane_lo_() { unsigned l; asm volatile("v_mbcnt_lo_u32_b32 %0, -1, 0" : "=v"(l)); return l; }
__device__ __forceinline__ int lane_id_() { unsigned l; asm volatile("v_mbcnt_lo_u32_b32 %0, -1, 0\n\tv_mbcnt_hi_u32_b32 %0, -1, %0" : "=v"(l)); return (int)l; }
namespace pg8 {
#define PG8_LAS __attribute__((address_space(3)))
typedef unsigned short bf16_t;
typedef short bf16x8 __attribute__((ext_vector_type(8)));
typedef float f32x4 __attribute__((ext_vector_type(4)));
typedef unsigned u32x4 __attribute__((ext_vector_type(4)));
constexpr int BM = 256, BK = 64, HALF = 128, HTB = HALF * BK * 2  , STAGE_BYTES = 8 * HTB, NXCD = 8, WGM = 4;

__host__ __device__ __forceinline__ int lds_byte(int r, int c) { const int st = (r >> 4) * 2 + (c >> 5), rr = r & 15, cc = c & 31, ob = rr * 64 + cc * 2; return st * 1024 + (ob ^ (((ob >> 9) & 1) << 5)); }
__host__ __device__ __forceinline__ void stage_rc(int b, int& R, int& C) { const int st = b / 1024, sb = b % 1024, swz = sb ^ (((sb >> 9) & 1) << 5); R = (st >> 1) * 16 + swz / 64; C = (st & 1) * 32 + (swz % 64) / 2; }
__host__ __device__ __forceinline__ int perm32(int rho) { const int n = rho >> 4, i = rho & 15; return 8 * (i >> 2) + 4 * n + (i & 3); }

struct Unit { int pm, pn; };
struct Gemm { const bf16_t* A; const bf16_t* Bt; int M, N, K; int ld = 0; };

struct StaticOrder {
    int nM, nN, nwg, G, c;
    __host__ __device__ void init(int M, int N, int G_, int c_) { nM = M / BM; nN = N / BM; nwg = nM * nN; G = G_; c = c_; }
    __host__ __device__ bool next(int i, Unit& u) const {
        const long L = (long)i * G + c; if (L >= nwg) return false;
        int wgid = (int)L; { const int q = nwg / NXCD, r = nwg % NXCD, xcd = wgid % NXCD, off = wgid / NXCD; wgid = (xcd < r ? xcd * (q + 1) : r * (q + 1) + (xcd - r) * q) + off; }
        const int nig = WGM * nN, gid = wgid / nig, fm = gid * WGM, gsz = (nM - fm) < WGM ? (nM - fm) : WGM;
        u.pm = fm + ((wgid % nig) % gsz); u.pn = (wgid % nig) / gsz; return true;
    }
    __device__ __forceinline__ void a_ready(const Unit&) const {}
    __device__ __forceinline__ void done(const Unit&) const {}
};

__device__ __forceinline__ unsigned cvt_pk_bf16(float lo, float hi) { unsigned r; asm volatile("v_cvt_pk_bf16_f32 %0, %1, %2" : "=v"(r) : "v"(lo), "v"(hi)); return r; }
template <class Epi, class Sched, bool ALIGN_EPI = false, bool SP2 = false>
__device__ __forceinline__ void gemm_phase(PG8_LAS unsigned char* lds, const Gemm g, const Sched& S, const Epi& E, const int wave_id) {
    int lane_ = lane_id_(); asm volatile("" : "+v"(lane_));
    const int tid = wave_id * 64 + lane_;
    int widq_ = wave_id; asm volatile("" : "+s"(widq_));
    const int wid = widq_, lane = tid & 63, wr = wid >> 2, wc = wid & 3, fr = lane & 15, fq = lane >> 4;
    const int K = g.K, nt = K / BK, LD = g.ld > 0 ? g.ld : K;
    unsigned voffA[2], voffB[2];
#pragma unroll
    for (int i = 0; i < 2; ++i) { int R, C; stage_rc(tid * 16 + i * 8192, R, C); const int Rb = Epi::PERM ? ((R & ~31) + perm32(R & 31)) : R;
        voffA[i] = (unsigned)(R * LD + C) * 2u; voffB[i] = (unsigned)(Rb * LD + C) * 2u; }
    const size_t kstep = (size_t)(BK * 2);
    const size_t hstep = (size_t)HALF * LD * 2;
    const size_t tstep = 2 * hstep;
    const unsigned ldsw = (unsigned)wid * 1024u;
    const int aoff = lds_byte(wr * 64 + fr, fq * 8), boff = lds_byte(wc * 32 + fr, fq * 8);
#define PG8_SA(b, h) (((b) * 2 + (h)) * HTB)
#define PG8_SB(b, h) ((4 + (b) * 2 + (h)) * HTB)
#define PG8_STAGE(bufoff, gbase, voff) do { _Pragma("unroll") for (int _i = 0; _i < 2; ++_i) \
        __builtin_amdgcn_global_load_lds((const unsigned*)((const char*)(gbase) + (voff)[_i]), (PG8_LAS unsigned*)(lds + (bufoff) + ldsw + _i * 8192), 16, 0, 0); } while (0)
#define PG8_LDA(dst, b, h) do { _Pragma("unroll") for (int m = 0; m < 4; ++m) _Pragma("unroll") for (int k = 0; k < 2; ++k) dst[m][k] = *(const PG8_LAS bf16x8*)(lds + PG8_SA(b, h) + aoff + m * 2048 + k * 1024); } while (0)
#define PG8_LDB(dst, b, h) do { _Pragma("unroll") for (int n = 0; n < 2; ++n) _Pragma("unroll") for (int k = 0; k < 2; ++k) dst[n][k] = *(const PG8_LAS bf16x8*)(lds + PG8_SB(b, h) + boff + n * 2048 + k * 1024); } while (0)
#define PG8_MMA(ai, bj, At, Bt) do { __builtin_amdgcn_s_setprio(1); _Pragma("unroll") for (int m = 0; m < 4; ++m) _Pragma("unroll") for (int n = 0; n < 2; ++n) _Pragma("unroll") for (int k = 0; k < 2; ++k) \
        acc[ai][bj][m][n] = __builtin_amdgcn_mfma_f32_16x16x32_bf16(Bt[n][k], At[m][k], acc[ai][bj][m][n], 0, 0, 0); __builtin_amdgcn_s_setprio(0); } while (0)
#define PG8_WAIT_V(n) asm volatile("s_waitcnt vmcnt(" #n ")" ::: "memory")
#define PG8_WAIT_VN(n) asm volatile("s_waitcnt vmcnt(%0)" :: "n"(n) : "memory")
#define PG8_WAIT_L(n) asm volatile("s_waitcnt lgkmcnt(" #n ")" ::: "memory")
#define PG8_BAR __builtin_amdgcn_s_barrier()
#define PG8_SCHED __builtin_amdgcn_sched_barrier(0)
    Unit cur, nxt; int ui = 0;
    if (!S.next(0, cur)) return;
    f32x4 acc[2][2][4][2];
#pragma unroll
    for (int a = 0; a < 2; ++a)
#pragma unroll
        for (int b = 0; b < 2; ++b)
#pragma unroll
            for (int m = 0; m < 4; ++m)
#pragma unroll
                for (int n = 0; n < 2; ++n) acc[a][b][m][n] = (f32x4){0.f, 0.f, 0.f, 0.f};
    bf16x8 At[4][2], B0[2][2], B1[2][2];
    const char* cA = (const char*)g.A + (size_t)cur.pm * tstep; const char* cB = (const char*)g.Bt + (size_t)cur.pn * tstep;
    S.a_ready(cur);
    if constexpr (SP2) {
        PG8_STAGE(PG8_SB(0, 0), cB, voffB); PG8_STAGE(PG8_SB(0, 1), cB + hstep, voffB); PG8_STAGE(PG8_SA(0, 0), cA, voffA); PG8_STAGE(PG8_SA(0, 1), cA + hstep, voffA);
        if (wr == 1) PG8_BAR;
        PG8_WAIT_V(2); PG8_BAR;
        PG8_STAGE(PG8_SB(1, 0), cB + kstep, voffB); PG8_STAGE(PG8_SA(1, 0), cA + kstep, voffA); PG8_STAGE(PG8_SB(1, 1), cB + hstep + kstep, voffB);
        PG8_WAIT_V(6); PG8_BAR;
    } else {
        PG8_STAGE(PG8_SB(0, 0), cB, voffB); PG8_STAGE(PG8_SA(0, 0), cA, voffA); PG8_STAGE(PG8_SB(0, 1), cB + hstep, voffB); PG8_STAGE(PG8_SA(0, 1), cA + hstep, voffA);
        if (wr == 1) PG8_BAR;
        PG8_WAIT_V(4); PG8_BAR;
        PG8_STAGE(PG8_SB(1, 0), cB + kstep, voffB); PG8_STAGE(PG8_SA(1, 0), cA + kstep, voffA); PG8_STAGE(PG8_SB(1, 1), cB + hstep + kstep, voffB);
        PG8_WAIT_V(6); PG8_BAR;
    }
    for (;;) {
        const bool has_next = S.next(ui + 1, nxt);
        const char* nA = has_next ? (const char*)g.A + (size_t)nxt.pm * tstep : cA; const char* nB = has_next ? (const char*)g.Bt + (size_t)nxt.pn * tstep : cB;
        for (int t = 0; t < nt; t += 2) {
            const bool last = (t == nt - 2);
            const char* a1 = cA + (size_t)(t + 1) * kstep;
            const char* a2 = last ? nA : cA + (size_t)(t + 2) * kstep; const char* b2 = last ? nB : cB + (size_t)(t + 2) * kstep;
            const char* a3 = a2 + kstep; const char* b3 = b2 + kstep;
            if (last && has_next) S.a_ready(nxt);
            if constexpr (SP2) {
            int tz_ = __builtin_amdgcn_readfirstlane(t | (ui > 0 ? 0 : 1)); asm volatile("" : "+s"(tz_));
            const bool strict = !(Epi::NS > 0 && tz_ == 0);
            PG8_LDB(B0, 0, 0); PG8_LDB(B1, 0, 1); PG8_SCHED; PG8_LDA(At, 0, 0); PG8_STAGE(PG8_SA(1, 1), a1 + hstep, voffA);
            PG8_WAIT_VN(8 + Epi::NS); if (strict) PG8_WAIT_V(8); PG8_WAIT_L(0); PG8_BAR; PG8_MMA(0, 0, At, B0); PG8_MMA(0, 1, At, B1); PG8_BAR; PG8_SCHED;
            PG8_LDA(At, 0, 1); PG8_STAGE(PG8_SB(0, 0), b2, voffB); PG8_STAGE(PG8_SB(0, 1), b2 + hstep, voffB); PG8_STAGE(PG8_SA(0, 0), a2, voffA);
            PG8_WAIT_VN(8 + Epi::NS); if (strict) PG8_WAIT_V(8); PG8_WAIT_L(0); PG8_BAR; PG8_MMA(1, 0, At, B0); PG8_MMA(1, 1, At, B1); PG8_BAR; PG8_SCHED;
            PG8_LDB(B0, 1, 0); PG8_LDB(B1, 1, 1); PG8_SCHED; PG8_LDA(At, 1, 0); PG8_STAGE(PG8_SA(0, 1), a2 + hstep, voffA);
            PG8_WAIT_V(8); PG8_WAIT_L(0); PG8_BAR; PG8_MMA(0, 0, At, B0); PG8_MMA(0, 1, At, B1); PG8_BAR; PG8_SCHED;
            PG8_LDA(At, 1, 1); PG8_STAGE(PG8_SB(1, 0), b3, voffB); PG8_STAGE(PG8_SB(1, 1), b3 + hstep, voffB); PG8_STAGE(PG8_SA(1, 0), a3, voffA);
            PG8_WAIT_V(8); PG8_WAIT_L(0); PG8_BAR; PG8_MMA(1, 0, At, B0); PG8_MMA(1, 1, At, B1); PG8_BAR; PG8_SCHED;
            } else {
            PG8_LDB(B0, 0, 0); PG8_SCHED; PG8_LDA(At, 0, 0); PG8_STAGE(PG8_SA(1, 1), a1 + hstep, voffA);
            PG8_WAIT_L(8); PG8_BAR; PG8_WAIT_L(0); PG8_MMA(0, 0, At, B0); PG8_BAR; PG8_SCHED;
            PG8_LDB(B1, 0, 1); PG8_STAGE(PG8_SB(0, 0), b2, voffB);
            PG8_BAR; PG8_WAIT_L(0); PG8_MMA(0, 1, At, B1); PG8_BAR;
            PG8_LDA(At, 0, 1); PG8_STAGE(PG8_SA(0, 0), a2, voffA);
            PG8_BAR; PG8_WAIT_L(0); PG8_MMA(1, 0, At, B0); PG8_BAR; PG8_SCHED;
            PG8_STAGE(PG8_SB(0, 1), b2 + hstep, voffB);
            PG8_WAIT_V(6); PG8_BAR; PG8_MMA(1, 1, At, B1); PG8_BAR;
            PG8_LDB(B0, 1, 0); PG8_SCHED; PG8_LDA(At, 1, 0); PG8_STAGE(PG8_SA(0, 1), a2 + hstep, voffA);
            PG8_WAIT_L(8); PG8_BAR; PG8_WAIT_L(0); PG8_MMA(0, 0, At, B0); PG8_BAR; PG8_SCHED;
            PG8_LDB(B1, 1, 1); PG8_STAGE(PG8_SB(1, 0), b3, voffB);
            PG8_BAR; PG8_WAIT_L(0); PG8_MMA(0, 1, At, B1); PG8_BAR;
            PG8_LDA(At, 1, 1); PG8_STAGE(PG8_SA(1, 0), a3, voffA);
            PG8_BAR; PG8_WAIT_L(0); PG8_MMA(1, 0, At, B0); PG8_BAR; PG8_SCHED;
            PG8_STAGE(PG8_SB(1, 1), b3 + hstep, voffB);
            PG8_WAIT_V(6); PG8_BAR; PG8_MMA(1, 1, At, B1); PG8_BAR;
            }
        }
        if constexpr (ALIGN_EPI) { if (wr == 0) PG8_BAR; }
        const bool keep_acc = E(acc, cur, wr, wc, fr, fq);
        if (!has_next) break;
        if (!keep_acc) {
#pragma unroll
        for (int a = 0; a < 2; ++a)
#pragma unroll
            for (int b = 0; b < 2; ++b)
#pragma unroll
                for (int m = 0; m < 4; ++m)
#pragma unroll
                    for (int n = 0; n < 2; ++n) acc[a][b][m][n] = (f32x4){0.f, 0.f, 0.f, 0.f};
        }
        cur = nxt; cA = nA; cB = nB; ++ui;
        if constexpr (ALIGN_EPI) { if (wr == 1) PG8_BAR; }
    }
    PG8_WAIT_V(0);
    if constexpr (!ALIGN_EPI) { if (wr == 0) PG8_BAR; }
    PG8_BAR;
#undef PG8_SA
#undef PG8_SB
#undef PG8_STAGE
#undef PG8_LDA
#undef PG8_LDB
#undef PG8_MMA
#undef PG8_WAIT_V
#undef PG8_WAIT_VN
#undef PG8_WAIT_L
#undef PG8_BAR
#undef PG8_SCHED
}
}

constexpr int D = 1024, NB = 32, T = 2048, DEPTH = 2, SBATCH = 8, ST = 32, PAST = 4096, NMETA = 16;
constexpr int HRET = 4, DKR = 128, DVR = 256, HSB = 8, DSB = 128, DFF = 2816, DIN = 10240, PBUF = 15;
constexpr int MP = NB * T;
constexpr int ROW_S = MP;
constexpr int ROW_M = MP + SBATCH * ST;
constexpr int M_PAD = ROW_M + 256;
constexpr int NPANEL = M_PAD / 256;
constexpr float LN_EPS = 1e-5f;
constexpr float ALPHA = 1.41421356237f;
constexpr float LOG2E = 1.44269504089f;
constexpr int KT_SP = PAST + ST;
constexpr int KT_PP = NMETA + T;

constexpr size_t O_YP = 0;
constexpr size_t O_YS = O_YP + (size_t)NB * T * D;
constexpr size_t O_KP = O_YS + (size_t)SBATCH * ST * D;
constexpr size_t O_VP = O_KP + (size_t)DEPTH * NB * KT_PP * D;
constexpr size_t O_RP = O_VP + (size_t)DEPTH * NB * KT_PP * D;
constexpr size_t O_PP = O_RP + (size_t)DEPTH * NB * HRET * DKR * DVR;
constexpr size_t O_KS = O_PP + (size_t)DEPTH * NB * PBUF * D;
constexpr size_t O_VS = O_KS + (size_t)DEPTH * SBATCH * ST * D;
constexpr size_t O_RS = O_VS + (size_t)DEPTH * SBATCH * ST * D;
constexpr size_t O_PS = O_RS + (size_t)DEPTH * SBATCH * HRET * DKR * DVR;
constexpr size_t O_END = O_PS + (size_t)DEPTH * SBATCH * PBUF * D;
static_assert(O_END == 350666752ull, "output size");

constexpr size_t MiB = 1u << 20;
constexpr size_t AL(size_t x) { return (x + 4095) & ~(size_t)4095; }
constexpr size_t WS_CTL = 0, CTL_ZERO_BYTES = 1 * MiB;
constexpr size_t WS_YB = WS_CTL + CTL_ZERO_BYTES;
constexpr size_t WS_HB = AL(WS_YB + (size_t)M_PAD * D * 2);
constexpr size_t WS_ACT = AL(WS_HB + (size_t)M_PAD * D * 2);
constexpr size_t WS_QR = AL(WS_ACT + (size_t)M_PAD * DFF * 2);
constexpr size_t WS_KR = AL(WS_QR + (size_t)M_PAD * 512 * 2);
constexpr size_t WS_VR = AL(WS_KR + (size_t)M_PAD * 512 * 2);
constexpr size_t WS_GR = AL(WS_VR + (size_t)M_PAD * D * 2);
constexpr size_t WS_QS = AL(WS_GR + (size_t)M_PAD * D * 2);
constexpr size_t WS_KS = AL(WS_QS + (size_t)M_PAD * D * 2);
constexpr size_t WS_VS = AL(WS_KS + (size_t)M_PAD * D * 2);
constexpr size_t WS_U = AL(WS_VS + (size_t)M_PAD * D * 2);
constexpr size_t WS_GT = AL(WS_U + (size_t)M_PAD * D * 2);
constexpr size_t WS_BR = AL(WS_GT + (size_t)M_PAD * 3 * D * 2);
constexpr size_t WS_MIX = AL(WS_BR + (size_t)3 * M_PAD * D * 2);
constexpr size_t WS_W = AL(WS_MIX + (size_t)M_PAD * D * 2);
constexpr size_t LW_UP1 = 0;
constexpr size_t LW_DN1 = LW_UP1 + (size_t)2 * DFF * D * 2;
constexpr size_t LW_IN = LW_DN1 + (size_t)D * DFF * 2;
constexpr size_t LW_BR = LW_IN + (size_t)DIN * D * 2;
constexpr size_t LW_OUT = LW_BR + (size_t)3 * D * D * 2;
constexpr size_t LW_UP2 = LW_OUT + (size_t)D * D * 2;
constexpr size_t LW_DN2 = LW_UP2 + (size_t)2 * DFF * D * 2;
constexpr size_t LW_SIZE = AL(LW_DN2 + (size_t)D * DFF * 2);
constexpr size_t WS_END = WS_W + DEPTH * LW_SIZE;
static_assert(WS_END < (size_t)4000 * MiB, "workspace budget");

constexpr int CW_BAR = 4096;
constexpr int CW_Q = 16384;
constexpr int CW_CH = 24576;
constexpr int CW_DBG = 32768;
constexpr int CW_KN = 65536;
static_assert((CW_KN + DEPTH * 33 * 8 * 16) * 4 <= (int)CTL_ZERO_BYTES, "ctl region");

constexpr int RING_BYTES = 131072;
constexpr int LDSCTL_OFF = RING_BYTES, MISC_OFF = LDSCTL_OFF + 320;
constexpr int LDS_BYTES = 147456;

#define GAS __attribute__((address_space(1)))
#define LAS __attribute__((address_space(3)))
typedef unsigned short bf16;
typedef unsigned v4u __attribute__((ext_vector_type(4)));
typedef unsigned v2u __attribute__((ext_vector_type(2)));
typedef float f32x4 __attribute__((ext_vector_type(4)));
typedef short bf16x8 __attribute__((ext_vector_type(8)));
typedef short s16x4 __attribute__((ext_vector_type(4)));
typedef GAS unsigned gu32;
#define RLX_AGENT __ATOMIC_RELAXED, __HIP_MEMORY_SCOPE_AGENT
__device__ __forceinline__ unsigned f2bf(float f) { unsigned u = __builtin_bit_cast(unsigned, f); return (u + 0x7fffu + ((u >> 16) & 1u)) >> 16; }
__device__ __forceinline__ unsigned pk2(float lo, float hi) { return f2bf(lo) | (f2bf(hi) << 16); }
__device__ __forceinline__ float bf2f(unsigned short b) { return __builtin_bit_cast(float, (unsigned)b << 16); }
__device__ __forceinline__ float bflo(unsigned w) { return __builtin_bit_cast(float, w << 16); }
__device__ __forceinline__ float bfhi(unsigned w) { return __builtin_bit_cast(float, w & 0xffff0000u); }
__device__ __forceinline__ float fast_exp2(float x) { return __builtin_amdgcn_exp2f(x); }
__device__ __forceinline__ float fast_log2(float x) { return __builtin_amdgcn_logf(x); }
__device__ __forceinline__ float fast_rcp(float x) { return __builtin_amdgcn_rcpf(x); }
__device__ __forceinline__ float sigmoidf_(float x) { return fast_rcp(1.0f + fast_exp2(-x * LOG2E)); }
__device__ __forceinline__ float siluf_(float x) { return x * sigmoidf_(x); }
__device__ __forceinline__ float wave_sum(float v) {
#pragma unroll
    for (int o = 1; o < 64; o <<= 1) v += __shfl_xor(v, o);
    return v;
}
#define XB_TMO      128
#define XB_XCNT(j)  (256  + 64 * (j))
#define XB_XSUB(j)  (1280 + 64 * (j))
#define XB_XGEN(j)  (2304 + 64 * (j))
#define XB_TOP      3328
#define XB_TOPGEN   3392
#define XCD_BAR_WORDS 3456
#define XB_SPIN_CAP (1u << 20)

__device__ __forceinline__ unsigned xb_ld(unsigned* p)              { return __hip_atomic_load(p, __ATOMIC_RELAXED, __HIP_MEMORY_SCOPE_AGENT); }
__device__ __forceinline__ unsigned xb_add(unsigned* p, unsigned v) { return __hip_atomic_fetch_add(p, v, __ATOMIC_RELAXED, __HIP_MEMORY_SCOPE_AGENT); }
__device__ __forceinline__ unsigned xb_xcc_id() { return (unsigned)__builtin_amdgcn_s_getreg((3 << 11) | 20) & 0xFu; }
#define XB_SPIN(cond, bar) do { unsigned _sp = 0; while (cond) { __builtin_amdgcn_s_sleep(1); \
    if ((++_sp & 255u) == 0u) { if (xb_ld(&(bar)[XB_TMO])) break; if (_sp > XB_SPIN_CAP) { atomicAdd(&(bar)[XB_TMO], 1u); break; } } } } while (0)

struct XcdBarrier {
    unsigned* bar; unsigned x; unsigned w0;
    volatile LAS unsigned* st;
};

__device__ __forceinline__ XcdBarrier xcd_barrier_post(unsigned* bar, volatile LAS unsigned* st) {
    XcdBarrier b; b.bar = bar; b.x = xb_xcc_id(); b.st = st; b.w0 = (__builtin_amdgcn_readfirstlane((int)threadIdx.x >> 6) == 0) ? 1u : 0u;
    if (threadIdx.x == 0) (void)xb_add(&bar[XB_XCNT(b.x)], 1u);
    return b;
}
__device__ __forceinline__ void xcd_barrier_complete(unsigned* bar, unsigned x, unsigned& nloc, unsigned& nx) {
    const unsigned G = gridDim.x * gridDim.y * gridDim.z;
    unsigned sum, cnt, mine, sp = 0u;
    for (;;) {
        sum = 0u; cnt = 0u; mine = 0u;
#pragma unroll
        for (unsigned j = 0; j < 16; ++j) { const unsigned c = xb_ld(&bar[XB_XCNT(j)]); sum += c; cnt += (c > 0u) ? 1u : 0u; mine = (j == x) ? c : mine; }
        if (sum == G) break;
        __builtin_amdgcn_s_sleep(1);
        if ((++sp & 255u) == 0u) { if (xb_ld(&bar[XB_TMO])) break; if (sp > XB_SPIN_CAP) { atomicAdd(&bar[XB_TMO], 1u); break; } }
    }
    nloc = mine > 0u ? mine : 1u; nx = cnt > 0u ? cnt : 1u;
}

__device__ __forceinline__ void xcd_barrier(const XcdBarrier& b) {
    asm volatile("s_waitcnt vmcnt(0)" ::: "memory");
    __syncthreads();
    if (b.w0 != 0u && lane_lo_() == 0u) {
        unsigned* bar = b.bar; unsigned bx = b.x; asm volatile("" : "+s"(bar), "+s"(bx));
        __builtin_amdgcn_s_waitcnt(0);
        unsigned nloc = b.st[0], nx = b.st[1];
        if (nloc == 0u) { xcd_barrier_complete(bar, bx, nloc, nx); b.st[0] = nloc; b.st[1] = nx; }
        const unsigned old = xb_add(&bar[XB_XSUB(bx)], 1u);
        const unsigned gen = old / nloc;
        if (old + 1u == (gen + 1u) * nloc) {
            __builtin_amdgcn_fence(__ATOMIC_RELEASE, "agent");
            asm volatile("s_waitcnt vmcnt(0)" ::: "memory");
            const unsigned og = xb_add(&bar[XB_TOP], 1u);
            const unsigned tg = og / nx;
            if (og + 1u == (tg + 1u) * nx) xb_add(&bar[XB_TOPGEN], 1u);
            else XB_SPIN(xb_ld(&bar[XB_TOPGEN]) == tg, bar);
            __builtin_amdgcn_fence(__ATOMIC_ACQUIRE, "agent");
            xb_add(&bar[XB_XGEN(bx)], 1u);
            asm volatile("s_waitcnt vmcnt(0)" ::: "memory");
        } else {
            XB_SPIN(xb_ld(&bar[XB_XGEN(bx)]) == gen, bar);
            __builtin_amdgcn_fence(__ATOMIC_ACQUIRE, "agent");
            asm volatile("s_waitcnt vmcnt(0)" ::: "memory");
        }
    }
    __syncthreads();
}

struct Frame {
    LAS unsigned char* lds;
    volatile LAS unsigned* MISC;
    gu32* ctl;
    int G, wave;
    float* out; unsigned char* ws;
};
__device__ __forceinline__ const float* in_ptr(int i) {
    const __attribute__((address_space(4))) char* k = (const __attribute__((address_space(4))) char*)__builtin_amdgcn_kernarg_segment_ptr();
    asm volatile("" : "+s"(k));
    return *(const float* const __attribute__((address_space(4)))*)(k + 8 * i);
}
enum { IN_XP = 0, IN_XS, IN_CK, IN_CV, IN_SRET, IN_SPOOL, IN_META, IN_WIN, IN_RETG, IN_PMIX, IN_PSCALE, IN_WBR, IN_WOUT, IN_UP1, IN_DN1, IN_UP2, IN_DN2, IN_LNG, IN_LNB };
__device__ __forceinline__ unsigned char* wsq(unsigned char* p) { asm volatile("" : "+s"(p)); return p; }
#define WSB(F, off) ((bf16*)(wsq((F).ws) + (off)))
struct TC { int tid, lane, wave; };
__device__ __forceinline__ TC thread_coords(int wave) { TC c; int l = lane_id_(); asm volatile("" : "+v"(l)); c.lane = l; c.wave = wave; c.tid = wave * 64 + l; return c; }
__device__ __forceinline__ bf16* lw(const Frame& F, int l, size_t off) { return (bf16*)(wsq(F.ws) + WS_W + (size_t)l * LW_SIZE + off); }
__device__ __forceinline__ float* yrow(const Frame& F, int m) {
    if (m < MP) return F.out + O_YP + (size_t)m * D;
    if (m < ROW_M) return F.out + O_YS + (size_t)(m - ROW_S) * D;
    return nullptr;
}

__device__ __forceinline__ int srccol(int kind, int n) {
    if (kind == 1) { const int pn = n >> 8, p = n & 255, bj = p >> 7, wc = (p >> 5) & 3, fq = (p >> 3) & 3, nn = (p >> 2) & 1, e = p & 3;
        return (nn ? DFF : 0) + 128 * pn + 64 * bj + 16 * wc + 4 * fq + e; }
    if (kind == 2 && n < 1024) { const int hb_ = n & ~127, p = n & 127, wc = p >> 5, fq = (p >> 3) & 3, nn = (p >> 2) & 1, e = p & 3;
        return hb_ + 16 * wc + 4 * fq + e + 64 * nn; }
    return n;
}
__device__ __forceinline__ void p0_transpose_item(const float* W, int K, int ldw, int N, bf16* WT, int kind, LAS float* scr, int item, int lane) {
    const int nblk = N / 32, kb = item / nblk, nb = item % nblk, k0 = 64 * kb, n0 = 32 * nb;
    const int sc = srccol(kind, n0 + (lane & 31));
    float t_[32];
#pragma unroll
    for (int i = 0; i < 32; ++i) t_[i] = W[(size_t)(k0 + 2 * i + (lane >> 5)) * ldw + sc];
#pragma unroll
    for (int i = 0; i < 32; ++i) scr[(2 * i + (lane >> 5)) * 33 + (lane & 31)] = t_[i];
    asm volatile("s_waitcnt lgkmcnt(0)" ::: "memory");
    const int c = lane & 7;
#pragma unroll
    for (int j = 0; j < 4; ++j) { const int n = (lane >> 3) + 8 * j; const LAS float* s = scr + (8 * c) * 33 + n;
        v4u o; o.x = pk2(s[0 * 33], s[1 * 33]); o.y = pk2(s[2 * 33], s[3 * 33]); o.z = pk2(s[4 * 33], s[5 * 33]); o.w = pk2(s[6 * 33], s[7 * 33]);
        *(GAS v4u*)(WT + (size_t)(n0 + n) * K + k0 + 8 * c) = o; }
    asm volatile("s_waitcnt lgkmcnt(0)" ::: "memory");
}
__device__ __forceinline__ void p0_poolfold_item(const float* mixw  , const float* scale  , const float* wb2  , bf16* WT  , int item, int lane) {
    const int g = item >> 7, r = item & 127, cb = r >> 4, nb = r & 15;
    const int n = nb * 64 + lane, c0 = cb * 32;
    float acc[32];
#pragma unroll
    for (int i = 0; i < 32; ++i) acc[i] = 0.f;
    const float* mw = mixw + ((size_t)g * 256 + c0) * 256;
    for (int d0 = 0; d0 < 256; d0 += 8) {
        float a[8];
#pragma unroll
        for (int j = 0; j < 8; ++j) a[j] = scale[g * 256 + d0 + j] * wb2[(size_t)(g * 256 + d0 + j) * D + n];
#pragma unroll
        for (int i = 0; i < 32; ++i)
#pragma unroll
            for (int j = 0; j < 8; ++j) acc[i] += mw[(size_t)i * 256 + d0 + j] * a[j];
    }
    bf16* dst = WT + (size_t)n * D + g * 256 + c0;
#pragma unroll
    for (int i = 0; i < 32; i += 8) { v4u o; o.x = pk2(acc[i], acc[i + 1]); o.y = pk2(acc[i + 2], acc[i + 3]); o.z = pk2(acc[i + 4], acc[i + 5]); o.w = pk2(acc[i + 6], acc[i + 7]); *(GAS v4u*)(dst + i) = o; }
}
__device__ __forceinline__ void p0_prologue(Frame& F) {
    const TC tc = thread_coords(F.wave); const int gw = blockIdx.x * 8 + tc.wave, NGW = F.G * 8;
    LAS float* scr = (LAS float*)(F.lds + tc.wave * 16384);
    for (int l = 0; l < DEPTH; ++l) {
        constexpr int I_UP = (D / 64) * (2 * DFF / 32), I_DN = (DFF / 64) * (D / 32), I_IN = (D / 64) * (DIN / 32), I_SQ = (D / 64) * (D / 32), I_PF = 4 * 4 * 32;
        constexpr int NIT = 2 * I_UP + 2 * I_DN + I_IN + 3 * I_SQ + I_PF;
        for (int it = (gw + l * (NGW / 2)) % NGW; it < NIT; it += NGW) {
            int r = it;
            if (r < I_UP) { p0_transpose_item(in_ptr(IN_UP1) + (size_t)l * D * 2 * DFF, D, 2 * DFF, 2 * DFF, lw(F, l, LW_UP1), 1, scr, r, tc.lane); continue; } r -= I_UP;
            if (r < I_UP) { p0_transpose_item(in_ptr(IN_UP2) + (size_t)l * D * 2 * DFF, D, 2 * DFF, 2 * DFF, lw(F, l, LW_UP2), 1, scr, r, tc.lane); continue; } r -= I_UP;
            if (r < I_DN) { p0_transpose_item(in_ptr(IN_DN1) + (size_t)l * DFF * D, DFF, D, D, lw(F, l, LW_DN1), 0, scr, r, tc.lane); continue; } r -= I_DN;
            if (r < I_DN) { p0_transpose_item(in_ptr(IN_DN2) + (size_t)l * DFF * D, DFF, D, D, lw(F, l, LW_DN2), 0, scr, r, tc.lane); continue; } r -= I_DN;
            if (r < I_IN) { p0_transpose_item(in_ptr(IN_WIN) + (size_t)l * D * DIN, D, DIN, DIN, lw(F, l, LW_IN), 2, scr, r, tc.lane); continue; } r -= I_IN;
            if (r < I_SQ) { p0_transpose_item(in_ptr(IN_WBR) + (size_t)(l * 3 + 0) * D * D, D, D, D, lw(F, l, LW_BR), 0, scr, r, tc.lane); continue; } r -= I_SQ;
            if (r < I_SQ) { p0_transpose_item(in_ptr(IN_WBR) + (size_t)(l * 3 + 1) * D * D, D, D, D, lw(F, l, LW_BR) + (size_t)D * D, 0, scr, r, tc.lane); continue; } r -= I_SQ;
            if (r < I_SQ) { p0_transpose_item(in_ptr(IN_WOUT) + (size_t)l * D * D, D, D, D, lw(F, l, LW_OUT), 0, scr, r, tc.lane); continue; } r -= I_SQ;
            p0_poolfold_item(in_ptr(IN_PMIX) + (size_t)l * 4 * 256 * 256, in_ptr(IN_PSCALE) + (size_t)l * D, in_ptr(IN_WBR) + (size_t)(l * 3 + 2) * D * D, lw(F, l, LW_BR) + (size_t)2 * D * D, r, tc.lane);
        }
    }
    for (int m0 = gw; m0 < M_PAD; m0 += 2 * NGW) {
        f32x4 v[2][4];
#pragma unroll
        for (int r = 0; r < 2; ++r) { const int m = m0 + r * NGW;
            const float* src = (m < MP) ? in_ptr(IN_XP) + (size_t)m * D : (m < ROW_M) ? in_ptr(IN_XS) + (size_t)(m - ROW_S) * D : (m - ROW_M < NMETA) ? in_ptr(IN_META) + (size_t)(m - ROW_M) * D : nullptr;
#pragma unroll
            for (int j = 0; j < 4; ++j) v[r][j] = (src && m < M_PAD) ? ((const GAS f32x4*)src)[tc.lane + 64 * j] : (f32x4){0.f, 0.f, 0.f, 0.f}; }
#pragma unroll
        for (int r = 0; r < 2; ++r) { const int m = m0 + r * NGW;
            if (m < M_PAD) { GAS v2u* o8 = (GAS v2u*)(WSB(F, WS_HB) + (size_t)m * D) + tc.lane;
#pragma unroll
                for (int j = 0; j < 4; ++j) o8[64 * j] = (v2u){pk2(v[r][j].x, v[r][j].y), pk2(v[r][j].z, v[r][j].w)}; } }
    }
}

__device__ __forceinline__ void ln_rows(const Frame& F, int idx, bool final_out, int row_lo, int row_hi, int gw0, int NGW, bool comb = false) {
    const TC tc = thread_coords(F.wave); const int gw = gw0 + tc.wave;
    const float* g = in_ptr(IN_LNG) + (size_t)idx * D; const float* b = in_ptr(IN_LNB) + (size_t)idx * D;
    f32x4 gv[4], bv[4];
#pragma unroll
    for (int j = 0; j < 2; ++j) { gv[2 * j] = ((const GAS f32x4*)g)[2 * tc.lane + 128 * j]; gv[2 * j + 1] = ((const GAS f32x4*)g)[2 * tc.lane + 128 * j + 1];
                                  bv[2 * j] = ((const GAS f32x4*)b)[2 * tc.lane + 128 * j]; bv[2 * j + 1] = ((const GAS f32x4*)b)[2 * tc.lane + 128 * j + 1]; }
    for (int m0 = row_lo + gw; m0 < row_hi; m0 += 2 * NGW) {
        v4u w[2][2]; const bool two = m0 + NGW < row_hi;
#pragma unroll
        for (int r = 0; r < 2; ++r) { const int m = (r == 0 || two) ? m0 + r * NGW : m0; const GAS v4u* yr = (const GAS v4u*)(WSB(F, comb ? WS_HB : WS_YB) + (size_t)m * D) + tc.lane; w[r][0] = yr[0]; w[r][1] = yr[64]; }
#pragma unroll
        for (int r = 0; r < 2; ++r) { const int m = m0 + r * NGW; if (r == 1 && !two) break;
        f32x4 v[4]; float s = 0.f;
#pragma unroll
        for (int j = 0; j < 2; ++j) { const v4u x = w[r][j]; v[2 * j] = (f32x4){bflo(x.x), bfhi(x.x), bflo(x.y), bfhi(x.y)}; v[2 * j + 1] = (f32x4){bflo(x.z), bfhi(x.z), bflo(x.w), bfhi(x.w)}; }
        if (comb) {
            const GAS f32x4* pa = (const GAS f32x4*)((const float*)WSB(F, WS_ACT) + (size_t)(m - MP) * D) + 2 * tc.lane; const GAS f32x4* pb = pa + (size_t)512 * D / 4;
#pragma unroll
            for (int j = 0; j < 2; ++j) { v[2 * j] = v[2 * j] * ALPHA + (pa[128 * j] + pb[128 * j]) * 0.5f; v[2 * j + 1] = v[2 * j + 1] * ALPHA + (pa[128 * j + 1] + pb[128 * j + 1]) * 0.5f; } }
#pragma unroll
        for (int j = 0; j < 4; ++j) s += (v[j].x + v[j].y) + (v[j].z + v[j].w);
        const float mean = wave_sum(s) * (1.f / D); float s2 = 0.f;
#pragma unroll
        for (int j = 0; j < 4; ++j) { v[j] = v[j] - mean; s2 += (v[j].x * v[j].x + v[j].y * v[j].y) + (v[j].z * v[j].z + v[j].w * v[j].w); }
        const float rstd = 1.f / sqrtf(wave_sum(s2) * (1.f / D) + LN_EPS);
#pragma unroll
        for (int j = 0; j < 4; ++j) v[j] = v[j] * rstd * gv[j] + bv[j];
        if (!final_out) { GAS v4u* o = (GAS v4u*)(WSB(F, WS_HB) + (size_t)m * D) + tc.lane;
#pragma unroll
            for (int j = 0; j < 2; ++j) o[64 * j] = (v4u){pk2(v[2 * j].x, v[2 * j].y), pk2(v[2 * j].z, v[2 * j].w), pk2(v[2 * j + 1].x, v[2 * j + 1].y), pk2(v[2 * j + 1].z, v[2 * j + 1].w)}; }
        else { float* yo = yrow(F, m); if (yo) { GAS f32x4* o = (GAS f32x4*)yo + 2 * tc.lane;
#pragma unroll
            for (int j = 0; j < 2; ++j) { o[128 * j] = v[2 * j]; o[128 * j + 1] = v[2 * j + 1]; } } }
        }
    }
}
__device__ __forceinline__ void ln_phase(const Frame& F, int idx, bool final_out, int row_lo, int row_hi, int cu_lo, bool comb = false) { ln_rows(F, idx, final_out, row_lo, row_hi, ((int)blockIdx.x - cu_lo) * 8, (F.G - cu_lo) * 8, comb); }
__device__ __forceinline__ float ret_lg2(int h);

using pg8::Unit;
typedef f32x4 AccT[2][2][4][2];
#ifndef LANE_TR
#define LANE_TR 1
#endif
struct LaneT { int tfr, tfq, pull, push; };
#if LANE_TR
__device__ __forceinline__ LaneT lane_t(int fr, int fq) { LaneT t; const int L = fq * 16 + fr; t.tfr = L >> 2; t.tfq = L & 3; t.pull = ((t.tfq << 4) + t.tfr) << 2; t.push = ((fr << 2) + fq) << 2; return t; }
__device__ __forceinline__ unsigned bperm(int a, unsigned x) { return (unsigned)__builtin_amdgcn_ds_bpermute(a, (int)x); }
__device__ __forceinline__ v4u tr4(int a, v4u x) { return (v4u){bperm(a, x.x), bperm(a, x.y), bperm(a, x.z), bperm(a, x.w)}; }
__device__ __forceinline__ v2u tr2(int a, v2u x) { return (v2u){bperm(a, x.x), bperm(a, x.y)}; }
#else
__device__ __forceinline__ LaneT lane_t(int fr, int fq) { LaneT t; t.tfr = fr; t.tfq = fq; t.pull = 0; t.push = 0; return t; }
__device__ __forceinline__ v4u tr4(int, v4u x) { return x; }
__device__ __forceinline__ v2u tr2(int, v2u x) { return x; }
#endif
__device__ __forceinline__ f32x4 tr4f(int a, f32x4 x) { return __builtin_bit_cast(f32x4, tr4(a, __builtin_bit_cast(v4u, x))); }
__device__ __forceinline__ v4u pack8(const f32x4& a, const f32x4& b) { return (v4u){pg8::cvt_pk_bf16(a[0], a[1]), pg8::cvt_pk_bf16(a[2], a[3]), pg8::cvt_pk_bf16(b[0], b[1]), pg8::cvt_pk_bf16(b[2], b[3])}; }

struct EpiSwiglu {
    static constexpr bool PERM = true; static constexpr int NS = 8;
    bf16* act;
    __device__ __forceinline__ bool operator()(AccT& acc, const Unit& u, int wr, int wc, int fr, int fq) const {
        asm volatile("" : "+s"(wr), "+s"(wc), "+v"(fr), "+v"(fq));
        const int row0 = u.pm * 256 + wr * 64 + fr + 16 * (fq & 1), col0 = u.pn * 128 + wc * 16 + 4 * (fq & 2);
#pragma unroll
        for (int ai = 0; ai < 2; ++ai)
#pragma unroll
            for (int mp = 0; mp < 2; ++mp) { bf16* rowp = act + (size_t)(row0 + ai * 128 + mp * 32) * DFF + col0;
#pragma unroll
                for (int bj = 0; bj < 2; ++bj) { unsigned pk[2][2];
#pragma unroll
                    for (int k = 0; k < 2; ++k) { const f32x4 g = acc[ai][bj][2 * mp + k][0], up = acc[ai][bj][2 * mp + k][1];
                        pk[k][0] = pg8::cvt_pk_bf16(siluf_(g[0]) * up[0], siluf_(g[1]) * up[1]); pk[k][1] = pg8::cvt_pk_bf16(siluf_(g[2]) * up[2], siluf_(g[3]) * up[3]); }
                    const auto sx = __builtin_amdgcn_permlane16_swap(pk[0][0], pk[1][0], false, false), sy = __builtin_amdgcn_permlane16_swap(pk[0][1], pk[1][1], false, false);
                    *(GAS v4u*)(rowp + bj * 64) = (v4u){sx[0], sy[0], sx[1], sy[1]}; } }
        return false;
    }
};

struct EpiResid {
    static constexpr bool PERM = true; static constexpr int NS = 16;
    unsigned char* ws; float ca, cb;
    __device__ __forceinline__ bool operator()(AccT& acc, const Unit& u, int wr, int wc, int fr, int fq) const {
        asm volatile("" : "+s"(wr), "+s"(wc), "+v"(fr), "+v"(fq));
        const LaneT t = lane_t(fr, fq);
        const bf16* src = (const bf16*)(ws + WS_HB); bf16* dst = (bf16*)(ws + WS_YB);
        const int row0 = u.pm * 256 + wr * 64 + t.tfr, col0 = u.pn * 256 + wc * 32 + 8 * t.tfq;
#pragma unroll
        for (int ai = 0; ai < 2; ++ai)
#pragma unroll
            for (int m = 0; m < 4; ++m) { const size_t off = (size_t)(row0 + ai * 128 + m * 16) * D + col0;
#pragma unroll
                for (int bj = 0; bj < 2; ++bj) { const v4u r = tr4(t.push, *(const GAS v4u*)(src + off + bj * 128));
                    const f32x4 y0 = (f32x4){bflo(r.x), bfhi(r.x), bflo(r.y), bfhi(r.y)} * ca + acc[ai][bj][m][0] * cb, y1 = (f32x4){bflo(r.z), bfhi(r.z), bflo(r.w), bfhi(r.w)} * ca + acc[ai][bj][m][1] * cb;
                    *(GAS v4u*)(dst + off + bj * 128) = tr4(t.pull, pack8(y0, y1)); } }
        return false;
    }
};

struct EpiGate {
    static constexpr bool PERM = true; static constexpr int NS = 0;
    unsigned char* ws;
    __device__ __forceinline__ bool operator()(AccT& acc, const Unit& u, int wr, int wc, int fr, int fq) const {
        asm volatile("" : "+s"(wr), "+s"(wc), "+v"(fr), "+v"(fq));
        const LaneT t = lane_t(fr, fq);
        const bf16* Gt = (const bf16*)(ws + WS_GT); bf16* mix = (bf16*)(ws + WS_MIX);
        const int n = u.pm / NPANEL, pm = u.pm - n * NPANEL, pn = u.pn & 3;
        const int row0 = pm * 256 + wr * 64 + t.tfr, col0 = pn * 256 + wc * 32 + 8 * t.tfq;
#pragma unroll
        for (int ai = 0; ai < 2; ++ai)
#pragma unroll
            for (int m = 0; m < 4; ++m) { const size_t r = (size_t)(row0 + ai * 128 + m * 16);
#pragma unroll
                for (int bj = 0; bj < 2; ++bj) {
                    const v4u ga = tr4(t.push, *(const GAS v4u*)(Gt + r * (3 * D) + n * D + col0 + bj * 128));
                    float f[8] = {bflo(ga.x), bfhi(ga.x), bflo(ga.y), bfhi(ga.y), bflo(ga.z), bfhi(ga.z), bflo(ga.w), bfhi(ga.w)};
                    if (n < 2) { const v4u gb = tr4(t.push, *(const GAS v4u*)(Gt + r * (3 * D) + (n + 1) * D + col0 + bj * 128));
                        const float h[8] = {bflo(gb.x), bfhi(gb.x), bflo(gb.y), bfhi(gb.y), bflo(gb.z), bfhi(gb.z), bflo(gb.w), bfhi(gb.w)};
#pragma unroll
                        for (int e = 0; e < 8; ++e) f[e] = f[e] * fast_rcp(fmaxf(h[e], 1e-30f)); }
                    f32x4 v0 = acc[ai][bj][m][0], v1 = acc[ai][bj][m][1];
                    v0 = v0 * (f32x4){f[0], f[1], f[2], f[3]}; v1 = v1 * (f32x4){f[4], f[5], f[6], f[7]};
                    acc[ai][bj][m][0] = v0; acc[ai][bj][m][1] = v1;
                    if (n == 2) *(GAS v4u*)(mix + r * D + col0 + bj * 128) = tr4(t.pull, pack8(v0, v1));
                } }
        return n < 2;
    }
};
struct Order3 : pg8::StaticOrder {
    __device__ __forceinline__ bool next(int i, Unit& u) const { Unit t; if (!pg8::StaticOrder::next(i / 3, t)) return false; const int k = i % 3; u.pm = t.pm + k * NPANEL; u.pn = t.pn + 4 * k; return true; }
};

struct SmallOrder {
    int c;
    __device__ __forceinline__ bool next(int i, Unit& u) const { if (i > 0 || c >= 8) return false; u.pm = 256 + (c >> 2); u.pn = c & 3; return true; }
    __device__ __forceinline__ void a_ready(const Unit&) const {}
    __device__ __forceinline__ void done(const Unit&) const {}
};

struct SmallOrderH {
    int c;
    __device__ __forceinline__ bool next(int i, Unit& u) const { if (i > 0 || c >= 16) return false; u.pm = 256 + ((c >> 2) & 1); u.pn = c & 3; return true; }
    __device__ __forceinline__ void a_ready(const Unit&) const {}
    __device__ __forceinline__ void done(const Unit&) const {}
};
struct EpiPart {
    static constexpr bool PERM = true; static constexpr int NS = 16;
    float* part;
    __device__ __forceinline__ bool operator()(AccT& acc, const Unit& u, int wr, int wc, int fr, int fq) const {
        asm volatile("" : "+s"(wr), "+s"(wc), "+v"(fr), "+v"(fq));
        float* p0 = part + (size_t)((u.pm - 256) * 256 + wr * 64 + fr) * D + u.pn * 256 + wc * 32 + 8 * fq;
#pragma unroll
        for (int ai = 0; ai < 2; ++ai)
#pragma unroll
            for (int m = 0; m < 4; ++m)
#pragma unroll
                for (int bj = 0; bj < 2; ++bj)
#pragma unroll
                    for (int n = 0; n < 2; ++n) *(GAS f32x4*)(p0 + (size_t)(ai * 128 + m * 16) * D + bj * 128 + 4 * n) = acc[ai][bj][m][n];
        return false;
    }
};

struct SmallOrder3 {
    int c;
    __device__ __forceinline__ bool next(int i, Unit& u) const { if (i > 2) return false; u.pm = 256 + (c >> 2) + i * NPANEL; u.pn = (c & 3) + 4 * i; return true; }
    __device__ __forceinline__ void a_ready(const Unit&) const {}
    __device__ __forceinline__ void done(const Unit&) const {}
};
struct SmallOrderW {
    int c;
    __device__ __forceinline__ bool next(int i, Unit& u) const { if (i > 0) return false; const int p = c >= 22 ? 1 : 0; u.pm = 256 + p; u.pn = c - 22 * p; return true; }
    __device__ __forceinline__ void a_ready(const Unit&) const {}
    __device__ __forceinline__ void done(const Unit&) const {}
};

struct EpiWin {
    static constexpr bool PERM = true; static constexpr int NS = 16;
    unsigned char* ws; float* out; int layer;
    __device__ __forceinline__ bool operator()(AccT& acc, const Unit& u, int wr, int wc, int fr, int fq) const {
        asm volatile("" : "+s"(wr), "+s"(wc), "+v"(fr), "+v"(fq));
        const LaneT t = lane_t(fr, fq);
        const int pn = u.pn, pm = u.pm, rl0 = wr * 64 + fr, trl0 = wr * 64 + t.tfr;
        if (pn < 4) {
            const bool isk = pn >= 2; bf16* dst = (bf16*)(ws + (isk ? WS_KR : WS_QR)); const float sc = isk ? 0.08838834764831845f : 1.0f;
            const float lgA = ret_lg2(2 * (pn & 1)) * (isk ? -1.f : 1.f), lgB = ret_lg2(2 * (pn & 1) + 1) * (isk ? -1.f : 1.f);
            float invf[4];
#pragma unroll
            for (int e = 0; e < 4; ++e) invf[e] = fast_exp2(-(float)(16 * wc + 4 * fq + e) * (13.287712379549449f / 64.0f)) * 0.15915494309189535f;
#pragma unroll
            for (int ai = 0; ai < 2; ++ai)
#pragma unroll
                for (int mp = 0; mp < 2; ++mp) { unsigned pk1[2][2][2], pk2[2][2][2];
#pragma unroll
                    for (int k = 0; k < 2; ++k) { const int rl = rl0 + ai * 128 + (2 * mp + k) * 16, r = pm * 256 + rl;
                        const float pos = (float)(pm < 256 ? NMETA + (r & (T - 1)) : (pm == 256 ? NMETA + PAST + (rl & (ST - 1)) : rl));
                        const float jp1 = (float)((pm < 256 ? (r & 63) : (pm == 256 ? (rl & (ST - 1)) : rl)) + 1);
                        const float dsc[2] = {sc * fast_exp2(jp1 * lgA), sc * fast_exp2(jp1 * lgB)};
                        f32x4 cs, sn;
#pragma unroll
                        for (int e = 0; e < 4; ++e) { float rev = pos * invf[e]; rev = rev - floorf(rev); cs[e] = __builtin_amdgcn_cosf(rev); sn[e] = __builtin_amdgcn_sinf(rev); }
#pragma unroll
                        for (int bj = 0; bj < 2; ++bj) { const f32x4 x1 = acc[ai][bj][2 * mp + k][0], x2 = acc[ai][bj][2 * mp + k][1];
                            const f32x4 o1 = (x1 * cs - x2 * sn) * dsc[bj], o2 = (x2 * cs + x1 * sn) * dsc[bj];
                            pk1[k][bj][0] = pg8::cvt_pk_bf16(o1[0], o1[1]); pk1[k][bj][1] = pg8::cvt_pk_bf16(o1[2], o1[3]);
                            pk2[k][bj][0] = pg8::cvt_pk_bf16(o2[0], o2[1]); pk2[k][bj][1] = pg8::cvt_pk_bf16(o2[2], o2[3]); } }
                    const size_t srow = (size_t)(pm * 256 + rl0 + ai * 128 + (2 * mp + (fq & 1)) * 16);
#pragma unroll
                    for (int bj = 0; bj < 2; ++bj) { bf16* rowp = dst + srow * 512 + (2 * (pn & 1) + bj) * 128 + 16 * wc + 4 * (fq & 2);
                        { const auto sx = __builtin_amdgcn_permlane16_swap(pk1[0][bj][0], pk1[1][bj][0], false, false), sy = __builtin_amdgcn_permlane16_swap(pk1[0][bj][1], pk1[1][bj][1], false, false);
                          *(GAS v4u*)rowp = (v4u){sx[0], sy[0], sx[1], sy[1]}; }
                        { const auto sx = __builtin_amdgcn_permlane16_swap(pk2[0][bj][0], pk2[1][bj][0], false, false), sy = __builtin_amdgcn_permlane16_swap(pk2[0][bj][1], pk2[1][bj][1], false, false);
                          *(GAS v4u*)(rowp + 64) = (v4u){sx[0], sy[0], sx[1], sy[1]}; } } }
            return false;
        }
        const int seg = (pn - 4) >> 2;
        const int colt = ((pn - 4) & 3) * 256 + wc * 32 + 8 * t.tfq;
        if (seg == 0 || seg == 1 || seg == 2 || seg >= 6) {
            bf16* dst = (bf16*)(ws + (seg == 0 ? WS_VR : seg == 1 ? WS_GR : seg == 2 ? WS_QS : WS_GT)); const int ld = seg >= 6 ? 3 * D : D; const int cofs = seg >= 6 ? (seg - 6) * D : 0;
#pragma unroll
            for (int ai = 0; ai < 2; ++ai)
#pragma unroll
                for (int m = 0; m < 4; ++m) { const size_t r = (size_t)(pm * 256 + trl0 + ai * 128 + m * 16);
#pragma unroll
                    for (int bj = 0; bj < 2; ++bj) { f32x4 v0 = acc[ai][bj][m][0], v1 = acc[ai][bj][m][1];
                        if (seg == 1) {
#pragma unroll
                            for (int e = 0; e < 4; ++e) { v0[e] = siluf_(v0[e]); v1[e] = siluf_(v1[e]); } }
                        else if (seg == 2) { v0 = v0 * (0.08838834764831845f * LOG2E); v1 = v1 * (0.08838834764831845f * LOG2E); }
                        else if (seg >= 6) {
#pragma unroll
                            for (int e = 0; e < 4; ++e) { v0[e] = sigmoidf_(v0[e]); v1[e] = sigmoidf_(v1[e]); } }
                        *(GAS v4u*)(dst + r * ld + cofs + colt + bj * 128) = tr4(t.pull, pack8(v0, v1)); } }
            return false;
        }
        if (seg == 3 || seg == 4) {
            bf16* dst = (bf16*)(ws + (seg == 3 ? WS_KS : WS_VS));
            float* op = out + (seg == 3 ? O_KP : O_VP) + (size_t)layer * NB * KT_PP * D;
            float* os = out + (seg == 3 ? O_KS : O_VS) + (size_t)layer * SBATCH * ST * D;
#pragma unroll
            for (int ai = 0; ai < 2; ++ai)
#pragma unroll
                for (int m = 0; m < 4; ++m) { const int rl = trl0 + ai * 128 + m * 16; const size_t r = (size_t)(pm * 256 + rl);
#pragma unroll
                    for (int bj = 0; bj < 2; ++bj) { const f32x4 v0 = tr4f(t.pull, acc[ai][bj][m][0]), v1 = tr4f(t.pull, acc[ai][bj][m][1]); const int c = colt + bj * 128;
                        *(GAS v4u*)(dst + r * D + c) = pack8(v0, v1);
                        if (pm < 256) { float* o = op + ((size_t)(r >> 11) * KT_PP + NMETA + (r & (T - 1))) * D + c; *(GAS f32x4*)o = v0; *(GAS f32x4*)(o + 4) = v1; }
                        else if (pm == 256) { float* o = os + (size_t)rl * D + c; *(GAS f32x4*)o = v0; *(GAS f32x4*)(o + 4) = v1; }
                        else if (rl < NMETA) { for (int bb = 0; bb < NB; ++bb) { float* o = op + ((size_t)bb * KT_PP + rl) * D + c; *(GAS f32x4*)o = v0; *(GAS f32x4*)(o + 4) = v1; } }
                    } }
            return false;
        }
        {
            float* op = out + O_PP + (size_t)layer * NB * PBUF * D;
            float* os = out + O_PS + (size_t)layer * SBATCH * PBUF * D;
#pragma unroll
            for (int ai = 0; ai < 2; ++ai)
#pragma unroll
                for (int m = 0; m < 4; ++m) { const int rl = trl0 + ai * 128 + m * 16; const size_t r = (size_t)(pm * 256 + rl);
#pragma unroll
                    for (int bj = 0; bj < 2; ++bj) { const f32x4 v0 = tr4f(t.pull, acc[ai][bj][m][0]), v1 = tr4f(t.pull, acc[ai][bj][m][1]); const int c = colt + bj * 128;
                        *(GAS v4u*)((bf16*)(ws + WS_U) + r * D + c) = pack8(v0, v1);
                        if (pm < 256) { const int tt = (int)(r & (T - 1)); if (tt >= T - PBUF) { float* o = op + ((size_t)(r >> 11) * PBUF + (tt - (T - PBUF))) * D + c; *(GAS f32x4*)o = v0; *(GAS f32x4*)(o + 4) = v1; } }
                        else if (pm == 256) { const int tt = rl & (ST - 1); if (tt >= ST - PBUF) { float* o = os + ((size_t)(rl >> 5) * PBUF + (tt - (ST - PBUF))) * D + c; *(GAS f32x4*)o = v0; *(GAS f32x4*)(o + 4) = v1; } }
                    } }
            return false;
        }
    }
};

__device__ __forceinline__ int grab(const Frame& F, gu32* ctr) {
    __syncthreads();
    if (F.wave == 0 && lane_lo_() == 0u) F.MISC[16] = __hip_atomic_fetch_add(ctr, 1u, RLX_AGENT);
    __syncthreads();
    return (int)F.MISC[16];
}
__device__ __forceinline__ unsigned grab_issue(const Frame& F, gu32* ctr) { return (F.wave == 0 && lane_lo_() == 0u) ? __hip_atomic_fetch_add(ctr, 1u, RLX_AGENT) : 0u; }
__device__ __forceinline__ int grab_publish(const Frame& F, unsigned nxt) {
    __syncthreads();
    if (F.wave == 0 && lane_lo_() == 0u) F.MISC[16] = nxt;
    __syncthreads();
    return (int)F.MISC[16];
}
typedef float f32x4_t __attribute__((ext_vector_type(4)));
#define MFMA16(a, b, c) __builtin_amdgcn_mfma_f32_16x16x32_bf16((a), (b), (c), 0, 0, 0)
__device__ __forceinline__ s16x4 tr16(const LAS unsigned char* p) { typedef short v4i16_t __attribute__((ext_vector_type(4))); return __builtin_bit_cast(s16x4, __builtin_amdgcn_ds_read_tr16_b64_v4i16((LAS v4i16_t*)p)); }

constexpr int RT_QS = 272, RT_VS = 528, RT_AS = 144;
constexpr int RT_Q = 0, RT_K = 64 * RT_QS, RT_V = 2 * 64 * RT_QS, RT_A = RT_V + 64 * RT_VS, RT_END = RT_A + 64 * RT_AS;
static_assert(RT_END <= RING_BYTES && 64 * 256 * 4 <= RT_END, "retention LDS map");
__device__ __forceinline__ float ret_lg2(int h) { return fast_log2(1.0f - fast_exp2(-5.0f - (float)h * (4.0f / 3.0f))); }
__device__ __forceinline__ void ret_unit(const Frame& F, int layer, int uid) {
    const int h = uid & 3; int stream, b;
    if (uid < 128) { stream = 0; b = uid >> 2; } else if (uid < 160) { stream = 1; b = (uid - 128) >> 2; } else { stream = 2; b = 0; }
    const TC tc = thread_coords(F.wave); const int tid = tc.tid, lane = tc.lane, w = tc.wave, l15 = lane & 15, g = lane >> 4, q4 = l15 >> 2, p4 = l15 & 3;
    const float lg2 = ret_lg2(h);
    const int nch = stream == 0 ? 1 + T / 64 : 1;
    f32x4 accS[8][2];
#pragma unroll
    for (int m = 0; m < 8; ++m)
#pragma unroll
        for (int n = 0; n < 2; ++n) accS[m][n] = (f32x4){0.f, 0.f, 0.f, 0.f};
    if (stream == 1) { const float* s0 = in_ptr(IN_SRET) + (((size_t)layer * SBATCH + b) * HRET + h) * DKR * DVR;
#pragma unroll
        for (int m = 0; m < 8; ++m)
#pragma unroll
            for (int n = 0; n < 2; ++n)
#pragma unroll
                for (int r = 0; r < 4; ++r) accS[m][n][r] = s0[(size_t)(16 * m + 4 * g + r) * DVR + 32 * w + 16 * n + l15]; }
    v4u qreg[2], kreg[2], vreg[4];
    const int lrow = tid >> 4, lch = tid & 15, vrow = tid >> 5, vch = tid & 31;
#define RT_CHUNK(c, rb, vl) do { if (stream == 0) { if ((c) == 0) { rb = ROW_M; vl = NMETA; } else { rb = b * T + 64 * ((c) - 1); vl = 64; } } \
        else if (stream == 1) { rb = ROW_S + b * ST; vl = ST; } else { rb = ROW_M; vl = NMETA; } } while (0)
#define RT_LOAD(c) do { int rb_, vl_; RT_CHUNK(c, rb_, vl_); \
        _Pragma("unroll") for (int i_ = 0; i_ < 2; ++i_) { const int r_ = lrow + 32 * i_; qreg[i_] = (v4u){0u, 0u, 0u, 0u}; kreg[i_] = (v4u){0u, 0u, 0u, 0u}; \
            if (r_ < vl_) { const size_t o_ = (size_t)(rb_ + r_) * 512 + h * 128 + lch * 8; qreg[i_] = *(const GAS v4u*)(WSB(F, WS_QR) + o_); kreg[i_] = *(const GAS v4u*)(WSB(F, WS_KR) + o_); } } \
        _Pragma("unroll") for (int i_ = 0; i_ < 4; ++i_) { const int r_ = vrow + 16 * i_; vreg[i_] = (v4u){0u, 0u, 0u, 0u}; \
            if (r_ < vl_) vreg[i_] = *(const GAS v4u*)(WSB(F, WS_VR) + (size_t)(rb_ + r_) * D + h * 256 + vch * 8); } } while (0)
    RT_LOAD(0);
    const LAS unsigned char* Ql = F.lds + RT_Q; const LAS unsigned char* Kl = F.lds + RT_K; const LAS unsigned char* Vl = F.lds + RT_V; const LAS unsigned char* Al = F.lds + RT_A;
    for (int c = 0; c < nch; ++c) {
        int rowbase, valid; RT_CHUNK(c, rowbase, valid);
        const bool write_out = !(stream == 0 && c == 0);
        const float dc = fast_exp2((float)valid * lg2);
        __syncthreads();
#pragma unroll
        for (int i = 0; i < 2; ++i) { *(LAS v4u*)(F.lds + RT_Q + (lrow + 32 * i) * RT_QS + lch * 16) = qreg[i]; *(LAS v4u*)(F.lds + RT_K + (lrow + 32 * i) * RT_QS + lch * 16) = kreg[i]; }
#pragma unroll
        for (int i = 0; i < 4; ++i) *(LAS v4u*)(F.lds + RT_V + (vrow + 16 * i) * RT_VS + vch * 16) = vreg[i];
        __syncthreads();
        if (c + 1 < nch) RT_LOAD(c + 1);
#pragma unroll
        for (int tt = 0; tt < 2; ++tt) { const int id = 2 * w + tt, mt = id >> 2, nt = id & 3;
            f32x4 a4 = (f32x4){0.f, 0.f, 0.f, 0.f};
            if (mt <= nt) {
#pragma unroll
                for (int ks = 0; ks < 4; ++ks) { const bf16x8 A = *(const LAS bf16x8*)(Kl + (16 * mt + l15) * RT_QS + 64 * ks + 16 * g); const bf16x8 B = *(const LAS bf16x8*)(Ql + (16 * nt + l15) * RT_QS + 64 * ks + 16 * g);
                    a4 = MFMA16(A, B, a4); }
#pragma unroll
                for (int r = 0; r < 4; ++r) a4[r] = (16 * mt + 4 * g + r <= 16 * nt + l15) ? a4[r] : 0.f;
            }
            *(LAS v2u*)(F.lds + RT_A + (16 * nt + l15) * RT_AS + (16 * mt + 4 * g) * 2) = (v2u){pg8::cvt_pk_bf16(a4[0], a4[1]), pg8::cvt_pk_bf16(a4[2], a4[3])}; }
        __syncthreads();
        f32x4 accO[4][2];
#pragma unroll
        for (int m = 0; m < 4; ++m)
#pragma unroll
            for (int n = 0; n < 2; ++n) accO[m][n] = (f32x4){0.f, 0.f, 0.f, 0.f};
#pragma unroll
        for (int ks = 0; ks < 4; ++ks) {
            bf16x8 Sf[2];
#pragma unroll
            for (int n = 0; n < 2; ++n) Sf[n] = __builtin_bit_cast(bf16x8, (v4u){pg8::cvt_pk_bf16(accS[2 * ks][n][0], accS[2 * ks][n][1]), pg8::cvt_pk_bf16(accS[2 * ks][n][2], accS[2 * ks][n][3]),
                                                                               pg8::cvt_pk_bf16(accS[2 * ks + 1][n][0], accS[2 * ks + 1][n][1]), pg8::cvt_pk_bf16(accS[2 * ks + 1][n][2], accS[2 * ks + 1][n][3])});
#pragma unroll
            for (int m = 0; m < 4; ++m) { const v2u lo = *(const LAS v2u*)(Ql + (16 * m + l15) * RT_QS + (32 * ks + 4 * g) * 2), hi = *(const LAS v2u*)(Ql + (16 * m + l15) * RT_QS + (32 * ks + 16 + 4 * g) * 2);
                const bf16x8 A = __builtin_bit_cast(bf16x8, (v4u){lo.x, lo.y, hi.x, hi.y});
#pragma unroll
                for (int n = 0; n < 2; ++n) accO[m][n] = MFMA16(A, Sf[n], accO[m][n]); }
        }
        bf16x8 Bv[2][2];
#pragma unroll
        for (int k2 = 0; k2 < 2; ++k2)
#pragma unroll
            for (int n = 0; n < 2; ++n) { const s16x4 lo = tr16(Vl + (32 * k2 + 8 * g + q4) * RT_VS + (32 * w + 16 * n + 4 * p4) * 2), hi = tr16(Vl + (32 * k2 + 8 * g + 4 + q4) * RT_VS + (32 * w + 16 * n + 4 * p4) * 2);
                Bv[k2][n] = __builtin_shufflevector(lo, hi, 0, 1, 2, 3, 4, 5, 6, 7); }
#pragma unroll
        for (int k2 = 0; k2 < 2; ++k2)
#pragma unroll
            for (int m = 0; m < 4; ++m) { const bf16x8 A = *(const LAS bf16x8*)(Al + (16 * m + l15) * RT_AS + (32 * k2 + 8 * g) * 2);
#pragma unroll
                for (int n = 0; n < 2; ++n) accO[m][n] = MFMA16(A, Bv[k2][n], accO[m][n]); }
#pragma unroll
        for (int m = 0; m < 8; ++m)
#pragma unroll
            for (int k2 = 0; k2 < 2; ++k2) { const s16x4 lo = tr16(Kl + (32 * k2 + 8 * g + q4) * RT_QS + (16 * m + 4 * p4) * 2), hi = tr16(Kl + (32 * k2 + 8 * g + 4 + q4) * RT_QS + (16 * m + 4 * p4) * 2);
                const bf16x8 A = __builtin_shufflevector(lo, hi, 0, 1, 2, 3, 4, 5, 6, 7);
#pragma unroll
                for (int n = 0; n < 2; ++n) accS[m][n] = MFMA16(A, Bv[k2][n], accS[m][n]); }
#pragma unroll
        for (int m = 0; m < 8; ++m)
#pragma unroll
            for (int n = 0; n < 2; ++n) accS[m][n] = accS[m][n] * dc;
        if (write_out) {
            __syncthreads();
            LAS float* oL = (LAS float*)F.lds;
#pragma unroll
            for (int m = 0; m < 4; ++m)
#pragma unroll
                for (int n = 0; n < 2; ++n)
#pragma unroll
                    for (int r = 0; r < 4; ++r) oL[(16 * m + 4 * g + r) * 256 + 32 * w + 16 * n + l15] = accO[m][n][r];
            __syncthreads();
            const f32x4 gn = *(const GAS f32x4*)(in_ptr(IN_RETG) + ((size_t)layer * HRET + h) * DVR + lane * 4);
#pragma unroll
            for (int hb2 = 0; hb2 < 2; ++hb2) {
            f32x4 x[4]; v2u gr[4]; float s1[4], s2[4];
#pragma unroll
            for (int tt = 0; tt < 4; ++tt) { const int t = w * 8 + hb2 * 4 + tt; x[tt] = *(const LAS f32x4*)(oL + t * 256 + lane * 4); gr[tt] = *(const GAS v2u*)(WSB(F, WS_GR) + (size_t)(rowbase + t) * D + h * 256 + lane * 4);
                s1[tt] = (x[tt][0] + x[tt][1]) + (x[tt][2] + x[tt][3]); }
#pragma unroll
            for (int o = 1; o < 64; o <<= 1)
#pragma unroll
                for (int tt = 0; tt < 4; ++tt) s1[tt] += __shfl_xor(s1[tt], o);
#pragma unroll
            for (int tt = 0; tt < 4; ++tt) { x[tt] = x[tt] - s1[tt] * (1.f / 256.f); s2[tt] = (x[tt][0] * x[tt][0] + x[tt][1] * x[tt][1]) + (x[tt][2] * x[tt][2] + x[tt][3] * x[tt][3]); }
#pragma unroll
            for (int o = 1; o < 64; o <<= 1)
#pragma unroll
                for (int tt = 0; tt < 4; ++tt) s2[tt] += __shfl_xor(s2[tt], o);
#pragma unroll
            for (int tt = 0; tt < 4; ++tt) { const int t = w * 8 + hb2 * 4 + tt; const float rstd = 1.f / sqrtf(s2[tt] * (1.f / 256.f) + LN_EPS);
                const f32x4 y = x[tt] * rstd * gn * (f32x4){bflo(gr[tt].x), bfhi(gr[tt].x), bflo(gr[tt].y), bfhi(gr[tt].y)};
                if (t < valid) *(GAS v2u*)(WSB(F, WS_BR) + (size_t)(rowbase + t) * D + h * 256 + lane * 4) = (v2u){pk2(y[0], y[1]), pk2(y[2], y[3])}; }
            }
        }
    }
#undef RT_LOAD
#undef RT_CHUNK
    if (stream != 2) { float* d = F.out + (stream == 0 ? O_RP + (((size_t)layer * NB + b) * HRET + h) * DKR * DVR : O_RS + (((size_t)layer * SBATCH + b) * HRET + h) * DKR * DVR);
#pragma unroll
        for (int m = 0; m < 8; ++m)
#pragma unroll
            for (int n = 0; n < 2; ++n)
#pragma unroll
                for (int r = 0; r < 4; ++r) d[(size_t)(16 * m + 4 * g + r) * DVR + 32 * w + 16 * n + l15] = accS[m][n][r]; }
}

constexpr int AT_RS = 272;
constexpr int AT_VOFF = 64 * AT_RS;
constexpr int AT_QOFF = 36864;
static_assert(AT_QOFF >= 2 * 64 * AT_RS && AT_QOFF + 8 * 8 * 1024 <= RING_BYTES, "attention LDS map");
template <bool F32KV> __device__ __forceinline__ void attn_unit(const Frame& F, int layer, int uid) {
    int stream, b, h, qb;
    if (uid < 64) { stream = 1; b = uid >> 3; h = uid & 7; qb = 0; }
    else if (uid < 64 + 2048) { const int idx = uid - 64; qb = 7 - (idx >> 8); b = (idx & 255) >> 3; h = idx & 7; stream = 0; }
    else { stream = 2; b = 0; h = (uid - (64 + 2048)) & 7; qb = 0; }
    const bf16 *k0p = nullptr, *k1p = nullptr, *v0p = nullptr, *v1p = nullptr; const float *k0f = nullptr, *k1f = nullptr, *v0f = nullptr, *v1f = nullptr; int len0, Tq, rowbase;
    if (stream == 0) { k0p = WSB(F, WS_KS) + (size_t)ROW_M * D; v0p = WSB(F, WS_VS) + (size_t)ROW_M * D; len0 = NMETA; k1p = WSB(F, WS_KS) + (size_t)b * T * D; v1p = WSB(F, WS_VS) + (size_t)b * T * D; Tq = T; rowbase = b * T; }
    else if (stream == 1) { k0f = in_ptr(IN_CK) + ((size_t)layer * SBATCH + b) * PAST * D; v0f = in_ptr(IN_CV) + ((size_t)layer * SBATCH + b) * PAST * D; len0 = PAST;
        k1f = F.out + O_KS + ((size_t)layer * SBATCH + b) * ST * D; v1f = F.out + O_VS + ((size_t)layer * SBATCH + b) * ST * D; Tq = ST; rowbase = ROW_S + b * ST; }
    else { k0p = k1p = WSB(F, WS_KS) + (size_t)ROW_M * D; v0p = v1p = WSB(F, WS_VS) + (size_t)ROW_M * D; len0 = 0; Tq = NMETA; rowbase = ROW_M; }
    constexpr int NQ = F32KV ? 1 : 2, QPW = 16 * NQ, QBLK = 8 * QPW;
    const int Stot = len0 + Tq, q0 = qb * QBLK;
    const TC tc = thread_coords(F.wave); const int tid = tc.tid, lane = tc.lane, w = tc.wave, l15 = lane & 15, g = lane >> 4;
    int qi[NQ]; bool valid_q[NQ]; int lim[NQ];
#pragma unroll
    for (int nb = 0; nb < NQ; ++nb) { qi[nb] = q0 + 16 * (NQ == 2 ? (nb == 0 ? w : 15 - w) : w) + l15; valid_q[nb] = qi[nb] < Tq; lim[nb] = len0 + qi[nb]; }
    bf16x8 qf[NQ][4];
#pragma unroll
    for (int nb = 0; nb < NQ; ++nb)
#pragma unroll
    for (int ks = 0; ks < 4; ++ks) { v4u t4 = (v4u){0u, 0u, 0u, 0u}; if (valid_q[nb]) t4 = *(const GAS v4u*)(WSB(F, WS_QS) + (size_t)(rowbase + qi[nb]) * D + h * 128 + 32 * ks + 8 * g); qf[nb][ks] = __builtin_bit_cast(bf16x8, t4); }
    float zq[NQ];
#pragma unroll
    for (int nb = 0; nb < NQ; ++nb) zq[nb] = 64.0f;
    f32x4 o[NQ][8];
#pragma unroll
    for (int nb = 0; nb < NQ; ++nb)
#pragma unroll
    for (int i = 0; i < 8; ++i) o[nb][i] = (f32x4){0.f, 0.f, 0.f, 0.f};
    float R[NQ]; bool anyv_ = false;
#pragma unroll
    for (int nb = 0; nb < NQ; ++nb) { R[nb] = 0.f; anyv_ = anyv_ || valid_q[nb]; }
    bool wave_done = __all(!anyv_) != 0;
    const int qend = (q0 + QBLK < Tq) ? q0 + QBLK : Tq;
    const int kt_max = (len0 + qend - 2) >> 6;
    const int lrow = tid >> 4, lch = tid & 15;
    constexpr int NR = F32KV ? 4 : 2;
    constexpr int DIST = F32KV ? 1 : 2;
    v4u kregA[NR], vregA[NR], kregB[NR], vregB[NR];
#define AT_LOAD(kt, KR, VR) do { _Pragma("unroll") for (int i_ = 0; i_ < 2; ++i_) { int s_ = ((kt) > 0 ? (kt) : 0) * 64 + lrow + 32 * i_; s_ = s_ < Stot ? s_ : Stot - 1; \
        const size_t off_ = (s_ < len0 ? (size_t)s_ : (size_t)(s_ - len0)) * D + h * 128 + lch * 8; \
        if constexpr (F32KV) { const float* kp_ = (s_ < len0 ? k0f : k1f) + off_; const float* vp_ = (s_ < len0 ? v0f : v1f) + off_; \
            asm volatile("global_load_dwordx4 %0, %1, off" : "=&v"(KR[2 * i_]) : "v"(kp_) : "memory"); asm volatile("global_load_dwordx4 %0, %1, off offset:16" : "=&v"(KR[2 * i_ + 1]) : "v"(kp_) : "memory"); \
            asm volatile("global_load_dwordx4 %0, %1, off" : "=&v"(VR[2 * i_]) : "v"(vp_) : "memory"); asm volatile("global_load_dwordx4 %0, %1, off offset:16" : "=&v"(VR[2 * i_ + 1]) : "v"(vp_) : "memory"); } \
        else { const bf16* kp_ = (s_ < len0 ? k0p : k1p) + off_; const bf16* vp_ = (s_ < len0 ? v0p : v1p) + off_; \
            asm volatile("global_load_dwordx4 %0, %1, off" : "=&v"(KR[i_]) : "v"(kp_) : "memory"); asm volatile("global_load_dwordx4 %0, %1, off" : "=&v"(VR[i_]) : "v"(vp_) : "memory"); } } } while (0)
    AT_LOAD(kt_max, kregA, vregA);
    if constexpr (!F32KV) AT_LOAD(kt_max - 1, kregB, vregB);
    const LAS unsigned char* Ql = F.lds + AT_QOFF + w * (NQ * 4096);
#pragma unroll
    for (int nb = 0; nb < NQ; ++nb)
#pragma unroll
        for (int ks = 0; ks < 4; ++ks) *(LAS v4u*)(F.lds + AT_QOFF + w * (NQ * 4096) + ((nb * 4 + ks) * 64 + lane) * 16) = __builtin_bit_cast(v4u, qf[nb][ks]);
    const LAS unsigned char* Kl = F.lds; const LAS unsigned char* Vl = F.lds + AT_VOFF;
    const int q4 = l15 >> 2, p4 = l15 & 3;
#define AT_BODY(NB0_) { \
        f32x4 z[NQ][4]; \
        _Pragma("unroll") \
        for (int mt = 0; mt < 4; ++mt) { _Pragma("unroll") for (int nb = (NB0_); nb < NQ; ++nb) z[nb][mt] = (f32x4){0.f, 0.f, 0.f, 0.f}; } \
        _Pragma("unroll") \
        for (int ks = 0; ks < 4; ++ks) { bf16x8 qa[NQ]; _Pragma("unroll") for (int nb = (NB0_); nb < NQ; ++nb) qa[nb] = *(const LAS bf16x8*)(Ql + ((nb * 4 + ks) * 64 + lane) * 16); \
        _Pragma("unroll") \
            for (int mt = 0; mt < 4; ++mt) { const bf16x8 a = *(const LAS bf16x8*)(Kl + (16 * mt + l15) * AT_RS + 64 * ks + 16 * g); _Pragma("unroll") for (int nb = (NB0_); nb < NQ; ++nb) z[nb][mt] = MFMA16(a, qa[nb], z[nb][mt]); } } \
        bf16x8 pf[NQ][2]; \
        _Pragma("unroll") \
        for (int nb = (NB0_); nb < NQ; ++nb) { \
        bf16x8 triA, triB, ones; \
        _Pragma("unroll") \
        for (int e = 0; e < 8; ++e) { const int jl = 16 * (e >> 2) + 4 * g + (e & 3); triA[e] = (short)(jl >= l15 ? 0x3f80 : 0); triB[e] = (short)(jl >= l15 + 16 ? 0x3f80 : 0); ones[e] = (short)0x3f80; } \
        f32x4 sp[4]; \
        if (need_mask) { \
        _Pragma("unroll") \
            for (int mt = 0; mt < 4; ++mt) \
        _Pragma("unroll") \
                for (int r = 0; r < 4; ++r) { const bool vis = (tb + 16 * mt + 4 * g + r) < lim[nb]; const float zz = fminf(z[nb][mt][r], 80.f); z[nb][mt][r] = vis ? zz : -1.0e30f; \
                    sp[mt][r] = vis ? fast_log2(1.0f + fast_exp2(zz)) : 0.f; } \
        } else { \
        _Pragma("unroll") \
            for (int mt = 0; mt < 4; ++mt) \
        _Pragma("unroll") \
                for (int r = 0; r < 4; ++r) { const float zz = fminf(z[nb][mt][r], 80.f); z[nb][mt][r] = zz; sp[mt][r] = fast_log2(1.0f + fast_exp2(zz)); } \
        } \
        bf16x8 spf[2]; \
        _Pragma("unroll") \
        for (int k2 = 0; k2 < 2; ++k2) spf[k2] = __builtin_bit_cast(bf16x8, (v4u){pg8::cvt_pk_bf16(sp[2 * k2][0], sp[2 * k2][1]), pg8::cvt_pk_bf16(sp[2 * k2][2], sp[2 * k2][3]), \
                                                                                  pg8::cvt_pk_bf16(sp[2 * k2 + 1][0], sp[2 * k2 + 1][1]), pg8::cvt_pk_bf16(sp[2 * k2 + 1][2], sp[2 * k2 + 1][3])}); \
        const f32x4 zero4 = (f32x4){0.f, 0.f, 0.f, 0.f}; \
        f32x4 I0 = MFMA16(triA, spf[0], zero4); I0 = MFMA16(ones, spf[1], I0); \
        f32x4 I1 = MFMA16(triB, spf[0], zero4); I1 = MFMA16(ones, spf[1], I1); \
        f32x4 I2 = MFMA16(triA, spf[1], zero4); \
        f32x4 I3 = MFMA16(triB, spf[1], zero4); \
        f32x4 tot = MFMA16(ones, spf[0], zero4); tot = MFMA16(ones, spf[1], tot); \
        const f32x4 II[4] = {I0, I1, I2, I3}; \
        f32x4 wv[4]; \
        _Pragma("unroll") \
        for (int mt = 0; mt < 4; ++mt) \
        _Pragma("unroll") \
            for (int r = 0; r < 4; ++r) wv[mt][r] = fast_exp2(z[nb][mt][r] - II[mt][r] - R[nb]); \
        _Pragma("unroll") \
        for (int k2 = 0; k2 < 2; ++k2) pf[nb][k2] = __builtin_bit_cast(bf16x8, (v4u){pg8::cvt_pk_bf16(wv[2 * k2][0], wv[2 * k2][1]), pg8::cvt_pk_bf16(wv[2 * k2][2], wv[2 * k2][3]), \
                                                                                 pg8::cvt_pk_bf16(wv[2 * k2 + 1][0], wv[2 * k2 + 1][1]), pg8::cvt_pk_bf16(wv[2 * k2 + 1][2], wv[2 * k2 + 1][3])}); \
        R[nb] += tot[0]; \
        } \
        _Pragma("unroll") \
        for (int mt8 = 0; mt8 < 8; ++mt8) \
        _Pragma("unroll") \
            for (int k2 = 0; k2 < 2; ++k2) { \
                const s16x4 lo = tr16(Vl + (32 * k2 + 4 * g + q4) * AT_RS + (16 * mt8 + 4 * p4) * 2); \
                const s16x4 hi = tr16(Vl + (32 * k2 + 16 + 4 * g + q4) * AT_RS + (16 * mt8 + 4 * p4) * 2); \
                const bf16x8 a = __builtin_shufflevector(lo, hi, 0, 1, 2, 3, 4, 5, 6, 7); \
                _Pragma("unroll") for (int nb = (NB0_); nb < NQ; ++nb) o[nb][mt8] = MFMA16(a, pf[nb][k2], o[nb][mt8]); } \
        }
#define AT_ITER(KT_, KR_, VR_) { const int kt = (KT_); \
        __syncthreads(); \
        if (kt < kt_max) { unsigned allok = 1u; \
        _Pragma("unroll") \
            for (int i = 0; i < 8; ++i) allok &= F.MISC[24 + i]; \
            if (allok) break; } \
        if constexpr (F32KV) asm volatile("s_waitcnt vmcnt(0)" : "+v"(KR_[0]), "+v"(VR_[0]), "+v"(KR_[1]), "+v"(VR_[1]), "+v"(KR_[NR - 2]), "+v"(VR_[NR - 2]), "+v"(KR_[NR - 1]), "+v"(VR_[NR - 1]) :: "memory"); \
        else asm volatile("s_waitcnt vmcnt(4)" : "+v"(KR_[0]), "+v"(VR_[0]), "+v"(KR_[1]), "+v"(VR_[1]) :: "memory");     \
        _Pragma("unroll") \
        for (int i = 0; i < 2; ++i) { const bool in_ = (kt * 64 + lrow + 32 * i) < Stot; const v4u z4_ = (v4u){0u, 0u, 0u, 0u}; v4u kk_, vv_; \
            if constexpr (F32KV) { kk_ = pack8(__builtin_bit_cast(f32x4, KR_[(2 * i) % NR]), __builtin_bit_cast(f32x4, KR_[(2 * i + 1) % NR])); vv_ = pack8(__builtin_bit_cast(f32x4, VR_[(2 * i) % NR]), __builtin_bit_cast(f32x4, VR_[(2 * i + 1) % NR])); } \
            else { kk_ = KR_[i % NR]; vv_ = VR_[i % NR]; } \
            *(LAS v4u*)(F.lds + (lrow + 32 * i) * AT_RS + lch * 16) = in_ ? kk_ : z4_; *(LAS v4u*)(F.lds + AT_VOFF + (lrow + 32 * i) * AT_RS + lch * 16) = in_ ? vv_ : z4_; } \
        __syncthreads(); \
        AT_LOAD(kt - DIST, KR_, VR_); \
        const int tb = kt * 64; \
        const int lim_lo = len0 + q0 + 16 * w, lim_hi = NQ == 2 ? len0 + q0 + 16 * (15 - w) : lim_lo;      \
        const bool act0 = tb < lim_lo + 15, act1 = tb < lim_hi + 15;                                           \
        if (!wave_done && act1) { \
        const bool need_mask = (tb + 64 > (act0 ? lim_lo : lim_hi)); \
        if (NQ == 2 && !act0) AT_BODY(NQ - 1) else AT_BODY(0) \
        { bool dn_ = true; _Pragma("unroll") for (int nb = 0; nb < NQ; ++nb) dn_ = dn_ && ((!valid_q[nb]) || (R[nb] > zq[nb])); wave_done = __all(dn_) != 0; } \
        } \
        if (lane == 0) F.MISC[24 + w] = wave_done ? 1u : 0u; \
    }
    for (int kt2 = kt_max; kt2 >= 0; kt2 -= 2) {
        AT_ITER(kt2, kregA, vregA)
        if (kt2 == 0) break;
        if constexpr (F32KV) { AT_ITER(kt2 - 1, kregA, vregA) } else { AT_ITER(kt2 - 1, kregB, vregB) }
    }
#undef AT_ITER
#undef AT_BODY
    if constexpr (F32KV) asm volatile("s_waitcnt vmcnt(0)" : "+v"(kregA[0]), "+v"(vregA[0]), "+v"(kregA[1]), "+v"(vregA[1]), "+v"(kregA[NR - 2]), "+v"(vregA[NR - 2]), "+v"(kregA[NR - 1]), "+v"(vregA[NR - 1]) :: "memory");
    else asm volatile("s_waitcnt vmcnt(0)" : "+v"(kregA[0]), "+v"(vregA[0]), "+v"(kregA[1]), "+v"(vregA[1]), "+v"(kregB[0]), "+v"(vregB[0]), "+v"(kregB[1]), "+v"(vregB[1]) :: "memory");
#undef AT_LOAD
#pragma unroll
    for (int nb = 0; nb < NQ; ++nb)
    if (valid_q[nb]) { bf16* orow = WSB(F, WS_BR) + (size_t)M_PAD * D + (size_t)(rowbase + qi[nb]) * D + h * 128 + 4 * g;
#pragma unroll
        for (int mt8 = 0; mt8 < 8; ++mt8) *(GAS v2u*)(orow + 16 * mt8) = (v2u){pg8::cvt_pk_bf16(o[nb][mt8][0], o[nb][mt8][1]), pg8::cvt_pk_bf16(o[nb][mt8][2], o[nb][mt8][3])}; }
}

__device__ __forceinline__ void pool_row(const Frame& F, int layer, int stream, int b, int rowbase, int tp, int ch, float (&v)[8]) {
    if (tp >= 0 || stream == 0) { const size_t row = tp >= 0 ? (size_t)(rowbase + tp) : (size_t)(ROW_M + NMETA + tp);
        const v4u x = *(const GAS v4u*)(WSB(F, WS_U) + row * D + ch * 8);
        v[0] = bflo(x.x); v[1] = bfhi(x.x); v[2] = bflo(x.y); v[3] = bfhi(x.y); v[4] = bflo(x.z); v[5] = bfhi(x.z); v[6] = bflo(x.w); v[7] = bfhi(x.w); }
    else if (stream == 1) { const float* sp = in_ptr(IN_SPOOL) + (((size_t)layer * SBATCH + b) * PBUF + (PBUF + tp)) * D + ch * 8;
        const f32x4 a = *(const GAS f32x4*)sp, c = *(const GAS f32x4*)(sp + 4);
        v[0] = a[0]; v[1] = a[1]; v[2] = a[2]; v[3] = a[3]; v[4] = c[0]; v[5] = c[1]; v[6] = c[2]; v[7] = c[3]; }
    else {
#pragma unroll
        for (int e = 0; e < 8; ++e) v[e] = 0.f; }
}
__device__ __forceinline__ void pool_unit(const Frame& F, int layer, int uid) {
    int stream, b, t0, Tlen, rowbase;
    if (uid < 1024) { stream = 0; b = uid >> 5; t0 = (uid & 31) * 64; Tlen = T; rowbase = b * T; }
    else if (uid < 1032) { stream = 1; b = uid - 1024; t0 = 0; Tlen = ST; rowbase = ROW_S + b * ST; }
    else { stream = 2; b = 0; t0 = 0; Tlen = NMETA; rowbase = ROW_M; }
    const TC tc = thread_coords(F.wave); const int ch = tc.tid & 127, tsub = tc.tid >> 7, win = 2 << (ch >> 5);
    const int ts = t0 + tsub * 16; if (ts >= Tlen) return;
    float acc[8];
#pragma unroll
    for (int e = 0; e < 8; ++e) acc[e] = 0.f;
#pragma unroll
    for (int j = 1; j < 16; ++j) if (j < win) { float v[8]; pool_row(F, layer, stream, b, rowbase, ts - j, ch, v);
#pragma unroll
        for (int e = 0; e < 8; ++e) acc[e] += v[e]; }
#pragma unroll 4
    for (int tt = 0; tt < 16; ++tt) {
        const int t = ts + tt;
        float vn[8], vo[8]; pool_row(F, layer, stream, b, rowbase, t, ch, vn);
        if (tt > 0) pool_row(F, layer, stream, b, rowbase, t - win, ch, vo);
#pragma unroll
        for (int e = 0; e < 8; ++e) acc[e] += vn[e] - (tt > 0 ? vo[e] : 0.f);
        const int have = (stream == 2) ? (t + 1 < win ? t + 1 : win) : win;
        const float inv = 1.0f / (float)have;
        float y[8];
#pragma unroll
        for (int e = 0; e < 8; ++e) y[e] = acc[e] * inv - vn[e];
        *(GAS v4u*)(WSB(F, WS_BR) + (size_t)2 * M_PAD * D + (size_t)(rowbase + t) * D + ch * 8) = (v4u){pk2(y[0], y[1]), pk2(y[2], y[3]), pk2(y[4], y[5]), pk2(y[6], y[7])};
    }
}

struct Args { const float* in[19]; float* out; unsigned char* ws; };

__device__ __forceinline__ int opq(int x) { asm volatile("" : "+s"(x)); return x; }

constexpr int CH_TOTAL = 25;
__device__ __forceinline__ int ch_stage(int ci) { return ci < 8 ? 1 : ci < 16 ? 2 : 3; }
__device__ __forceinline__ int ch_first(int s) { return s == 1 ? 0 : s == 2 ? 8 : s == 3 ? 16 : CH_TOTAL; }
__device__ __forceinline__ unsigned ch_cnt(int s) { return s == 0 ? 117u : s == 3 ? 9u : 8u; }
__device__ __forceinline__ void chain_signal(const Frame& F, gu32* ch, int s) {
    asm volatile("s_waitcnt vmcnt(0)" ::: "memory");
    __syncthreads();
    if (F.wave == 0 && lane_lo_() == 0u) {
        __builtin_amdgcn_fence(__ATOMIC_RELEASE, "agent");
        asm volatile("s_waitcnt vmcnt(0)" ::: "memory");
        const unsigned old = __hip_atomic_fetch_add(ch + 64 * (2 + s), 1u, RLX_AGENT);
        if (old + 1u == ch_cnt(s) && s < 3) __hip_atomic_store(ch + 64, (unsigned)ch_first(s + 2), RLX_AGENT);
    }
}
__device__ __forceinline__ void chain_item(const Frame& F, int l, gu32* ch, int ci) {
    const int s = ch_stage(ci);
    if (s == 1) { pg8::Gemm g{WSB(F, WS_BR), lw(F, l, LW_BR), 3 * M_PAD, 3 * D, D}; SmallOrder3 S{ci}; EpiGate E{F.ws};
        pg8::gemm_phase<EpiGate, SmallOrder3, true, true>(F.lds, g, S, E, F.wave); }
    else if (s == 2) { pg8::Gemm g{WSB(F, WS_MIX), lw(F, l, LW_OUT), M_PAD, D, D}; SmallOrder S{ci - 8}; EpiResid E{F.ws, ALPHA, 1.0f};
        pg8::gemm_phase<EpiResid, SmallOrder, true, true>(F.lds, g, S, E, F.wave); }
    else { const int i = ci - 16; ln_rows(F, l * 3 + 1, false, MP + 32 * i, MP + 32 * i + 32, 0, 8); }
    chain_signal(F, ch, s);
}
__device__ __forceinline__ int mq_count(int kq) { return kq == 0 ? 164 : kq == 1 ? 9 : kq == 2 ? 64 : kq == 3 ? 2056 : 1024; }

__global__ void __launch_bounds__(512, 2) mega_fwd(Args args) {
    extern __shared__ __attribute__((aligned(16))) unsigned char lds[];
    Frame F;
    F.lds = (LAS unsigned char*)lds;
    F.MISC = (volatile LAS unsigned*)(F.lds + MISC_OFF);
    F.G = gridDim.x; F.wave = __builtin_amdgcn_readfirstlane((int)threadIdx.x >> 6);
    F.ws = args.ws; F.out = args.out; F.ctl = (gu32*)(args.ws + WS_CTL);
    for (int u = threadIdx.x; u < (LDS_BYTES - LDSCTL_OFF) / 4; u += 512) ((LAS unsigned*)(F.lds + LDSCTL_OFF))[u] = 0u;
    __syncthreads();
    XcdBarrier bar = xcd_barrier_post((unsigned*)(F.ctl + CW_BAR), F.MISC + 8);
#define GRID_BAR() xcd_barrier(bar)

    p0_prologue(F);

    GRID_BAR();

    for (int l = 0; l < DEPTH; ++l) {
        { pg8::Gemm g{WSB(F, WS_HB), lw(F, l, LW_UP1), M_PAD, 2 * DFF, D}; pg8::StaticOrder S; S.init(M_PAD, 2 * DFF, opq(F.G), opq((int)blockIdx.x)); EpiSwiglu E{WSB(F, WS_ACT)};
          pg8::gemm_phase<EpiSwiglu, pg8::StaticOrder, true, true>(F.lds, g, S, E, F.wave); }

        GRID_BAR();
        { pg8::Gemm g{WSB(F, WS_ACT), lw(F, l, LW_DN1), M_PAD, D, DFF}; pg8::StaticOrder S; S.init(MP, D, opq(F.G), opq((int)blockIdx.x));
          EpiResid E{F.ws, ALPHA, 0.5f};
          pg8::gemm_phase<EpiResid, pg8::StaticOrder, true, true>(F.lds, g, S, E, F.wave); }

        GRID_BAR();
        if (blockIdx.x < 16) { const int kh = opq((int)blockIdx.x) >> 3; pg8::Gemm g{WSB(F, WS_ACT) + kh * (DFF / 2), lw(F, l, LW_DN1) + kh * (DFF / 2), M_PAD, D, DFF / 2, DFF}; SmallOrderH S{opq((int)blockIdx.x)};
            EpiPart E{(float*)WSB(F, WS_ACT) + (size_t)kh * 512 * D};
            pg8::gemm_phase<EpiPart, SmallOrderH, true, true>(F.lds, g, S, E, F.wave); }
        else ln_phase(F, l * 3 + 0, false, 0, MP, 16);
        GRID_BAR();
        ln_phase(F, l * 3 + 0, false, MP, M_PAD, 0, true);
        GRID_BAR();
        { pg8::Gemm g{WSB(F, WS_HB), lw(F, l, LW_IN), M_PAD, DIN, D}; pg8::StaticOrder S; S.init(M_PAD, DIN, opq(F.G), opq((int)blockIdx.x));
          EpiWin E{F.ws, F.out, l};
          pg8::gemm_phase<EpiWin, pg8::StaticOrder, true, true>(F.lds, g, S, E, F.wave);
        }

        GRID_BAR();
        { gu32* q = F.ctl + CW_Q + 64 * (l * 8); gu32* ch = F.ctl + CW_CH + 1024 * l;
          int kq = 0, u = __builtin_amdgcn_readfirstlane(grab(F, q)), chain_open = 1;
          for (;;) {
              while (kq < 5 && u >= mq_count(kq)) { ++kq; if (kq < 5) u = __builtin_amdgcn_readfirstlane(grab(F, q + 64 * kq)); }
              unsigned l0_ = lane_lo_(); asm volatile("" : "+v"(l0_));
              const bool t0 = F.wave == 0 && l0_ == 0u;
              unsigned nx = 0u, hd = 0u, rd = 0u;
              if (t0) { if (kq < 5) nx = __hip_atomic_fetch_add(q + 64 * kq, 1u, RLX_AGENT); if (chain_open) { hd = __hip_atomic_load(ch, RLX_AGENT); rd = __hip_atomic_load(ch + 64, RLX_AGENT); } }
              if (kq == 0) { ret_unit(F, l, u < 36 ? 128 + u : u - 36); if (u < 36) chain_signal(F, ch, 0); }
              else if (kq == 1 || kq == 4) { pool_unit(F, l, kq == 1 ? 1024 + u : u); if (kq == 1) chain_signal(F, ch, 0); }
              else if (kq == 2) { attn_unit<true>(F, l, u); chain_signal(F, ch, 0); }
              else if (kq == 3) { attn_unit<false>(F, l, u < 8 ? 64 + 2048 + u : 64 + u - 8); if (u < 8) chain_signal(F, ch, 0); }
              __syncthreads();
              if (t0) { int ci = -1;
                  if (chain_open) {
                      if (kq == 5) { unsigned sp = 0u;
                          for (;;) { hd = __hip_atomic_load(ch, RLX_AGENT); if (hd >= (unsigned)CH_TOTAL) { ci = -2; break; } rd = __hip_atomic_load(ch + 64, RLX_AGENT);
                              if (hd < rd) { unsigned e = hd; if (__hip_atomic_compare_exchange_strong(ch, &e, hd + 1u, __ATOMIC_RELAXED, __ATOMIC_RELAXED, __HIP_MEMORY_SCOPE_AGENT)) { ci = (int)hd; break; } }
                              else { __builtin_amdgcn_s_sleep(2); if ((++sp & 255u) == 0u) { if (xb_ld((unsigned*)(F.ctl + CW_BAR) + XB_TMO)) { ci = -2; break; } if (sp > XB_SPIN_CAP) { atomicAdd((unsigned*)(F.ctl + CW_BAR) + XB_TMO, 1u); ci = -2; break; } } } } }
                      else if (hd >= (unsigned)CH_TOTAL) ci = -3;
                      else if (hd < rd) { unsigned e = hd; if (__hip_atomic_compare_exchange_strong(ch, &e, hd + 1u, __ATOMIC_RELAXED, __ATOMIC_RELAXED, __HIP_MEMORY_SCOPE_AGENT)) ci = (int)hd; }
                      if (ci >= 0) { __builtin_amdgcn_fence(__ATOMIC_ACQUIRE, "agent"); asm volatile("s_waitcnt vmcnt(0)" ::: "memory"); }
                  } else if (kq == 5) ci = -2;
                  F.MISC[16] = nx; F.MISC[17] = (unsigned)ci; }
              __syncthreads();
              u = __builtin_amdgcn_readfirstlane((int)F.MISC[16]); const int ci = __builtin_amdgcn_readfirstlane((int)F.MISC[17]);
              if (ci == -2) break;
              if (ci == -3) chain_open = 0;
              if (ci >= 0) chain_item(F, l, ch, ci);
          }
          __syncthreads(); }
        GRID_BAR();
        { pg8::Gemm g{WSB(F, WS_BR), lw(F, l, LW_BR), 3 * M_PAD, 3 * D, D}; Order3 S; S.init(MP, D, opq(F.G), opq((int)blockIdx.x)); EpiGate E{F.ws};
          pg8::gemm_phase<EpiGate, Order3, true, true>(F.lds, g, S, E, F.wave); }

        GRID_BAR();
        { pg8::Gemm g{WSB(F, WS_MIX), lw(F, l, LW_OUT), M_PAD, D, D}; pg8::StaticOrder S; S.init(MP, D, opq(F.G), opq((int)blockIdx.x));
          EpiResid E{F.ws, ALPHA, 1.0f};
          pg8::gemm_phase<EpiResid, pg8::StaticOrder, true, true>(F.lds, g, S, E, F.wave); }

        GRID_BAR();
        if (blockIdx.x < 44) { pg8::Gemm g{WSB(F, WS_HB), lw(F, l, LW_UP2), M_PAD, 2 * DFF, D}; SmallOrderW S{opq((int)blockIdx.x)}; EpiSwiglu E{WSB(F, WS_ACT)};
            pg8::gemm_phase<EpiSwiglu, SmallOrderW, true, true>(F.lds, g, S, E, F.wave); }
        else ln_phase(F, l * 3 + 1, false, 0, MP, 44);
        GRID_BAR();
        { pg8::Gemm g{WSB(F, WS_HB), lw(F, l, LW_UP2), M_PAD, 2 * DFF, D}; pg8::StaticOrder S; S.init(MP, 2 * DFF, opq(F.G), opq((int)blockIdx.x)); EpiSwiglu E{WSB(F, WS_ACT)};
          pg8::gemm_phase<EpiSwiglu, pg8::StaticOrder, true, true>(F.lds, g, S, E, F.wave); }

        GRID_BAR();
        { pg8::Gemm g{WSB(F, WS_ACT), lw(F, l, LW_DN2), M_PAD, D, DFF}; pg8::StaticOrder S; S.init(MP, D, opq(F.G), opq((int)blockIdx.x));
          EpiResid E{F.ws, ALPHA, 0.5f};
          pg8::gemm_phase<EpiResid, pg8::StaticOrder, true, true>(F.lds, g, S, E, F.wave); }

        GRID_BAR();
        if (blockIdx.x < 16) { const int kh = opq((int)blockIdx.x) >> 3; pg8::Gemm g{WSB(F, WS_ACT) + kh * (DFF / 2), lw(F, l, LW_DN2) + kh * (DFF / 2), M_PAD, D, DFF / 2, DFF}; SmallOrderH S{opq((int)blockIdx.x)};
            EpiPart E{(float*)WSB(F, WS_ACT) + (size_t)kh * 512 * D};
            pg8::gemm_phase<EpiPart, SmallOrderH, true, true>(F.lds, g, S, E, F.wave); }
        else ln_phase(F, l * 3 + 2, l + 1 == DEPTH, 0, MP, 16);
        GRID_BAR();
        ln_phase(F, l * 3 + 2, l + 1 == DEPTH, MP, M_PAD, 0, true);
        if (l + 1 < DEPTH) GRID_BAR();
    }
}

extern "C" void kernel_launch(void* const* d_in, const int* in_sizes, int n_in, void* d_out, int out_size, void* d_ws, size_t ws_size, hipStream_t stream) {
    static int grid = 0;
    if (grid == 0) {
        if (n_in != 19 || (size_t)out_size != O_END || ws_size < WS_END) { fprintf(stderr, "kernel_launch: unexpected sizes (n_in %d out %d ws %zu need %zu)\n", n_in, out_size, ws_size, (size_t)WS_END); grid = -1; return; }
        int dev = 0, cus = 0, per_cu = 0;
        if (hipGetDevice(&dev) != hipSuccess || hipDeviceGetAttribute(&cus, hipDeviceAttributeMultiprocessorCount, dev) != hipSuccess) { grid = -1; return; }
        if (hipFuncSetAttribute((const void*)mega_fwd, hipFuncAttributeMaxDynamicSharedMemorySize, LDS_BYTES) != hipSuccess) { fprintf(stderr, "kernel_launch: hipFuncSetAttribute failed\n"); grid = -1; return; }
        if (hipOccupancyMaxActiveBlocksPerMultiprocessor(&per_cu, (const void*)mega_fwd, 512, LDS_BYTES) != hipSuccess || per_cu < 1) { fprintf(stderr, "kernel_launch: occupancy query says %d\n", per_cu); }
        (void)hipGetLastError();
        grid = cus;
    }
    if (grid < 0) return;
    if (hipMemsetAsync((char*)d_ws + WS_CTL, 0, CTL_ZERO_BYTES, stream) != hipSuccess) return;
    Args a{};
    for (int i = 0; i < 19; ++i) a.in[i] = (const float*)d_in[i];
    a.out = (float*)d_out; a.ws = (unsigned char*)d_ws;
    hipLaunchKernelGGL(mega_fwd, dim3(grid), dim3(512), LDS_BYTES, stream, a);
}
```

```cpp
#include <hip/hip_runtime.h>
#include <cstdio>
#include <cstdint>
__device__ __forceinline__ unsigned lane_lo_() { unsigned l; asm volatile("v_mbcnt_lo_u32_b32 %0, -1, 0" : "=v"(l)); return l; }
__device__ __forceinline__ int lane_id_() { unsigned l; asm volatile("v_mbcnt_lo_u32_b32 %0, -1, 0\n\tv_mbcnt_hi_u32_b32 %0, -1, %0" : "=v"(l)); return (int)l; }
namespace pg8 {
#define PG8_LAS __attribute__((address_space(3)))
typedef unsigned short bf16_t;
typedef short bf16x8 __attribute__((ext_vector_type(8)));
typedef float f32x4 __attribute__((ext_vector_type(4)));
typedef unsigned u32x4 __attribute__((ext_vector_type(4)));
constexpr int BM = 256, BK = 64, HALF = 128, HTB = HALF * BK * 2  , STAGE_BYTES = 8 * HTB, NXCD = 8, WGM = 4;

__host__ __device__ __forceinline__ int lds_byte(int r, int c) { const int st = (r >> 4) * 2 + (c >> 5), rr = r & 15, cc = c & 31, ob = rr * 64 + cc * 2; return st * 1024 + (ob ^ (((ob >> 9) & 1) << 5)); }
__host__ __device__ __forceinline__ void stage_rc(int b, int& R, int& C) { const int st = b / 1024, sb = b % 1024, swz = sb ^ (((sb >> 9) & 1) << 5); R = (st >> 1) * 16 + swz / 64; C = (st & 1) * 32 + (swz % 64) / 2; }
__host__ __device__ __forceinline__ int perm32(int rho) { const int n = rho >> 4, i = rho & 15; return 8 * (i >> 2) + 4 * n + (i & 3); }

struct Unit { int pm, pn; };
struct Gemm { const bf16_t* A; const bf16_t* Bt; int M, N, K; int ld = 0; };

struct StaticOrder {
    int nM, nN, nwg, G, c;
    __host__ __device__ void init(int M, int N, int G_, int c_) { nM = M / BM; nN = N / BM; nwg = nM * nN; G = G_; c = c_; }
    __host__ __device__ bool next(int i, Unit& u) const {
        const long L = (long)i * G + c; if (L >= nwg) return false;
        int wgid = (int)L; { const int q = nwg / NXCD, r = nwg % NXCD, xcd = wgid % NXCD, off = wgid / NXCD; wgid = (xcd < r ? xcd * (q + 1) : r * (q + 1) + (xcd - r) * q) + off; }
        const int nig = WGM * nN, gid = wgid / nig, fm = gid * WGM, gsz = (nM - fm) < WGM ? (nM - fm) : WGM;
        u.pm = fm + ((wgid % nig) % gsz); u.pn = (wgid % nig) / gsz; return true;
    }
    __device__ __forceinline__ void a_ready(const Unit&) const {}
    __device__ __forceinline__ void done(const Unit&) const {}
};

__device__ __forceinline__ unsigned cvt_pk_bf16(float lo, float hi) { unsigned r; asm volatile("v_cvt_pk_bf16_f32 %0, %1, %2" : "=v"(r) : "v"(lo), "v"(hi)); return r; }
template <class Epi, class Sched, bool ALIGN_EPI = false, bool SP2 = false>
__device__ __forceinline__ void gemm_phase(PG8_LAS unsigned char* lds, const Gemm g, const Sched& S, const Epi& E, const int wave_id) {
    int lane_ = lane_id_(); asm volatile("" : "+v"(lane_));
    const int tid = wave_id * 64 + lane_;
    int widq_ = wave_id; asm volatile("" : "+s"(widq_));
    const int wid = widq_, lane = tid & 63, wr = wid >> 2, wc = wid & 3, fr = lane & 15, fq = lane >> 4;
    const int K = g.K, nt = K / BK, LD = g.ld > 0 ? g.ld : K;
    unsigned voffA[2], voffB[2];
#pragma unroll
    for (int i = 0; i < 2; ++i) { int R, C; stage_rc(tid * 16 + i * 8192, R, C); const int Rb = Epi::PERM ? ((R & ~31) + perm32(R & 31)) : R;
        voffA[i] = (unsigned)(R * LD + C) * 2u; voffB[i] = (unsigned)(Rb * LD + C) * 2u; }
    const size_t kstep = (size_t)(BK * 2);
    const size_t hstep = (size_t)HALF * LD * 2;
    const size_t tstep = 2 * hstep;
    const unsigned ldsw = (unsigned)wid * 1024u;
    const int aoff = lds_byte(wr * 64 + fr, fq * 8), boff = lds_byte(wc * 32 + fr, fq * 8);
#define PG8_SA(b, h) (((b) * 2 + (h)) * HTB)
#define PG8_SB(b, h) ((4 + (b) * 2 + (h)) * HTB)
#define PG8_STAGE(bufoff, gbase, voff) do { _Pragma("unroll") for (int _i = 0; _i < 2; ++_i) \
        __builtin_amdgcn_global_load_lds((const unsigned*)((const char*)(gbase) + (voff)[_i]), (PG8_LAS unsigned*)(lds + (bufoff) + ldsw + _i * 8192), 16, 0, 0); } while (0)
#define PG8_LDA(dst, b, h) do { _Pragma("unroll") for (int m = 0; m < 4; ++m) _Pragma("unroll") for (int k = 0; k < 2; ++k) dst[m][k] = *(const PG8_LAS bf16x8*)(lds + PG8_SA(b, h) + aoff + m * 2048 + k * 1024); } while (0)
#define PG8_LDB(dst, b, h) do { _Pragma("unroll") for (int n = 0; n < 2; ++n) _Pragma("unroll") for (int k = 0; k < 2; ++k) dst[n][k] = *(const PG8_LAS bf16x8*)(lds + PG8_SB(b, h) + boff + n * 2048 + k * 1024); } while (0)
#define PG8_MMA(ai, bj, At, Bt) do { __builtin_amdgcn_s_setprio(1); _Pragma("unroll") for (int m = 0; m < 4; ++m) _Pragma("unroll") for (int n = 0; n < 2; ++n) _Pragma("unroll") for (int k = 0; k < 2; ++k) \
        acc[ai][bj][m][n] = __builtin_amdgcn_mfma_f32_16x16x32_bf16(Bt[n][k], At[m][k], acc[ai][bj][m][n], 0, 0, 0); __builtin_amdgcn_s_setprio(0); } while (0)
#define PG8_WAIT_V(n) asm volatile("s_waitcnt vmcnt(" #n ")" ::: "memory")
#define PG8_WAIT_VN(n) asm volatile("s_waitcnt vmcnt(%0)" :: "n"(n) : "memory")
#define PG8_WAIT_L(n) asm volatile("s_waitcnt lgkmcnt(" #n ")" ::: "memory")
#define PG8_BAR __builtin_amdgcn_s_barrier()
#define PG8_SCHED __builtin_amdgcn_sched_barrier(0)
    Unit cur, nxt; int ui = 0;
    if (!S.next(0, cur)) return;
    f32x4 acc[2][2][4][2];
#pragma unroll
    for (int a = 0; a < 2; ++a)
#pragma unroll
        for (int b = 0; b < 2; ++b)
#pragma unroll
            for (int m = 0; m < 4; ++m)
#pragma unroll
                for (int n = 0; n < 2; ++n) acc[a][b][m][n] = (f32x4){0.f, 0.f, 0.f, 0.f};
    bf16x8 At[4][2], B0[2][2], B1[2][2];
    const char* cA = (const char*)g.A + (size_t)cur.pm * tstep; const char* cB = (const char*)g.Bt + (size_t)cur.pn * tstep;
    S.a_ready(cur);
    if constexpr (SP2) {
        PG8_STAGE(PG8_SB(0, 0), cB, voffB); PG8_STAGE(PG8_SB(0, 1), cB + hstep, voffB); PG8_STAGE(PG8_SA(0, 0), cA, voffA); PG8_STAGE(PG8_SA(0, 1), cA + hstep, voffA);
        if (wr == 1) PG8_BAR;
        PG8_WAIT_V(2); PG8_BAR;
        PG8_STAGE(PG8_SB(1, 0), cB + kstep, voffB); PG8_STAGE(PG8_SA(1, 0), cA + kstep, voffA); PG8_STAGE(PG8_SB(1, 1), cB + hstep + kstep, voffB);
        PG8_WAIT_V(6); PG8_BAR;
    } else {
        PG8_STAGE(PG8_SB(0, 0), cB, voffB); PG8_STAGE(PG8_SA(0, 0), cA, voffA); PG8_STAGE(PG8_SB(0, 1), cB + hstep, voffB); PG8_STAGE(PG8_SA(0, 1), cA + hstep, voffA);
        if (wr == 1) PG8_BAR;
        PG8_WAIT_V(4); PG8_BAR;
        PG8_STAGE(PG8_SB(1, 0), cB + kstep, voffB); PG8_STAGE(PG8_SA(1, 0), cA + kstep, voffA); PG8_STAGE(PG8_SB(1, 1), cB + hstep + kstep, voffB);
        PG8_WAIT_V(6); PG8_BAR;
    }
    for (;;) {
        const bool has_next = S.next(ui + 1, nxt);
        const char* nA = has_next ? (const char*)g.A + (size_t)nxt.pm * tstep : cA; const char* nB = has_next ? (const char*)g.Bt + (size_t)nxt.pn * tstep : cB;
        for (int t = 0; t < nt; t += 2) {
            const bool last = (t == nt - 2);
            const char* a1 = cA + (size_t)(t + 1) * kstep;
            const char* a2 = last ? nA : cA + (size_t)(t + 2) * kstep; const char* b2 = last ? nB : cB + (size_t)(t + 2) * kstep;
            const char* a3 = a2 + kstep; const char* b3 = b2 + kstep;
            if (last && has_next) S.a_ready(nxt);
            if constexpr (SP2) {
            int tz_ = __builtin_amdgcn_readfirstlane(t | (ui > 0 ? 0 : 1)); asm volatile("" : "+s"(tz_));
            const bool strict = !(Epi::NS > 0 && tz_ == 0);
            PG8_LDB(B0, 0, 0); PG8_LDB(B1, 0, 1); PG8_SCHED; PG8_LDA(At, 0, 0); PG8_STAGE(PG8_SA(1, 1), a1 + hstep, voffA);
            PG8_WAIT_VN(8 + Epi::NS); if (strict) PG8_WAIT_V(8); PG8_WAIT_L(0); PG8_BAR; PG8_MMA(0, 0, At, B0); PG8_MMA(0, 1, At, B1); PG8_BAR; PG8_SCHED;
            PG8_LDA(At, 0, 1); PG8_STAGE(PG8_SB(0, 0), b2, voffB); PG8_STAGE(PG8_SB(0, 1), b2 + hstep, voffB); PG8_STAGE(PG8_SA(0, 0), a2, voffA);
            PG8_WAIT_VN(8 + Epi::NS); if (strict) PG8_WAIT_V(8); PG8_WAIT_L(0); PG8_BAR; PG8_MMA(1, 0, At, B0); PG8_MMA(1, 1, At, B1); PG8_BAR; PG8_SCHED;
            PG8_LDB(B0, 1, 0); PG8_LDB(B1, 1, 1); PG8_SCHED; PG8_LDA(At, 1, 0); PG8_STAGE(PG8_SA(0, 1), a2 + hstep, voffA);
            PG8_WAIT_V(8); PG8_WAIT_L(0); PG8_BAR; PG8_MMA(0, 0, At, B0); PG8_MMA(0, 1, At, B1); PG8_BAR; PG8_SCHED;
            PG8_LDA(At, 1, 1); PG8_STAGE(PG8_SB(1, 0), b3, voffB); PG8_STAGE(PG8_SB(1, 1), b3 + hstep, voffB); PG8_STAGE(PG8_SA(1, 0), a3, voffA);
            PG8_WAIT_V(8); PG8_WAIT_L(0); PG8_BAR; PG8_MMA(1, 0, At, B0); PG8_MMA(1, 1, At, B1); PG8_BAR; PG8_SCHED;
            } else {
            PG8_LDB(B0, 0, 0); PG8_SCHED; PG8_LDA(At, 0, 0); PG8_STAGE(PG8_SA(1, 1), a1 + hstep, voffA);
            PG8_WAIT_L(8); PG8_BAR; PG8_WAIT_L(0); PG8_MMA(0, 0, At, B0); PG8_BAR; PG8_SCHED;
            PG8_LDB(B1, 0, 1); PG8_STAGE(PG8_SB(0, 0), b2, voffB);
            PG8_BAR; PG8_WAIT_L(0); PG8_MMA(0, 1, At, B1); PG8_BAR;
            PG8_LDA(At, 0, 1); PG8_STAGE(PG8_SA(0, 0), a2, voffA);
            PG8_BAR; PG8_WAIT_L(0); PG8_MMA(1, 0, At, B0); PG8_BAR; PG8_SCHED;
            PG8_STAGE(PG8_SB(0, 1), b2 + hstep, voffB);
            PG8_WAIT_V(6); PG8_BAR; PG8_MMA(1, 1, At, B1); PG8_BAR;
            PG8_LDB(B0, 1, 0); PG8_SCHED; PG8_LDA(At, 1, 0); PG8_STAGE(PG8_SA(0, 1), a2 + hstep, voffA);
            PG8_WAIT_L(8); PG8_BAR; PG8_WAIT_L(0); PG8_MMA(0, 0, At, B0); PG8_BAR; PG8_SCHED;
            PG8_LDB(B1, 1, 1); PG8_STAGE(PG8_SB(1, 0), b3, voffB);
            PG8_BAR; PG8_WAIT_L(0); PG8_MMA(0, 1, At, B1); PG8_BAR;
            PG8_LDA(At, 1, 1); PG8_STAGE(PG8_SA(1, 0), a3, voffA);
            PG8_BAR; PG8_WAIT_L(0); PG8_MMA(1, 0, At, B0); PG8_BAR; PG8_SCHED;
            PG8_STAGE(PG8_SB(1, 1), b3 + hstep, voffB);
            PG8_WAIT_V(6); PG8_BAR; PG8_MMA(1, 1, At, B1); PG8_BAR;
            }
        }
        if constexpr (ALIGN_EPI) { if (wr == 0) PG8_BAR; }
        const bool keep_acc = E(acc, cur, wr, wc, fr, fq);
        if (!has_next) break;
        if (!keep_acc) {
#pragma unroll
        for (int a = 0; a < 2; ++a)
#pragma unroll
            for (int b = 0; b < 2; ++b)
#pragma unroll
                for (int m = 0; m < 4; ++m)
#pragma unroll
                    for (int n = 0; n < 2; ++n) acc[a][b][m][n] = (f32x4){0.f, 0.f, 0.f, 0.f};
        }
        cur = nxt; cA = nA; cB = nB; ++ui;
        if constexpr (ALIGN_EPI) { if (wr == 1) PG8_BAR; }
    }
    PG8_WAIT_V(0);
    if constexpr (!ALIGN_EPI) { if (wr == 0) PG8_BAR; }
    PG8_BAR;
#undef PG8_SA
#undef PG8_SB
#undef PG8_STAGE
#undef PG8_LDA
#undef PG8_LDB
#undef PG8_MMA
#undef PG8_WAIT_V
#undef PG8_WAIT_VN
#undef PG8_WAIT_L
#undef PG8_BAR
#undef PG8_SCHED
}
}

constexpr int D = 1024, NB = 32, T = 2048, DEPTH = 2, SBATCH = 8, ST = 32, PAST = 4096, NMETA = 16;
constexpr int HRET = 4, DKR = 128, DVR = 256, HSB = 8, DSB = 128, DFF = 2816, DIN = 10240, PBUF = 15;
constexpr int MP = NB * T;
constexpr int ROW_S = MP;
constexpr int ROW_M = MP + SBATCH * ST;
constexpr int M_PAD = ROW_M + 256;
constexpr int NPANEL = M_PAD / 256;
constexpr float LN_EPS = 1e-5f;
constexpr float ALPHA = 1.41421356237f;
constexpr float LOG2E = 1.44269504089f;
constexpr int KT_SP = PAST + ST;
constexpr int KT_PP = NMETA + T;

constexpr size_t O_YP = 0;
constexpr size_t O_YS = O_YP + (size_t)NB * T * D;
constexpr size_t O_KP = O_YS + (size_t)SBATCH * ST * D;
constexpr size_t O_VP = O_KP + (size_t)DEPTH * NB * KT_PP * D;
constexpr size_t O_RP = O_VP + (size_t)DEPTH * NB * KT_PP * D;
constexpr size_t O_PP = O_RP + (size_t)DEPTH * NB * HRET * DKR * DVR;
constexpr size_t O_KS = O_PP + (size_t)DEPTH * NB * PBUF * D;
constexpr size_t O_VS = O_KS + (size_t)DEPTH * SBATCH * ST * D;
constexpr size_t O_RS = O_VS + (size_t)DEPTH * SBATCH * ST * D;
constexpr size_t O_PS = O_RS + (size_t)DEPTH * SBATCH * HRET * DKR * DVR;
constexpr size_t O_END = O_PS + (size_t)DEPTH * SBATCH * PBUF * D;
static_assert(O_END == 350666752ull, "output size");

constexpr size_t MiB = 1u << 20;
constexpr size_t AL(size_t x) { return (x + 4095) & ~(size_t)4095; }
constexpr size_t WS_CTL = 0, CTL_ZERO_BYTES = 1 * MiB;
constexpr size_t WS_YB = WS_CTL + CTL_ZERO_BYTES;
constexpr size_t WS_HB = AL(WS_YB + (size_t)M_PAD * D * 2);
constexpr size_t WS_ACT = AL(WS_HB + (size_t)M_PAD * D * 2);
constexpr size_t WS_QR = AL(WS_ACT + (size_t)M_PAD * DFF * 2);
constexpr size_t WS_KR = AL(WS_QR + (size_t)M_PAD * 512 * 2);
constexpr size_t WS_VR = AL(WS_KR + (size_t)M_PAD * 512 * 2);
constexpr size_t WS_GR = AL(WS_VR + (size_t)M_PAD * D * 2);
constexpr size_t WS_QS = AL(WS_GR + (size_t)M_PAD * D * 2);
constexpr size_t WS_KS = AL(WS_QS + (size_t)M_PAD * D * 2);
constexpr size_t WS_VS = AL(WS_KS + (size_t)M_PAD * D * 2);
constexpr size_t WS_U = AL(WS_VS + (size_t)M_PAD * D * 2);
constexpr size_t WS_GT = AL(WS_U + (size_t)M_PAD * D * 2);
constexpr size_t WS_BR = AL(WS_GT + (size_t)M_PAD * 3 * D * 2);
constexpr size_t WS_MIX = AL(WS_BR + (size_t)3 * M_PAD * D * 2);
constexpr size_t WS_W = AL(WS_MIX + (size_t)M_PAD * D * 2);
constexpr size_t LW_UP1 = 0;
constexpr size_t LW_DN1 = LW_UP1 + (size_t)2 * DFF * D * 2;
constexpr size_t LW_IN = LW_DN1 + (size_t)D * DFF * 2;
constexpr size_t LW_BR = LW_IN + (size_t)DIN * D * 2;
constexpr size_t LW_OUT = LW_BR + (size_t)3 * D * D * 2;
constexpr size_t LW_UP2 = LW_OUT + (size_t)D * D * 2;
constexpr size_t LW_DN2 = LW_UP2 + (size_t)2 * DFF * D * 2;
constexpr size_t LW_SIZE = AL(LW_DN2 + (size_t)D * DFF * 2);
constexpr size_t WS_END = WS_W + DEPTH * LW_SIZE;
static_assert(WS_END < (size_t)4000 * MiB, "workspace budget");

constexpr int CW_BAR = 4096;
constexpr int CW_Q = 16384;
constexpr int CW_CH = 24576;
constexpr int CW_DBG = 32768;
constexpr int CW_KN = 65536;
static_assert((CW_KN + DEPTH * 33 * 8 * 16) * 4 <= (int)CTL_ZERO_BYTES, "ctl region");

constexpr int RING_BYTES = 131072;
constexpr int LDSCTL_OFF = RING_BYTES, MISC_OFF = LDSCTL_OFF + 320;
constexpr int LDS_BYTES = 147456;

#define GAS __attribute__((address_space(1)))
#define LAS __attribute__((address_space(3)))
typedef unsigned short bf16;
typedef unsigned v4u __attribute__((ext_vector_type(4)));
typedef unsigned v2u __attribute__((ext_vector_type(2)));
typedef float f32x4 __attribute__((ext_vector_type(4)));
typedef short bf16x8 __attribute__((ext_vector_type(8)));
typedef short s16x4 __attribute__((ext_vector_type(4)));
typedef GAS unsigned gu32;
#define RLX_AGENT __ATOMIC_RELAXED, __HIP_MEMORY_SCOPE_AGENT
__device__ __forceinline__ unsigned f2bf(float f) { unsigned u = __builtin_bit_cast(unsigned, f); return (u + 0x7fffu + ((u >> 16) & 1u)) >> 16; }
__device__ __forceinline__ unsigned pk2(float lo, float hi) { return f2bf(lo) | (f2bf(hi) << 16); }
__device__ __forceinline__ float bf2f(unsigned short b) { return __builtin_bit_cast(float, (unsigned)b << 16); }
__device__ __forceinline__ float bflo(unsigned w) { return __builtin_bit_cast(float, w << 16); }
__device__ __forceinline__ float bfhi(unsigned w) { return __builtin_bit_cast(float, w & 0xffff0000u); }
__device__ __forceinline__ float fast_exp2(float x) { return __builtin_amdgcn_exp2f(x); }
__device__ __forceinline__ float fast_log2(float x) { return __builtin_amdgcn_logf(x); }
__device__ __forceinline__ float fast_rcp(float x) { return __builtin_amdgcn_rcpf(x); }
__device__ __forceinline__ float sigmoidf_(float x) { return fast_rcp(1.0f + fast_exp2(-x * LOG2E)); }
__device__ __forceinline__ float siluf_(float x) { return x * sigmoidf_(x); }
__device__ __forceinline__ float wave_sum(float v) {
#pragma unroll
    for (int o = 1; o < 64; o <<= 1) v += __shfl_xor(v, o);
    return v;
}
#define XB_TMO      128
#define XB_XCNT(j)  (256  + 64 * (j))
#define XB_XSUB(j)  (1280 + 64 * (j))
#define XB_XGEN(j)  (2304 + 64 * (j))
#define XB_TOP      3328
#define XB_TOPGEN   3392
#define XCD_BAR_WORDS 3456
#define XB_SPIN_CAP (1u << 20)

__device__ __forceinline__ unsigned xb_ld(unsigned* p)              { return __hip_atomic_load(p, __ATOMIC_RELAXED, __HIP_MEMORY_SCOPE_AGENT); }
__device__ __forceinline__ unsigned xb_add(unsigned* p, unsigned v) { return __hip_atomic_fetch_add(p, v, __ATOMIC_RELAXED, __HIP_MEMORY_SCOPE_AGENT); }
__device__ __forceinline__ unsigned xb_xcc_id() { return (unsigned)__builtin_amdgcn_s_getreg((3 << 11) | 20) & 0xFu; }
#define XB_SPIN(cond, bar) do { unsigned _sp = 0; while (cond) { __builtin_amdgcn_s_sleep(1); \
    if ((++_sp & 255u) == 0u) { if (xb_ld(&(bar)[XB_TMO])) break; if (_sp > XB_SPIN_CAP) { atomicAdd(&(bar)[XB_TMO], 1u); break; } } } } while (0)

struct XcdBarrier {
    unsigned* bar; unsigned x; unsigned w0;
    volatile LAS unsigned* st;
};

__device__ __forceinline__ XcdBarrier xcd_barrier_post(unsigned* bar, volatile LAS unsigned* st) {
    XcdBarrier b; b.bar = bar; b.x = xb_xcc_id(); b.st = st; b.w0 = (__builtin_amdgcn_readfirstlane((int)threadIdx.x >> 6) == 0) ? 1u : 0u;
    if (threadIdx.x == 0) (void)xb_add(&bar[XB_XCNT(b.x)], 1u);
    return b;
}
__device__ __forceinline__ void xcd_barrier_complete(unsigned* bar, unsigned x, unsigned& nloc, unsigned& nx) {
    const unsigned G = gridDim.x * gridDim.y * gridDim.z;
    unsigned sum, cnt, mine, sp = 0u;
    for (;;) {
        sum = 0u; cnt = 0u; mine = 0u;
#pragma unroll
        for (unsigned j = 0; j < 16; ++j) { const unsigned c = xb_ld(&bar[XB_XCNT(j)]); sum += c; cnt += (c > 0u) ? 1u : 0u; mine = (j == x) ? c : mine; }
        if (sum == G) break;
        __builtin_amdgcn_s_sleep(1);
        if ((++sp & 255u) == 0u) { if (xb_ld(&bar[XB_TMO])) break; if (sp > XB_SPIN_CAP) { atomicAdd(&bar[XB_TMO], 1u); break; } }
    }
    nloc = mine > 0u ? mine : 1u; nx = cnt > 0u ? cnt : 1u;
}

__device__ __forceinline__ void xcd_barrier(const XcdBarrier& b) {
    asm volatile("s_waitcnt vmcnt(0)" ::: "memory");
    __syncthreads();
    if (b.w0 != 0u && lane_lo_() == 0u) {
        unsigned* bar = b.bar; unsigned bx = b.x; asm volatile("" : "+s"(bar), "+s"(bx));
        __builtin_amdgcn_s_waitcnt(0);
        unsigned nloc = b.st[0], nx = b.st[1];
        if (nloc == 0u) { xcd_barrier_complete(bar, bx, nloc, nx); b.st[0] = nloc; b.st[1] = nx; }
        const unsigned old = xb_add(&bar[XB_XSUB(bx)], 1u);
        const unsigned gen = old / nloc;
        if (old + 1u == (gen + 1u) * nloc) {
            __builtin_amdgcn_fence(__ATOMIC_RELEASE, "agent");
            asm volatile("s_waitcnt vmcnt(0)" ::: "memory");
            const unsigned og = xb_add(&bar[XB_TOP], 1u);
            const unsigned tg = og / nx;
            if (og + 1u == (tg + 1u) * nx) xb_add(&bar[XB_TOPGEN], 1u);
            else XB_SPIN(xb_ld(&bar[XB_TOPGEN]) == tg, bar);
            __builtin_amdgcn_fence(__ATOMIC_ACQUIRE, "agent");
            xb_add(&bar[XB_XGEN(bx)], 1u);
            asm volatile("s_waitcnt vmcnt(0)" ::: "memory");
        } else {
            XB_SPIN(xb_ld(&bar[XB_XGEN(bx)]) == gen, bar);
            __builtin_amdgcn_fence(__ATOMIC_ACQUIRE, "agent");
            asm volatile("s_waitcnt vmcnt(0)" ::: "memory");
        }
    }
    __syncthreads();
}

struct Frame {
    LAS unsigned char* lds;
    volatile LAS unsigned* MISC;
    gu32* ctl;
    int G, wave;
    float* out; unsigned char* ws;
};
__device__ __forceinline__ const float* in_ptr(int i) {
    const __attribute__((address_space(4))) char* k = (const __attribute__((address_space(4))) char*)__builtin_amdgcn_kernarg_segment_ptr();
    asm volatile("" : "+s"(k));
    return *(const float* const __attribute__((address_space(4)))*)(k + 8 * i);
}
enum { IN_XP = 0, IN_XS, IN_CK, IN_CV, IN_SRET, IN_SPOOL, IN_META, IN_WIN, IN_RETG, IN_PMIX, IN_PSCALE, IN_WBR, IN_WOUT, IN_UP1, IN_DN1, IN_UP2, IN_DN2, IN_LNG, IN_LNB };
__device__ __forceinline__ unsigned char* wsq(unsigned char* p) { asm volatile("" : "+s"(p)); return p; }
#define WSB(F, off) ((bf16*)(wsq((F).ws) + (off)))
struct TC { int tid, lane, wave; };
__device__ __forceinline__ TC thread_coords(int wave) { TC c; int l = lane_id_(); asm volatile("" : "+v"(l)); c.lane = l; c.wave = wave; c.tid = wave * 64 + l; return c; }
__device__ __forceinline__ bf16* lw(const Frame& F, int l, size_t off) { return (bf16*)(wsq(F.ws) + WS_W + (size_t)l * LW_SIZE + off); }
__device__ __forceinline__ float* yrow(const Frame& F, int m) {
    if (m < MP) return F.out + O_YP + (size_t)m * D;
    if (m < ROW_M) return F.out + O_YS + (size_t)(m - ROW_S) * D;
    return nullptr;
}

__device__ __forceinline__ int srccol(int kind, int n) {
    if (kind == 1) { const int pn = n >> 8, p = n & 255, bj = p >> 7, wc = (p >> 5) & 3, fq = (p >> 3) & 3, nn = (p >> 2) & 1, e = p & 3;
        return (nn ? DFF : 0) + 128 * pn + 64 * bj + 16 * wc + 4 * fq + e; }
    if (kind == 2 && n < 1024) { const int hb_ = n & ~127, p = n & 127, wc = p >> 5, fq = (p >> 3) & 3, nn = (p >> 2) & 1, e = p & 3;
        return hb_ + 16 * wc + 4 * fq + e + 64 * nn; }
    return n;
}
__device__ __forceinline__ void p0_transpose_item(const float* W, int K, int ldw, int N, bf16* WT, int kind, LAS float* scr, int item, int lane) {
    const int nblk = N / 32, kb = item / nblk, nb = item % nblk, k0 = 64 * kb, n0 = 32 * nb;
    const int sc = srccol(kind, n0 + (lane & 31));
    float t_[32];
#pragma unroll
    for (int i = 0; i < 32; ++i) t_[i] = W[(size_t)(k0 + 2 * i + (lane >> 5)) * ldw + sc];
#pragma unroll
    for (int i = 0; i < 32; ++i) scr[(2 * i + (lane >> 5)) * 33 + (lane & 31)] = t_[i];
    asm volatile("s_waitcnt lgkmcnt(0)" ::: "memory");
    const int c = lane & 7;
#pragma unroll
    for (int j = 0; j < 4; ++j) { const int n = (lane >> 3) + 8 * j; const LAS float* s = scr + (8 * c) * 33 + n;
        v4u o; o.x = pk2(s[0 * 33], s[1 * 33]); o.y = pk2(s[2 * 33], s[3 * 33]); o.z = pk2(s[4 * 33], s[5 * 33]); o.w = pk2(s[6 * 33], s[7 * 33]);
        *(GAS v4u*)(WT + (size_t)(n0 + n) * K + k0 + 8 * c) = o; }
    asm volatile("s_waitcnt lgkmcnt(0)" ::: "memory");
}
__device__ __forceinline__ void p0_poolfold_item(const float* mixw  , const float* scale  , const float* wb2  , bf16* WT  , int item, int lane) {
    const int g = item >> 7, r = item & 127, cb = r >> 4, nb = r & 15;
    const int n = nb * 64 + lane, c0 = cb * 32;
    float acc[32];
#pragma unroll
    for (int i = 0; i < 32; ++i) acc[i] = 0.f;
    const float* mw = mixw + ((size_t)g * 256 + c0) * 256;
    for (int d0 = 0; d0 < 256; d0 += 8) {
        float a[8];
#pragma unroll
        for (int j = 0; j < 8; ++j) a[j] = scale[g * 256 + d0 + j] * wb2[(size_t)(g * 256 + d0 + j) * D + n];
#pragma unroll
        for (int i = 0; i < 32; ++i)
#pragma unroll
            for (int j = 0; j < 8; ++j) acc[i] += mw[(size_t)i * 256 + d0 + j] * a[j];
    }
    bf16* dst = WT + (size_t)n * D + g * 256 + c0;
#pragma unroll
    for (int i = 0; i < 32; i += 8) { v4u o; o.x = pk2(acc[i], acc[i + 1]); o.y = pk2(acc[i + 2], acc[i + 3]); o.z = pk2(acc[i + 4], acc[i + 5]); o.w = pk2(acc[i + 6], acc[i + 7]); *(GAS v4u*)(dst + i) = o; }
}
__device__ __forceinline__ void p0_prologue(Frame& F) {
    const TC tc = thread_coords(F.wave); const int gw = blockIdx.x * 8 + tc.wave, NGW = F.G * 8;
    LAS float* scr = (LAS float*)(F.lds + tc.wave * 16384);
    for (int l = 0; l < DEPTH; ++l) {
        constexpr int I_UP = (D / 64) * (2 * DFF / 32), I_DN = (DFF / 64) * (D / 32), I_IN = (D / 64) * (DIN / 32), I_SQ = (D / 64) * (D / 32), I_PF = 4 * 4 * 32;
        constexpr int NIT = 2 * I_UP + 2 * I_DN + I_IN + 3 * I_SQ + I_PF;
        for (int it = (gw + l * (NGW / 2)) % NGW; it < NIT; it += NGW) {
            int r = it;
            if (r < I_UP) { p0_transpose_item(in_ptr(IN_UP1) + (size_t)l * D * 2 * DFF, D, 2 * DFF, 2 * DFF, lw(F, l, LW_UP1), 1, scr, r, tc.lane); continue; } r -= I_UP;
            if (r < I_UP) { p0_transpose_item(in_ptr(IN_UP2) + (size_t)l * D * 2 * DFF, D, 2 * DFF, 2 * DFF, lw(F, l, LW_UP2), 1, scr, r, tc.lane); continue; } r -= I_UP;
            if (r < I_DN) { p0_transpose_item(in_ptr(IN_DN1) + (size_t)l * DFF * D, DFF, D, D, lw(F, l, LW_DN1), 0, scr, r, tc.lane); continue; } r -= I_DN;
            if (r < I_DN) { p0_transpose_item(in_ptr(IN_DN2) + (size_t)l * DFF * D, DFF, D, D, lw(F, l, LW_DN2), 0, scr, r, tc.lane); continue; } r -= I_DN;
            if (r < I_IN) { p0_transpose_item(in_ptr(IN_WIN) + (size_t)l * D * DIN, D, DIN, DIN, lw(F, l, LW_IN), 2, scr, r, tc.lane); continue; } r -= I_IN;
            if (r < I_SQ) { p0_transpose_item(in_ptr(IN_WBR) + (size_t)(l * 3 + 0) * D * D, D, D, D, lw(F, l, LW_BR), 0, scr, r, tc.lane); continue; } r -= I_SQ;
            if (r < I_SQ) { p0_transpose_item(in_ptr(IN_WBR) + (size_t)(l * 3 + 1) * D * D, D, D, D, lw(F, l, LW_BR) + (size_t)D * D, 0, scr, r, tc.lane); continue; } r -= I_SQ;
            if (r < I_SQ) { p0_transpose_item(in_ptr(IN_WOUT) + (size_t)l * D * D, D, D, D, lw(F, l, LW_OUT), 0, scr, r, tc.lane); continue; } r -= I_SQ;
            p0_poolfold_item(in_ptr(IN_PMIX) + (size_t)l * 4 * 256 * 256, in_ptr(IN_PSCALE) + (size_t)l * D, in_ptr(IN_WBR) + (size_t)(l * 3 + 2) * D * D, lw(F, l, LW_BR) + (size_t)2 * D * D, r, tc.lane);
        }
    }
    for (int m0 = gw; m0 < M_PAD; m0 += 2 * NGW) {
        f32x4 v[2][4];
#pragma unroll
        for (int r = 0; r < 2; ++r) { const int m = m0 + r * NGW;
            const float* src = (m < MP) ? in_ptr(IN_XP) + (size_t)m * D : (m < ROW_M) ? in_ptr(IN_XS) + (size_t)(m - ROW_S) * D : (m - ROW_M < NMETA) ? in_ptr(IN_META) + (size_t)(m - ROW_M) * D : nullptr;
#pragma unroll
            for (int j = 0; j < 4; ++j) v[r][j] = (src && m < M_PAD) ? ((const GAS f32x4*)src)[tc.lane + 64 * j] : (f32x4){0.f, 0.f, 0.f, 0.f}; }
#pragma unroll
        for (int r = 0; r < 2; ++r) { const int m = m0 + r * NGW;
            if (m < M_PAD) { GAS v2u* o8 = (GAS v2u*)(WSB(F, WS_HB) + (size_t)m * D) + tc.lane;
#pragma unroll
                for (int j = 0; j < 4; ++j) o8[64 * j] = (v2u){pk2(v[r][j].x, v[r][j].y), pk2(v[r][j].z, v[r][j].w)}; } }
    }
}

__device__ __forceinline__ void ln_rows(const Frame& F, int idx, bool final_out, int row_lo, int row_hi, int gw0, int NGW, bool comb = false) {
    const TC tc = thread_coords(F.wave); const int gw = gw0 + tc.wave;
    const float* g = in_ptr(IN_LNG) + (size_t)idx * D; const float* b = in_ptr(IN_LNB) + (size_t)idx * D;
    f32x4 gv[4], bv[4];
#pragma unroll
    for (int j = 0; j < 2; ++j) { gv[2 * j] = ((const GAS f32x4*)g)[2 * tc.lane + 128 * j]; gv[2 * j + 1] = ((const GAS f32x4*)g)[2 * tc.lane + 128 * j + 1];
                                  bv[2 * j] = ((const GAS f32x4*)b)[2 * tc.lane + 128 * j]; bv[2 * j + 1] = ((const GAS f32x4*)b)[2 * tc.lane + 128 * j + 1]; }
    for (int m0 = row_lo + gw; m0 < row_hi; m0 += 2 * NGW) {
        v4u w[2][2]; const bool two = m0 + NGW < row_hi;
#pragma unroll
        for (int r = 0; r < 2; ++r) { const int m = (r == 0 || two) ? m0 + r * NGW : m0; const GAS v4u* yr = (const GAS v4u*)(WSB(F, comb ? WS_HB : WS_YB) + (size_t)m * D) + tc.lane; w[r][0] = yr[0]; w[r][1] = yr[64]; }
#pragma unroll
        for (int r = 0; r < 2; ++r) { const int m = m0 + r * NGW; if (r == 1 && !two) break;
        f32x4 v[4]; float s = 0.f;
#pragma unroll
        for (int j = 0; j < 2; ++j) { const v4u x = w[r][j]; v[2 * j] = (f32x4){bflo(x.x), bfhi(x.x), bflo(x.y), bfhi(x.y)}; v[2 * j + 1] = (f32x4){bflo(x.z), bfhi(x.z), bflo(x.w), bfhi(x.w)}; }
        if (comb) {
            const GAS f32x4* pa = (const GAS f32x4*)((const float*)WSB(F, WS_ACT) + (size_t)(m - MP) * D) + 2 * tc.lane; const GAS f32x4* pb = pa + (size_t)512 * D / 4;
#pragma unroll
            for (int j = 0; j < 2; ++j) { v[2 * j] = v[2 * j] * ALPHA + (pa[128 * j] + pb[128 * j]) * 0.5f; v[2 * j + 1] = v[2 * j + 1] * ALPHA + (pa[128 * j + 1] + pb[128 * j + 1]) * 0.5f; } }
#pragma unroll
        for (int j = 0; j < 4; ++j) s += (v[j].x + v[j].y) + (v[j].z + v[j].w);
        const float mean = wave_sum(s) * (1.f / D); float s2 = 0.f;
#pragma unroll
        for (int j = 0; j < 4; ++j) { v[j] = v[j] - mean; s2 += (v[j].x * v[j].x + v[j].y * v[j].y) + (v[j].z * v[j].z + v[j].w * v[j].w); }
        const float rstd = 1.f / sqrtf(wave_sum(s2) * (1.f / D) + LN_EPS);
#pragma unroll
        for (int j = 0; j < 4; ++j) v[j] = v[j] * rstd * gv[j] + bv[j];
        if (!final_out) { GAS v4u* o = (GAS v4u*)(WSB(F, WS_HB) + (size_t)m * D) + tc.lane;
#pragma unroll
            for (int j = 0; j < 2; ++j) o[64 * j] = (v4u){pk2(v[2 * j].x, v[2 * j].y), pk2(v[2 * j].z, v[2 * j].w), pk2(v[2 * j + 1].x, v[2 * j + 1].y), pk2(v[2 * j + 1].z, v[2 * j + 1].w)}; }
        else { float* yo = yrow(F, m); if (yo) { GAS f32x4* o = (GAS f32x4*)yo + 2 * tc.lane;
#pragma unroll
            for (int j = 0; j < 2; ++j) { o[128 * j] = v[2 * j]; o[128 * j + 1] = v[2 * j + 1]; } } }
        }
    }
}
__device__ __forceinline__ void ln_phase(const Frame& F, int idx, bool final_out, int row_lo, int row_hi, int cu_lo, bool comb = false) { ln_rows(F, idx, final_out, row_lo, row_hi, ((int)blockIdx.x - cu_lo) * 8, (F.G - cu_lo) * 8, comb); }
__device__ __forceinline__ float ret_lg2(int h);

using pg8::Unit;
typedef f32x4 AccT[2][2][4][2];
#ifndef LANE_TR
#define LANE_TR 1
#endif
struct LaneT { int tfr, tfq, pull, push; };
#if LANE_TR
__device__ __forceinline__ LaneT lane_t(int fr, int fq) { LaneT t; const int L = fq * 16 + fr; t.tfr = L >> 2; t.tfq = L & 3; t.pull = ((t.tfq << 4) + t.tfr) << 2; t.push = ((fr << 2) + fq) << 2; return t; }
__device__ __forceinline__ unsigned bperm(int a, unsigned x) { return (unsigned)__builtin_amdgcn_ds_bpermute(a, (int)x); }
__device__ __forceinline__ v4u tr4(int a, v4u x) { return (v4u){bperm(a, x.x), bperm(a, x.y), bperm(a, x.z), bperm(a, x.w)}; }
__device__ __forceinline__ v2u tr2(int a, v2u x) { return (v2u){bperm(a, x.x), bperm(a, x.y)}; }
#else
__device__ __forceinline__ LaneT lane_t(int fr, int fq) { LaneT t; t.tfr = fr; t.tfq = fq; t.pull = 0; t.push = 0; return t; }
__device__ __forceinline__ v4u tr4(int, v4u x) { return x; }
__device__ __forceinline__ v2u tr2(int, v2u x) { return x; }
#endif
__device__ __forceinline__ f32x4 tr4f(int a, f32x4 x) { return __builtin_bit_cast(f32x4, tr4(a, __builtin_bit_cast(v4u, x))); }
__device__ __forceinline__ v4u pack8(const f32x4& a, const f32x4& b) { return (v4u){pg8::cvt_pk_bf16(a[0], a[1]), pg8::cvt_pk_bf16(a[2], a[3]), pg8::cvt_pk_bf16(b[0], b[1]), pg8::cvt_pk_bf16(b[2], b[3])}; }

struct EpiSwiglu {
    static constexpr bool PERM = true; static constexpr int NS = 8;
    bf16* act;
    __device__ __forceinline__ bool operator()(AccT& acc, const Unit& u, int wr, int wc, int fr, int fq) const {
        asm volatile("" : "+s"(wr), "+s"(wc), "+v"(fr), "+v"(fq));
        const int row0 = u.pm * 256 + wr * 64 + fr + 16 * (fq & 1), col0 = u.pn * 128 + wc * 16 + 4 * (fq & 2);
#pragma unroll
        for (int ai = 0; ai < 2; ++ai)
#pragma unroll
            for (int mp = 0; mp < 2; ++mp) { bf16* rowp = act + (size_t)(row0 + ai * 128 + mp * 32) * DFF + col0;
#pragma unroll
                for (int bj = 0; bj < 2; ++bj) { unsigned pk[2][2];
#pragma unroll
                    for (int k = 0; k < 2; ++k) { const f32x4 g = acc[ai][bj][2 * mp + k][0], up = acc[ai][bj][2 * mp + k][1];
                        pk[k][0] = pg8::cvt_pk_bf16(siluf_(g[0]) * up[0], siluf_(g[1]) * up[1]); pk[k][1] = pg8::cvt_pk_bf16(siluf_(g[2]) * up[2], siluf_(g[3]) * up[3]); }
                    const auto sx = __builtin_amdgcn_permlane16_swap(pk[0][0], pk[1][0], false, false), sy = __builtin_amdgcn_permlane16_swap(pk[0][1], pk[1][1], false, false);
                    *(GAS v4u*)(rowp + bj * 64) = (v4u){sx[0], sy[0], sx[1], sy[1]}; } }
        return false;
    }
};

struct EpiResid {
    static constexpr bool PERM = true; static constexpr int NS = 16;
    unsigned char* ws; float ca, cb;
    __device__ __forceinline__ bool operator()(AccT& acc, const Unit& u, int wr, int wc, int fr, int fq) const {
        asm volatile("" : "+s"(wr), "+s"(wc), "+v"(fr), "+v"(fq));
        const LaneT t = lane_t(fr, fq);
        const bf16* src = (const bf16*)(ws + WS_HB); bf16* dst = (bf16*)(ws + WS_YB);
        const int row0 = u.pm * 256 + wr * 64 + t.tfr, col0 = u.pn * 256 + wc * 32 + 8 * t.tfq;
#pragma unroll
        for (int ai = 0; ai < 2; ++ai)
#pragma unroll
            for (int m = 0; m < 4; ++m) { const size_t off = (size_t)(row0 + ai * 128 + m * 16) * D + col0;
#pragma unroll
                for (int bj = 0; bj < 2; ++bj) { const v4u r = tr4(t.push, *(const GAS v4u*)(src + off + bj * 128));
                    const f32x4 y0 = (f32x4){bflo(r.x), bfhi(r.x), bflo(r.y), bfhi(r.y)} * ca + acc[ai][bj][m][0] * cb, y1 = (f32x4){bflo(r.z), bfhi(r.z), bflo(r.w), bfhi(r.w)} * ca + acc[ai][bj][m][1] * cb;
                    *(GAS v4u*)(dst + off + bj * 128) = tr4(t.pull, pack8(y0, y1)); } }
        return false;
    }
};

struct EpiGate {
    static constexpr bool PERM = true; static constexpr int NS = 0;
    unsigned char* ws;
    __device__ __forceinline__ bool operator()(AccT& acc, const Unit& u, int wr, int wc, int fr, int fq) const {
        asm volatile("" : "+s"(wr), "+s"(wc), "+v"(fr), "+v"(fq));
        const LaneT t = lane_t(fr, fq);
        const bf16* Gt = (const bf16*)(ws + WS_GT); bf16* mix = (bf16*)(ws + WS_MIX);
        const int n = u.pm / NPANEL, pm = u.pm - n * NPANEL, pn = u.pn & 3;
        const int row0 = pm * 256 + wr * 64 + t.tfr, col0 = pn * 256 + wc * 32 + 8 * t.tfq;
#pragma unroll
        for (int ai = 0; ai < 2; ++ai)
#pragma unroll
            for (int m = 0; m < 4; ++m) { const size_t r = (size_t)(row0 + ai * 128 + m * 16);
#pragma unroll
                for (int bj = 0; bj < 2; ++bj) {
                    const v4u ga = tr4(t.push, *(const GAS v4u*)(Gt + r * (3 * D) + n * D + col0 + bj * 128));
                    float f[8] = {bflo(ga.x), bfhi(ga.x), bflo(ga.y), bfhi(ga.y), bflo(ga.z), bfhi(ga.z), bflo(ga.w), bfhi(ga.w)};
                    if (n < 2) { const v4u gb = tr4(t.push, *(const GAS v4u*)(Gt + r * (3 * D) + (n + 1) * D + col0 + bj * 128));
                        const float h[8] = {bflo(gb.x), bfhi(gb.x), bflo(gb.y), bfhi(gb.y), bflo(gb.z), bfhi(gb.z), bflo(gb.w), bfhi(gb.w)};
#pragma unroll
                        for (int e = 0; e < 8; ++e) f[e] = f[e] * fast_rcp(fmaxf(h[e], 1e-30f)); }
                    f32x4 v0 = acc[ai][bj][m][0], v1 = acc[ai][bj][m][1];
                    v0 = v0 * (f32x4){f[0], f[1], f[2], f[3]}; v1 = v1 * (f32x4){f[4], f[5], f[6], f[7]};
                    acc[ai][bj][m][0] = v0; acc[ai][bj][m][1] = v1;
                    if (n == 2) *(GAS v4u*)(mix + r * D + col0 + bj * 128) = tr4(t.pull, pack8(v0, v1));
                } }
        return n < 2;
    }
};
struct Order3 : pg8::StaticOrder {
    __device__ __forceinline__ bool next(int i, Unit& u) const { Unit t; if (!pg8::StaticOrder::next(i / 3, t)) return false; const int k = i % 3; u.pm = t.pm + k * NPANEL; u.pn = t.pn + 4 * k; return true; }
};

struct SmallOrder {
    int c;
    __device__ __forceinline__ bool next(int i, Unit& u) const { if (i > 0 || c >= 8) return false; u.pm = 256 + (c >> 2); u.pn = c & 3; return true; }
    __device__ __forceinline__ void a_ready(const Unit&) const {}
    __device__ __forceinline__ void done(const Unit&) const {}
};

struct SmallOrderH {
    int c;
    __device__ __forceinline__ bool next(int i, Unit& u) const { if (i > 0 || c >= 16) return false; u.pm = 256 + ((c >> 2) & 1); u.pn = c & 3; return true; }
    __device__ __forceinline__ void a_ready(const Unit&) const {}
    __device__ __forceinline__ void done(const Unit&) const {}
};
struct EpiPart {
    static constexpr bool PERM = true; static constexpr int NS = 16;
    float* part;
    __device__ __forceinline__ bool operator()(AccT& acc, const Unit& u, int wr, int wc, int fr, int fq) const {
        asm volatile("" : "+s"(wr), "+s"(wc), "+v"(fr), "+v"(fq));
        float* p0 = part + (size_t)((u.pm - 256) * 256 + wr * 64 + fr) * D + u.pn * 256 + wc * 32 + 8 * fq;
#pragma unroll
        for (int ai = 0; ai < 2; ++ai)
#pragma unroll
            for (int m = 0; m < 4; ++m)
#pragma unroll
                for (int bj = 0; bj < 2; ++bj)
#pragma unroll
                    for (int n = 0; n < 2; ++n) *(GAS f32x4*)(p0 + (size_t)(ai * 128 + m * 16) * D + bj * 128 + 4 * n) = acc[ai][bj][m][n];
        return false;
    }
};

struct SmallOrder3 {
    int c;
    __device__ __forceinline__ bool next(int i, Unit& u) const { if (i > 2) return false; u.pm = 256 + (c >> 2) + i * NPANEL; u.pn = (c & 3) + 4 * i; return true; }
    __device__ __forceinline__ void a_ready(const Unit&) const {}
    __device__ __forceinline__ void done(const Unit&) const {}
};
struct SmallOrderW {
    int c;
    __device__ __forceinline__ bool next(int i, Unit& u) const { if (i > 0) return false; const int p = c >= 22 ? 1 : 0; u.pm = 256 + p; u.pn = c - 22 * p; return true; }
    __device__ __forceinline__ void a_ready(const Unit&) const {}
    __device__ __forceinline__ void done(const Unit&) const {}
};

struct EpiWin {
    static constexpr bool PERM = true; static constexpr int NS = 16;
    unsigned char* ws; float* out; int layer;
    __device__ __forceinline__ bool operator()(AccT& acc, const Unit& u, int wr, int wc, int fr, int fq) const {
        asm volatile("" : "+s"(wr), "+s"(wc), "+v"(fr), "+v"(fq));
        const LaneT t = lane_t(fr, fq);
        const int pn = u.pn, pm = u.pm, rl0 = wr * 64 + fr, trl0 = wr * 64 + t.tfr;
        if (pn < 4) {
            const bool isk = pn >= 2; bf16* dst = (bf16*)(ws + (isk ? WS_KR : WS_QR)); const float sc = isk ? 0.08838834764831845f : 1.0f;
            const float lgA = ret_lg2(2 * (pn & 1)) * (isk ? -1.f : 1.f), lgB = ret_lg2(2 * (pn & 1) + 1) * (isk ? -1.f : 1.f);
            float invf[4];
#pragma unroll
            for (int e = 0; e < 4; ++e) invf[e] = fast_exp2(-(float)(16 * wc + 4 * fq + e) * (13.287712379549449f / 64.0f)) * 0.15915494309189535f;
#pragma unroll
            for (int ai = 0; ai < 2; ++ai)
#pragma unroll
                for (int mp = 0; mp < 2; ++mp) { unsigned pk1[2][2][2], pk2[2][2][2];
#pragma unroll
                    for (int k = 0; k < 2; ++k) { const int rl = rl0 + ai * 128 + (2 * mp + k) * 16, r = pm * 256 + rl;
                        const float pos = (float)(pm < 256 ? NMETA + (r & (T - 1)) : (pm == 256 ? NMETA + PAST + (rl & (ST - 1)) : rl));
                        const float jp1 = (float)((pm < 256 ? (r & 63) : (pm == 256 ? (rl & (ST - 1)) : rl)) + 1);
                        const float dsc[2] = {sc * fast_exp2(jp1 * lgA), sc * fast_exp2(jp1 * lgB)};
                        f32x4 cs, sn;
#pragma unroll
                        for (int e = 0; e < 4; ++e) { float rev = pos * invf[e]; rev = rev - floorf(rev); cs[e] = __builtin_amdgcn_cosf(rev); sn[e] = __builtin_amdgcn_sinf(rev); }
#pragma unroll
                        for (int bj = 0; bj < 2; ++bj) { const f32x4 x1 = acc[ai][bj][2 * mp + k][0], x2 = acc[ai][bj][2 * mp + k][1];
                            const f32x4 o1 = (x1 * cs - x2 * sn) * dsc[bj], o2 = (x2 * cs + x1 * sn) * dsc[bj];
                            pk1[k][bj][0] = pg8::cvt_pk_bf16(o1[0], o1[1]); pk1[k][bj][1] = pg8::cvt_pk_bf16(o1[2], o1[3]);
                            pk2[k][bj][0] = pg8::cvt_pk_bf16(o2[0], o2[1]); pk2[k][bj][1] = pg8::cvt_pk_bf16(o2[2], o2[3]); } }
                    const size_t srow = (size_t)(pm * 256 + rl0 + ai * 128 + (2 * mp + (fq & 1)) * 16);
#pragma unroll
                    for (int bj = 0; bj < 2; ++bj) { bf16* rowp = dst + srow * 512 + (2 * (pn & 1) + bj) * 128 + 16 * wc + 4 * (fq & 2);
                        { const auto sx = __builtin_amdgcn_permlane16_swap(pk1[0][bj][0], pk1[1][bj][0], false, false), sy = __builtin_amdgcn_permlane16_swap(pk1[0][bj][1], pk1[1][bj][1], false, false);
                          *(GAS v4u*)rowp = (v4u){sx[0], sy[0], sx[1], sy[1]}; }
                        { const auto sx = __builtin_amdgcn_permlane16_swap(pk2[0][bj][0], pk2[1][bj][0], false, false), sy = __builtin_amdgcn_permlane16_swap(pk2[0][bj][1], pk2[1][bj][1], false, false);
                          *(GAS v4u*)(rowp + 64) = (v4u){sx[0], sy[0], sx[1], sy[1]}; } } }
            return false;
        }
        const int seg = (pn - 4) >> 2;
        const int colt = ((pn - 4) & 3) * 256 + wc * 32 + 8 * t.tfq;
        if (seg == 0 || seg == 1 || seg == 2 || seg >= 6) {
            bf16* dst = (bf16*)(ws + (seg == 0 ? WS_VR : seg == 1 ? WS_GR : seg == 2 ? WS_QS : WS_GT)); const int ld = seg >= 6 ? 3 * D : D; const int cofs = seg >= 6 ? (seg - 6) * D : 0;
#pragma unroll
            for (int ai = 0; ai < 2; ++ai)
#pragma unroll
                for (int m = 0; m < 4; ++m) { const size_t r = (size_t)(pm * 256 + trl0 + ai * 128 + m * 16);
#pragma unroll
                    for (int bj = 0; bj < 2; ++bj) { f32x4 v0 = acc[ai][bj][m][0], v1 = acc[ai][bj][m][1];
                        if (seg == 1) {
#pragma unroll
                            for (int e = 0; e < 4; ++e) { v0[e] = siluf_(v0[e]); v1[e] = siluf_(v1[e]); } }
                        else if (seg == 2) { v0 = v0 * (0.08838834764831845f * LOG2E); v1 = v1 * (0.08838834764831845f * LOG2E); }
                        else if (seg >= 6) {
#pragma unroll
                            for (int e = 0; e < 4; ++e) { v0[e] = sigmoidf_(v0[e]); v1[e] = sigmoidf_(v1[e]); } }
                        *(GAS v4u*)(dst + r * ld + cofs + colt + bj * 128) = tr4(t.pull, pack8(v0, v1)); } }
            return false;
        }
        if (seg == 3 || seg == 4) {
            bf16* dst = (bf16*)(ws + (seg == 3 ? WS_KS : WS_VS));
            float* op = out + (seg == 3 ? O_KP : O_VP) + (size_t)layer * NB * KT_PP * D;
            float* os = out + (seg == 3 ? O_KS : O_VS) + (size_t)layer * SBATCH * ST * D;
#pragma unroll
            for (int ai = 0; ai < 2; ++ai)
#pragma unroll
                for (int m = 0; m < 4; ++m) { const int rl = trl0 + ai * 128 + m * 16; const size_t r = (size_t)(pm * 256 + rl);
#pragma unroll
                    for (int bj = 0; bj < 2; ++bj) { const f32x4 v0 = tr4f(t.pull, acc[ai][bj][m][0]), v1 = tr4f(t.pull, acc[ai][bj][m][1]); const int c = colt + bj * 128;
                        *(GAS v4u*)(dst + r * D + c) = pack8(v0, v1);
                        if (pm < 256) { float* o = op + ((size_t)(r >> 11) * KT_PP + NMETA + (r & (T - 1))) * D + c; *(GAS f32x4*)o = v0; *(GAS f32x4*)(o + 4) = v1; }
                        else if (pm == 256) { float* o = os + (size_t)rl * D + c; *(GAS f32x4*)o = v0; *(GAS f32x4*)(o + 4) = v1; }
                        else if (rl < NMETA) { for (int bb = 0; bb < NB; ++bb) { float* o = op + ((size_t)bb * KT_PP + rl) * D + c; *(GAS f32x4*)o = v0; *(GAS f32x4*)(o + 4) = v1; } }
                    } }
            return false;
        }
        {
            float* op = out + O_PP + (size_t)layer * NB * PBUF * D;
            float* os = out + O_PS + (size_t)layer * SBATCH * PBUF * D;
#pragma unroll
            for (int ai = 0; ai < 2; ++ai)
#pragma unroll
                for (int m = 0; m < 4; ++m) { const int rl = trl0 + ai * 128 + m * 16; const size_t r = (size_t)(pm * 256 + rl);
#pragma unroll
                    for (int bj = 0; bj < 2; ++bj) { const f32x4 v0 = tr4f(t.pull, acc[ai][bj][m][0]), v1 = tr4f(t.pull, acc[ai][bj][m][1]); const int c = colt + bj * 128;
                        *(GAS v4u*)((bf16*)(ws + WS_U) + r * D + c) = pack8(v0, v1);
                        if (pm < 256) { const int tt = (int)(r & (T - 1)); if (tt >= T - PBUF) { float* o = op + ((size_t)(r >> 11) * PBUF + (tt - (T - PBUF))) * D + c; *(GAS f32x4*)o = v0; *(GAS f32x4*)(o + 4) = v1; } }
                        else if (pm == 256) { const int tt = rl & (ST - 1); if (tt >= ST - PBUF) { float* o = os + ((size_t)(rl >> 5) * PBUF + (tt - (ST - PBUF))) * D + c; *(GAS f32x4*)o = v0; *(GAS f32x4*)(o + 4) = v1; } }
                    } }
            return false;
        }
    }
};

__device__ __forceinline__ int grab(const Frame& F, gu32* ctr) {
    __syncthreads();
    if (F.wave == 0 && lane_lo_() == 0u) F.MISC[16] = __hip_atomic_fetch_add(ctr, 1u, RLX_AGENT);
    __syncthreads();
    return (int)F.MISC[16];
}
__device__ __forceinline__ unsigned grab_issue(const Frame& F, gu32* ctr) { return (F.wave == 0 && lane_lo_() == 0u) ? __hip_atomic_fetch_add(ctr, 1u, RLX_AGENT) : 0u; }
__device__ __forceinline__ int grab_publish(const Frame& F, unsigned nxt) {
    __syncthreads();
    if (F.wave == 0 && lane_lo_() == 0u) F.MISC[16] = nxt;
    __syncthreads();
    return (int)F.MISC[16];
}
typedef float f32x4_t __attribute__((ext_vector_type(4)));
#define MFMA16(a, b, c) __builtin_amdgcn_mfma_f32_16x16x32_bf16((a), (b), (c), 0, 0, 0)
__device__ __forceinline__ s16x4 tr16(const LAS unsigned char* p) { typedef short v4i16_t __attribute__((ext_vector_type(4))); return __builtin_bit_cast(s16x4, __builtin_amdgcn_ds_read_tr16_b64_v4i16((LAS v4i16_t*)p)); }

constexpr int RT_QS = 272, RT_VS = 528, RT_AS = 144;
constexpr int RT_Q = 0, RT_K = 64 * RT_QS, RT_V = 2 * 64 * RT_QS, RT_A = RT_V + 64 * RT_VS, RT_END = RT_A + 64 * RT_AS;
static_assert(RT_END <= RING_BYTES && 64 * 256 * 4 <= RT_END, "retention LDS map");
__device__ __forceinline__ float ret_lg2(int h) { return fast_log2(1.0f - fast_exp2(-5.0f - (float)h * (4.0f / 3.0f))); }
__device__ __forceinline__ void ret_unit(const Frame& F, int layer, int uid) {
    const int h = uid & 3; int stream, b;
    if (uid < 128) { stream = 0; b = uid >> 2; } else if (uid < 160) { stream = 1; b = (uid - 128) >> 2; } else { stream = 2; b = 0; }
    const TC tc = thread_coords(F.wave); const int tid = tc.tid, lane = tc.lane, w = tc.wave, l15 = lane & 15, g = lane >> 4, q4 = l15 >> 2, p4 = l15 & 3;
    const float lg2 = ret_lg2(h);
    const int nch = stream == 0 ? 1 + T / 64 : 1;
    f32x4 accS[8][2];
#pragma unroll
    for (int m = 0; m < 8; ++m)
#pragma unroll
        for (int n = 0; n < 2; ++n) accS[m][n] = (f32x4){0.f, 0.f, 0.f, 0.f};
    if (stream == 1) { const float* s0 = in_ptr(IN_SRET) + (((size_t)layer * SBATCH + b) * HRET + h) * DKR * DVR;
#pragma unroll
        for (int m = 0; m < 8; ++m)
#pragma unroll
            for (int n = 0; n < 2; ++n)
#pragma unroll
                for (int r = 0; r < 4; ++r) accS[m][n][r] = s0[(size_t)(16 * m + 4 * g + r) * DVR + 32 * w + 16 * n + l15]; }
    v4u qreg[2], kreg[2], vreg[4];
    const int lrow = tid >> 4, lch = tid & 15, vrow = tid >> 5, vch = tid & 31;
#define RT_CHUNK(c, rb, vl) do { if (stream == 0) { if ((c) == 0) { rb = ROW_M; vl = NMETA; } else { rb = b * T + 64 * ((c) - 1); vl = 64; } } \
        else if (stream == 1) { rb = ROW_S + b * ST; vl = ST; } else { rb = ROW_M; vl = NMETA; } } while (0)
#define RT_LOAD(c) do { int rb_, vl_; RT_CHUNK(c, rb_, vl_); \
        _Pragma("unroll") for (int i_ = 0; i_ < 2; ++i_) { const int r_ = lrow + 32 * i_; qreg[i_] = (v4u){0u, 0u, 0u, 0u}; kreg[i_] = (v4u){0u, 0u, 0u, 0u}; \
            if (r_ < vl_) { const size_t o_ = (size_t)(rb_ + r_) * 512 + h * 128 + lch * 8; qreg[i_] = *(const GAS v4u*)(WSB(F, WS_QR) + o_); kreg[i_] = *(const GAS v4u*)(WSB(F, WS_KR) + o_); } } \
        _Pragma("unroll") for (int i_ = 0; i_ < 4; ++i_) { const int r_ = vrow + 16 * i_; vreg[i_] = (v4u){0u, 0u, 0u, 0u}; \
            if (r_ < vl_) vreg[i_] = *(const GAS v4u*)(WSB(F, WS_VR) + (size_t)(rb_ + r_) * D + h * 256 + vch * 8); } } while (0)
    RT_LOAD(0);
    const LAS unsigned char* Ql = F.lds + RT_Q; const LAS unsigned char* Kl = F.lds + RT_K; const LAS unsigned char* Vl = F.lds + RT_V; const LAS unsigned char* Al = F.lds + RT_A;
    for (int c = 0; c < nch; ++c) {
        int rowbase, valid; RT_CHUNK(c, rowbase, valid);
        const bool write_out = !(stream == 0 && c == 0);
        const float dc = fast_exp2((float)valid * lg2);
        __syncthreads();
#pragma unroll
        for (int i = 0; i < 2; ++i) { *(LAS v4u*)(F.lds + RT_Q + (lrow + 32 * i) * RT_QS + lch * 16) = qreg[i]; *(LAS v4u*)(F.lds + RT_K + (lrow + 32 * i) * RT_QS + lch * 16) = kreg[i]; }
#pragma unroll
        for (int i = 0; i < 4; ++i) *(LAS v4u*)(F.lds + RT_V + (vrow + 16 * i) * RT_VS + vch * 16) = vreg[i];
        __syncthreads();
        if (c + 1 < nch) RT_LOAD(c + 1);
#pragma unroll
        for (int tt = 0; tt < 2; ++tt) { const int id = 2 * w + tt, mt = id >> 2, nt = id & 3;
            f32x4 a4 = (f32x4){0.f, 0.f, 0.f, 0.f};
            if (mt <= nt) {
#pragma unroll
                for (int ks = 0; ks < 4; ++ks) { const bf16x8 A = *(const LAS bf16x8*)(Kl + (16 * mt + l15) * RT_QS + 64 * ks + 16 * g); const bf16x8 B = *(const LAS bf16x8*)(Ql + (16 * nt + l15) * RT_QS + 64 * ks + 16 * g);
                    a4 = MFMA16(A, B, a4); }
#pragma unroll
                for (int r = 0; r < 4; ++r) a4[r] = (16 * mt + 4 * g + r <= 16 * nt + l15) ? a4[r] : 0.f;
            }
            *(LAS v2u*)(F.lds + RT_A + (16 * nt + l15) * RT_AS + (16 * mt + 4 * g) * 2) = (v2u){pg8::cvt_pk_bf16(a4[0], a4[1]), pg8::cvt_pk_bf16(a4[2], a4[3])}; }
        __syncthreads();
        f32x4 accO[4][2];
#pragma unroll
        for (int m = 0; m < 4; ++m)
#pragma unroll
            for (int n = 0; n < 2; ++n) accO[m][n] = (f32x4){0.f, 0.f, 0.f, 0.f};
#pragma unroll
        for (int ks = 0; ks < 4; ++ks) {
            bf16x8 Sf[2];
#pragma unroll
            for (int n = 0; n < 2; ++n) Sf[n] = __builtin_bit_cast(bf16x8, (v4u){pg8::cvt_pk_bf16(accS[2 * ks][n][0], accS[2 * ks][n][1]), pg8::cvt_pk_bf16(accS[2 * ks][n][2], accS[2 * ks][n][3]),
                                                                               pg8::cvt_pk_bf16(accS[2 * ks + 1][n][0], accS[2 * ks + 1][n][1]), pg8::cvt_pk_bf16(accS[2 * ks + 1][n][2], accS[2 * ks + 1][n][3])});
#pragma unroll
            for (int m = 0; m < 4; ++m) { const v2u lo = *(const LAS v2u*)(Ql + (16 * m + l15) * RT_QS + (32 * ks + 4 * g) * 2), hi = *(const LAS v2u*)(Ql + (16 * m + l15) * RT_QS + (32 * ks + 16 + 4 * g) * 2);
                const bf16x8 A = __builtin_bit_cast(bf16x8, (v4u){lo.x, lo.y, hi.x, hi.y});
#pragma unroll
                for (int n = 0; n < 2; ++n) accO[m][n] = MFMA16(A, Sf[n], accO[m][n]); }
        }
        bf16x8 Bv[2][2];
#pragma unroll
        for (int k2 = 0; k2 < 2; ++k2)
#pragma unroll
            for (int n = 0; n < 2; ++n) { const s16x4 lo = tr16(Vl + (32 * k2 + 8 * g + q4) * RT_VS + (32 * w + 16 * n + 4 * p4) * 2), hi = tr16(Vl + (32 * k2 + 8 * g + 4 + q4) * RT_VS + (32 * w + 16 * n + 4 * p4) * 2);
                Bv[k2][n] = __builtin_shufflevector(lo, hi, 0, 1, 2, 3, 4, 5, 6, 7); }
#pragma unroll
        for (int k2 = 0; k2 < 2; ++k2)
#pragma unroll
            for (int m = 0; m < 4; ++m) { const bf16x8 A = *(const LAS bf16x8*)(Al + (16 * m + l15) * RT_AS + (32 * k2 + 8 * g) * 2);
#pragma unroll
                for (int n = 0; n < 2; ++n) accO[m][n] = MFMA16(A, Bv[k2][n], accO[m][n]); }
#pragma unroll
        for (int m = 0; m < 8; ++m)
#pragma unroll
            for (int k2 = 0; k2 < 2; ++k2) { const s16x4 lo = tr16(Kl + (32 * k2 + 8 * g + q4) * RT_QS + (16 * m + 4 * p4) * 2), hi = tr16(Kl + (32 * k2 + 8 * g + 4 + q4) * RT_QS + (16 * m + 4 * p4) * 2);
                const bf16x8 A = __builtin_shufflevector(lo, hi, 0, 1, 2, 3, 4, 5, 6, 7);
#pragma unroll
                for (int n = 0; n < 2; ++n) accS[m][n] = MFMA16(A, Bv[k2][n], accS[m][n]); }
#pragma unroll
        for (int m = 0; m < 8; ++m)
#pragma unroll
            for (int n = 0; n < 2; ++n) accS[m][n] = accS[m][n] * dc;
        if (write_out) {
            __syncthreads();
            LAS float* oL = (LAS float*)F.lds;
#pragma unroll
            for (int m = 0; m < 4; ++m)
#pragma unroll
                for (int n = 0; n < 2; ++n)
#pragma unroll
                    for (int r = 0; r < 4; ++r) oL[(16 * m + 4 * g + r) * 256 + 32 * w + 16 * n + l15] = accO[m][n][r];
            __syncthreads();
            const f32x4 gn = *(const GAS f32x4*)(in_ptr(IN_RETG) + ((size_t)layer * HRET + h) * DVR + lane * 4);
#pragma unroll
            for (int hb2 = 0; hb2 < 2; ++hb2) {
            f32x4 x[4]; v2u gr[4]; float s1[4], s2[4];
#pragma unroll
            for (int tt = 0; tt < 4; ++tt) { const int t = w * 8 + hb2 * 4 + tt; x[tt] = *(const LAS f32x4*)(oL + t * 256 + lane * 4); gr[tt] = *(const GAS v2u*)(WSB(F, WS_GR) + (size_t)(rowbase + t) * D + h * 256 + lane * 4);
                s1[tt] = (x[tt][0] + x[tt][1]) + (x[tt][2] + x[tt][3]); }
#pragma unroll
            for (int o = 1; o < 64; o <<= 1)
#pragma unroll
                for (int tt = 0; tt < 4; ++tt) s1[tt] += __shfl_xor(s1[tt], o);
#pragma unroll
            for (int tt = 0; tt < 4; ++tt) { x[tt] = x[tt] - s1[tt] * (1.f / 256.f); s2[tt] = (x[tt][0] * x[tt][0] + x[tt][1] * x[tt][1]) + (x[tt][2] * x[tt][2] + x[tt][3] * x[tt][3]); }
#pragma unroll
            for (int o = 1; o < 64; o <<= 1)
#pragma unroll
                for (int tt = 0; tt < 4; ++tt) s2[tt] += __shfl_xor(s2[tt], o);
#pragma unroll
            for (int tt = 0; tt < 4; ++tt) { const int t = w * 8 + hb2 * 4 + tt; const float rstd = 1.f / sqrtf(s2[tt] * (1.f / 256.f) + LN_EPS);
                const f32x4 y = x[tt] * rstd * gn * (f32x4){bflo(gr[tt].x), bfhi(gr[tt].x), bflo(gr[tt].y), bfhi(gr[tt].y)};
                if (t < valid) *(GAS v2u*)(WSB(F, WS_BR) + (size_t)(rowbase + t) * D + h * 256 + lane * 4) = (v2u){pk2(y[0], y[1]), pk2(y[2], y[3])}; }
            }
        }
    }
#undef RT_LOAD
#undef RT_CHUNK
    if (stream != 2) { float* d = F.out + (stream == 0 ? O_RP + (((size_t)layer * NB + b) * HRET + h) * DKR * DVR : O_RS + (((size_t)layer * SBATCH + b) * HRET + h) * DKR * DVR);
#pragma unroll
        for (int m = 0; m < 8; ++m)
#pragma unroll
            for (int n = 0; n < 2; ++n)
#pragma unroll
                for (int r = 0; r < 4; ++r) d[(size_t)(16 * m + 4 * g + r) * DVR + 32 * w + 16 * n + l15] = accS[m][n][r]; }
}

constexpr int AT_RS = 272;
constexpr int AT_VOFF = 64 * AT_RS;
constexpr int AT_QOFF = 36864;
static_assert(AT_QOFF >= 2 * 64 * AT_RS && AT_QOFF + 8 * 8 * 1024 <= RING_BYTES, "attention LDS map");
template <bool F32KV> __device__ __forceinline__ void attn_unit(const Frame& F, int layer, int uid) {
    int stream, b, h, qb;
    if (uid < 64) { stream = 1; b = uid >> 3; h = uid & 7; qb = 0; }
    else if (uid < 64 + 2048) { const int idx = uid - 64; qb = 7 - (idx >> 8); b = (idx & 255) >> 3; h = idx & 7; stream = 0; }
    else { stream = 2; b = 0; h = (uid - (64 + 2048)) & 7; qb = 0; }
    const bf16 *k0p = nullptr, *k1p = nullptr, *v0p = nullptr, *v1p = nullptr; const float *k0f = nullptr, *k1f = nullptr, *v0f = nullptr, *v1f = nullptr; int len0, Tq, rowbase;
    if (stream == 0) { k0p = WSB(F, WS_KS) + (size_t)ROW_M * D; v0p = WSB(F, WS_VS) + (size_t)ROW_M * D; len0 = NMETA; k1p = WSB(F, WS_KS) + (size_t)b * T * D; v1p = WSB(F, WS_VS) + (size_t)b * T * D; Tq = T; rowbase = b * T; }
    else if (stream == 1) { k0f = in_ptr(IN_CK) + ((size_t)layer * SBATCH + b) * PAST * D; v0f = in_ptr(IN_CV) + ((size_t)layer * SBATCH + b) * PAST * D; len0 = PAST;
        k1f = F.out + O_KS + ((size_t)layer * SBATCH + b) * ST * D; v1f = F.out + O_VS + ((size_t)layer * SBATCH + b) * ST * D; Tq = ST; rowbase = ROW_S + b * ST; }
    else { k0p = k1p = WSB(F, WS_KS) + (size_t)ROW_M * D; v0p = v1p = WSB(F, WS_VS) + (size_t)ROW_M * D; len0 = 0; Tq = NMETA; rowbase = ROW_M; }
    constexpr int NQ = F32KV ? 1 : 2, QPW = 16 * NQ, QBLK = 8 * QPW;
    const int Stot = len0 + Tq, q0 = qb * QBLK;
    const TC tc = thread_coords(F.wave); const int tid = tc.tid, lane = tc.lane, w = tc.wave, l15 = lane & 15, g = lane >> 4;
    int qi[NQ]; bool valid_q[NQ]; int lim[NQ];
#pragma unroll
    for (int nb = 0; nb < NQ; ++nb) { qi[nb] = q0 + 16 * (NQ == 2 ? (nb == 0 ? w : 15 - w) : w) + l15; valid_q[nb] = qi[nb] < Tq; lim[nb] = len0 + qi[nb]; }
    bf16x8 qf[NQ][4];
#pragma unroll
    for (int nb = 0; nb < NQ; ++nb)
#pragma unroll
    for (int ks = 0; ks < 4; ++ks) { v4u t4 = (v4u){0u, 0u, 0u, 0u}; if (valid_q[nb]) t4 = *(const GAS v4u*)(WSB(F, WS_QS) + (size_t)(rowbase + qi[nb]) * D + h * 128 + 32 * ks + 8 * g); qf[nb][ks] = __builtin_bit_cast(bf16x8, t4); }
    float zq[NQ];
#pragma unroll
    for (int nb = 0; nb < NQ; ++nb) zq[nb] = 64.0f;
    f32x4 o[NQ][8];
#pragma unroll
    for (int nb = 0; nb < NQ; ++nb)
#pragma unroll
    for (int i = 0; i < 8; ++i) o[nb][i] = (f32x4){0.f, 0.f, 0.f, 0.f};
    float R[NQ]; bool anyv_ = false;
#pragma unroll
    for (int nb = 0; nb < NQ; ++nb) { R[nb] = 0.f; anyv_ = anyv_ || valid_q[nb]; }
    bool done1 = false;
    bool wave_done = __all(!anyv_) != 0;
    const int qend = (q0 + QBLK < Tq) ? q0 + QBLK : Tq;
    const int kt_max = (len0 + qend - 2) >> 6;
    const int lrow = tid >> 4, lch = tid & 15;
    constexpr int NR = F32KV ? 4 : 2;
    constexpr int DIST = F32KV ? 1 : 2;
    v4u kregA[NR], vregA[NR], kregB[NR], vregB[NR];
#define AT_LOAD(kt, KR, VR) do { _Pragma("unroll") for (int i_ = 0; i_ < 2; ++i_) { int s_ = ((kt) > 0 ? (kt) : 0) * 64 + lrow + 32 * i_; s_ = s_ < Stot ? s_ : Stot - 1; \
        const size_t off_ = (s_ < len0 ? (size_t)s_ : (size_t)(s_ - len0)) * D + h * 128 + lch * 8; \
        if constexpr (F32KV) { const float* kp_ = (s_ < len0 ? k0f : k1f) + off_; const float* vp_ = (s_ < len0 ? v0f : v1f) + off_; \
            asm volatile("global_load_dwordx4 %0, %1, off" : "=&v"(KR[2 * i_]) : "v"(kp_) : "memory"); asm volatile("global_load_dwordx4 %0, %1, off offset:16" : "=&v"(KR[2 * i_ + 1]) : "v"(kp_) : "memory"); \
            asm volatile("global_load_dwordx4 %0, %1, off" : "=&v"(VR[2 * i_]) : "v"(vp_) : "memory"); asm volatile("global_load_dwordx4 %0, %1, off offset:16" : "=&v"(VR[2 * i_ + 1]) : "v"(vp_) : "memory"); } \
        else { const bf16* kp_ = (s_ < len0 ? k0p : k1p) + off_; const bf16* vp_ = (s_ < len0 ? v0p : v1p) + off_; \
            asm volatile("global_load_dwordx4 %0, %1, off" : "=&v"(KR[i_]) : "v"(kp_) : "memory"); asm volatile("global_load_dwordx4 %0, %1, off" : "=&v"(VR[i_]) : "v"(vp_) : "memory"); } } } while (0)
    AT_LOAD(kt_max, kregA, vregA);
    if constexpr (!F32KV) AT_LOAD(kt_max - 1, kregB, vregB);
    const LAS unsigned char* Ql = F.lds + AT_QOFF + w * (NQ * 4096);
#pragma unroll
    for (int nb = 0; nb < NQ; ++nb)
#pragma unroll
        for (int ks = 0; ks < 4; ++ks) *(LAS v4u*)(F.lds + AT_QOFF + w * (NQ * 4096) + ((nb * 4 + ks) * 64 + lane) * 16) = __builtin_bit_cast(v4u, qf[nb][ks]);
    const LAS unsigned char* Kl = F.lds; const LAS unsigned char* Vl = F.lds + AT_VOFF;
    const int q4 = l15 >> 2, p4 = l15 & 3;
#define AT_BODY(NB0_, NB1_) { \
        f32x4 z[NQ][4]; \
        _Pragma("unroll") \
        for (int mt = 0; mt < 4; ++mt) { _Pragma("unroll") for (int nb = (NB0_); nb < (NB1_); ++nb) z[nb][mt] = (f32x4){0.f, 0.f, 0.f, 0.f}; } \
        _Pragma("unroll") \
        for (int ks = 0; ks < 4; ++ks) { bf16x8 qa[NQ]; _Pragma("unroll") for (int nb = (NB0_); nb < (NB1_); ++nb) qa[nb] = *(const LAS bf16x8*)(Ql + ((nb * 4 + ks) * 64 + lane) * 16); \
        _Pragma("unroll") \
            for (int mt = 0; mt < 4; ++mt) { const bf16x8 a = *(const LAS bf16x8*)(Kl + (16 * mt + l15) * AT_RS + 64 * ks + 16 * g); _Pragma("unroll") for (int nb = (NB0_); nb < (NB1_); ++nb) z[nb][mt] = MFMA16(a, qa[nb], z[nb][mt]); } } \
        bf16x8 pf[NQ][2]; \
        _Pragma("unroll") \
        for (int nb = (NB0_); nb < (NB1_); ++nb) { \
        bf16x8 triA, triB, ones; \
        _Pragma("unroll") \
        for (int e = 0; e < 8; ++e) { const int jl = 16 * (e >> 2) + 4 * g + (e & 3); triA[e] = (short)(jl >= l15 ? 0x3f80 : 0); triB[e] = (short)(jl >= l15 + 16 ? 0x3f80 : 0); ones[e] = (short)0x3f80; } \
        f32x4 sp[4]; \
        if (need_mask) { \
        _Pragma("unroll") \
            for (int mt = 0; mt < 4; ++mt) \
        _Pragma("unroll") \
                for (int r = 0; r < 4; ++r) { const bool vis = (tb + 16 * mt + 4 * g + r) < lim[nb]; const float zz = fminf(z[nb][mt][r], 80.f); z[nb][mt][r] = vis ? zz : -1.0e30f; \
                    sp[mt][r] = vis ? fast_log2(1.0f + fast_exp2(zz)) : 0.f; } \
        } else { \
        _Pragma("unroll") \
            for (int mt = 0; mt < 4; ++mt) \
        _Pragma("unroll") \
                for (int r = 0; r < 4; ++r) { const float zz = fminf(z[nb][mt][r], 80.f); z[nb][mt][r] = zz; sp[mt][r] = fast_log2(1.0f + fast_exp2(zz)); } \
        } \
        bf16x8 spf[2]; \
        _Pragma("unroll") \
        for (int k2 = 0; k2 < 2; ++k2) spf[k2] = __builtin_bit_cast(bf16x8, (v4u){pg8::cvt_pk_bf16(sp[2 * k2][0], sp[2 * k2][1]), pg8::cvt_pk_bf16(sp[2 * k2][2], sp[2 * k2][3]), \
                                                                                  pg8::cvt_pk_bf16(sp[2 * k2 + 1][0], sp[2 * k2 + 1][1]), pg8::cvt_pk_bf16(sp[2 * k2 + 1][2], sp[2 * k2 + 1][3])}); \
        const f32x4 zero4 = (f32x4){0.f, 0.f, 0.f, 0.f}; \
        f32x4 I0 = MFMA16(triA, spf[0], zero4); I0 = MFMA16(ones, spf[1], I0); \
        f32x4 I1 = MFMA16(triB, spf[0], zero4); I1 = MFMA16(ones, spf[1], I1); \
        f32x4 I2 = MFMA16(triA, spf[1], zero4); \
        f32x4 I3 = MFMA16(triB, spf[1], zero4); \
        f32x4 tot = MFMA16(ones, spf[0], zero4); tot = MFMA16(ones, spf[1], tot); \
        const f32x4 II[4] = {I0, I1, I2, I3}; \
        f32x4 wv[4]; \
        _Pragma("unroll") \
        for (int mt = 0; mt < 4; ++mt) \
        _Pragma("unroll") \
            for (int r = 0; r < 4; ++r) wv[mt][r] = fast_exp2(z[nb][mt][r] - II[mt][r] - R[nb]); \
        _Pragma("unroll") \
        for (int k2 = 0; k2 < 2; ++k2) pf[nb][k2] = __builtin_bit_cast(bf16x8, (v4u){pg8::cvt_pk_bf16(wv[2 * k2][0], wv[2 * k2][1]), pg8::cvt_pk_bf16(wv[2 * k2][2], wv[2 * k2][3]), \
                                                                                 pg8::cvt_pk_bf16(wv[2 * k2 + 1][0], wv[2 * k2 + 1][1]), pg8::cvt_pk_bf16(wv[2 * k2 + 1][2], wv[2 * k2 + 1][3])}); \
        R[nb] += tot[0]; \
        } \
        _Pragma("unroll") \
        for (int mt8 = 0; mt8 < 8; ++mt8) \
        _Pragma("unroll") \
            for (int k2 = 0; k2 < 2; ++k2) { \
                const s16x4 lo = tr16(Vl + (32 * k2 + 4 * g + q4) * AT_RS + (16 * mt8 + 4 * p4) * 2); \
                const s16x4 hi = tr16(Vl + (32 * k2 + 16 + 4 * g + q4) * AT_RS + (16 * mt8 + 4 * p4) * 2); \
                const bf16x8 a = __builtin_shufflevector(lo, hi, 0, 1, 2, 3, 4, 5, 6, 7); \
                _Pragma("unroll") for (int nb = (NB0_); nb < (NB1_); ++nb) o[nb][mt8] = MFMA16(a, pf[nb][k2], o[nb][mt8]); } \
        }
#define AT_ITER(KT_, KR_, VR_) { const int kt = (KT_); \
        __syncthreads(); \
        if (kt < kt_max) { unsigned allok = 1u; \
        _Pragma("unroll") \
            for (int i = 0; i < 8; ++i) allok &= F.MISC[24 + i]; \
            if (allok) break; } \
        if constexpr (F32KV) asm volatile("s_waitcnt vmcnt(0)" : "+v"(KR_[0]), "+v"(VR_[0]), "+v"(KR_[1]), "+v"(VR_[1]), "+v"(KR_[NR - 2]), "+v"(VR_[NR - 2]), "+v"(KR_[NR - 1]), "+v"(VR_[NR - 1]) :: "memory"); \
        else asm volatile("s_waitcnt vmcnt(4)" : "+v"(KR_[0]), "+v"(VR_[0]), "+v"(KR_[1]), "+v"(VR_[1]) :: "memory");     \
        _Pragma("unroll") \
        for (int i = 0; i < 2; ++i) { const bool in_ = (kt * 64 + lrow + 32 * i) < Stot; const v4u z4_ = (v4u){0u, 0u, 0u, 0u}; v4u kk_, vv_; \
            if constexpr (F32KV) { kk_ = pack8(__builtin_bit_cast(f32x4, KR_[(2 * i) % NR]), __builtin_bit_cast(f32x4, KR_[(2 * i + 1) % NR])); vv_ = pack8(__builtin_bit_cast(f32x4, VR_[(2 * i) % NR]), __builtin_bit_cast(f32x4, VR_[(2 * i + 1) % NR])); } \
            else { kk_ = KR_[i % NR]; vv_ = VR_[i % NR]; } \
            *(LAS v4u*)(F.lds + (lrow + 32 * i) * AT_RS + lch * 16) = in_ ? kk_ : z4_; *(LAS v4u*)(F.lds + AT_VOFF + (lrow + 32 * i) * AT_RS + lch * 16) = in_ ? vv_ : z4_; } \
        __syncthreads(); \
        AT_LOAD(kt - DIST, KR_, VR_); \
        const int tb = kt * 64; \
        const int lim_lo = len0 + q0 + 16 * w, lim_hi = NQ == 2 ? len0 + q0 + 16 * (15 - w) : lim_lo;      \
        const bool act0 = tb < lim_lo + 15, act1 = tb < lim_hi + 15;                                           \
        if (!wave_done && act1 && (act0 || !done1)) { \
        const bool need_mask = (tb + 64 > (act0 ? lim_lo : lim_hi)); \
        if (NQ == 2 && !act0) AT_BODY(NQ - 1, NQ) else if (NQ == 2 && done1) AT_BODY(0, 1) else AT_BODY(0, NQ)        \
        { bool dn_ = true; _Pragma("unroll") for (int nb = 0; nb < NQ; ++nb) dn_ = dn_ && ((!valid_q[nb]) || (R[nb] > zq[nb])); wave_done = __all(dn_) != 0; if constexpr (NQ == 2) done1 = __all((!valid_q[NQ - 1]) || (R[NQ - 1] > zq[NQ - 1])) != 0; } \
        } \
        if (lane == 0) F.MISC[24 + w] = wave_done ? 1u : 0u; \
    }
    for (int kt2 = kt_max; kt2 >= 0; kt2 -= 2) {
        AT_ITER(kt2, kregA, vregA)
        if (kt2 == 0) break;
        if constexpr (F32KV) { AT_ITER(kt2 - 1, kregA, vregA) } else { AT_ITER(kt2 - 1, kregB, vregB) }
    }
#undef AT_ITER
#undef AT_BODY
    if constexpr (F32KV) asm volatile("s_waitcnt vmcnt(0)" : "+v"(kregA[0]), "+v"(vregA[0]), "+v"(kregA[1]), "+v"(vregA[1]), "+v"(kregA[NR - 2]), "+v"(vregA[NR - 2]), "+v"(kregA[NR - 1]), "+v"(vregA[NR - 1]) :: "memory");
    else asm volatile("s_waitcnt vmcnt(0)" : "+v"(kregA[0]), "+v"(vregA[0]), "+v"(kregA[1]), "+v"(vregA[1]), "+v"(kregB[0]), "+v"(vregB[0]), "+v"(kregB[1]), "+v"(vregB[1]) :: "memory");
#undef AT_LOAD
#pragma unroll
    for (int nb = 0; nb < NQ; ++nb)
    if (valid_q[nb]) { bf16* orow = WSB(F, WS_BR) + (size_t)M_PAD * D + (size_t)(rowbase + qi[nb]) * D + h * 128 + 4 * g;
#pragma unroll
        for (int mt8 = 0; mt8 < 8; ++mt8) *(GAS v2u*)(orow + 16 * mt8) = (v2u){pg8::cvt_pk_bf16(o[nb][mt8][0], o[nb][mt8][1]), pg8::cvt_pk_bf16(o[nb][mt8][2], o[nb][mt8][3])}; }
}

__device__ __forceinline__ void pool_row(const Frame& F, int layer, int stream, int b, int rowbase, int tp, int ch, float (&v)[8]) {
    if (tp >= 0 || stream == 0) { const size_t row = tp >= 0 ? (size_t)(rowbase + tp) : (size_t)(ROW_M + NMETA + tp);
        const v4u x = *(const GAS v4u*)(WSB(F, WS_U) + row * D + ch * 8);
        v[0] = bflo(x.x); v[1] = bfhi(x.x); v[2] = bflo(x.y); v[3] = bfhi(x.y); v[4] = bflo(x.z); v[5] = bfhi(x.z); v[6] = bflo(x.w); v[7] = bfhi(x.w); }
    else if (stream == 1) { const float* sp = in_ptr(IN_SPOOL) + (((size_t)layer * SBATCH + b) * PBUF + (PBUF + tp)) * D + ch * 8;
        const f32x4 a = *(const GAS f32x4*)sp, c = *(const GAS f32x4*)(sp + 4);
        v[0] = a[0]; v[1] = a[1]; v[2] = a[2]; v[3] = a[3]; v[4] = c[0]; v[5] = c[1]; v[6] = c[2]; v[7] = c[3]; }
    else {
#pragma unroll
        for (int e = 0; e < 8; ++e) v[e] = 0.f; }
}
__device__ __forceinline__ void pool_unit(const Frame& F, int layer, int uid) {
    int stream, b, t0, Tlen, rowbase;
    if (uid < 1024) { stream = 0; b = uid >> 5; t0 = (uid & 31) * 64; Tlen = T; rowbase = b * T; }
    else if (uid < 1032) { stream = 1; b = uid - 1024; t0 = 0; Tlen = ST; rowbase = ROW_S + b * ST; }
    else { stream = 2; b = 0; t0 = 0; Tlen = NMETA; rowbase = ROW_M; }
    const TC tc = thread_coords(F.wave); const int ch = tc.tid & 127, tsub = tc.tid >> 7, win = 2 << (ch >> 5);
    const int ts = t0 + tsub * 16; if (ts >= Tlen) return;
    float acc[8];
#pragma unroll
    for (int e = 0; e < 8; ++e) acc[e] = 0.f;
#pragma unroll
    for (int j = 1; j < 16; ++j) if (j < win) { float v[8]; pool_row(F, layer, stream, b, rowbase, ts - j, ch, v);
#pragma unroll
        for (int e = 0; e < 8; ++e) acc[e] += v[e]; }
#pragma unroll 4
    for (int tt = 0; tt < 16; ++tt) {
        const int t = ts + tt;
        float vn[8], vo[8]; pool_row(F, layer, stream, b, rowbase, t, ch, vn);
        if (tt > 0) pool_row(F, layer, stream, b, rowbase, t - win, ch, vo);
#pragma unroll
        for (int e = 0; e < 8; ++e) acc[e] += vn[e] - (tt > 0 ? vo[e] : 0.f);
        const int have = (stream == 2) ? (t + 1 < win ? t + 1 : win) : win;
        const float inv = 1.0f / (float)have;
        float y[8];
#pragma unroll
        for (int e = 0; e < 8; ++e) y[e] = acc[e] * inv - vn[e];
        *(GAS v4u*)(WSB(F, WS_BR) + (size_t)2 * M_PAD * D + (size_t)(rowbase + t) * D + ch * 8) = (v4u){pk2(y[0], y[1]), pk2(y[2], y[3]), pk2(y[4], y[5]), pk2(y[6], y[7])};
    }
}

struct Args { const float* in[19]; float* out; unsigned char* ws; };

__device__ __forceinline__ int opq(int x) { asm volatile("" : "+s"(x)); return x; }

constexpr int CH_TOTAL = 25;
__device__ __forceinline__ int ch_stage(int ci) { return ci < 8 ? 1 : ci < 16 ? 2 : 3; }
__device__ __forceinline__ int ch_first(int s) { return s == 1 ? 0 : s == 2 ? 8 : s == 3 ? 16 : CH_TOTAL; }
__device__ __forceinline__ unsigned ch_cnt(int s) { return s == 0 ? 117u : s == 3 ? 9u : 8u; }
__device__ __forceinline__ void chain_signal(const Frame& F, gu32* ch, int s) {
    asm volatile("s_waitcnt vmcnt(0)" ::: "memory");
    __syncthreads();
    if (F.wave == 0 && lane_lo_() == 0u) {
        __builtin_amdgcn_fence(__ATOMIC_RELEASE, "agent");
        asm volatile("s_waitcnt vmcnt(0)" ::: "memory");
        const unsigned old = __hip_atomic_fetch_add(ch + 64 * (2 + s), 1u, RLX_AGENT);
        if (old + 1u == ch_cnt(s) && s < 3) __hip_atomic_store(ch + 64, (unsigned)ch_first(s + 2), RLX_AGENT);
    }
}
__device__ __forceinline__ void chain_item(const Frame& F, int l, gu32* ch, int ci) {
    const int s = ch_stage(ci);
    if (s == 1) { pg8::Gemm g{WSB(F, WS_BR), lw(F, l, LW_BR), 3 * M_PAD, 3 * D, D}; SmallOrder3 S{ci}; EpiGate E{F.ws};
        pg8::gemm_phase<EpiGate, SmallOrder3, true, true>(F.lds, g, S, E, F.wave); }
    else if (s == 2) { pg8::Gemm g{WSB(F, WS_MIX), lw(F, l, LW_OUT), M_PAD, D, D}; SmallOrder S{ci - 8}; EpiResid E{F.ws, ALPHA, 1.0f};
        pg8::gemm_phase<EpiResid, SmallOrder, true, true>(F.lds, g, S, E, F.wave); }
    else { const int i = ci - 16; ln_rows(F, l * 3 + 1, false, MP + 32 * i, MP + 32 * i + 32, 0, 8); }
    chain_signal(F, ch, s);
}
__device__ __forceinline__ int mq_count(int kq) { return kq == 0 ? 164 : kq == 1 ? 9 : kq == 2 ? 64 : kq == 3 ? 2056 : 1024; }

__global__ void __launch_bounds__(512, 2) mega_fwd(Args args) {
    extern __shared__ __attribute__((aligned(16))) unsigned char lds[];
    Frame F;
    F.lds = (LAS unsigned char*)lds;
    F.MISC = (volatile LAS unsigned*)(F.lds + MISC_OFF);
    F.G = gridDim.x; F.wave = __builtin_amdgcn_readfirstlane((int)threadIdx.x >> 6);
    F.ws = args.ws; F.out = args.out; F.ctl = (gu32*)(args.ws + WS_CTL);
    for (int u = threadIdx.x; u < (LDS_BYTES - LDSCTL_OFF) / 4; u += 512) ((LAS unsigned*)(F.lds + LDSCTL_OFF))[u] = 0u;
    __syncthreads();
    XcdBarrier bar = xcd_barrier_post((unsigned*)(F.ctl + CW_BAR), F.MISC + 8);
#define GRID_BAR() xcd_barrier(bar)

    p0_prologue(F);

    GRID_BAR();

    for (int l = 0; l < DEPTH; ++l) {
        { pg8::Gemm g{WSB(F, WS_HB), lw(F, l, LW_UP1), M_PAD, 2 * DFF, D}; pg8::StaticOrder S; S.init(M_PAD, 2 * DFF, opq(F.G), opq((int)blockIdx.x)); EpiSwiglu E{WSB(F, WS_ACT)};
          pg8::gemm_phase<EpiSwiglu, pg8::StaticOrder, true, true>(F.lds, g, S, E, F.wave); }

        GRID_BAR();
        { pg8::Gemm g{WSB(F, WS_ACT), lw(F, l, LW_DN1), M_PAD, D, DFF}; pg8::StaticOrder S; S.init(MP, D, opq(F.G), opq((int)blockIdx.x));
          EpiResid E{F.ws, ALPHA, 0.5f};
          pg8::gemm_phase<EpiResid, pg8::StaticOrder, true, true>(F.lds, g, S, E, F.wave); }

        GRID_BAR();
        if (blockIdx.x < 16) { const int kh = opq((int)blockIdx.x) >> 3; pg8::Gemm g{WSB(F, WS_ACT) + kh * (DFF / 2), lw(F, l, LW_DN1) + kh * (DFF / 2), M_PAD, D, DFF / 2, DFF}; SmallOrderH S{opq((int)blockIdx.x)};
            EpiPart E{(float*)WSB(F, WS_ACT) + (size_t)kh * 512 * D};
            pg8::gemm_phase<EpiPart, SmallOrderH, true, true>(F.lds, g, S, E, F.wave); }
        else ln_phase(F, l * 3 + 0, false, 0, MP, 16);
        GRID_BAR();
        ln_phase(F, l * 3 + 0, false, MP, M_PAD, 0, true);
        GRID_BAR();
        { pg8::Gemm g{WSB(F, WS_HB), lw(F, l, LW_IN), M_PAD, DIN, D}; pg8::StaticOrder S; S.init(M_PAD, DIN, opq(F.G), opq((int)blockIdx.x));
          EpiWin E{F.ws, F.out, l};
          pg8::gemm_phase<EpiWin, pg8::StaticOrder, true, true>(F.lds, g, S, E, F.wave);
        }

        GRID_BAR();
        { gu32* q = F.ctl + CW_Q + 64 * (l * 8); gu32* ch = F.ctl + CW_CH + 1024 * l;
          int kq = 0, u = __builtin_amdgcn_readfirstlane(grab(F, q)), chain_open = 1;
          for (;;) {
              while (kq < 5 && u >= mq_count(kq)) { ++kq; if (kq < 5) u = __builtin_amdgcn_readfirstlane(grab(F, q + 64 * kq)); }
              unsigned l0_ = lane_lo_(); asm volatile("" : "+v"(l0_));
              const bool t0 = F.wave == 0 && l0_ == 0u;
              unsigned nx = 0u, hd = 0u, rd = 0u;
              if (t0) { if (kq < 5) nx = __hip_atomic_fetch_add(q + 64 * kq, 1u, RLX_AGENT); if (chain_open) { hd = __hip_atomic_load(ch, RLX_AGENT); rd = __hip_atomic_load(ch + 64, RLX_AGENT); } }
              if (kq == 0) { ret_unit(F, l, u < 36 ? 128 + u : u - 36); if (u < 36) chain_signal(F, ch, 0); }
              else if (kq == 1 || kq == 4) { pool_unit(F, l, kq == 1 ? 1024 + u : u); if (kq == 1) chain_signal(F, ch, 0); }
              else if (kq == 2) { attn_unit<true>(F, l, u); chain_signal(F, ch, 0); }
              else if (kq == 3) { attn_unit<false>(F, l, u < 8 ? 64 + 2048 + u : 64 + u - 8); if (u < 8) chain_signal(F, ch, 0); }
              __syncthreads();
              if (t0) { int ci = -1;
                  if (chain_open) {
                      if (kq == 5) { unsigned sp = 0u;
                          for (;;) { hd = __hip_atomic_load(ch, RLX_AGENT); if (hd >= (unsigned)CH_TOTAL) { ci = -2; break; } rd = __hip_atomic_load(ch + 64, RLX_AGENT);
                              if (hd < rd) { unsigned e = hd; if (__hip_atomic_compare_exchange_strong(ch, &e, hd + 1u, __ATOMIC_RELAXED, __ATOMIC_RELAXED, __HIP_MEMORY_SCOPE_AGENT)) { ci = (int)hd; break; } }
                              else { __builtin_amdgcn_s_sleep(2); if ((++sp & 255u) == 0u) { if (xb_ld((unsigned*)(F.ctl + CW_BAR) + XB_TMO)) { ci = -2; break; } if (sp > XB_SPIN_CAP) { atomicAdd((unsigned*)(F.ctl + CW_BAR) + XB_TMO, 1u); ci = -2; break; } } } } }
                      else if (hd >= (unsigned)CH_TOTAL) ci = -3;
                      else if (hd < rd) { unsigned e = hd; if (__hip_atomic_compare_exchange_strong(ch, &e, hd + 1u, __ATOMIC_RELAXED, __ATOMIC_RELAXED, __HIP_MEMORY_SCOPE_AGENT)) ci = (int)hd; }
                      if (ci >= 0) { __builtin_amdgcn_fence(__ATOMIC_ACQUIRE, "agent"); asm volatile("s_waitcnt vmcnt(0)" ::: "memory"); }
                  } else if (kq == 5) ci = -2;
                  F.MISC[16] = nx; F.MISC[17] = (unsigned)ci; }
              __syncthreads();
              u = __builtin_amdgcn_readfirstlane((int)F.MISC[16]); const int ci = __builtin_amdgcn_readfirstlane((int)F.MISC[17]);
              if (ci == -2) break;
              if (ci == -3) chain_open = 0;
              if (ci >= 0) chain_item(F, l, ch, ci);
          }
          __syncthreads(); }
        GRID_BAR();
        { pg8::Gemm g{WSB(F, WS_BR), lw(F, l, LW_BR), 3 * M_PAD, 3 * D, D}; Order3 S; S.init(MP, D, opq(F.G), opq((int)blockIdx.x)); EpiGate E{F.ws};
          pg8::gemm_phase<EpiGate, Order3, true, true>(F.lds, g, S, E, F.wave); }

        GRID_BAR();
        { pg8::Gemm g{WSB(F, WS_MIX), lw(F, l, LW_OUT), M_PAD, D, D}; pg8::StaticOrder S; S.init(MP, D, opq(F.G), opq((int)blockIdx.x));
          EpiResid E{F.ws, ALPHA, 1.0f};
          pg8::gemm_phase<EpiResid, pg8::StaticOrder, true, true>(F.lds, g, S, E, F.wave); }

        GRID_BAR();
        if (blockIdx.x < 44) { pg8::Gemm g{WSB(F, WS_HB), lw(F, l, LW_UP2), M_PAD, 2 * DFF, D}; SmallOrderW S{opq((int)blockIdx.x)}; EpiSwiglu E{WSB(F, WS_ACT)};
            pg8::gemm_phase<EpiSwiglu, SmallOrderW, true, true>(F.lds, g, S, E, F.wave); }
        else ln_phase(F, l * 3 + 1, false, 0, MP, 44);
        GRID_BAR();
        { pg8::Gemm g{WSB(F, WS_HB), lw(F, l, LW_UP2), M_PAD, 2 * DFF, D}; pg8::StaticOrder S; S.init(MP, 2 * DFF, opq(F.G), opq((int)blockIdx.x)); EpiSwiglu E{WSB(F, WS_ACT)};
          pg8::gemm_phase<EpiSwiglu, pg8::StaticOrder, true, true>(F.lds, g, S, E, F.wave); }

        GRID_BAR();
        { pg8::Gemm g{WSB(F, WS_ACT), lw(F, l, LW_DN2), M_PAD, D, DFF}; pg8::StaticOrder S; S.init(MP, D, opq(F.G), opq((int)blockIdx.x));
          EpiResid E{F.ws, ALPHA, 0.5f};
          pg8::gemm_phase<EpiResid, pg8::StaticOrder, true, true>(F.lds, g, S, E, F.wave); }

        GRID_BAR();
        if (blockIdx.x < 16) { const int kh = opq((int)blockIdx.x) >> 3; pg8::Gemm g{WSB(F, WS_ACT) + kh * (DFF / 2), lw(F, l, LW_DN2) + kh * (DFF / 2), M_PAD, D, DFF / 2, DFF}; SmallOrderH S{opq((int)blockIdx.x)};
            EpiPart E{(float*)WSB(F, WS_ACT) + (size_t)kh * 512 * D};
            pg8::gemm_phase<EpiPart, SmallOrderH, true, true>(F.lds, g, S, E, F.wave); }
        else ln_phase(F, l * 3 + 2, l + 1 == DEPTH, 0, MP, 16);
        GRID_BAR();
        ln_phase(F, l * 3 + 2, l + 1 == DEPTH, MP, M_PAD, 0, true);
        if (l + 1 < DEPTH) GRID_BAR();
    }
}

extern "C" void kernel_launch(void* const* d_in, const int* in_sizes, int n_in, void* d_out, int out_size, void* d_ws, size_t ws_size, hipStream_t stream) {
    static int grid = 0;
    if (grid == 0) {
        if (n_in != 19 || (size_t)out_size != O_END || ws_size < WS_END) { fprintf(stderr, "kernel_launch: unexpected sizes (n_in %d out %d ws %zu need %zu)\n", n_in, out_size, ws_size, (size_t)WS_END); grid = -1; return; }
        int dev = 0, cus = 0, per_cu = 0;
        if (hipGetDevice(&dev) != hipSuccess || hipDeviceGetAttribute(&cus, hipDeviceAttributeMultiprocessorCount, dev) != hipSuccess) { grid = -1; return; }
        if (hipFuncSetAttribute((const void*)mega_fwd, hipFuncAttributeMaxDynamicSharedMemorySize, LDS_BYTES) != hipSuccess) { fprintf(stderr, "kernel_launch: hipFuncSetAttribute failed\n"); grid = -1; return; }
        if (hipOccupancyMaxActiveBlocksPerMultiprocessor(&per_cu, (const void*)mega_fwd, 512, LDS_BYTES) != hipSuccess || per_cu < 1) { fprintf(stderr, "kernel_launch: occupancy query says %d\n", per_cu); }
        (void)hipGetLastError();
        grid = cus;
    }
    if (grid < 0) return;
    if (hipMemsetAsync((char*)d_ws + WS_CTL, 0, CTL_ZERO_BYTES, stream) != hipSuccess) return;
    Args a{};
    for (int i = 0; i < 19; ++i) a.in[i] = (const float*)d_in[i];
    a.out = (float*)d_out; a.ws = (unsigned char*)d_ws;
    hipLaunchKernelGGL(mega_fwd, dim3(grid), dim3(512), LDS_BYTES, stream, a);
}
```

```cpp
#include <hip/hip_runtime.h>
#include <cstdio>
#include <cstdint>
__device__ __forceinline__ unsigned lane_lo_() { unsigned l; asm volatile("v_mbcnt_lo_u32_b32 %0, -1, 0" : "=v"(l)); return l; }
__device__ __forceinline__ int lane_id_() { unsigned l; asm volatile("v_mbcnt_lo_u32_b32 %0, -1, 0\n\tv_mbcnt_hi_u32_b32 %0, -1, %0" : "=v"(l)); return (int)l; }
namespace pg8 {
#define PG8_LAS __attribute__((address_space(3)))
typedef unsigned short bf16_t;
typedef short bf16x8 __attribute__((ext_vector_type(8)));
typedef float f32x4 __attribute__((ext_vector_type(4)));
typedef unsigned u32x4 __attribute__((ext_vector_type(4)));
constexpr int BM = 256, BK = 64, HALF = 128, HTB = HALF * BK * 2  , STAGE_BYTES = 8 * HTB, NXCD = 8, WGM = 4;

__host__ __device__ __forceinline__ int lds_byte(int r, int c) { const int st = (r >> 4) * 2 + (c >> 5), rr = r & 15, cc = c & 31, ob = rr * 64 + cc * 2; return st * 1024 + (ob ^ (((ob >> 9) & 1) << 5)); }
__host__ __device__ __forceinline__ void stage_rc(int b, int& R, int& C) { const int st = b / 1024, sb = b % 1024, swz = sb ^ (((sb >> 9) & 1) << 5); R = (st >> 1) * 16 + swz / 64; C = (st & 1) * 32 + (swz % 64) / 2; }
__host__ __device__ __forceinline__ int perm32(int rho) { const int n = rho >> 4, i = rho & 15; return 8 * (i >> 2) + 4 * n + (i & 3); }

struct Unit { int pm, pn; };
struct Gemm { const bf16_t* A; const bf16_t* Bt; int M, N, K; int ld = 0; };

struct StaticOrder {
    int nM, nN, nwg, G, c;
    __host__ __device__ void init(int M, int N, int G_, int c_) { nM = M / BM; nN = N / BM; nwg = nM * nN; G = G_; c = c_; }
    __host__ __device__ bool next(int i, Unit& u) const {
        const long L = (long)i * G + c; if (L >= nwg) return false;
        int wgid = (int)L; { const int q = nwg / NXCD, r = nwg % NXCD, xcd = wgid % NXCD, off = wgid / NXCD; wgid = (xcd < r ? xcd * (q + 1) : r * (q + 1) + (xcd - r) * q) + off; }
        const int nig = WGM * nN, gid = wgid / nig, fm = gid * WGM, gsz = (nM - fm) < WGM ? (nM - fm) : WGM;
        u.pm = fm + ((wgid % nig) % gsz); u.pn = (wgid % nig) / gsz; return true;
    }
    __device__ __forceinline__ void a_ready(const Unit&) const {}
    __device__ __forceinline__ void done(const Unit&) const {}
};

__device__ __forceinline__ unsigned cvt_pk_bf16(float lo, float hi) { unsigned r; asm volatile("v_cvt_pk_bf16_f32 %0, %1, %2" : "=v"(r) : "v"(lo), "v"(hi)); return r; }
template <class Epi, class Sched, bool ALIGN_EPI = false, bool SP2 = false>
__device__ __forceinline__ void gemm_phase(PG8_LAS unsigned char* lds, const Gemm g, const Sched& S, const Epi& E, const int wave_id) {
    int lane_ = lane_id_(); asm volatile("" : "+v"(lane_));
    const int tid = wave_id * 64 + lane_;
    int widq_ = wave_id; asm volatile("" : "+s"(widq_));
    const int wid = widq_, lane = tid & 63, wr = wid >> 2, wc = wid & 3, fr = lane & 15, fq = lane >> 4;
    const int K = g.K, nt = K / BK, LD = g.ld > 0 ? g.ld : K;
    unsigned voffA[2], voffB[2];
#pragma unroll
    for (int i = 0; i < 2; ++i) { int R, C; stage_rc(tid * 16 + i * 8192, R, C); const int Rb = Epi::PERM ? ((R & ~31) + perm32(R & 31)) : R;
        voffA[i] = (unsigned)(R * LD + C) * 2u; voffB[i] = (unsigned)(Rb * LD + C) * 2u; }
    const size_t kstep = (size_t)(BK * 2);
    const size_t hstep = (size_t)HALF * LD * 2;
    const size_t tstep = 2 * hstep;
    const unsigned ldsw = (unsigned)wid * 1024u;
    const int aoff = lds_byte(wr * 64 + fr, fq * 8), boff = lds_byte(wc * 32 + fr, fq * 8);
#define PG8_SA(b, h) (((b) * 2 + (h)) * HTB)
#define PG8_SB(b, h) ((4 + (b) * 2 + (h)) * HTB)
#define PG8_STAGE(bufoff, gbase, voff) do { _Pragma("unroll") for (int _i = 0; _i < 2; ++_i) \
        __builtin_amdgcn_global_load_lds((const unsigned*)((const char*)(gbase) + (voff)[_i]), (PG8_LAS unsigned*)(lds + (bufoff) + ldsw + _i * 8192), 16, 0, 0); } while (0)
#define PG8_LDA(dst, b, h) do { _Pragma("unroll") for (int m = 0; m < 4; ++m) _Pragma("unroll") for (int k = 0; k < 2; ++k) dst[m][k] = *(const PG8_LAS bf16x8*)(lds + PG8_SA(b, h) + aoff + m * 2048 + k * 1024); } while (0)
#define PG8_LDB(dst, b, h) do { _Pragma("unroll") for (int n = 0; n < 2; ++n) _Pragma("unroll") for (int k = 0; k < 2; ++k) dst[n][k] = *(const PG8_LAS bf16x8*)(lds + PG8_SB(b, h) + boff + n * 2048 + k * 1024); } while (0)
#define PG8_MMA(ai, bj, At, Bt) do { __builtin_amdgcn_s_setprio(1); _Pragma("unroll") for (int m = 0; m < 4; ++m) _Pragma("unroll") for (int n = 0; n < 2; ++n) _Pragma("unroll") for (int k = 0; k < 2; ++k) \
        acc[ai][bj][m][n] = __builtin_amdgcn_mfma_f32_16x16x32_bf16(Bt[n][k], At[m][k], acc[ai][bj][m][n], 0, 0, 0); __builtin_amdgcn_s_setprio(0); } while (0)
#define PG8_WAIT_V(n) asm volatile("s_waitcnt vmcnt(" #n ")" ::: "memory")
#define PG8_WAIT_VN(n) asm volatile("s_waitcnt vmcnt(%0)" :: "n"(n) : "memory")
#define PG8_WAIT_L(n) asm volatile("s_waitcnt lgkmcnt(" #n ")" ::: "memory")
#define PG8_BAR __builtin_amdgcn_s_barrier()
#define PG8_SCHED __builtin_amdgcn_sched_barrier(0)
    Unit cur, nxt; int ui = 0;
    if (!S.next(0, cur)) return;
    f32x4 acc[2][2][4][2];
#pragma unroll
    for (int a = 0; a < 2; ++a)
#pragma unroll
        for (int b = 0; b < 2; ++b)
#pragma unroll
            for (int m = 0; m < 4; ++m)
#pragma unroll
                for (int n = 0; n < 2; ++n) acc[a][b][m][n] = (f32x4){0.f, 0.f, 0.f, 0.f};
    bf16x8 At[4][2], B0[2][2], B1[2][2];
    const char* cA = (const char*)g.A + (size_t)cur.pm * tstep; const char* cB = (const char*)g.Bt + (size_t)cur.pn * tstep;
    S.a_ready(cur);
    if constexpr (SP2) {
        PG8_STAGE(PG8_SB(0, 0), cB, voffB); PG8_STAGE(PG8_SB(0, 1), cB + hstep, voffB); PG8_STAGE(PG8_SA(0, 0), cA, voffA); PG8_STAGE(PG8_SA(0, 1), cA + hstep, voffA);
        if (wr == 1) PG8_BAR;
        PG8_WAIT_V(2); PG8_BAR;
        PG8_STAGE(PG8_SB(1, 0), cB + kstep, voffB); PG8_STAGE(PG8_SA(1, 0), cA + kstep, voffA); PG8_STAGE(PG8_SB(1, 1), cB + hstep + kstep, voffB);
        PG8_WAIT_V(6); PG8_BAR;
    } else {
        PG8_STAGE(PG8_SB(0, 0), cB, voffB); PG8_STAGE(PG8_SA(0, 0), cA, voffA); PG8_STAGE(PG8_SB(0, 1), cB + hstep, voffB); PG8_STAGE(PG8_SA(0, 1), cA + hstep, voffA);
        if (wr == 1) PG8_BAR;
        PG8_WAIT_V(4); PG8_BAR;
        PG8_STAGE(PG8_SB(1, 0), cB + kstep, voffB); PG8_STAGE(PG8_SA(1, 0), cA + kstep, voffA); PG8_STAGE(PG8_SB(1, 1), cB + hstep + kstep, voffB);
        PG8_WAIT_V(6); PG8_BAR;
    }
    for (;;) {
        const bool has_next = S.next(ui + 1, nxt);
        const char* nA = has_next ? (const char*)g.A + (size_t)nxt.pm * tstep : cA; const char* nB = has_next ? (const char*)g.Bt + (size_t)nxt.pn * tstep : cB;
        for (int t = 0; t < nt; t += 2) {
            const bool last = (t == nt - 2);
            const char* a1 = cA + (size_t)(t + 1) * kstep;
            const char* a2 = last ? nA : cA + (size_t)(t + 2) * kstep; const char* b2 = last ? nB : cB + (size_t)(t + 2) * kstep;
            const char* a3 = a2 + kstep; const char* b3 = b2 + kstep;
            if (last && has_next) S.a_ready(nxt);
            if constexpr (SP2) {
            int tz_ = __builtin_amdgcn_readfirstlane(t | (ui > 0 ? 0 : 1)); asm volatile("" : "+s"(tz_));
            const bool strict = !(Epi::NS > 0 && tz_ == 0);
            PG8_LDB(B0, 0, 0); PG8_LDB(B1, 0, 1); PG8_SCHED; PG8_LDA(At, 0, 0); PG8_STAGE(PG8_SA(1, 1), a1 + hstep, voffA);
            PG8_WAIT_VN(8 + Epi::NS); if (strict) PG8_WAIT_V(8); PG8_WAIT_L(0); PG8_BAR; PG8_MMA(0, 0, At, B0); PG8_MMA(0, 1, At, B1); PG8_BAR; PG8_SCHED;
            PG8_LDA(At, 0, 1); PG8_STAGE(PG8_SB(0, 0), b2, voffB); PG8_STAGE(PG8_SB(0, 1), b2 + hstep, voffB); PG8_STAGE(PG8_SA(0, 0), a2, voffA);
            PG8_WAIT_VN(8 + Epi::NS); if (strict) PG8_WAIT_V(8); PG8_WAIT_L(0); PG8_BAR; PG8_MMA(1, 0, At, B0); PG8_MMA(1, 1, At, B1); PG8_BAR; PG8_SCHED;
            PG8_LDB(B0, 1, 0); PG8_LDB(B1, 1, 1); PG8_SCHED; PG8_LDA(At, 1, 0); PG8_STAGE(PG8_SA(0, 1), a2 + hstep, voffA);
            PG8_WAIT_V(8); PG8_WAIT_L(0); PG8_BAR; PG8_MMA(0, 0, At, B0); PG8_MMA(0, 1, At, B1); PG8_BAR; PG8_SCHED;
            PG8_LDA(At, 1, 1); PG8_STAGE(PG8_SB(1, 0), b3, voffB); PG8_STAGE(PG8_SB(1, 1), b3 + hstep, voffB); PG8_STAGE(PG8_SA(1, 0), a3, voffA);
            PG8_WAIT_V(8); PG8_WAIT_L(0); PG8_BAR; PG8_MMA(1, 0, At, B0); PG8_MMA(1, 1, At, B1); PG8_BAR; PG8_SCHED;
            } else {
            PG8_LDB(B0, 0, 0); PG8_SCHED; PG8_LDA(At, 0, 0); PG8_STAGE(PG8_SA(1, 1), a1 + hstep, voffA);
            PG8_WAIT_L(8); PG8_BAR; PG8_WAIT_L(0); PG8_MMA(0, 0, At, B0); PG8_BAR; PG8_SCHED;
            PG8_LDB(B1, 0, 1); PG8_STAGE(PG8_SB(0, 0), b2, voffB);
            PG8_BAR; PG8_WAIT_L(0); PG8_MMA(0, 1, At, B1); PG8_BAR;
            PG8_LDA(At, 0, 1); PG8_STAGE(PG8_SA(0, 0), a2, voffA);
            PG8_BAR; PG8_WAIT_L(0); PG8_MMA(1, 0, At, B0); PG8_BAR; PG8_SCHED;
            PG8_STAGE(PG8_SB(0, 1), b2 + hstep, voffB);
            PG8_WAIT_V(6); PG8_BAR; PG8_MMA(1, 1, At, B1); PG8_BAR;
            PG8_LDB(B0, 1, 0); PG8_SCHED; PG8_LDA(At, 1, 0); PG8_STAGE(PG8_SA(0, 1), a2 + hstep, voffA);
            PG8_WAIT_L(8); PG8_BAR; PG8_WAIT_L(0); PG8_MMA(0, 0, At, B0); PG8_BAR; PG8_SCHED;
            PG8_LDB(B1, 1, 1); PG8_STAGE(PG8_SB(1, 0), b3, voffB);
            PG8_BAR; PG8_WAIT_L(0); PG8_MMA(0, 1, At, B1); PG8_BAR;
            PG8_LDA(At, 1, 1); PG8_STAGE(PG8_SA(1, 0), a3, voffA);
            PG8_BAR; PG8_WAIT_L(0); PG8_MMA(1, 0, At, B0); PG8_BAR; PG8_SCHED;
            PG8_STAGE(PG8_SB(1, 1), b3 + hstep, voffB);
            PG8_WAIT_V(6); PG8_BAR; PG8_MMA(1, 1, At, B1); PG8_BAR;
            }
        }
        if constexpr (ALIGN_EPI) { if (wr == 0) PG8_BAR; }
        const bool keep_acc = E(acc, cur, wr, wc, fr, fq);
        if (!has_next) break;
        if (!keep_acc) {
#pragma unroll
        for (int a = 0; a < 2; ++a)
#pragma unroll
            for (int b = 0; b < 2; ++b)
#pragma unroll
                for (int m = 0; m < 4; ++m)
#pragma unroll
                    for (int n = 0; n < 2; ++n) acc[a][b][m][n] = (f32x4){0.f, 0.f, 0.f, 0.f};
        }
        cur = nxt; cA = nA; cB = nB; ++ui;
        if constexpr (ALIGN_EPI) { if (wr == 1) PG8_BAR; }
    }
    PG8_WAIT_V(0);
    if constexpr (!ALIGN_EPI) { if (wr == 0) PG8_BAR; }
    PG8_BAR;
#undef PG8_SA
#undef PG8_SB
#undef PG8_STAGE
#undef PG8_LDA
#undef PG8_LDB
#undef PG8_MMA
#undef PG8_WAIT_V
#undef PG8_WAIT_VN
#undef PG8_WAIT_L
#undef PG8_BAR
#undef PG8_SCHED
}
}

constexpr int D = 1024, NB = 32, T = 2048, DEPTH = 2, SBATCH = 8, ST = 32, PAST = 4096, NMETA = 16;
constexpr int HRET = 4, DKR = 128, DVR = 256, HSB = 8, DSB = 128, DFF = 2816, DIN = 10240, PBUF = 15;
constexpr int MP = NB * T;
constexpr int ROW_S = MP;
constexpr int ROW_M = MP + SBATCH * ST;
constexpr int M_PAD = ROW_M + 256;
constexpr int NPANEL = M_PAD / 256;
constexpr float LN_EPS = 1e-5f;
constexpr float ALPHA = 1.41421356237f;
constexpr float LOG2E = 1.44269504089f;
constexpr int KT_SP = PAST + ST;
constexpr int KT_PP = NMETA + T;

constexpr size_t O_YP = 0;
constexpr size_t O_YS = O_YP + (size_t)NB * T * D;
constexpr size_t O_KP = O_YS + (size_t)SBATCH * ST * D;
constexpr size_t O_VP = O_KP + (size_t)DEPTH * NB * KT_PP * D;
constexpr size_t O_RP = O_VP + (size_t)DEPTH * NB * KT_PP * D;
constexpr size_t O_PP = O_RP + (size_t)DEPTH * NB * HRET * DKR * DVR;
constexpr size_t O_KS = O_PP + (size_t)DEPTH * NB * PBUF * D;
constexpr size_t O_VS = O_KS + (size_t)DEPTH * SBATCH * ST * D;
constexpr size_t O_RS = O_VS + (size_t)DEPTH * SBATCH * ST * D;
constexpr size_t O_PS = O_RS + (size_t)DEPTH * SBATCH * HRET * DKR * DVR;
constexpr size_t O_END = O_PS + (size_t)DEPTH * SBATCH * PBUF * D;
static_assert(O_END == 350666752ull, "output size");

constexpr size_t MiB = 1u << 20;
constexpr size_t AL(size_t x) { return (x + 4095) & ~(size_t)4095; }
constexpr size_t WS_CTL = 0, CTL_ZERO_BYTES = 1 * MiB;
constexpr size_t WS_YB = WS_CTL + CTL_ZERO_BYTES;
constexpr size_t WS_HB = AL(WS_YB + (size_t)M_PAD * D * 2);
constexpr size_t WS_ACT = AL(WS_HB + (size_t)M_PAD * D * 2);
constexpr size_t WS_QR = AL(WS_ACT + (size_t)M_PAD * DFF * 2);
constexpr size_t WS_KR = AL(WS_QR + (size_t)M_PAD * 512 * 2);
constexpr size_t WS_VR = AL(WS_KR + (size_t)M_PAD * 512 * 2);
constexpr size_t WS_GR = AL(WS_VR + (size_t)M_PAD * D * 2);
constexpr size_t WS_QS = AL(WS_GR + (size_t)M_PAD * D * 2);
constexpr size_t WS_KS = AL(WS_QS + (size_t)M_PAD * D * 2);
constexpr size_t WS_VS = AL(WS_KS + (size_t)M_PAD * D * 2);
constexpr size_t WS_U = AL(WS_VS + (size_t)M_PAD * D * 2);
constexpr size_t WS_GT = AL(WS_U + (size_t)M_PAD * D * 2);
constexpr size_t WS_BR = AL(WS_GT + (size_t)M_PAD * 3 * D * 2);
constexpr size_t WS_MIX = AL(WS_BR + (size_t)3 * M_PAD * D * 2);
constexpr size_t WS_W = AL(WS_MIX + (size_t)M_PAD * D * 2);
constexpr size_t LW_UP1 = 0;
constexpr size_t LW_DN1 = LW_UP1 + (size_t)2 * DFF * D * 2;
constexpr size_t LW_IN = LW_DN1 + (size_t)D * DFF * 2;
constexpr size_t LW_BR = LW_IN + (size_t)DIN * D * 2;
constexpr size_t LW_OUT = LW_BR + (size_t)3 * D * D * 2;
constexpr size_t LW_UP2 = LW_OUT + (size_t)D * D * 2;
constexpr size_t LW_DN2 = LW_UP2 + (size_t)2 * DFF * D * 2;
constexpr size_t LW_SIZE = AL(LW_DN2 + (size_t)D * DFF * 2);
constexpr size_t WS_END = WS_W + DEPTH * LW_SIZE;
static_assert(WS_END < (size_t)4000 * MiB, "workspace budget");

constexpr int CW_BAR = 4096;
constexpr int CW_Q = 16384;
constexpr int CW_CH = 24576;
constexpr int CW_DBG = 32768;
constexpr int CW_KN = 65536;
static_assert((CW_KN + DEPTH * 33 * 8 * 16) * 4 <= (int)CTL_ZERO_BYTES, "ctl region");

constexpr int RING_BYTES = 131072;
constexpr int LDSCTL_OFF = RING_BYTES, MISC_OFF = LDSCTL_OFF + 320;
constexpr int LDS_BYTES = 147456;

#define GAS __attribute__((address_space(1)))
#define LAS __attribute__((address_space(3)))
typedef unsigned short bf16;
typedef unsigned v4u __attribute__((ext_vector_type(4)));
typedef unsigned v2u __attribute__((ext_vector_type(2)));
typedef float f32x4 __attribute__((ext_vector_type(4)));
typedef short bf16x8 __attribute__((ext_vector_type(8)));
typedef short s16x4 __attribute__((ext_vector_type(4)));
typedef GAS unsigned gu32;
#define RLX_AGENT __ATOMIC_RELAXED, __HIP_MEMORY_SCOPE_AGENT
__device__ __forceinline__ unsigned f2bf(float f) { unsigned u = __builtin_bit_cast(unsigned, f); return (u + 0x7fffu + ((u >> 16) & 1u)) >> 16; }
__device__ __forceinline__ unsigned pk2(float lo, float hi) { return f2bf(lo) | (f2bf(hi) << 16); }
__device__ __forceinline__ float bf2f(unsigned short b) { return __builtin_bit_cast(float, (unsigned)b << 16); }
__device__ __forceinline__ float bflo(unsigned w) { return __builtin_bit_cast(float, w << 16); }
__device__ __forceinline__ float bfhi(unsigned w) { return __builtin_bit_cast(float, w & 0xffff0000u); }
__device__ __forceinline__ float fast_exp2(float x) { return __builtin_amdgcn_exp2f(x); }
__device__ __forceinline__ float fast_log2(float x) { return __builtin_amdgcn_logf(x); }
__device__ __forceinline__ float fast_rcp(float x) { return __builtin_amdgcn_rcpf(x); }
__device__ __forceinline__ float sigmoidf_(float x) { return fast_rcp(1.0f + fast_exp2(-x * LOG2E)); }
__device__ __forceinline__ float siluf_(float x) { return x * sigmoidf_(x); }
__device__ __forceinline__ float wave_sum(float v) {
#pragma unroll
    for (int o = 1; o < 64; o <<= 1) v += __shfl_xor(v, o);
    return v;
}
#define XB_TMO      128
#define XB_XCNT(j)  (256  + 64 * (j))
#define XB_XSUB(j)  (1280 + 64 * (j))
#define XB_XGEN(j)  (2304 + 64 * (j))
#define XB_TOP      3328
#define XB_TOPGEN   3392
#define XCD_BAR_WORDS 3456
#define XB_SPIN_CAP (1u << 20)

__device__ __forceinline__ unsigned xb_ld(unsigned* p)              { return __hip_atomic_load(p, __ATOMIC_RELAXED, __HIP_MEMORY_SCOPE_AGENT); }
__device__ __forceinline__ unsigned xb_add(unsigned* p, unsigned v) { return __hip_atomic_fetch_add(p, v, __ATOMIC_RELAXED, __HIP_MEMORY_SCOPE_AGENT); }
__device__ __forceinline__ unsigned xb_xcc_id() { return (unsigned)__builtin_amdgcn_s_getreg((3 << 11) | 20) & 0xFu; }
#define XB_SPIN(cond, bar) do { unsigned _sp = 0; while (cond) { __builtin_amdgcn_s_sleep(1); \
    if ((++_sp & 255u) == 0u) { if (xb_ld(&(bar)[XB_TMO])) break; if (_sp > XB_SPIN_CAP) { atomicAdd(&(bar)[XB_TMO], 1u); break; } } } } while (0)

struct XcdBarrier {
    unsigned* bar; unsigned x; unsigned w0;
    volatile LAS unsigned* st;
};

__device__ __forceinline__ XcdBarrier xcd_barrier_post(unsigned* bar, volatile LAS unsigned* st) {
    XcdBarrier b; b.bar = bar; b.x = xb_xcc_id(); b.st = st; b.w0 = (__builtin_amdgcn_readfirstlane((int)threadIdx.x >> 6) == 0) ? 1u : 0u;
    if (threadIdx.x == 0) (void)xb_add(&bar[XB_XCNT(b.x)], 1u);
    return b;
}
__device__ __forceinline__ void xcd_barrier_complete(unsigned* bar, unsigned x, unsigned& nloc, unsigned& nx) {
    const unsigned G = gridDim.x * gridDim.y * gridDim.z;
    unsigned sum, cnt, mine, sp = 0u;
    for (;;) {
        sum = 0u; cnt = 0u; mine = 0u;
#pragma unroll
        for (unsigned j = 0; j < 16; ++j) { const unsigned c = xb_ld(&bar[XB_XCNT(j)]); sum += c; cnt += (c > 0u) ? 1u : 0u; mine = (j == x) ? c : mine; }
        if (sum == G) break;
        __builtin_amdgcn_s_sleep(1);
        if ((++sp & 255u) == 0u) { if (xb_ld(&bar[XB_TMO])) break; if (sp > XB_SPIN_CAP) { atomicAdd(&bar[XB_TMO], 1u); break; } }
    }
    nloc = mine > 0u ? mine : 1u; nx = cnt > 0u ? cnt : 1u;
}

__device__ __forceinline__ void xcd_barrier(const XcdBarrier& b) {
    asm volatile("s_waitcnt vmcnt(0)" ::: "memory");
    __syncthreads();
    if (b.w0 != 0u && lane_lo_() == 0u) {
        unsigned* bar = b.bar; unsigned bx = b.x; asm volatile("" : "+s"(bar), "+s"(bx));
        __builtin_amdgcn_s_waitcnt(0);
        unsigned nloc = b.st[0], nx = b.st[1];
        if (nloc == 0u) { xcd_barrier_complete(bar, bx, nloc, nx); b.st[0] = nloc; b.st[1] = nx; }
        const unsigned old = xb_add(&bar[XB_XSUB(bx)], 1u);
        const unsigned gen = old / nloc;
        if (old + 1u == (gen + 1u) * nloc) {
            __builtin_amdgcn_fence(__ATOMIC_RELEASE, "agent");
            asm volatile("s_waitcnt vmcnt(0)" ::: "memory");
            const unsigned og = xb_add(&bar[XB_TOP], 1u);
            const unsigned tg = og / nx;
            if (og + 1u == (tg + 1u) * nx) xb_add(&bar[XB_TOPGEN], 1u);
            else XB_SPIN(xb_ld(&bar[XB_TOPGEN]) == tg, bar);
            __builtin_amdgcn_fence(__ATOMIC_ACQUIRE, "agent");
            xb_add(&bar[XB_XGEN(bx)], 1u);
            asm volatile("s_waitcnt vmcnt(0)" ::: "memory");
        } else {
            XB_SPIN(xb_ld(&bar[XB_XGEN(bx)]) == gen, bar);
            __builtin_amdgcn_fence(__ATOMIC_ACQUIRE, "agent");
            asm volatile("s_waitcnt vmcnt(0)" ::: "memory");
        }
    }
    __syncthreads();
}

struct Frame {
    LAS unsigned char* lds;
    volatile LAS unsigned* MISC;
    gu32* ctl;
    int G, wave;
    float* out; unsigned char* ws;
};
__device__ __forceinline__ const float* in_ptr(int i) {
    const __attribute__((address_space(4))) char* k = (const __attribute__((address_space(4))) char*)__builtin_amdgcn_kernarg_segment_ptr();
    asm volatile("" : "+s"(k));
    return *(const float* const __attribute__((address_space(4)))*)(k + 8 * i);
}
enum { IN_XP = 0, IN_XS, IN_CK, IN_CV, IN_SRET, IN_SPOOL, IN_META, IN_WIN, IN_RETG, IN_PMIX, IN_PSCALE, IN_WBR, IN_WOUT, IN_UP1, IN_DN1, IN_UP2, IN_DN2, IN_LNG, IN_LNB };
__device__ __forceinline__ unsigned char* wsq(unsigned char* p) { asm volatile("" : "+s"(p)); return p; }
#define WSB(F, off) ((bf16*)(wsq((F).ws) + (off)))
struct TC { int tid, lane, wave; };
__device__ __forceinline__ TC thread_coords(int wave) { TC c; int l = lane_id_(); asm volatile("" : "+v"(l)); c.lane = l; c.wave = wave; c.tid = wave * 64 + l; return c; }
__device__ __forceinline__ bf16* lw(const Frame& F, int l, size_t off) { return (bf16*)(wsq(F.ws) + WS_W + (size_t)l * LW_SIZE + off); }
__device__ __forceinline__ float* yrow(const Frame& F, int m) {
    if (m < MP) return F.out + O_YP + (size_t)m * D;
    if (m < ROW_M) return F.out + O_YS + (size_t)(m - ROW_S) * D;
    return nullptr;
}

__device__ __forceinline__ int srccol(int kind, int n) {
    if (kind == 1) { const int pn = n >> 8, p = n & 255, bj = p >> 7, wc = (p >> 5) & 3, fq = (p >> 3) & 3, nn = (p >> 2) & 1, e = p & 3;
        return (nn ? DFF : 0) + 128 * pn + 64 * bj + 16 * wc + 4 * fq + e; }
    if (kind == 2 && n < 1024) { const int hb_ = n & ~127, p = n & 127, wc = p >> 5, fq = (p >> 3) & 3, nn = (p >> 2) & 1, e = p & 3;
        return hb_ + 16 * wc + 4 * fq + e + 64 * nn; }
    return n;
}
__device__ __forceinline__ void p0_transpose_item(const float* W, int K, int ldw, int N, bf16* WT, int kind, LAS float* scr, int item, int lane) {
    const int nblk = N / 32, kb = item / nblk, nb = item % nblk, k0 = 64 * kb, n0 = 32 * nb;
    const int sc = srccol(kind, n0 + (lane & 31));
    float t_[32];
#pragma unroll
    for (int i = 0; i < 32; ++i) t_[i] = W[(size_t)(k0 + 2 * i + (lane >> 5)) * ldw + sc];
#pragma unroll
    for (int i = 0; i < 32; ++i) scr[(2 * i + (lane >> 5)) * 33 + (lane & 31)] = t_[i];
    asm volatile("s_waitcnt lgkmcnt(0)" ::: "memory");
    const int c = lane & 7;
#pragma unroll
    for (int j = 0; j < 4; ++j) { const int n = (lane >> 3) + 8 * j; const LAS float* s = scr + (8 * c) * 33 + n;
        v4u o; o.x = pk2(s[0 * 33], s[1 * 33]); o.y = pk2(s[2 * 33], s[3 * 33]); o.z = pk2(s[4 * 33], s[5 * 33]); o.w = pk2(s[6 * 33], s[7 * 33]);
        *(GAS v4u*)(WT + (size_t)(n0 + n) * K + k0 + 8 * c) = o; }
    asm volatile("s_waitcnt lgkmcnt(0)" ::: "memory");
}
__device__ __forceinline__ void p0_poolfold_item(const float* mixw  , const float* scale  , const float* wb2  , bf16* WT  , int item, int lane) {
    const int g = item >> 7, r = item & 127, cb = r >> 4, nb = r & 15;
    const int n = nb * 64 + lane, c0 = cb * 32;
    float acc[32];
#pragma unroll
    for (int i = 0; i < 32; ++i) acc[i] = 0.f;
    const float* mw = mixw + ((size_t)g * 256 + c0) * 256;
    for (int d0 = 0; d0 < 256; d0 += 8) {
        float a[8];
#pragma unroll
        for (int j = 0; j < 8; ++j) a[j] = scale[g * 256 + d0 + j] * wb2[(size_t)(g * 256 + d0 + j) * D + n];
#pragma unroll
        for (int i = 0; i < 32; ++i)
#pragma unroll
            for (int j = 0; j < 8; ++j) acc[i] += mw[(size_t)i * 256 + d0 + j] * a[j];
    }
    bf16* dst = WT + (size_t)n * D + g * 256 + c0;
#pragma unroll
    for (int i = 0; i < 32; i += 8) { v4u o; o.x = pk2(acc[i], acc[i + 1]); o.y = pk2(acc[i + 2], acc[i + 3]); o.z = pk2(acc[i + 4], acc[i + 5]); o.w = pk2(acc[i + 6], acc[i + 7]); *(GAS v4u*)(dst + i) = o; }
}
__device__ __forceinline__ void p0_prologue(Frame& F) {
    const TC tc = thread_coords(F.wave); const int gw = blockIdx.x * 8 + tc.wave, NGW = F.G * 8;
    LAS float* scr = (LAS float*)(F.lds + tc.wave * 16384);
    for (int l = 0; l < DEPTH; ++l) {
        constexpr int I_UP = (D / 64) * (2 * DFF / 32), I_DN = (DFF / 64) * (D / 32), I_IN = (D / 64) * (DIN / 32), I_SQ = (D / 64) * (D / 32), I_PF = 4 * 4 * 32;
        constexpr int NIT = 2 * I_UP + 2 * I_DN + I_IN + 3 * I_SQ + I_PF;
        for (int it = (gw + l * (NGW / 2)) % NGW; it < NIT; it += NGW) {
            int r = it;
            if (r < I_UP) { p0_transpose_item(in_ptr(IN_UP1) + (size_t)l * D * 2 * DFF, D, 2 * DFF, 2 * DFF, lw(F, l, LW_UP1), 1, scr, r, tc.lane); continue; } r -= I_UP;
            if (r < I_UP) { p0_transpose_item(in_ptr(IN_UP2) + (size_t)l * D * 2 * DFF, D, 2 * DFF, 2 * DFF, lw(F, l, LW_UP2), 1, scr, r, tc.lane); continue; } r -= I_UP;
            if (r < I_DN) { p0_transpose_item(in_ptr(IN_DN1) + (size_t)l * DFF * D, DFF, D, D, lw(F, l, LW_DN1), 0, scr, r, tc.lane); continue; } r -= I_DN;
            if (r < I_DN) { p0_transpose_item(in_ptr(IN_DN2) + (size_t)l * DFF * D, DFF, D, D, lw(F, l, LW_DN2), 0, scr, r, tc.lane); continue; } r -= I_DN;
            if (r < I_IN) { p0_transpose_item(in_ptr(IN_WIN) + (size_t)l * D * DIN, D, DIN, DIN, lw(F, l, LW_IN), 2, scr, r, tc.lane); continue; } r -= I_IN;
            if (r < I_SQ) { p0_transpose_item(in_ptr(IN_WBR) + (size_t)(l * 3 + 0) * D * D, D, D, D, lw(F, l, LW_BR), 0, scr, r, tc.lane); continue; } r -= I_SQ;
            if (r < I_SQ) { p0_transpose_item(in_ptr(IN_WBR) + (size_t)(l * 3 + 1) * D * D, D, D, D, lw(F, l, LW_BR) + (size_t)D * D, 0, scr, r, tc.lane); continue; } r -= I_SQ;
            if (r < I_SQ) { p0_transpose_item(in_ptr(IN_WOUT) + (size_t)l * D * D, D, D, D, lw(F, l, LW_OUT), 0, scr, r, tc.lane); continue; } r -= I_SQ;
            p0_poolfold_item(in_ptr(IN_PMIX) + (size_t)l * 4 * 256 * 256, in_ptr(IN_PSCALE) + (size_t)l * D, in_ptr(IN_WBR) + (size_t)(l * 3 + 2) * D * D, lw(F, l, LW_BR) + (size_t)2 * D * D, r, tc.lane);
        }
    }
    for (int m0 = gw; m0 < M_PAD; m0 += 2 * NGW) {
        f32x4 v[2][4];
#pragma unroll
        for (int r = 0; r < 2; ++r) { const int m = m0 + r * NGW;
            const float* src = (m < MP) ? in_ptr(IN_XP) + (size_t)m * D : (m < ROW_M) ? in_ptr(IN_XS) + (size_t)(m - ROW_S) * D : (m - ROW_M < NMETA) ? in_ptr(IN_META) + (size_t)(m - ROW_M) * D : nullptr;
#pragma unroll
            for (int j = 0; j < 4; ++j) v[r][j] = (src && m < M_PAD) ? ((const GAS f32x4*)src)[tc.lane + 64 * j] : (f32x4){0.f, 0.f, 0.f, 0.f}; }
#pragma unroll
        for (int r = 0; r < 2; ++r) { const int m = m0 + r * NGW;
            if (m < M_PAD) { GAS v2u* o8 = (GAS v2u*)(WSB(F, WS_HB) + (size_t)m * D) + tc.lane;
#pragma unroll
                for (int j = 0; j < 4; ++j) o8[64 * j] = (v2u){pk2(v[r][j].x, v[r][j].y), pk2(v[r][j].z, v[r][j].w)}; } }
    }
}

__device__ __forceinline__ void ln_rows(const Frame& F, int idx, bool final_out, int row_lo, int row_hi, int gw0, int NGW, bool comb = false) {
    const TC tc = thread_coords(F.wave); const int gw = gw0 + tc.wave;
    const float* g = in_ptr(IN_LNG) + (size_t)idx * D; const float* b = in_ptr(IN_LNB) + (size_t)idx * D;
    f32x4 gv[4], bv[4];
#pragma unroll
    for (int j = 0; j < 2; ++j) { gv[2 * j] = ((const GAS f32x4*)g)[2 * tc.lane + 128 * j]; gv[2 * j + 1] = ((const GAS f32x4*)g)[2 * tc.lane + 128 * j + 1];
                                  bv[2 * j] = ((const GAS f32x4*)b)[2 * tc.lane + 128 * j]; bv[2 * j + 1] = ((const GAS f32x4*)b)[2 * tc.lane + 128 * j + 1]; }
    for (int m0 = row_lo + gw; m0 < row_hi; m0 += 2 * NGW) {
        v4u w[2][2]; const bool two = m0 + NGW < row_hi;
#pragma unroll
        for (int r = 0; r < 2; ++r) { const int m = (r == 0 || two) ? m0 + r * NGW : m0; const GAS v4u* yr = (const GAS v4u*)(WSB(F, comb ? WS_HB : WS_YB) + (size_t)m * D) + tc.lane; w[r][0] = yr[0]; w[r][1] = yr[64]; }
#pragma unroll
        for (int r = 0; r < 2; ++r) { const int m = m0 + r * NGW; if (r == 1 && !two) break;
        f32x4 v[4]; float s = 0.f;
#pragma unroll
        for (int j = 0; j < 2; ++j) { const v4u x = w[r][j]; v[2 * j] = (f32x4){bflo(x.x), bfhi(x.x), bflo(x.y), bfhi(x.y)}; v[2 * j + 1] = (f32x4){bflo(x.z), bfhi(x.z), bflo(x.w), bfhi(x.w)}; }
        if (comb) {
            const GAS f32x4* pa = (const GAS f32x4*)((const float*)WSB(F, WS_ACT) + (size_t)(m - MP) * D) + 2 * tc.lane; const GAS f32x4* pb = pa + (size_t)512 * D / 4;
#pragma unroll
            for (int j = 0; j < 2; ++j) { v[2 * j] = v[2 * j] * ALPHA + (pa[128 * j] + pb[128 * j]) * 0.5f; v[2 * j + 1] = v[2 * j + 1] * ALPHA + (pa[128 * j + 1] + pb[128 * j + 1]) * 0.5f; } }
#pragma unroll
        for (int j = 0; j < 4; ++j) s += (v[j].x + v[j].y) + (v[j].z + v[j].w);
        const float mean = wave_sum(s) * (1.f / D); float s2 = 0.f;
#pragma unroll
        for (int j = 0; j < 4; ++j) { v[j] = v[j] - mean; s2 += (v[j].x * v[j].x + v[j].y * v[j].y) + (v[j].z * v[j].z + v[j].w * v[j].w); }
        const float rstd = 1.f / sqrtf(wave_sum(s2) * (1.f / D) + LN_EPS);
#pragma unroll
        for (int j = 0; j < 4; ++j) v[j] = v[j] * rstd * gv[j] + bv[j];
        if (!final_out) { GAS v4u* o = (GAS v4u*)(WSB(F, WS_HB) + (size_t)m * D) + tc.lane;
#pragma unroll
            for (int j = 0; j < 2; ++j) o[64 * j] = (v4u){pk2(v[2 * j].x, v[2 * j].y), pk2(v[2 * j].z, v[2 * j].w), pk2(v[2 * j + 1].x, v[2 * j + 1].y), pk2(v[2 * j + 1].z, v[2 * j + 1].w)}; }
        else { float* yo = yrow(F, m); if (yo) { GAS f32x4* o = (GAS f32x4*)yo + 2 * tc.lane;
#pragma unroll
            for (int j = 0; j < 2; ++j) { o[128 * j] = v[2 * j]; o[128 * j + 1] = v[2 * j + 1]; } } }
        }
    }
}
__device__ __forceinline__ void ln_phase(const Frame& F, int idx, bool final_out, int row_lo, int row_hi, int cu_lo, bool comb = false) { ln_rows(F, idx, final_out, row_lo, row_hi, ((int)blockIdx.x - cu_lo) * 8, (F.G - cu_lo) * 8, comb); }
__device__ __forceinline__ float ret_lg2(int h);

using pg8::Unit;
typedef f32x4 AccT[2][2][4][2];
#ifndef LANE_TR
#define LANE_TR 1
#endif
struct LaneT { int tfr, tfq, pull, push; };
#if LANE_TR
__device__ __forceinline__ LaneT lane_t(int fr, int fq) { LaneT t; const int L = fq * 16 + fr; t.tfr = L >> 2; t.tfq = L & 3; t.pull = ((t.tfq << 4) + t.tfr) << 2; t.push = ((fr << 2) + fq) << 2; return t; }
__device__ __forceinline__ unsigned bperm(int a, unsigned x) { return (unsigned)__builtin_amdgcn_ds_bpermute(a, (int)x); }
__device__ __forceinline__ v4u tr4(int a, v4u x) { return (v4u){bperm(a, x.x), bperm(a, x.y), bperm(a, x.z), bperm(a, x.w)}; }
__device__ __forceinline__ v2u tr2(int a, v2u x) { return (v2u){bperm(a, x.x), bperm(a, x.y)}; }
#else
__device__ __forceinline__ LaneT lane_t(int fr, int fq) { LaneT t; t.tfr = fr; t.tfq = fq; t.pull = 0; t.push = 0; return t; }
__device__ __forceinline__ v4u tr4(int, v4u x) { return x; }
__device__ __forceinline__ v2u tr2(int, v2u x) { return x; }
#endif
__device__ __forceinline__ f32x4 tr4f(int a, f32x4 x) { return __builtin_bit_cast(f32x4, tr4(a, __builtin_bit_cast(v4u, x))); }
__device__ __forceinline__ v4u pack8(const f32x4& a, const f32x4& b) { return (v4u){pg8::cvt_pk_bf16(a[0], a[1]), pg8::cvt_pk_bf16(a[2], a[3]), pg8::cvt_pk_bf16(b[0], b[1]), pg8::cvt_pk_bf16(b[2], b[3])}; }

struct EpiSwiglu {
    static constexpr bool PERM = true; static constexpr int NS = 8;
    bf16* act;
    __device__ __forceinline__ bool operator()(AccT& acc, const Unit& u, int wr, int wc, int fr, int fq) const {
        asm volatile("" : "+s"(wr), "+s"(wc), "+v"(fr), "+v"(fq));
        const int row0 = u.pm * 256 + wr * 64 + fr + 16 * (fq & 1), col0 = u.pn * 128 + wc * 16 + 4 * (fq & 2);
#pragma unroll
        for (int ai = 0; ai < 2; ++ai)
#pragma unroll
            for (int mp = 0; mp < 2; ++mp) { bf16* rowp = act + (size_t)(row0 + ai * 128 + mp * 32) * DFF + col0;
#pragma unroll
                for (int bj = 0; bj < 2; ++bj) { unsigned pk[2][2];
#pragma unroll
                    for (int k = 0; k < 2; ++k) { const f32x4 g = acc[ai][bj][2 * mp + k][0], up = acc[ai][bj][2 * mp + k][1];
                        pk[k][0] = pg8::cvt_pk_bf16(siluf_(g[0]) * up[0], siluf_(g[1]) * up[1]); pk[k][1] = pg8::cvt_pk_bf16(siluf_(g[2]) * up[2], siluf_(g[3]) * up[3]); }
                    const auto sx = __builtin_amdgcn_permlane16_swap(pk[0][0], pk[1][0], false, false), sy = __builtin_amdgcn_permlane16_swap(pk[0][1], pk[1][1], false, false);
                    *(GAS v4u*)(rowp + bj * 64) = (v4u){sx[0], sy[0], sx[1], sy[1]}; } }
        return false;
    }
};

struct EpiResid {
    static constexpr bool PERM = true; static constexpr int NS = 16;
    unsigned char* ws; float ca, cb;
    __device__ __forceinline__ bool operator()(AccT& acc, const Unit& u, int wr, int wc, int fr, int fq) const {
        asm volatile("" : "+s"(wr), "+s"(wc), "+v"(fr), "+v"(fq));
        const LaneT t = lane_t(fr, fq);
        const bf16* src = (const bf16*)(ws + WS_HB); bf16* dst = (bf16*)(ws + WS_YB);
        const int row0 = u.pm * 256 + wr * 64 + t.tfr, col0 = u.pn * 256 + wc * 32 + 8 * t.tfq;
#pragma unroll
        for (int ai = 0; ai < 2; ++ai)
#pragma unroll
            for (int m = 0; m < 4; ++m) { const size_t off = (size_t)(row0 + ai * 128 + m * 16) * D + col0;
#pragma unroll
                for (int bj = 0; bj < 2; ++bj) { const v4u r = tr4(t.push, *(const GAS v4u*)(src + off + bj * 128));
                    const f32x4 y0 = (f32x4){bflo(r.x), bfhi(r.x), bflo(r.y), bfhi(r.y)} * ca + acc[ai][bj][m][0] * cb, y1 = (f32x4){bflo(r.z), bfhi(r.z), bflo(r.w), bfhi(r.w)} * ca + acc[ai][bj][m][1] * cb;
                    *(GAS v4u*)(dst + off + bj * 128) = tr4(t.pull, pack8(y0, y1)); } }
        return false;
    }
};

struct EpiGate {
    static constexpr bool PERM = true; static constexpr int NS = 0;
    unsigned char* ws;
    __device__ __forceinline__ bool operator()(AccT& acc, const Unit& u, int wr, int wc, int fr, int fq) const {
        asm volatile("" : "+s"(wr), "+s"(wc), "+v"(fr), "+v"(fq));
        const LaneT t = lane_t(fr, fq);
        const bf16* Gt = (const bf16*)(ws + WS_GT); bf16* mix = (bf16*)(ws + WS_MIX);
        const int n = u.pm / NPANEL, pm = u.pm - n * NPANEL, pn = u.pn & 3;
        const int row0 = pm * 256 + wr * 64 + t.tfr, col0 = pn * 256 + wc * 32 + 8 * t.tfq;
#pragma unroll
        for (int ai = 0; ai < 2; ++ai)
#pragma unroll
            for (int m = 0; m < 4; ++m) { const size_t r = (size_t)(row0 + ai * 128 + m * 16);
#pragma unroll
                for (int bj = 0; bj < 2; ++bj) {
                    const v4u ga = tr4(t.push, *(const GAS v4u*)(Gt + r * (3 * D) + n * D + col0 + bj * 128));
                    float f[8] = {bflo(ga.x), bfhi(ga.x), bflo(ga.y), bfhi(ga.y), bflo(ga.z), bfhi(ga.z), bflo(ga.w), bfhi(ga.w)};
                    if (n < 2) { const v4u gb = tr4(t.push, *(const GAS v4u*)(Gt + r * (3 * D) + (n + 1) * D + col0 + bj * 128));
                        const float h[8] = {bflo(gb.x), bfhi(gb.x), bflo(gb.y), bfhi(gb.y), bflo(gb.z), bfhi(gb.z), bflo(gb.w), bfhi(gb.w)};
#pragma unroll
                        for (int e = 0; e < 8; ++e) f[e] = f[e] * fast_rcp(fmaxf(h[e], 1e-30f)); }
                    f32x4 v0 = acc[ai][bj][m][0], v1 = acc[ai][bj][m][1];
                    v0 = v0 * (f32x4){f[0], f[1], f[2], f[3]}; v1 = v1 * (f32x4){f[4], f[5], f[6], f[7]};
                    acc[ai][bj][m][0] = v0; acc[ai][bj][m][1] = v1;
                    if (n == 2) *(GAS v4u*)(mix + r * D + col0 + bj * 128) = tr4(t.pull, pack8(v0, v1));
                } }
        return n < 2;
    }
};
struct Order3 : pg8::StaticOrder {
    __device__ __forceinline__ bool next(int i, Unit& u) const { Unit t; if (!pg8::StaticOrder::next(i / 3, t)) return false; const int k = i % 3; u.pm = t.pm + k * NPANEL; u.pn = t.pn + 4 * k; return true; }
};

struct SmallOrder {
    int c;
    __device__ __forceinline__ bool next(int i, Unit& u) const { if (i > 0 || c >= 8) return false; u.pm = 256 + (c >> 2); u.pn = c & 3; return true; }
    __device__ __forceinline__ void a_ready(const Unit&) const {}
    __device__ __forceinline__ void done(const Unit&) const {}
};

struct SmallOrderH {
    int c;
    __device__ __forceinline__ bool next(int i, Unit& u) const { if (i > 0 || c >= 16) return false; u.pm = 256 + ((c >> 2) & 1); u.pn = c & 3; return true; }
    __device__ __forceinline__ void a_ready(const Unit&) const {}
    __device__ __forceinline__ void done(const Unit&) const {}
};
struct EpiPart {
    static constexpr bool PERM = true; static constexpr int NS = 16;
    float* part;
    __device__ __forceinline__ bool operator()(AccT& acc, const Unit& u, int wr, int wc, int fr, int fq) const {
        asm volatile("" : "+s"(wr), "+s"(wc), "+v"(fr), "+v"(fq));
        float* p0 = part + (size_t)((u.pm - 256) * 256 + wr * 64 + fr) * D + u.pn * 256 + wc * 32 + 8 * fq;
#pragma unroll
        for (int ai = 0; ai < 2; ++ai)
#pragma unroll
            for (int m = 0; m < 4; ++m)
#pragma unroll
                for (int bj = 0; bj < 2; ++bj)
#pragma unroll
                    for (int n = 0; n < 2; ++n) *(GAS f32x4*)(p0 + (size_t)(ai * 128 + m * 16) * D + bj * 128 + 4 * n) = acc[ai][bj][m][n];
        return false;
    }
};

struct SmallOrder3 {
    int c;
    __device__ __forceinline__ bool next(int i, Unit& u) const { if (i > 2) return false; u.pm = 256 + (c >> 2) + i * NPANEL; u.pn = (c & 3) + 4 * i; return true; }
    __device__ __forceinline__ void a_ready(const Unit&) const {}
    __device__ __forceinline__ void done(const Unit&) const {}
};
struct SmallOrderW {
    int c;
    __device__ __forceinline__ bool next(int i, Unit& u) const { if (i > 0) return false; const int p = c >= 22 ? 1 : 0; u.pm = 256 + p; u.pn = c - 22 * p; return true; }
    __device__ __forceinline__ void a_ready(const Unit&) const {}
    __device__ __forceinline__ void done(const Unit&) const {}
};

struct EpiWin {
    static constexpr bool PERM = true; static constexpr int NS = 16;
    unsigned char* ws; float* out; int layer;
    __device__ __forceinline__ bool operator()(AccT& acc, const Unit& u, int wr, int wc, int fr, int fq) const {
        asm volatile("" : "+s"(wr), "+s"(wc), "+v"(fr), "+v"(fq));
        const LaneT t = lane_t(fr, fq);
        const int pn = u.pn, pm = u.pm, rl0 = wr * 64 + fr, trl0 = wr * 64 + t.tfr;
        if (pn < 4) {
            const bool isk = pn >= 2; bf16* dst = (bf16*)(ws + (isk ? WS_KR : WS_QR)); const float sc = isk ? 0.08838834764831845f : 1.0f;
            const float lgA = ret_lg2(2 * (pn & 1)) * (isk ? -1.f : 1.f), lgB = ret_lg2(2 * (pn & 1) + 1) * (isk ? -1.f : 1.f);
            float invf[4];
#pragma unroll
            for (int e = 0; e < 4; ++e) invf[e] = fast_exp2(-(float)(16 * wc + 4 * fq + e) * (13.287712379549449f / 64.0f)) * 0.15915494309189535f;
#pragma unroll
            for (int ai = 0; ai < 2; ++ai)
#pragma unroll
                for (int mp = 0; mp < 2; ++mp) { unsigned pk1[2][2][2], pk2[2][2][2];
#pragma unroll
                    for (int k = 0; k < 2; ++k) { const int rl = rl0 + ai * 128 + (2 * mp + k) * 16, r = pm * 256 + rl;
                        const float pos = (float)(pm < 256 ? NMETA + (r & (T - 1)) : (pm == 256 ? NMETA + PAST + (rl & (ST - 1)) : rl));
                        const float jp1 = (float)((pm < 256 ? (r & 63) : (pm == 256 ? (rl & (ST - 1)) : rl)) + 1);
                        const float dsc[2] = {sc * fast_exp2(jp1 * lgA), sc * fast_exp2(jp1 * lgB)};
                        f32x4 cs, sn;
#pragma unroll
                        for (int e = 0; e < 4; ++e) { float rev = pos * invf[e]; rev = rev - floorf(rev); cs[e] = __builtin_amdgcn_cosf(rev); sn[e] = __builtin_amdgcn_sinf(rev); }
#pragma unroll
                        for (int bj = 0; bj < 2; ++bj) { const f32x4 x1 = acc[ai][bj][2 * mp + k][0], x2 = acc[ai][bj][2 * mp + k][1];
                            const f32x4 o1 = (x1 * cs - x2 * sn) * dsc[bj], o2 = (x2 * cs + x1 * sn) * dsc[bj];
                            pk1[k][bj][0] = pg8::cvt_pk_bf16(o1[0], o1[1]); pk1[k][bj][1] = pg8::cvt_pk_bf16(o1[2], o1[3]);
                            pk2[k][bj][0] = pg8::cvt_pk_bf16(o2[0], o2[1]); pk2[k][bj][1] = pg8::cvt_pk_bf16(o2[2], o2[3]); } }
                    const size_t srow = (size_t)(pm * 256 + rl0 + ai * 128 + (2 * mp + (fq & 1)) * 16);
#pragma unroll
                    for (int bj = 0; bj < 2; ++bj) { bf16* rowp = dst + srow * 512 + (2 * (pn & 1) + bj) * 128 + 16 * wc + 4 * (fq & 2);
                        { const auto sx = __builtin_amdgcn_permlane16_swap(pk1[0][bj][0], pk1[1][bj][0], false, false), sy = __builtin_amdgcn_permlane16_swap(pk1[0][bj][1], pk1[1][bj][1], false, false);
                          *(GAS v4u*)rowp = (v4u){sx[0], sy[0], sx[1], sy[1]}; }
                        { const auto sx = __builtin_amdgcn_permlane16_swap(pk2[0][bj][0], pk2[1][bj][0], false, false), sy = __builtin_amdgcn_permlane16_swap(pk2[0][bj][1], pk2[1][bj][1], false, false);
                          *(GAS v4u*)(rowp + 64) = (v4u){sx[0], sy[0], sx[1], sy[1]}; } } }
            return false;
        }
        const int seg = (pn - 4) >> 2;
        const int colt = ((pn - 4) & 3) * 256 + wc * 32 + 8 * t.tfq;
        if (seg == 0 || seg == 1 || seg == 2 || seg >= 6) {
            bf16* dst = (bf16*)(ws + (seg == 0 ? WS_VR : seg == 1 ? WS_GR : seg == 2 ? WS_QS : WS_GT)); const int ld = seg >= 6 ? 3 * D : D; const int cofs = seg >= 6 ? (seg - 6) * D : 0;
#pragma unroll
            for (int ai = 0; ai < 2; ++ai)
#pragma unroll
                for (int m = 0; m < 4; ++m) { const size_t r = (size_t)(pm * 256 + trl0 + ai * 128 + m * 16);
#pragma unroll
                    for (int bj = 0; bj < 2; ++bj) { f32x4 v0 = acc[ai][bj][m][0], v1 = acc[ai][bj][m][1];
                        if (seg == 1) {
#pragma unroll
                            for (int e = 0; e < 4; ++e) { v0[e] = siluf_(v0[e]); v1[e] = siluf_(v1[e]); } }
                        else if (seg == 2) { v0 = v0 * (0.08838834764831845f * LOG2E); v1 = v1 * (0.08838834764831845f * LOG2E); }
                        else if (seg >= 6) {
#pragma unroll
                            for (int e = 0; e < 4; ++e) { v0[e] = sigmoidf_(v0[e]); v1[e] = sigmoidf_(v1[e]); } }
                        *(GAS v4u*)(dst + r * ld + cofs + colt + bj * 128) = tr4(t.pull, pack8(v0, v1)); } }
            return false;
        }
        if (seg == 3 || seg == 4) {
            bf16* dst = (bf16*)(ws + (seg == 3 ? WS_KS : WS_VS));
            float* op = out + (seg == 3 ? O_KP : O_VP) + (size_t)layer * NB * KT_PP * D;
            float* os = out + (seg == 3 ? O_KS : O_VS) + (size_t)layer * SBATCH * ST * D;
#pragma unroll
            for (int ai = 0; ai < 2; ++ai)
#pragma unroll
                for (int m = 0; m < 4; ++m) { const int rl = trl0 + ai * 128 + m * 16; const size_t r = (size_t)(pm * 256 + rl);
#pragma unroll
                    for (int bj = 0; bj < 2; ++bj) { const f32x4 v0 = tr4f(t.pull, acc[ai][bj][m][0]), v1 = tr4f(t.pull, acc[ai][bj][m][1]); const int c = colt + bj * 128;
                        *(GAS v4u*)(dst + r * D + c) = pack8(v0, v1);
                        if (pm < 256) { float* o = op + ((size_t)(r >> 11) * KT_PP + NMETA + (r & (T - 1))) * D + c; *(GAS f32x4*)o = v0; *(GAS f32x4*)(o + 4) = v1; }
                        else if (pm == 256) { float* o = os + (size_t)rl * D + c; *(GAS f32x4*)o = v0; *(GAS f32x4*)(o + 4) = v1; }
                        else if (rl < NMETA) { for (int bb = 0; bb < NB; ++bb) { float* o = op + ((size_t)bb * KT_PP + rl) * D + c; *(GAS f32x4*)o = v0; *(GAS f32x4*)(o + 4) = v1; } }
                    } }
            return false;
        }
        {
            float* op = out + O_PP + (size_t)layer * NB * PBUF * D;
            float* os = out + O_PS + (size_t)layer * SBATCH * PBUF * D;
#pragma unroll
            for (int ai = 0; ai < 2; ++ai)
#pragma unroll
                for (int m = 0; m < 4; ++m) { const int rl = trl0 + ai * 128 + m * 16; const size_t r = (size_t)(pm * 256 + rl);
#pragma unroll
                    for (int bj = 0; bj < 2; ++bj) { const f32x4 v0 = tr4f(t.pull, acc[ai][bj][m][0]), v1 = tr4f(t.pull, acc[ai][bj][m][1]); const int c = colt + bj * 128;
                        *(GAS v4u*)((bf16*)(ws + WS_U) + r * D + c) = pack8(v0, v1);
                        if (pm < 256) { const int tt = (int)(r & (T - 1)); if (tt >= T - PBUF) { float* o = op + ((size_t)(r >> 11) * PBUF + (tt - (T - PBUF))) * D + c; *(GAS f32x4*)o = v0; *(GAS f32x4*)(o + 4) = v1; } }
                        else if (pm == 256) { const int tt = rl & (ST - 1); if (tt >= ST - PBUF) { float* o = os + ((size_t)(rl >> 5) * PBUF + (tt - (ST - PBUF))) * D + c; *(GAS f32x4*)o = v0; *(GAS f32x4*)(o + 4) = v1; } }
                    } }
            return false;
        }
    }
};

__device__ __forceinline__ int grab(const Frame& F, gu32* ctr) {
    __syncthreads();
    if (F.wave == 0 && lane_lo_() == 0u) F.MISC[16] = __hip_atomic_fetch_add(ctr, 1u, RLX_AGENT);
    __syncthreads();
    return (int)F.MISC[16];
}
__device__ __forceinline__ unsigned grab_issue(const Frame& F, gu32* ctr) { return (F.wave == 0 && lane_lo_() == 0u) ? __hip_atomic_fetch_add(ctr, 1u, RLX_AGENT) : 0u; }
__device__ __forceinline__ int grab_publish(const Frame& F, unsigned nxt) {
    __syncthreads();
    if (F.wave == 0 && lane_lo_() == 0u) F.MISC[16] = nxt;
    __syncthreads();
    return (int)F.MISC[16];
}
typedef float f32x4_t __attribute__((ext_vector_type(4)));
#define MFMA16(a, b, c) __builtin_amdgcn_mfma_f32_16x16x32_bf16((a), (b), (c), 0, 0, 0)
__device__ __forceinline__ s16x4 tr16(const LAS unsigned char* p) { typedef short v4i16_t __attribute__((ext_vector_type(4))); return __builtin_bit_cast(s16x4, __builtin_amdgcn_ds_read_tr16_b64_v4i16((LAS v4i16_t*)p)); }

constexpr int RT_QS = 272, RT_VS = 528, RT_AS = 144;
constexpr int RT_Q = 0, RT_K = 64 * RT_QS, RT_V = 2 * 64 * RT_QS, RT_A = RT_V + 64 * RT_VS, RT_END = RT_A + 64 * RT_AS;
static_assert(RT_END <= RING_BYTES && 64 * 256 * 4 <= RT_END, "retention LDS map");
__device__ __forceinline__ float ret_lg2(int h) { return fast_log2(1.0f - fast_exp2(-5.0f - (float)h * (4.0f / 3.0f))); }
__device__ __forceinline__ void ret_unit(const Frame& F, int layer, int uid) {
    const int h = uid & 3; int stream, b;
    if (uid < 128) { stream = 0; b = uid >> 2; } else if (uid < 160) { stream = 1; b = (uid - 128) >> 2; } else { stream = 2; b = 0; }
    const TC tc = thread_coords(F.wave); const int tid = tc.tid, lane = tc.lane, w = tc.wave, l15 = lane & 15, g = lane >> 4, q4 = l15 >> 2, p4 = l15 & 3;
    const float lg2 = ret_lg2(h);
    const int nch = stream == 0 ? 1 + T / 64 : 1;
    f32x4 accS[8][2];
#pragma unroll
    for (int m = 0; m < 8; ++m)
#pragma unroll
        for (int n = 0; n < 2; ++n) accS[m][n] = (f32x4){0.f, 0.f, 0.f, 0.f};
    if (stream == 1) { const float* s0 = in_ptr(IN_SRET) + (((size_t)layer * SBATCH + b) * HRET + h) * DKR * DVR;
#pragma unroll
        for (int m = 0; m < 8; ++m)
#pragma unroll
            for (int n = 0; n < 2; ++n)
#pragma unroll
                for (int r = 0; r < 4; ++r) accS[m][n][r] = s0[(size_t)(16 * m + 4 * g + r) * DVR + 32 * w + 16 * n + l15]; }
    v4u qreg[2], kreg[2], vreg[4];
    const int lrow = tid >> 4, lch = tid & 15, vrow = tid >> 5, vch = tid & 31;
#define RT_CHUNK(c, rb, vl) do { if (stream == 0) { if ((c) == 0) { rb = ROW_M; vl = NMETA; } else { rb = b * T + 64 * ((c) - 1); vl = 64; } } \
        else if (stream == 1) { rb = ROW_S + b * ST; vl = ST; } else { rb = ROW_M; vl = NMETA; } } while (0)
#define RT_LOAD(c) do { int rb_, vl_; RT_CHUNK(c, rb_, vl_); \
        _Pragma("unroll") for (int i_ = 0; i_ < 2; ++i_) { const int r_ = lrow + 32 * i_; qreg[i_] = (v4u){0u, 0u, 0u, 0u}; kreg[i_] = (v4u){0u, 0u, 0u, 0u}; \
            if (r_ < vl_) { const size_t o_ = (size_t)(rb_ + r_) * 512 + h * 128 + lch * 8; qreg[i_] = *(const GAS v4u*)(WSB(F, WS_QR) + o_); kreg[i_] = *(const GAS v4u*)(WSB(F, WS_KR) + o_); } } \
        _Pragma("unroll") for (int i_ = 0; i_ < 4; ++i_) { const int r_ = vrow + 16 * i_; vreg[i_] = (v4u){0u, 0u, 0u, 0u}; \
            if (r_ < vl_) vreg[i_] = *(const GAS v4u*)(WSB(F, WS_VR) + (size_t)(rb_ + r_) * D + h * 256 + vch * 8); } } while (0)
    RT_LOAD(0);
    const LAS unsigned char* Ql = F.lds + RT_Q; const LAS unsigned char* Kl = F.lds + RT_K; const LAS unsigned char* Vl = F.lds + RT_V; const LAS unsigned char* Al = F.lds + RT_A;
    for (int c = 0; c < nch; ++c) {
        int rowbase, valid; RT_CHUNK(c, rowbase, valid);
        const bool write_out = !(stream == 0 && c == 0);
        const float dc = fast_exp2((float)valid * lg2);
        __syncthreads();
#pragma unroll
        for (int i = 0; i < 2; ++i) { *(LAS v4u*)(F.lds + RT_Q + (lrow + 32 * i) * RT_QS + lch * 16) = qreg[i]; *(LAS v4u*)(F.lds + RT_K + (lrow + 32 * i) * RT_QS + lch * 16) = kreg[i]; }
#pragma unroll
        for (int i = 0; i < 4; ++i) *(LAS v4u*)(F.lds + RT_V + (vrow + 16 * i) * RT_VS + vch * 16) = vreg[i];
        __syncthreads();
        if (c + 1 < nch) RT_LOAD(c + 1);
#pragma unroll
        for (int tt = 0; tt < 2; ++tt) { const int id = 2 * w + tt, mt = id >> 2, nt = id & 3;
            f32x4 a4 = (f32x4){0.f, 0.f, 0.f, 0.f};
            if (mt <= nt) {
#pragma unroll
                for (int ks = 0; ks < 4; ++ks) { const bf16x8 A = *(const LAS bf16x8*)(Kl + (16 * mt + l15) * RT_QS + 64 * ks + 16 * g); const bf16x8 B = *(const LAS bf16x8*)(Ql + (16 * nt + l15) * RT_QS + 64 * ks + 16 * g);
                    a4 = MFMA16(A, B, a4); }
#pragma unroll
                for (int r = 0; r < 4; ++r) a4[r] = (16 * mt + 4 * g + r <= 16 * nt + l15) ? a4[r] : 0.f;
            }
            *(LAS v2u*)(F.lds + RT_A + (16 * nt + l15) * RT_AS + (16 * mt + 4 * g) * 2) = (v2u){pg8::cvt_pk_bf16(a4[0], a4[1]), pg8::cvt_pk_bf16(a4[2], a4[3])}; }
        __syncthreads();
        f32x4 accO[4][2];
#pragma unroll
        for (int m = 0; m < 4; ++m)
#pragma unroll
            for (int n = 0; n < 2; ++n) accO[m][n] = (f32x4){0.f, 0.f, 0.f, 0.f};
#pragma unroll
        for (int ks = 0; ks < 4; ++ks) {
            bf16x8 Sf[2];
#pragma unroll
            for (int n = 0; n < 2; ++n) Sf[n] = __builtin_bit_cast(bf16x8, (v4u){pg8::cvt_pk_bf16(accS[2 * ks][n][0], accS[2 * ks][n][1]), pg8::cvt_pk_bf16(accS[2 * ks][n][2], accS[2 * ks][n][3]),
                                                                               pg8::cvt_pk_bf16(accS[2 * ks + 1][n][0], accS[2 * ks + 1][n][1]), pg8::cvt_pk_bf16(accS[2 * ks + 1][n][2], accS[2 * ks + 1][n][3])});
#pragma unroll
            for (int m = 0; m < 4; ++m) { const v2u lo = *(const LAS v2u*)(Ql + (16 * m + l15) * RT_QS + (32 * ks + 4 * g) * 2), hi = *(const LAS v2u*)(Ql + (16 * m + l15) * RT_QS + (32 * ks + 16 + 4 * g) * 2);
                const bf16x8 A = __builtin_bit_cast(bf16x8, (v4u){lo.x, lo.y, hi.x, hi.y});
#pragma unroll
                for (int n = 0; n < 2; ++n) accO[m][n] = MFMA16(A, Sf[n], accO[m][n]); }
        }
        bf16x8 Bv[2][2];
#pragma unroll
        for (int k2 = 0; k2 < 2; ++k2)
#pragma unroll
            for (int n = 0; n < 2; ++n) { const s16x4 lo = tr16(Vl + (32 * k2 + 8 * g + q4) * RT_VS + (32 * w + 16 * n + 4 * p4) * 2), hi = tr16(Vl + (32 * k2 + 8 * g + 4 + q4) * RT_VS + (32 * w + 16 * n + 4 * p4) * 2);
                Bv[k2][n] = __builtin_shufflevector(lo, hi, 0, 1, 2, 3, 4, 5, 6, 7); }
#pragma unroll
        for (int k2 = 0; k2 < 2; ++k2)
#pragma unroll
            for (int m = 0; m < 4; ++m) { const bf16x8 A = *(const LAS bf16x8*)(Al + (16 * m + l15) * RT_AS + (32 * k2 + 8 * g) * 2);
#pragma unroll
                for (int n = 0; n < 2; ++n) accO[m][n] = MFMA16(A, Bv[k2][n], accO[m][n]); }
#pragma unroll
        for (int m = 0; m < 8; ++m)
#pragma unroll
            for (int k2 = 0; k2 < 2; ++k2) { const s16x4 lo = tr16(Kl + (32 * k2 + 8 * g + q4) * RT_QS + (16 * m + 4 * p4) * 2), hi = tr16(Kl + (32 * k2 + 8 * g + 4 + q4) * RT_QS + (16 * m + 4 * p4) * 2);
                const bf16x8 A = __builtin_shufflevector(lo, hi, 0, 1, 2, 3, 4, 5, 6, 7);
#pragma unroll
                for (int n = 0; n < 2; ++n) accS[m][n] = MFMA16(A, Bv[k2][n], accS[m][n]); }
#pragma unroll
        for (int m = 0; m < 8; ++m)
#pragma unroll
            for (int n = 0; n < 2; ++n) accS[m][n] = accS[m][n] * dc;
        if (write_out) {
            __syncthreads();
            LAS float* oL = (LAS float*)F.lds;
#pragma unroll
            for (int m = 0; m < 4; ++m)
#pragma unroll
                for (int n = 0; n < 2; ++n)
#pragma unroll
                    for (int r = 0; r < 4; ++r) oL[(16 * m + 4 * g + r) * 256 + 32 * w + 16 * n + l15] = accO[m][n][r];
            __syncthreads();
            const f32x4 gn = *(const GAS f32x4*)(in_ptr(IN_RETG) + ((size_t)layer * HRET + h) * DVR + lane * 4);
#pragma unroll
            for (int hb2 = 0; hb2 < 2; ++hb2) {
            f32x4 x[4]; v2u gr[4]; float s1[4], s2[4];
#pragma unroll
            for (int tt = 0; tt < 4; ++tt) { const int t = w * 8 + hb2 * 4 + tt; x[tt] = *(const LAS f32x4*)(oL + t * 256 + lane * 4); gr[tt] = *(const GAS v2u*)(WSB(F, WS_GR) + (size_t)(rowbase + t) * D + h * 256 + lane * 4);
                s1[tt] = (x[tt][0] + x[tt][1]) + (x[tt][2] + x[tt][3]); }
#pragma unroll
            for (int o = 1; o < 64; o <<= 1)
#pragma unroll
                for (int tt = 0; tt < 4; ++tt) s1[tt] += __shfl_xor(s1[tt], o);
#pragma unroll
            for (int tt = 0; tt < 4; ++tt) { x[tt] = x[tt] - s1[tt] * (1.f / 256.f); s2[tt] = (x[tt][0] * x[tt][0] + x[tt][1] * x[tt][1]) + (x[tt][2] * x[tt][2] + x[tt][3] * x[tt][3]); }
#pragma unroll
            for (int o = 1; o < 64; o <<= 1)
#pragma unroll
                for (int tt = 0; tt < 4; ++tt) s2[tt] += __shfl_xor(s2[tt], o);
#pragma unroll
            for (int tt = 0; tt < 4; ++tt) { const int t = w * 8 + hb2 * 4 + tt; const float rstd = 1.f / sqrtf(s2[tt] * (1.f / 256.f) + LN_EPS);
                const f32x4 y = x[tt] * rstd * gn * (f32x4){bflo(gr[tt].x), bfhi(gr[tt].x), bflo(gr[tt].y), bfhi(gr[tt].y)};
                if (t < valid) *(GAS v2u*)(WSB(F, WS_BR) + (size_t)(rowbase + t) * D + h * 256 + lane * 4) = (v2u){pk2(y[0], y[1]), pk2(y[2], y[3])}; }
            }
        }
    }
#undef RT_LOAD
#undef RT_CHUNK
    if (stream != 2) { float* d = F.out + (stream == 0 ? O_RP + (((size_t)layer * NB + b) * HRET + h) * DKR * DVR : O_RS + (((size_t)layer * SBATCH + b) * HRET + h) * DKR * DVR);
#pragma unroll
        for (int m = 0; m < 8; ++m)
#pragma unroll
            for (int n = 0; n < 2; ++n)
#pragma unroll
                for (int r = 0; r < 4; ++r) d[(size_t)(16 * m + 4 * g + r) * DVR + 32 * w + 16 * n + l15] = accS[m][n][r]; }
}

constexpr int AT_RS = 272;
constexpr int AT_VOFF = 64 * AT_RS;
constexpr int AT_QOFF = 36864;
static_assert(AT_QOFF >= 2 * 64 * AT_RS && AT_QOFF + 8 * 8 * 1024 <= RING_BYTES, "attention LDS map");
template <bool F32KV> __device__ __forceinline__ void attn_unit(const Frame& F, int layer, int uid) {
    int stream, b, h, qb;
    if (uid < 64) { stream = 1; b = uid >> 3; h = uid & 7; qb = 0; }
    else if (uid < 64 + 2048) { const int idx = uid - 64; qb = 7 - (idx >> 8); b = (idx & 255) >> 3; h = idx & 7; stream = 0; }
    else { stream = 2; b = 0; h = (uid - (64 + 2048)) & 7; qb = 0; }
    const bf16 *k0p = nullptr, *k1p = nullptr, *v0p = nullptr, *v1p = nullptr; const float *k0f = nullptr, *k1f = nullptr, *v0f = nullptr, *v1f = nullptr; int len0, Tq, rowbase;
    if (stream == 0) { k0p = WSB(F, WS_KS) + (size_t)ROW_M * D; v0p = WSB(F, WS_VS) + (size_t)ROW_M * D; len0 = NMETA; k1p = WSB(F, WS_KS) + (size_t)b * T * D; v1p = WSB(F, WS_VS) + (size_t)b * T * D; Tq = T; rowbase = b * T; }
    else if (stream == 1) { k0f = in_ptr(IN_CK) + ((size_t)layer * SBATCH + b) * PAST * D; v0f = in_ptr(IN_CV) + ((size_t)layer * SBATCH + b) * PAST * D; len0 = PAST;
        k1f = F.out + O_KS + ((size_t)layer * SBATCH + b) * ST * D; v1f = F.out + O_VS + ((size_t)layer * SBATCH + b) * ST * D; Tq = ST; rowbase = ROW_S + b * ST; }
    else { k0p = k1p = WSB(F, WS_KS) + (size_t)ROW_M * D; v0p = v1p = WSB(F, WS_VS) + (size_t)ROW_M * D; len0 = 0; Tq = NMETA; rowbase = ROW_M; }
    constexpr int NQ = F32KV ? 1 : 2, QPW = 16 * NQ, QBLK = 8 * QPW;
    const int Stot = len0 + Tq, q0 = qb * QBLK;
    const TC tc = thread_coords(F.wave); const int tid = tc.tid, lane = tc.lane, w = tc.wave, l15 = lane & 15, g = lane >> 4;
    int qi[NQ]; bool valid_q[NQ]; int lim[NQ];
#pragma unroll
    for (int nb = 0; nb < NQ; ++nb) { qi[nb] = q0 + 16 * (NQ == 2 ? (nb == 0 ? w : 15 - w) : w) + l15; valid_q[nb] = qi[nb] < Tq; lim[nb] = len0 + qi[nb]; }
    bf16x8 qf[NQ][4];
#pragma unroll
    for (int nb = 0; nb < NQ; ++nb)
#pragma unroll
    for (int ks = 0; ks < 4; ++ks) { v4u t4 = (v4u){0u, 0u, 0u, 0u}; if (valid_q[nb]) t4 = *(const GAS v4u*)(WSB(F, WS_QS) + (size_t)(rowbase + qi[nb]) * D + h * 128 + 32 * ks + 8 * g); qf[nb][ks] = __builtin_bit_cast(bf16x8, t4); }
    float zq[NQ];
#pragma unroll
    for (int nb = 0; nb < NQ; ++nb) zq[nb] = 64.0f;
    f32x4 o[NQ][8];
#pragma unroll
    for (int nb = 0; nb < NQ; ++nb)
#pragma unroll
    for (int i = 0; i < 8; ++i) o[nb][i] = (f32x4){0.f, 0.f, 0.f, 0.f};
    float R[NQ]; bool anyv_ = false;
#pragma unroll
    for (int nb = 0; nb < NQ; ++nb) { R[nb] = 0.f; anyv_ = anyv_ || valid_q[nb]; }
    bool done1 = false;
    bool wave_done = __all(!anyv_) != 0;
    const int qend = (q0 + QBLK < Tq) ? q0 + QBLK : Tq;
    const int kt_max = (len0 + qend - 2) >> 6;
    const int lrow = tid >> 4, lch = tid & 15;
    constexpr int NR = F32KV ? 4 : 2;
    constexpr int DIST = F32KV ? 1 : 2;
    v4u kregA[NR], vregA[NR], kregB[NR], vregB[NR];
#define AT_LOAD(kt, KR, VR) do { _Pragma("unroll") for (int i_ = 0; i_ < 2; ++i_) { int s_ = ((kt) > 0 ? (kt) : 0) * 64 + lrow + 32 * i_; s_ = s_ < Stot ? s_ : Stot - 1; \
        const size_t off_ = (s_ < len0 ? (size_t)s_ : (size_t)(s_ - len0)) * D + h * 128 + lch * 8; \
        if constexpr (F32KV) { const float* kp_ = (s_ < len0 ? k0f : k1f) + off_; const float* vp_ = (s_ < len0 ? v0f : v1f) + off_; \
            asm volatile("global_load_dwordx4 %0, %1, off" : "=&v"(KR[2 * i_]) : "v"(kp_) : "memory"); asm volatile("global_load_dwordx4 %0, %1, off offset:16" : "=&v"(KR[2 * i_ + 1]) : "v"(kp_) : "memory"); \
            asm volatile("global_load_dwordx4 %0, %1, off" : "=&v"(VR[2 * i_]) : "v"(vp_) : "memory"); asm volatile("global_load_dwordx4 %0, %1, off offset:16" : "=&v"(VR[2 * i_ + 1]) : "v"(vp_) : "memory"); } \
        else { const bf16* kp_ = (s_ < len0 ? k0p : k1p) + off_; const bf16* vp_ = (s_ < len0 ? v0p : v1p) + off_; \
            asm volatile("global_load_dwordx4 %0, %1, off" : "=&v"(KR[i_]) : "v"(kp_) : "memory"); asm volatile("global_load_dwordx4 %0, %1, off" : "=&v"(VR[i_]) : "v"(vp_) : "memory"); } } } while (0)
    AT_LOAD(kt_max, kregA, vregA);
    if constexpr (!F32KV) AT_LOAD(kt_max - 1, kregB, vregB);
    const LAS unsigned char* Ql = F.lds + AT_QOFF + w * (NQ * 4096);
#pragma unroll
    for (int nb = 0; nb < NQ; ++nb)
#pragma unroll
        for (int ks = 0; ks < 4; ++ks) *(LAS v4u*)(F.lds + AT_QOFF + w * (NQ * 4096) + ((nb * 4 + ks) * 64 + lane) * 16) = __builtin_bit_cast(v4u, qf[nb][ks]);
    const LAS unsigned char* Kl = F.lds; const LAS unsigned char* Vl = F.lds + AT_VOFF;
    const int q4 = l15 >> 2, p4 = l15 & 3;
#define AT_BODY(NB0_, NB1_) { \
        f32x4 z[NQ][4]; \
        _Pragma("unroll") \
        for (int mt = 0; mt < 4; ++mt) { _Pragma("unroll") for (int nb = (NB0_); nb < (NB1_); ++nb) z[nb][mt] = (f32x4){0.f, 0.f, 0.f, 0.f}; } \
        _Pragma("unroll") \
        for (int ks = 0; ks < 4; ++ks) { bf16x8 qa[NQ]; _Pragma("unroll") for (int nb = (NB0_); nb < (NB1_); ++nb) qa[nb] = *(const LAS bf16x8*)(Ql + ((nb * 4 + ks) * 64 + lane) * 16); \
        _Pragma("unroll") \
            for (int mt = 0; mt < 4; ++mt) { const bf16x8 a = *(const LAS bf16x8*)(Kl + (16 * mt + l15) * AT_RS + 64 * ks + 16 * g); _Pragma("unroll") for (int nb = (NB0_); nb < (NB1_); ++nb) z[nb][mt] = MFMA16(a, qa[nb], z[nb][mt]); } } \
        bf16x8 pf[NQ][2]; \
        _Pragma("unroll") \
        for (int nb = (NB0_); nb < (NB1_); ++nb) { \
        bf16x8 triA, triB, ones; \
        _Pragma("unroll") \
        for (int e = 0; e < 8; ++e) { const int jl = 16 * (e >> 2) + 4 * g + (e & 3); triA[e] = (short)(jl >= l15 ? 0x3f80 : 0); triB[e] = (short)(jl >= l15 + 16 ? 0x3f80 : 0); ones[e] = (short)0x3f80; } \
        f32x4 sp[4]; \
        if (need_mask) { \
        _Pragma("unroll") \
            for (int mt = 0; mt < 4; ++mt) \
        _Pragma("unroll") \
                for (int r = 0; r < 4; ++r) { const bool vis = (tb + 16 * mt + 4 * g + r) < lim[nb]; const float zz = fminf(z[nb][mt][r], 80.f); z[nb][mt][r] = vis ? zz : -1.0e30f; \
                    sp[mt][r] = vis ? fast_log2(1.0f + fast_exp2(zz)) : 0.f; } \
        } else { \
        _Pragma("unroll") \
            for (int mt = 0; mt < 4; ++mt) \
        _Pragma("unroll") \
                for (int r = 0; r < 4; ++r) { const float zz = fminf(z[nb][mt][r], 80.f); z[nb][mt][r] = zz; sp[mt][r] = fast_log2(1.0f + fast_exp2(zz)); } \
        } \
        bf16x8 spf[2]; \
        _Pragma("unroll") \
        for (int k2 = 0; k2 < 2; ++k2) spf[k2] = __builtin_bit_cast(bf16x8, (v4u){pg8::cvt_pk_bf16(sp[2 * k2][0], sp[2 * k2][1]), pg8::cvt_pk_bf16(sp[2 * k2][2], sp[2 * k2][3]), \
                                                                                  pg8::cvt_pk_bf16(sp[2 * k2 + 1][0], sp[2 * k2 + 1][1]), pg8::cvt_pk_bf16(sp[2 * k2 + 1][2], sp[2 * k2 + 1][3])}); \
        const f32x4 zero4 = (f32x4){0.f, 0.f, 0.f, 0.f}; \
        f32x4 I0 = MFMA16(triA, spf[0], zero4); I0 = MFMA16(ones, spf[1], I0); \
        f32x4 I1 = MFMA16(triB, spf[0], zero4); I1 = MFMA16(ones, spf[1], I1); \
        f32x4 I2 = MFMA16(triA, spf[1], zero4); \
        f32x4 I3 = MFMA16(triB, spf[1], zero4); \
        f32x4 tot = MFMA16(ones, spf[0], zero4); tot = MFMA16(ones, spf[1], tot); \
        const f32x4 II[4] = {I0, I1, I2, I3}; \
        f32x4 wv[4]; \
        _Pragma("unroll") \
        for (int mt = 0; mt < 4; ++mt) \
        _Pragma("unroll") \
            for (int r = 0; r < 4; ++r) wv[mt][r] = fast_exp2(z[nb][mt][r] - II[mt][r] - R[nb]); \
        _Pragma("unroll") \
        for (int k2 = 0; k2 < 2; ++k2) pf[nb][k2] = __builtin_bit_cast(bf16x8, (v4u){pg8::cvt_pk_bf16(wv[2 * k2][0], wv[2 * k2][1]), pg8::cvt_pk_bf16(wv[2 * k2][2], wv[2 * k2][3]), \
                                                                                 pg8::cvt_pk_bf16(wv[2 * k2 + 1][0], wv[2 * k2 + 1][1]), pg8::cvt_pk_bf16(wv[2 * k2 + 1][2], wv[2 * k2 + 1][3])}); \
        R[nb] += tot[0]; \
        } \
        _Pragma("unroll") \
        for (int mt8 = 0; mt8 < 8; ++mt8) \
        _Pragma("unroll") \
            for (int k2 = 0; k2 < 2; ++k2) { \
                const s16x4 lo = tr16(Vl + (32 * k2 + 4 * g + q4) * AT_RS + (16 * mt8 + 4 * p4) * 2); \
                const s16x4 hi = tr16(Vl + (32 * k2 + 16 + 4 * g + q4) * AT_RS + (16 * mt8 + 4 * p4) * 2); \
                const bf16x8 a = __builtin_shufflevector(lo, hi, 0, 1, 2, 3, 4, 5, 6, 7); \
                _Pragma("unroll") for (int nb = (NB0_); nb < (NB1_); ++nb) o[nb][mt8] = MFMA16(a, pf[nb][k2], o[nb][mt8]); } \
        }
#define AT_ITER(KT_, KR_, VR_) { const int kt = (KT_); \
        __syncthreads(); \
        if (kt < kt_max) { unsigned allok = 1u; \
        _Pragma("unroll") \
            for (int i = 0; i < 8; ++i) allok &= F.MISC[24 + i]; \
            if (allok) break; } \
        if constexpr (F32KV) asm volatile("s_waitcnt vmcnt(0)" : "+v"(KR_[0]), "+v"(VR_[0]), "+v"(KR_[1]), "+v"(VR_[1]), "+v"(KR_[NR - 2]), "+v"(VR_[NR - 2]), "+v"(KR_[NR - 1]), "+v"(VR_[NR - 1]) :: "memory"); \
        else asm volatile("s_waitcnt vmcnt(4)" : "+v"(KR_[0]), "+v"(VR_[0]), "+v"(KR_[1]), "+v"(VR_[1]) :: "memory");     \
        _Pragma("unroll") \
        for (int i = 0; i < 2; ++i) { const bool in_ = (kt * 64 + lrow + 32 * i) < Stot; const v4u z4_ = (v4u){0u, 0u, 0u, 0u}; v4u kk_, vv_; \
            if constexpr (F32KV) { kk_ = pack8(__builtin_bit_cast(f32x4, KR_[(2 * i) % NR]), __builtin_bit_cast(f32x4, KR_[(2 * i + 1) % NR])); vv_ = pack8(__builtin_bit_cast(f32x4, VR_[(2 * i) % NR]), __builtin_bit_cast(f32x4, VR_[(2 * i + 1) % NR])); } \
            else { kk_ = KR_[i % NR]; vv_ = VR_[i % NR]; } \
            *(LAS v4u*)(F.lds + (lrow + 32 * i) * AT_RS + lch * 16) = in_ ? kk_ : z4_; *(LAS v4u*)(F.lds + AT_VOFF + (lrow + 32 * i) * AT_RS + lch * 16) = in_ ? vv_ : z4_; } \
        __syncthreads(); \
        AT_LOAD(kt - DIST, KR_, VR_); \
        const int tb = kt * 64; \
        const int lim_lo = len0 + q0 + 16 * w, lim_hi = NQ == 2 ? len0 + q0 + 16 * (15 - w) : lim_lo;      \
        const bool act0 = tb < lim_lo + 15, act1 = tb < lim_hi + 15;                                           \
        if (!wave_done && act1 && (act0 || !done1)) { \
        const bool need_mask = (tb + 64 > (act0 ? lim_lo : lim_hi)); \
        if (NQ == 2 && !act0) AT_BODY(NQ - 1, NQ) else if (NQ == 2 && done1) AT_BODY(0, 1) else AT_BODY(0, NQ)        \
        { bool dn_ = true; _Pragma("unroll") for (int nb = 0; nb < NQ; ++nb) dn_ = dn_ && ((!valid_q[nb]) || (R[nb] > zq[nb])); wave_done = __all(dn_) != 0; if constexpr (NQ == 2) done1 = __all((!valid_q[NQ - 1]) || (R[NQ - 1] > zq[NQ - 1])) != 0; } \
        } \
        if (lane == 0) F.MISC[24 + w] = wave_done ? 1u : 0u; \
    }
    for (int kt2 = kt_max; kt2 >= 0; kt2 -= 2) {
        AT_ITER(kt2, kregA, vregA)
        if (kt2 == 0) break;
        if constexpr (F32KV) { AT_ITER(kt2 - 1, kregA, vregA) } else { AT_ITER(kt2 - 1, kregB, vregB) }
    }
#undef AT_ITER
#undef AT_BODY
    if constexpr (F32KV) asm volatile("s_waitcnt vmcnt(0)" : "+v"(kregA[0]), "+v"(vregA[0]), "+v"(kregA[1]), "+v"(vregA[1]), "+v"(kregA[NR - 2]), "+v"(vregA[NR - 2]), "+v"(kregA[NR - 1]), "+v"(vregA[NR - 1]) :: "memory");
    else asm volatile("s_waitcnt vmcnt(0)" : "+v"(kregA[0]), "+v"(vregA[0]), "+v"(kregA[1]), "+v"(vregA[1]), "+v"(kregB[0]), "+v"(vregB[0]), "+v"(kregB[1]), "+v"(vregB[1]) :: "memory");
#undef AT_LOAD
#pragma unroll
    for (int nb = 0; nb < NQ; ++nb)
    if (valid_q[nb]) { bf16* orow = WSB(F, WS_BR) + (size_t)M_PAD * D + (size_t)(rowbase + qi[nb]) * D + h * 128 + 4 * g;
#pragma unroll
        for (int mt8 = 0; mt8 < 8; ++mt8) *(GAS v2u*)(orow + 16 * mt8) = (v2u){pg8::cvt_pk_bf16(o[nb][mt8][0], o[nb][mt8][1]), pg8::cvt_pk_bf16(o[nb][mt8][2], o[nb][mt8][3])}; }
}

__device__ __forceinline__ void pool_row(const Frame& F, int layer, int stream, int b, int rowbase, int tp, int ch, float (&v)[8]) {
    if (tp >= 0 || stream == 0) { const size_t row = tp >= 0 ? (size_t)(rowbase + tp) : (size_t)(ROW_M + NMETA + tp);
        const v4u x = *(const GAS v4u*)(WSB(F, WS_U) + row * D + ch * 8);
        v[0] = bflo(x.x); v[1] = bfhi(x.x); v[2] = bflo(x.y); v[3] = bfhi(x.y); v[4] = bflo(x.z); v[5] = bfhi(x.z); v[6] = bflo(x.w); v[7] = bfhi(x.w); }
    else if (stream == 1) { const float* sp = in_ptr(IN_SPOOL) + (((size_t)layer * SBATCH + b) * PBUF + (PBUF + tp)) * D + ch * 8;
        const f32x4 a = *(const GAS f32x4*)sp, c = *(const GAS f32x4*)(sp + 4);
        v[0] = a[0]; v[1] = a[1]; v[2] = a[2]; v[3] = a[3]; v[4] = c[0]; v[5] = c[1]; v[6] = c[2]; v[7] = c[3]; }
    else {
#pragma unroll
        for (int e = 0; e < 8; ++e) v[e] = 0.f; }
}
__device__ __forceinline__ void pool_unit(const Frame& F, int layer, int uid) {
    int stream, b, t0, Tlen, rowbase;
    if (uid < 1024) { stream = 0; b = uid >> 5; t0 = (uid & 31) * 64; Tlen = T; rowbase = b * T; }
    else if (uid < 1032) { stream = 1; b = uid - 1024; t0 = 0; Tlen = ST; rowbase = ROW_S + b * ST; }
    else { stream = 2; b = 0; t0 = 0; Tlen = NMETA; rowbase = ROW_M; }
    const TC tc = thread_coords(F.wave); const int ch = tc.tid & 127, tsub = tc.tid >> 7, win = 2 << (ch >> 5);
    const int ts = t0 + tsub * 16; if (ts >= Tlen) return;
    float acc[8];
#pragma unroll
    for (int e = 0; e < 8; ++e) acc[e] = 0.f;
#pragma unroll
    for (int j = 1; j < 16; ++j) if (j < win) { float v[8]; pool_row(F, layer, stream, b, rowbase, ts - j, ch, v);
#pragma unroll
        for (int e = 0; e < 8; ++e) acc[e] += v[e]; }
#pragma unroll 4
    for (int tt = 0; tt < 16; ++tt) {
        const int t = ts + tt;
        float vn[8], vo[8]; pool_row(F, layer, stream, b, rowbase, t, ch, vn);
        if (tt > 0) pool_row(F, layer, stream, b, rowbase, t - win, ch, vo);
#pragma unroll
        for (int e = 0; e < 8; ++e) acc[e] += vn[e] - (tt > 0 ? vo[e] : 0.f);
        const int have = (stream == 2) ? (t + 1 < win ? t + 1 : win) : win;
        const float inv = 1.0f / (float)have;
        float y[8];
#pragma unroll
        for (int e = 0; e < 8; ++e) y[e] = acc[e] * inv - vn[e];
        *(GAS v4u*)(WSB(F, WS_BR) + (size_t)2 * M_PAD * D + (size_t)(rowbase + t) * D + ch * 8) = (v4u){pk2(y[0], y[1]), pk2(y[2], y[3]), pk2(y[4], y[5]), pk2(y[6], y[7])};
    }
}

struct Args { const float* in[19]; float* out; unsigned char* ws; };

__device__ __forceinline__ int opq(int x) { asm volatile("" : "+s"(x)); return x; }

constexpr int CH_TOTAL = 25;
__device__ __forceinline__ int ch_stage(int ci) { return ci < 8 ? 1 : ci < 16 ? 2 : 3; }
__device__ __forceinline__ int ch_first(int s) { return s == 1 ? 0 : s == 2 ? 8 : s == 3 ? 16 : CH_TOTAL; }
__device__ __forceinline__ unsigned ch_cnt(int s) { return s == 0 ? 117u : s == 3 ? 9u : 8u; }
__device__ __forceinline__ void chain_signal(const Frame& F, gu32* ch, int s) {
    asm volatile("s_waitcnt vmcnt(0)" ::: "memory");
    __syncthreads();
    if (F.wave == 0 && lane_lo_() == 0u) {
        __builtin_amdgcn_fence(__ATOMIC_RELEASE, "agent");
        asm volatile("s_waitcnt vmcnt(0)" ::: "memory");
        const unsigned old = __hip_atomic_fetch_add(ch + 64 * (2 + s), 1u, RLX_AGENT);
        if (old + 1u == ch_cnt(s) && s < 3) __hip_atomic_store(ch + 64, (unsigned)ch_first(s + 2), RLX_AGENT);
    }
}
__device__ __forceinline__ void chain_item(const Frame& F, int l, gu32* ch, int ci) {
    const int s = ch_stage(ci);
    if (s == 1) { pg8::Gemm g{WSB(F, WS_BR), lw(F, l, LW_BR), 3 * M_PAD, 3 * D, D}; SmallOrder3 S{ci}; EpiGate E{F.ws};
        pg8::gemm_phase<EpiGate, SmallOrder3, true, true>(F.lds, g, S, E, F.wave); }
    else if (s == 2) { pg8::Gemm g{WSB(F, WS_MIX), lw(F, l, LW_OUT), M_PAD, D, D}; SmallOrder S{ci - 8}; EpiResid E{F.ws, ALPHA, 1.0f};
        pg8::gemm_phase<EpiResid, SmallOrder, true, true>(F.lds, g, S, E, F.wave); }
    else { const int i = ci - 16; ln_rows(F, l * 3 + 1, false, MP + 32 * i, MP + 32 * i + 32, 0, 8); }
    chain_signal(F, ch, s);
}
__device__ __forceinline__ int mq_count(int kq) { return kq == 0 ? 164 : kq == 1 ? 9 : kq == 2 ? 64 : kq == 3 ? 2056 : 1024; }

__global__ void __launch_bounds__(512, 2) mega_fwd(Args args) {
    extern __shared__ __attribute__((aligned(16))) unsigned char lds[];
    Frame F;
    F.lds = (LAS unsigned char*)lds;
    F.MISC = (volatile LAS unsigned*)(F.lds + MISC_OFF);
    F.G = gridDim.x; F.wave = __builtin_amdgcn_readfirstlane((int)threadIdx.x >> 6);
    F.ws = args.ws; F.out = args.out; F.ctl = (gu32*)(args.ws + WS_CTL);
    for (int u = threadIdx.x; u < (LDS_BYTES - LDSCTL_OFF) / 4; u += 512) ((LAS unsigned*)(F.lds + LDSCTL_OFF))[u] = 0u;
    __syncthreads();
    XcdBarrier bar = xcd_barrier_post((unsigned*)(F.ctl + CW_BAR), F.MISC + 8);
#define GRID_BAR() xcd_barrier(bar)

    p0_prologue(F);

    GRID_BAR();

    for (int l = 0; l < DEPTH; ++l) {
        { pg8::Gemm g{WSB(F, WS_HB), lw(F, l, LW_UP1), M_PAD, 2 * DFF, D}; pg8::StaticOrder S; S.init(M_PAD, 2 * DFF, opq(F.G), opq((int)blockIdx.x)); EpiSwiglu E{WSB(F, WS_ACT)};
          pg8::gemm_phase<EpiSwiglu, pg8::StaticOrder, true, true>(F.lds, g, S, E, F.wave); }

        GRID_BAR();
        { pg8::Gemm g{WSB(F, WS_ACT), lw(F, l, LW_DN1), M_PAD, D, DFF}; pg8::StaticOrder S; S.init(MP, D, opq(F.G), opq((int)blockIdx.x));
          EpiResid E{F.ws, ALPHA, 0.5f};
          pg8::gemm_phase<EpiResid, pg8::StaticOrder, true, true>(F.lds, g, S, E, F.wave); }

        GRID_BAR();
        if (blockIdx.x < 16) { const int kh = opq((int)blockIdx.x) >> 3; pg8::Gemm g{WSB(F, WS_ACT) + kh * (DFF / 2), lw(F, l, LW_DN1) + kh * (DFF / 2), M_PAD, D, DFF / 2, DFF}; SmallOrderH S{opq((int)blockIdx.x)};
            EpiPart E{(float*)WSB(F, WS_ACT) + (size_t)kh * 512 * D};
            pg8::gemm_phase<EpiPart, SmallOrderH, true, true>(F.lds, g, S, E, F.wave); }
        else ln_phase(F, l * 3 + 0, false, 0, MP, 16);
        GRID_BAR();
        ln_phase(F, l * 3 + 0, false, MP, M_PAD, 0, true);
        GRID_BAR();
        { pg8::Gemm g{WSB(F, WS_HB), lw(F, l, LW_IN), M_PAD, DIN, D}; pg8::StaticOrder S; S.init(M_PAD, DIN, opq(F.G), opq((int)blockIdx.x));
          EpiWin E{F.ws, F.out, l};
          pg8::gemm_phase<EpiWin, pg8::StaticOrder, true, true>(F.lds, g, S, E, F.wave);
        }

        GRID_BAR();
        { gu32* q = F.ctl + CW_Q + 64 * (l * 8); gu32* ch = F.ctl + CW_CH + 1024 * l;
          const int swp = opq((int)blockIdx.x) & 1;
#define MQ_ID(s_) ((swp && (s_) >= 3 && (s_) < 5) ? 7 - (s_) : (s_))
          int kq = 0, u = __builtin_amdgcn_readfirstlane(grab(F, q)), chain_open = 1;
          for (;;) {
              while (kq < 5 && u >= mq_count(MQ_ID(kq))) { ++kq; if (kq < 5) u = __builtin_amdgcn_readfirstlane(grab(F, q + 64 * MQ_ID(kq))); }
              const int qk = MQ_ID(kq);
              unsigned l0_ = lane_lo_(); asm volatile("" : "+v"(l0_));
              const bool t0 = F.wave == 0 && l0_ == 0u;
              unsigned nx = 0u, hd = 0u, rd = 0u;
              if (t0) { if (kq < 5) nx = __hip_atomic_fetch_add(q + 64 * qk, 1u, RLX_AGENT); if (chain_open) { hd = __hip_atomic_load(ch, RLX_AGENT); rd = __hip_atomic_load(ch + 64, RLX_AGENT); } }
              if (qk == 0) { ret_unit(F, l, u < 36 ? 128 + u : u - 36); if (u < 36) chain_signal(F, ch, 0); }
              else if (qk == 1 || qk == 4) { pool_unit(F, l, qk == 1 ? 1024 + u : u); if (qk == 1) chain_signal(F, ch, 0); }
              else if (qk == 2) { attn_unit<true>(F, l, u); chain_signal(F, ch, 0); }
              else if (qk == 3) { attn_unit<false>(F, l, u < 8 ? 64 + 2048 + u : 64 + u - 8); if (u < 8) chain_signal(F, ch, 0); }
              __syncthreads();
              if (t0) { int ci = -1;
                  if (chain_open) {
                      if (kq == 5) { unsigned sp = 0u;
                          for (;;) { hd = __hip_atomic_load(ch, RLX_AGENT); if (hd >= (unsigned)CH_TOTAL) { ci = -2; break; } rd = __hip_atomic_load(ch + 64, RLX_AGENT);
                              if (hd < rd) { unsigned e = hd; if (__hip_atomic_compare_exchange_strong(ch, &e, hd + 1u, __ATOMIC_RELAXED, __ATOMIC_RELAXED, __HIP_MEMORY_SCOPE_AGENT)) { ci = (int)hd; break; } }
                              else { __builtin_amdgcn_s_sleep(2); if ((++sp & 255u) == 0u) { if (xb_ld((unsigned*)(F.ctl + CW_BAR) + XB_TMO)) { ci = -2; break; } if (sp > XB_SPIN_CAP) { atomicAdd((unsigned*)(F.ctl + CW_BAR) + XB_TMO, 1u); ci = -2; break; } } } } }
                      else if (hd >= (unsigned)CH_TOTAL) ci = -3;
                      else if (hd < rd) { unsigned e = hd; if (__hip_atomic_compare_exchange_strong(ch, &e, hd + 1u, __ATOMIC_RELAXED, __ATOMIC_RELAXED, __HIP_MEMORY_SCOPE_AGENT)) ci = (int)hd; }
                      if (ci >= 0) { __builtin_amdgcn_fence(__ATOMIC_ACQUIRE, "agent"); asm volatile("s_waitcnt vmcnt(0)" ::: "memory"); }
                  } else if (kq == 5) ci = -2;
                  F.MISC[16] = nx; F.MISC[17] = (unsigned)ci; }
              __syncthreads();
              u = __builtin_amdgcn_readfirstlane((int)F.MISC[16]); const int ci = __builtin_amdgcn_readfirstlane((int)F.MISC[17]);
              if (ci == -2) break;
              if (ci == -3) chain_open = 0;
              if (ci >= 0) chain_item(F, l, ch, ci);
          }
          __syncthreads(); }
        GRID_BAR();
        { pg8::Gemm g{WSB(F, WS_BR), lw(F, l, LW_BR), 3 * M_PAD, 3 * D, D}; Order3 S; S.init(MP, D, opq(F.G), opq((int)blockIdx.x)); EpiGate E{F.ws};
          pg8::gemm_phase<EpiGate, Order3, true, true>(F.lds, g, S, E, F.wave); }

        GRID_BAR();
        { pg8::Gemm g{WSB(F, WS_MIX), lw(F, l, LW_OUT), M_PAD, D, D}; pg8::StaticOrder S; S.init(MP, D, opq(F.G), opq((int)blockIdx.x));
          EpiResid E{F.ws, ALPHA, 1.0f};
          pg8::gemm_phase<EpiResid, pg8::StaticOrder, true, true>(F.lds, g, S, E, F.wave); }

        GRID_BAR();
        if (blockIdx.x < 44) { pg8::Gemm g{WSB(F, WS_HB), lw(F, l, LW_UP2), M_PAD, 2 * DFF, D}; SmallOrderW S{opq((int)blockIdx.x)}; EpiSwiglu E{WSB(F, WS_ACT)};
            pg8::gemm_phase<EpiSwiglu, SmallOrderW, true, true>(F.lds, g, S, E, F.wave); }
        else ln_phase(F, l * 3 + 1, false, 0, MP, 44);
        GRID_BAR();
        { pg8::Gemm g{WSB(F, WS_HB), lw(F, l, LW_UP2), M_PAD, 2 * DFF, D}; pg8::StaticOrder S; S.init(MP, 2 * DFF, opq(F.G), opq((int)blockIdx.x)); EpiSwiglu E{WSB(F, WS_ACT)};
          pg8::gemm_phase<EpiSwiglu, pg8::StaticOrder, true, true>(F.lds, g, S, E, F.wave); }

        GRID_BAR();
        { pg8::Gemm g{WSB(F, WS_ACT), lw(F, l, LW_DN2), M_PAD, D, DFF}; pg8::StaticOrder S; S.init(MP, D, opq(F.G), opq((int)blockIdx.x));
          EpiResid E{F.ws, ALPHA, 0.5f};
          pg8::gemm_phase<EpiResid, pg8::StaticOrder, true, true>(F.lds, g, S, E, F.wave); }

        GRID_BAR();
        if (blockIdx.x < 16) { const int kh = opq((int)blockIdx.x) >> 3; pg8::Gemm g{WSB(F, WS_ACT) + kh * (DFF / 2), lw(F, l, LW_DN2) + kh * (DFF / 2), M_PAD, D, DFF / 2, DFF}; SmallOrderH S{opq((int)blockIdx.x)};
            EpiPart E{(float*)WSB(F, WS_ACT) + (size_t)kh * 512 * D};
            pg8::gemm_phase<EpiPart, SmallOrderH, true, true>(F.lds, g, S, E, F.wave); }
        else ln_phase(F, l * 3 + 2, l + 1 == DEPTH, 0, MP, 16);
        GRID_BAR();
        ln_phase(F, l * 3 + 2, l + 1 == DEPTH, MP, M_PAD, 0, true);
        if (l + 1 < DEPTH) GRID_BAR();
    }
}

extern "C" void kernel_launch(void* const* d_in, const int* in_sizes, int n_in, void* d_out, int out_size, void* d_ws, size_t ws_size, hipStream_t stream) {
    static int grid = 0;
    if (grid == 0) {
        if (n_in != 19 || (size_t)out_size != O_END || ws_size < WS_END) { fprintf(stderr, "kernel_launch: unexpected sizes (n_in %d out %d ws %zu need %zu)\n", n_in, out_size, ws_size, (size_t)WS_END); grid = -1; return; }
        int dev = 0, cus = 0, per_cu = 0;
        if (hipGetDevice(&dev) != hipSuccess || hipDeviceGetAttribute(&cus, hipDeviceAttributeMultiprocessorCount, dev) != hipSuccess) { grid = -1; return; }
        if (hipFuncSetAttribute((const void*)mega_fwd, hipFuncAttributeMaxDynamicSharedMemorySize, LDS_BYTES) != hipSuccess) { fprintf(stderr, "kernel_launch: hipFuncSetAttribute failed\n"); grid = -1; return; }
        if (hipOccupancyMaxActiveBlocksPerMultiprocessor(&per_cu, (const void*)mega_fwd, 512, LDS_BYTES) != hipSuccess || per_cu < 1) { fprintf(stderr, "kernel_launch: occupancy query says %d\n", per_cu); }
        (void)hipGetLastError();
        grid = cus;
    }
    if (grid < 0) return;
    if (hipMemsetAsync((char*)d_ws + WS_CTL, 0, CTL_ZERO_BYTES, stream) != hipSuccess) return;
    Args a{};
    for (int i = 0; i < 19; ++i) a.in[i] = (const float*)d_in[i];
    a.out = (float*)d_out; a.ws = (unsigned char*)d_ws;
    hipLaunchKernelGGL(mega_fwd, dim3(grid), dim3(512), LDS_BYTES, stream, a);
}
```

```cpp
#include <hip/hip_runtime.h>
#include <cstdio>
#include <cstdint>
__device__ __forceinline__ unsigned lane_lo_() { unsigned l; asm volatile("v_mbcnt_lo_u32_b32 %0, -1, 0" : "=v"(l)); return l; }
__device__ __forceinline__ int lane_id_() { unsigned l; asm volatile("v_mbcnt_lo_u32_b32 %0, -1, 0\n\tv_mbcnt_hi_u32_b32 %0, -1, %0" : "=v"(l)); return (int)l; }
namespace pg8 {
#define PG8_LAS __attribute__((address_space(3)))
typedef unsigned short bf16_t;
typedef short bf16x8 __attribute__((ext_vector_type(8)));
typedef float f32x4 __attribute__((ext_vector_type(4)));
typedef unsigned u32x4 __attribute__((ext_vector_type(4)));
constexpr int BM = 256, BK = 64, HALF = 128, HTB = HALF * BK * 2  , STAGE_BYTES = 8 * HTB, NXCD = 8, WGM = 4;

__host__ __device__ __forceinline__ int lds_byte(int r, int c) { const int st = (r >> 4) * 2 + (c >> 5), rr = r & 15, cc = c & 31, ob = rr * 64 + cc * 2; return st * 1024 + (ob ^ (((ob >> 9) & 1) << 5)); }
__host__ __device__ __forceinline__ void stage_rc(int b, int& R, int& C) { const int st = b / 1024, sb = b % 1024, swz = sb ^ (((sb >> 9) & 1) << 5); R = (st >> 1) * 16 + swz / 64; C = (st & 1) * 32 + (swz % 64) / 2; }
__host__ __device__ __forceinline__ int perm32(int rho) { const int n = rho >> 4, i = rho & 15; return 8 * (i >> 2) + 4 * n + (i & 3); }

struct Unit { int pm, pn; };
struct Gemm { const bf16_t* A; const bf16_t* Bt; int M, N, K; int ld = 0; };

struct StaticOrder {
    int nM, nN, nwg, G, c;
    __host__ __device__ void init(int M, int N, int G_, int c_) { nM = M / BM; nN = N / BM; nwg = nM * nN; G = G_; c = c_; }
    __host__ __device__ bool next(int i, Unit& u) const {
        const long L = (long)i * G + c; if (L >= nwg) return false;
        int wgid = (int)L; { const int q = nwg / NXCD, r = nwg % NXCD, xcd = wgid % NXCD, off = wgid / NXCD; wgid = (xcd < r ? xcd * (q + 1) : r * (q + 1) + (xcd - r) * q) + off; }
        const int nig = WGM * nN, gid = wgid / nig, fm = gid * WGM, gsz = (nM - fm) < WGM ? (nM - fm) : WGM;
        u.pm = fm + ((wgid % nig) % gsz); u.pn = (wgid % nig) / gsz; return true;
    }
    __device__ __forceinline__ void a_ready(const Unit&) const {}
    __device__ __forceinline__ void done(const Unit&) const {}
};

__device__ __forceinline__ unsigned cvt_pk_bf16(float lo, float hi) { unsigned r; asm volatile("v_cvt_pk_bf16_f32 %0, %1, %2" : "=v"(r) : "v"(lo), "v"(hi)); return r; }
template <class Epi, class Sched, bool ALIGN_EPI = false, bool SP2 = false>
__device__ __forceinline__ void gemm_phase(PG8_LAS unsigned char* lds, const Gemm g, const Sched& S, const Epi& E, const int wave_id) {
    int lane_ = lane_id_(); asm volatile("" : "+v"(lane_));
    const int tid = wave_id * 64 + lane_;
    int widq_ = wave_id; asm volatile("" : "+s"(widq_));
    const int wid = widq_, lane = tid & 63, wr = wid >> 2, wc = wid & 3, fr = lane & 15, fq = lane >> 4;
    const int K = g.K, nt = K / BK, LD = g.ld > 0 ? g.ld : K;
    unsigned voffA[2], voffB[2];
#pragma unroll
    for (int i = 0; i < 2; ++i) { int R, C; stage_rc(tid * 16 + i * 8192, R, C); const int Rb = Epi::PERM ? ((R & ~31) + perm32(R & 31)) : R;
        voffA[i] = (unsigned)(R * LD + C) * 2u; voffB[i] = (unsigned)(Rb * LD + C) * 2u; }
    const size_t kstep = (size_t)(BK * 2);
    const size_t hstep = (size_t)HALF * LD * 2;
    const size_t tstep = 2 * hstep;
    const unsigned ldsw = (unsigned)wid * 1024u;
    const int aoff = lds_byte(wr * 64 + fr, fq * 8), boff = lds_byte(wc * 32 + fr, fq * 8);
#define PG8_SA(b, h) (((b) * 2 + (h)) * HTB)
#define PG8_SB(b, h) ((4 + (b) * 2 + (h)) * HTB)
#define PG8_STAGE(bufoff, gbase, voff) do { _Pragma("unroll") for (int _i = 0; _i < 2; ++_i) \
        __builtin_amdgcn_global_load_lds((const unsigned*)((const char*)(gbase) + (voff)[_i]), (PG8_LAS unsigned*)(lds + (bufoff) + ldsw + _i * 8192), 16, 0, 0); } while (0)
#define PG8_LDA(dst, b, h) do { _Pragma("unroll") for (int m = 0; m < 4; ++m) _Pragma("unroll") for (int k = 0; k < 2; ++k) dst[m][k] = *(const PG8_LAS bf16x8*)(lds + PG8_SA(b, h) + aoff + m * 2048 + k * 1024); } while (0)
#define PG8_LDB(dst, b, h) do { _Pragma("unroll") for (int n = 0; n < 2; ++n) _Pragma("unroll") for (int k = 0; k < 2; ++k) dst[n][k] = *(const PG8_LAS bf16x8*)(lds + PG8_SB(b, h) + boff + n * 2048 + k * 1024); } while (0)
#define PG8_MMA(ai, bj, At, Bt) do { __builtin_amdgcn_s_setprio(1); _Pragma("unroll") for (int m = 0; m < 4; ++m) _Pragma("unroll") for (int n = 0; n < 2; ++n) _Pragma("unroll") for (int k = 0; k < 2; ++k) \
        acc[ai][bj][m][n] = __builtin_amdgcn_mfma_f32_16x16x32_bf16(Bt[n][k], At[m][k], acc[ai][bj][m][n], 0, 0, 0); __builtin_amdgcn_s_setprio(0); } while (0)
#define PG8_WAIT_V(n) asm volatile("s_waitcnt vmcnt(" #n ")" ::: "memory")
#define PG8_WAIT_VN(n) asm volatile("s_waitcnt vmcnt(%0)" :: "n"(n) : "memory")
#define PG8_WAIT_L(n) asm volatile("s_waitcnt lgkmcnt(" #n ")" ::: "memory")
#define PG8_BAR __builtin_amdgcn_s_barrier()
#define PG8_SCHED __builtin_amdgcn_sched_barrier(0)
    Unit cur, nxt; int ui = 0;
    if (!S.next(0, cur)) return;
    f32x4 acc[2][2][4][2];
#pragma unroll
    for (int a = 0; a < 2; ++a)
#pragma unroll
        for (int b = 0; b < 2; ++b)
#pragma unroll
            for (int m = 0; m < 4; ++m)
#pragma unroll
                for (int n = 0; n < 2; ++n) acc[a][b][m][n] = (f32x4){0.f, 0.f, 0.f, 0.f};
    bf16x8 At[4][2], B0[2][2], B1[2][2];
    const char* cA = (const char*)g.A + (size_t)cur.pm * tstep; const char* cB = (const char*)g.Bt + (size_t)cur.pn * tstep;
    S.a_ready(cur);
    if constexpr (SP2) {
        PG8_STAGE(PG8_SB(0, 0), cB, voffB); PG8_STAGE(PG8_SB(0, 1), cB + hstep, voffB); PG8_STAGE(PG8_SA(0, 0), cA, voffA); PG8_STAGE(PG8_SA(0, 1), cA + hstep, voffA);
        if (wr == 1) PG8_BAR;
        PG8_WAIT_V(2); PG8_BAR;
        PG8_STAGE(PG8_SB(1, 0), cB + kstep, voffB); PG8_STAGE(PG8_SA(1, 0), cA + kstep, voffA); PG8_STAGE(PG8_SB(1, 1), cB + hstep + kstep, voffB);
        PG8_WAIT_V(6); PG8_BAR;
    } else {
        PG8_STAGE(PG8_SB(0, 0), cB, voffB); PG8_STAGE(PG8_SA(0, 0), cA, voffA); PG8_STAGE(PG8_SB(0, 1), cB + hstep, voffB); PG8_STAGE(PG8_SA(0, 1), cA + hstep, voffA);
        if (wr == 1) PG8_BAR;
        PG8_WAIT_V(4); PG8_BAR;
        PG8_STAGE(PG8_SB(1, 0), cB + kstep, voffB); PG8_STAGE(PG8_SA(1, 0), cA + kstep, voffA); PG8_STAGE(PG8_SB(1, 1), cB + hstep + kstep, voffB);
        PG8_WAIT_V(6); PG8_BAR;
    }
    for (;;) {
        const bool has_next = S.next(ui + 1, nxt);
        const char* nA = has_next ? (const char*)g.A + (size_t)nxt.pm * tstep : cA; const char* nB = has_next ? (const char*)g.Bt + (size_t)nxt.pn * tstep : cB;
        for (int t = 0; t < nt; t += 2) {
            const bool last = (t == nt - 2);
            const char* a1 = cA + (size_t)(t + 1) * kstep;
            const char* a2 = last ? nA : cA + (size_t)(t + 2) * kstep; const char* b2 = last ? nB : cB + (size_t)(t + 2) * kstep;
            const char* a3 = a2 + kstep; const char* b3 = b2 + kstep;
            if (last && has_next) S.a_ready(nxt);
            if constexpr (SP2) {
            int tz_ = __builtin_amdgcn_readfirstlane(t | (ui > 0 ? 0 : 1)); asm volatile("" : "+s"(tz_));
            const bool strict = !(Epi::NS > 0 && tz_ == 0);
            PG8_LDB(B0, 0, 0); PG8_LDB(B1, 0, 1); PG8_SCHED; PG8_LDA(At, 0, 0); PG8_STAGE(PG8_SA(1, 1), a1 + hstep, voffA);
            PG8_WAIT_VN(8 + Epi::NS); if (strict) PG8_WAIT_V(8); PG8_WAIT_L(0); PG8_BAR; PG8_MMA(0, 0, At, B0); PG8_MMA(0, 1, At, B1); PG8_BAR; PG8_SCHED;
            PG8_LDA(At, 0, 1); PG8_STAGE(PG8_SB(0, 0), b2, voffB); PG8_STAGE(PG8_SB(0, 1), b2 + hstep, voffB); PG8_STAGE(PG8_SA(0, 0), a2, voffA);
            PG8_WAIT_VN(8 + Epi::NS); if (strict) PG8_WAIT_V(8); PG8_WAIT_L(0); PG8_BAR; PG8_MMA(1, 0, At, B0); PG8_MMA(1, 1, At, B1); PG8_BAR; PG8_SCHED;
            PG8_LDB(B0, 1, 0); PG8_LDB(B1, 1, 1); PG8_SCHED; PG8_LDA(At, 1, 0); PG8_STAGE(PG8_SA(0, 1), a2 + hstep, voffA);
            PG8_WAIT_V(8); PG8_WAIT_L(0); PG8_BAR; PG8_MMA(0, 0, At, B0); PG8_MMA(0, 1, At, B1); PG8_BAR; PG8_SCHED;
            PG8_LDA(At, 1, 1); PG8_STAGE(PG8_SB(1, 0), b3, voffB); PG8_STAGE(PG8_SB(1, 1), b3 + hstep, voffB); PG8_STAGE(PG8_SA(1, 0), a3, voffA);
            PG8_WAIT_V(8); PG8_WAIT_L(0); PG8_BAR; PG8_MMA(1, 0, At, B0); PG8_MMA(1, 1, At, B1); PG8_BAR; PG8_SCHED;
            } else {
            PG8_LDB(B0, 0, 0); PG8_SCHED; PG8_LDA(At, 0, 0); PG8_STAGE(PG8_SA(1, 1), a1 + hstep, voffA);
            PG8_WAIT_L(8); PG8_BAR; PG8_WAIT_L(0); PG8_MMA(0, 0, At, B0); PG8_BAR; PG8_SCHED;
            PG8_LDB(B1, 0, 1); PG8_STAGE(PG8_SB(0, 0), b2, voffB);
            PG8_BAR; PG8_WAIT_L(0); PG8_MMA(0, 1, At, B1); PG8_BAR;
            PG8_LDA(At, 0, 1); PG8_STAGE(PG8_SA(0, 0), a2, voffA);
            PG8_BAR; PG8_WAIT_L(0); PG8_MMA(1, 0, At, B0); PG8_BAR; PG8_SCHED;
            PG8_STAGE(PG8_SB(0, 1), b2 + hstep, voffB);
            PG8_WAIT_V(6); PG8_BAR; PG8_MMA(1, 1, At, B1); PG8_BAR;
            PG8_LDB(B0, 1, 0); PG8_SCHED; PG8_LDA(At, 1, 0); PG8_STAGE(PG8_SA(0, 1), a2 + hstep, voffA);
            PG8_WAIT_L(8); PG8_BAR; PG8_WAIT_L(0); PG8_MMA(0, 0, At, B0); PG8_BAR; PG8_SCHED;
            PG8_LDB(B1, 1, 1); PG8_STAGE(PG8_SB(1, 0), b3, voffB);
            PG8_BAR; PG8_WAIT_L(0); PG8_MMA(0, 1, At, B1); PG8_BAR;
            PG8_LDA(At, 1, 1); PG8_STAGE(PG8_SA(1, 0), a3, voffA);
            PG8_BAR; PG8_WAIT_L(0); PG8_MMA(1, 0, At, B0); PG8_BAR; PG8_SCHED;
            PG8_STAGE(PG8_SB(1, 1), b3 + hstep, voffB);
            PG8_WAIT_V(6); PG8_BAR; PG8_MMA(1, 1, At, B1); PG8_BAR;
            }
        }
        if constexpr (ALIGN_EPI) { if (wr == 0) PG8_BAR; }
        const bool keep_acc = E(acc, cur, wr, wc, fr, fq);
        if (!has_next) break;
        if (!keep_acc) {
#pragma unroll
        for (int a = 0; a < 2; ++a)
#pragma unroll
            for (int b = 0; b < 2; ++b)
#pragma unroll
                for (int m = 0; m < 4; ++m)
#pragma unroll
                    for (int n = 0; n < 2; ++n) acc[a][b][m][n] = (f32x4){0.f, 0.f, 0.f, 0.f};
        }
        cur = nxt; cA = nA; cB = nB; ++ui;
        if constexpr (ALIGN_EPI) { if (wr == 1) PG8_BAR; }
    }
    PG8_WAIT_V(0);
    if constexpr (!ALIGN_EPI) { if (wr == 0) PG8_BAR; }
    PG8_BAR;
#undef PG8_SA
#undef PG8_SB
#undef PG8_STAGE
#undef PG8_LDA
#undef PG8_LDB
#undef PG8_MMA
#undef PG8_WAIT_V
#undef PG8_WAIT_VN
#undef PG8_WAIT_L
#undef PG8_BAR
#undef PG8_SCHED
}
}

constexpr int D = 1024, NB = 32, T = 2048, DEPTH = 2, SBATCH = 8, ST = 32, PAST = 4096, NMETA = 16;
constexpr int HRET = 4, DKR = 128, DVR = 256, HSB = 8, DSB = 128, DFF = 2816, DIN = 10240, PBUF = 15;
constexpr int MP = NB * T;
constexpr int ROW_S = MP;
constexpr int ROW_M = MP + SBATCH * ST;
constexpr int M_PAD = ROW_M + 256;
constexpr int NPANEL = M_PAD / 256;
constexpr float LN_EPS = 1e-5f;
constexpr float ALPHA = 1.41421356237f;
constexpr float LOG2E = 1.44269504089f;
constexpr int KT_SP = PAST + ST;
constexpr int KT_PP = NMETA + T;

constexpr size_t O_YP = 0;
constexpr size_t O_YS = O_YP + (size_t)NB * T * D;
constexpr size_t O_KP = O_YS + (size_t)SBATCH * ST * D;
constexpr size_t O_VP = O_KP + (size_t)DEPTH * NB * KT_PP * D;
constexpr size_t O_RP = O_VP + (size_t)DEPTH * NB * KT_PP * D;
constexpr size_t O_PP = O_RP + (size_t)DEPTH * NB * HRET * DKR * DVR;
constexpr size_t O_KS = O_PP + (size_t)DEPTH * NB * PBUF * D;
constexpr size_t O_VS = O_KS + (size_t)DEPTH * SBATCH * ST * D;
constexpr size_t O_RS = O_VS + (size_t)DEPTH * SBATCH * ST * D;
constexpr size_t O_PS = O_RS + (size_t)DEPTH * SBATCH * HRET * DKR * DVR;
constexpr size_t O_END = O_PS + (size_t)DEPTH * SBATCH * PBUF * D;
static_assert(O_END == 350666752ull, "output size");

constexpr size_t MiB = 1u << 20;
constexpr size_t AL(size_t x) { return (x + 4095) & ~(size_t)4095; }
constexpr size_t WS_CTL = 0, CTL_ZERO_BYTES = 1 * MiB;
constexpr size_t WS_YB = WS_CTL + CTL_ZERO_BYTES;
constexpr size_t WS_HB = AL(WS_YB + (size_t)M_PAD * D * 2);
constexpr size_t WS_ACT = AL(WS_HB + (size_t)M_PAD * D * 2);
constexpr size_t WS_QR = AL(WS_ACT + (size_t)M_PAD * DFF * 2);
constexpr size_t WS_KR = AL(WS_QR + (size_t)M_PAD * 512 * 2);
constexpr size_t WS_VR = AL(WS_KR + (size_t)M_PAD * 512 * 2);
constexpr size_t WS_GR = AL(WS_VR + (size_t)M_PAD * D * 2);
constexpr size_t WS_QS = AL(WS_GR + (size_t)M_PAD * D * 2);
constexpr size_t WS_KS = AL(WS_QS + (size_t)M_PAD * D * 2);
constexpr size_t WS_VS = AL(WS_KS + (size_t)M_PAD * D * 2);
constexpr size_t WS_U = AL(WS_VS + (size_t)M_PAD * D * 2);
constexpr size_t WS_GT = AL(WS_U + (size_t)M_PAD * D * 2);
constexpr size_t WS_BR = AL(WS_GT + (size_t)M_PAD * 3 * D * 2);
constexpr size_t WS_MIX = AL(WS_BR + (size_t)3 * M_PAD * D * 2);
constexpr size_t WS_W = AL(WS_MIX + (size_t)M_PAD * D * 2);
constexpr size_t LW_UP1 = 0;
constexpr size_t LW_DN1 = LW_UP1 + (size_t)2 * DFF * D * 2;
constexpr size_t LW_IN = LW_DN1 + (size_t)D * DFF * 2;
constexpr size_t LW_BR = LW_IN + (size_t)DIN * D * 2;
constexpr size_t LW_OUT = LW_BR + (size_t)3 * D * D * 2;
constexpr size_t LW_UP2 = LW_OUT + (size_t)D * D * 2;
constexpr size_t LW_DN2 = LW_UP2 + (size_t)2 * DFF * D * 2;
constexpr size_t LW_SIZE = AL(LW_DN2 + (size_t)D * DFF * 2);
constexpr size_t WS_END = WS_W + DEPTH * LW_SIZE;
static_assert(WS_END < (size_t)4000 * MiB, "workspace budget");

constexpr int CW_BAR = 4096;
constexpr int CW_Q = 16384;
constexpr int CW_CH = 24576;
constexpr int CW_DBG = 32768;
constexpr int CW_KN = 65536;
static_assert((CW_KN + DEPTH * 33 * 8 * 16) * 4 <= (int)CTL_ZERO_BYTES, "ctl region");

constexpr int RING_BYTES = 131072;
constexpr int LDSCTL_OFF = RING_BYTES, MISC_OFF = LDSCTL_OFF + 320;
constexpr int LDS_BYTES = 147456;

#define GAS __attribute__((address_space(1)))
#define LAS __attribute__((address_space(3)))
typedef unsigned short bf16;
typedef unsigned v4u __attribute__((ext_vector_type(4)));
typedef unsigned v2u __attribute__((ext_vector_type(2)));
typedef float f32x4 __attribute__((ext_vector_type(4)));
typedef short bf16x8 __attribute__((ext_vector_type(8)));
typedef short s16x4 __attribute__((ext_vector_type(4)));
typedef GAS unsigned gu32;
#define RLX_AGENT __ATOMIC_RELAXED, __HIP_MEMORY_SCOPE_AGENT
__device__ __forceinline__ unsigned f2bf(float f) { unsigned u = __builtin_bit_cast(unsigned, f); return (u + 0x7fffu + ((u >> 16) & 1u)) >> 16; }
__device__ __forceinline__ unsigned pk2(float lo, float hi) { return f2bf(lo) | (f2bf(hi) << 16); }
__device__ __forceinline__ float bf2f(unsigned short b) { return __builtin_bit_cast(float, (unsigned)b << 16); }
__device__ __forceinline__ float bflo(unsigned w) { return __builtin_bit_cast(float, w << 16); }
__device__ __forceinline__ float bfhi(unsigned w) { return __builtin_bit_cast(float, w & 0xffff0000u); }
__device__ __forceinline__ float fast_exp2(float x) { return __builtin_amdgcn_exp2f(x); }
__device__ __forceinline__ float fast_log2(float x) { return __builtin_amdgcn_logf(x); }
__device__ __forceinline__ float fast_rcp(float x) { return __builtin_amdgcn_rcpf(x); }
__device__ __forceinline__ float sigmoidf_(float x) { return fast_rcp(1.0f + fast_exp2(-x * LOG2E)); }
__device__ __forceinline__ float siluf_(float x) { return x * sigmoidf_(x); }
__device__ __forceinline__ float wave_sum(float v) {
#pragma unroll
    for (int o = 1; o < 64; o <<= 1) v += __shfl_xor(v, o);
    return v;
}
#define XB_TMO      128
#define XB_XCNT(j)  (256  + 64 * (j))
#define XB_XSUB(j)  (1280 + 64 * (j))
#define XB_XGEN(j)  (2304 + 64 * (j))
#define XB_TOP      3328
#define XB_TOPGEN   3392
#define XCD_BAR_WORDS 3456
#define XB_SPIN_CAP (1u << 20)

__device__ __forceinline__ unsigned xb_ld(unsigned* p)              { return __hip_atomic_load(p, __ATOMIC_RELAXED, __HIP_MEMORY_SCOPE_AGENT); }
__device__ __forceinline__ unsigned xb_add(unsigned* p, unsigned v) { return __hip_atomic_fetch_add(p, v, __ATOMIC_RELAXED, __HIP_MEMORY_SCOPE_AGENT); }
__device__ __forceinline__ unsigned xb_xcc_id() { return (unsigned)__builtin_amdgcn_s_getreg((3 << 11) | 20) & 0xFu; }
#define XB_SPIN(cond, bar) do { unsigned _sp = 0; while (cond) { __builtin_amdgcn_s_sleep(1); \
    if ((++_sp & 255u) == 0u) { if (xb_ld(&(bar)[XB_TMO])) break; if (_sp > XB_SPIN_CAP) { atomicAdd(&(bar)[XB_TMO], 1u); break; } } } } while (0)

struct XcdBarrier {
    unsigned* bar; unsigned x; unsigned w0;
    volatile LAS unsigned* st;
};

__device__ __forceinline__ XcdBarrier xcd_barrier_post(unsigned* bar, volatile LAS unsigned* st) {
    XcdBarrier b; b.bar = bar; b.x = xb_xcc_id(); b.st = st; b.w0 = (__builtin_amdgcn_readfirstlane((int)threadIdx.x >> 6) == 0) ? 1u : 0u;
    if (threadIdx.x == 0) (void)xb_add(&bar[XB_XCNT(b.x)], 1u);
    return b;
}
__device__ __forceinline__ void xcd_barrier_complete(unsigned* bar, unsigned x, unsigned& nloc, unsigned& nx) {
    const unsigned G = gridDim.x * gridDim.y * gridDim.z;
    unsigned sum, cnt, mine, sp = 0u;
    for (;;) {
        sum = 0u; cnt = 0u; mine = 0u;
#pragma unroll
        for (unsigned j = 0; j < 16; ++j) { const unsigned c = xb_ld(&bar[XB_XCNT(j)]); sum += c; cnt += (c > 0u) ? 1u : 0u; mine = (j == x) ? c : mine; }
        if (sum == G) break;
        __builtin_amdgcn_s_sleep(1);
        if ((++sp & 255u) == 0u) { if (xb_ld(&bar[XB_TMO])) break; if (sp > XB_SPIN_CAP) { atomicAdd(&bar[XB_TMO], 1u); break; } }
    }
    nloc = mine > 0u ? mine : 1u; nx = cnt > 0u ? cnt : 1u;
}

__device__ __forceinline__ void xcd_barrier(const XcdBarrier& b) {
    asm volatile("s_waitcnt vmcnt(0)" ::: "memory");
    __syncthreads();
    if (b.w0 != 0u && lane_lo_() == 0u) {
        unsigned* bar = b.bar; unsigned bx = b.x; asm volatile("" : "+s"(bar), "+s"(bx));
        __builtin_amdgcn_s_waitcnt(0);
        unsigned nloc = b.st[0], nx = b.st[1];
        if (nloc == 0u) { xcd_barrier_complete(bar, bx, nloc, nx); b.st[0] = nloc; b.st[1] = nx; }
        const unsigned old = xb_add(&bar[XB_XSUB(bx)], 1u);
        const unsigned gen = old / nloc;
        if (old + 1u == (gen + 1u) * nloc) {
            __builtin_amdgcn_fence(__ATOMIC_RELEASE, "agent");
            asm volatile("s_waitcnt vmcnt(0)" ::: "memory");
            const unsigned og = xb_add(&bar[XB_TOP], 1u);
            const unsigned tg = og / nx;
            if (og + 1u == (tg + 1u) * nx) xb_add(&bar[XB_TOPGEN], 1u);
            else XB_SPIN(xb_ld(&bar[XB_TOPGEN]) == tg, bar);
            __builtin_amdgcn_fence(__ATOMIC_ACQUIRE, "agent");
            xb_add(&bar[XB_XGEN(bx)], 1u);
            asm volatile("s_waitcnt vmcnt(0)" ::: "memory");
        } else {
            XB_SPIN(xb_ld(&bar[XB_XGEN(bx)]) == gen, bar);
            __builtin_amdgcn_fence(__ATOMIC_ACQUIRE, "agent");
            asm volatile("s_waitcnt vmcnt(0)" ::: "memory");
        }
    }
    __syncthreads();
}

struct Frame {
    LAS unsigned char* lds;
    volatile LAS unsigned* MISC;
    gu32* ctl;
    int G, wave;
    float* out; unsigned char* ws;
};
__device__ __forceinline__ const float* in_ptr(int i) {
    const __attribute__((address_space(4))) char* k = (const __attribute__((address_space(4))) char*)__builtin_amdgcn_kernarg_segment_ptr();
    asm volatile("" : "+s"(k));
    return *(const float* const __attribute__((address_space(4)))*)(k + 8 * i);
}
enum { IN_XP = 0, IN_XS, IN_CK, IN_CV, IN_SRET, IN_SPOOL, IN_META, IN_WIN, IN_RETG, IN_PMIX, IN_PSCALE, IN_WBR, IN_WOUT, IN_UP1, IN_DN1, IN_UP2, IN_DN2, IN_LNG, IN_LNB };
__device__ __forceinline__ unsigned char* wsq(unsigned char* p) { asm volatile("" : "+s"(p)); return p; }
#define WSB(F, off) ((bf16*)(wsq((F).ws) + (off)))
struct TC { int tid, lane, wave; };
__device__ __forceinline__ TC thread_coords(int wave) { TC c; int l = lane_id_(); asm volatile("" : "+v"(l)); c.lane = l; c.wave = wave; c.tid = wave * 64 + l; return c; }
__device__ __forceinline__ bf16* lw(const Frame& F, int l, size_t off) { return (bf16*)(wsq(F.ws) + WS_W + (size_t)l * LW_SIZE + off); }
__device__ __forceinline__ float* yrow(const Frame& F, int m) {
    if (m < MP) return F.out + O_YP + (size_t)m * D;
    if (m < ROW_M) return F.out + O_YS + (size_t)(m - ROW_S) * D;
    return nullptr;
}

__device__ __forceinline__ int srccol(int kind, int n) {
    if (kind == 1) { const int pn = n >> 8, p = n & 255, bj = p >> 7, wc = (p >> 5) & 3, fq = (p >> 3) & 3, nn = (p >> 2) & 1, e = p & 3;
        return (nn ? DFF : 0) + 128 * pn + 64 * bj + 16 * wc + 4 * fq + e; }
    if (kind == 2 && n < 1024) { const int hb_ = n & ~127, p = n & 127, wc = p >> 5, fq = (p >> 3) & 3, nn = (p >> 2) & 1, e = p & 3;
        return hb_ + 16 * wc + 4 * fq + e + 64 * nn; }
    return n;
}
__device__ __forceinline__ void p0_transpose_item(const float* W, int K, int ldw, int N, bf16* WT, int kind, LAS float* scr, int item, int lane) {
    const int nblk = N / 32, kb = item / nblk, nb = item % nblk, k0 = 64 * kb, n0 = 32 * nb;
    const int sc = srccol(kind, n0 + (lane & 31));
    float t_[32];
#pragma unroll
    for (int i = 0; i < 32; ++i) t_[i] = W[(size_t)(k0 + 2 * i + (lane >> 5)) * ldw + sc];
#pragma unroll
    for (int i = 0; i < 32; ++i) scr[(2 * i + (lane >> 5)) * 33 + (lane & 31)] = t_[i];
    asm volatile("s_waitcnt lgkmcnt(0)" ::: "memory");
    const int c = lane & 7;
#pragma unroll
    for (int j = 0; j < 4; ++j) { const int n = (lane >> 3) + 8 * j; const LAS float* s = scr + (8 * c) * 33 + n;
        v4u o; o.x = pk2(s[0 * 33], s[1 * 33]); o.y = pk2(s[2 * 33], s[3 * 33]); o.z = pk2(s[4 * 33], s[5 * 33]); o.w = pk2(s[6 * 33], s[7 * 33]);
        *(GAS v4u*)(WT + (size_t)(n0 + n) * K + k0 + 8 * c) = o; }
    asm volatile("s_waitcnt lgkmcnt(0)" ::: "memory");
}
__device__ __forceinline__ void p0_poolfold_item(const float* mixw  , const float* scale  , const float* wb2  , bf16* WT  , int item, int lane) {
    const int g = item >> 7, r = item & 127, cb = r >> 4, nb = r & 15;
    const int n = nb * 64 + lane, c0 = cb * 32;
    float acc[32];
#pragma unroll
    for (int i = 0; i < 32; ++i) acc[i] = 0.f;
    const float* mw = mixw + ((size_t)g * 256 + c0) * 256;
    for (int d0 = 0; d0 < 256; d0 += 8) {
        float a[8];
#pragma unroll
        for (int j = 0; j < 8; ++j) a[j] = scale[g * 256 + d0 + j] * wb2[(size_t)(g * 256 + d0 + j) * D + n];
#pragma unroll
        for (int i = 0; i < 32; ++i)
#pragma unroll
            for (int j = 0; j < 8; ++j) acc[i] += mw[(size_t)i * 256 + d0 + j] * a[j];
    }
    bf16* dst = WT + (size_t)n * D + g * 256 + c0;
#pragma unroll
    for (int i = 0; i < 32; i += 8) { v4u o; o.x = pk2(acc[i], acc[i + 1]); o.y = pk2(acc[i + 2], acc[i + 3]); o.z = pk2(acc[i + 4], acc[i + 5]); o.w = pk2(acc[i + 6], acc[i + 7]); *(GAS v4u*)(dst + i) = o; }
}
__device__ __forceinline__ void p0_prologue(Frame& F) {
    const TC tc = thread_coords(F.wave); const int gw = blockIdx.x * 8 + tc.wave, NGW = F.G * 8;
    LAS float* scr = (LAS float*)(F.lds + tc.wave * 16384);
    for (int l = 0; l < DEPTH; ++l) {
        constexpr int I_UP = (D / 64) * (2 * DFF / 32), I_DN = (DFF / 64) * (D / 32), I_IN = (D / 64) * (DIN / 32), I_SQ = (D / 64) * (D / 32), I_PF = 4 * 4 * 32;
        constexpr int NIT = 2 * I_UP + 2 * I_DN + I_IN + 3 * I_SQ + I_PF;
        for (int it = (gw + l * (NGW / 2)) % NGW; it < NIT; it += NGW) {
            int r = it;
            if (r < I_UP) { p0_transpose_item(in_ptr(IN_UP1) + (size_t)l * D * 2 * DFF, D, 2 * DFF, 2 * DFF, lw(F, l, LW_UP1), 1, scr, r, tc.lane); continue; } r -= I_UP;
            if (r < I_UP) { p0_transpose_item(in_ptr(IN_UP2) + (size_t)l * D * 2 * DFF, D, 2 * DFF, 2 * DFF, lw(F, l, LW_UP2), 1, scr, r, tc.lane); continue; } r -= I_UP;
            if (r < I_DN) { p0_transpose_item(in_ptr(IN_DN1) + (size_t)l * DFF * D, DFF, D, D, lw(F, l, LW_DN1), 0, scr, r, tc.lane); continue; } r -= I_DN;
            if (r < I_DN) { p0_transpose_item(in_ptr(IN_DN2) + (size_t)l * DFF * D, DFF, D, D, lw(F, l, LW_DN2), 0, scr, r, tc.lane); continue; } r -= I_DN;
            if (r < I_IN) { p0_transpose_item(in_ptr(IN_WIN) + (size_t)l * D * DIN, D, DIN, DIN, lw(F, l, LW_IN), 2, scr, r, tc.lane); continue; } r -= I_IN;
            if (r < I_SQ) { p0_transpose_item(in_ptr(IN_WBR) + (size_t)(l * 3 + 0) * D * D, D, D, D, lw(F, l, LW_BR), 0, scr, r, tc.lane); continue; } r -= I_SQ;
            if (r < I_SQ) { p0_transpose_item(in_ptr(IN_WBR) + (size_t)(l * 3 + 1) * D * D, D, D, D, lw(F, l, LW_BR) + (size_t)D * D, 0, scr, r, tc.lane); continue; } r -= I_SQ;
            if (r < I_SQ) { p0_transpose_item(in_ptr(IN_WOUT) + (size_t)l * D * D, D, D, D, lw(F, l, LW_OUT), 0, scr, r, tc.lane); continue; } r -= I_SQ;
            p0_poolfold_item(in_ptr(IN_PMIX) + (size_t)l * 4 * 256 * 256, in_ptr(IN_PSCALE) + (size_t)l * D, in_ptr(IN_WBR) + (size_t)(l * 3 + 2) * D * D, lw(F, l, LW_BR) + (size_t)2 * D * D, r, tc.lane);
        }
    }
    for (int m0 = gw; m0 < M_PAD; m0 += 2 * NGW) {
        f32x4 v[2][4];
#pragma unroll
        for (int r = 0; r < 2; ++r) { const int m = m0 + r * NGW;
            const float* src = (m < MP) ? in_ptr(IN_XP) + (size_t)m * D : (m < ROW_M) ? in_ptr(IN_XS) + (size_t)(m - ROW_S) * D : (m - ROW_M < NMETA) ? in_ptr(IN_META) + (size_t)(m - ROW_M) * D : nullptr;
#pragma unroll
            for (int j = 0; j < 4; ++j) v[r][j] = (src && m < M_PAD) ? ((const GAS f32x4*)src)[tc.lane + 64 * j] : (f32x4){0.f, 0.f, 0.f, 0.f}; }
#pragma unroll
        for (int r = 0; r < 2; ++r) { const int m = m0 + r * NGW;
            if (m < M_PAD) { GAS v2u* o8 = (GAS v2u*)(WSB(F, WS_HB) + (size_t)m * D) + tc.lane;
#pragma unroll
                for (int j = 0; j < 4; ++j) o8[64 * j] = (v2u){pk2(v[r][j].x, v[r][j].y), pk2(v[r][j].z, v[r][j].w)}; } }
    }
}

__device__ __forceinline__ void ln_rows(const Frame& F, int idx, bool final_out, int row_lo, int row_hi, int gw0, int NGW, bool comb = false) {
    const TC tc = thread_coords(F.wave); const int gw = gw0 + tc.wave;
    const float* g = in_ptr(IN_LNG) + (size_t)idx * D; const float* b = in_ptr(IN_LNB) + (size_t)idx * D;
    f32x4 gv[4], bv[4];
#pragma unroll
    for (int j = 0; j < 2; ++j) { gv[2 * j] = ((const GAS f32x4*)g)[2 * tc.lane + 128 * j]; gv[2 * j + 1] = ((const GAS f32x4*)g)[2 * tc.lane + 128 * j + 1];
                                  bv[2 * j] = ((const GAS f32x4*)b)[2 * tc.lane + 128 * j]; bv[2 * j + 1] = ((const GAS f32x4*)b)[2 * tc.lane + 128 * j + 1]; }
    for (int m0 = row_lo + gw; m0 < row_hi; m0 += 2 * NGW) {
        v4u w[2][2]; const bool two = m0 + NGW < row_hi;
#pragma unroll
        for (int r = 0; r < 2; ++r) { const int m = (r == 0 || two) ? m0 + r * NGW : m0; const GAS v4u* yr = (const GAS v4u*)(WSB(F, comb ? WS_HB : WS_YB) + (size_t)m * D) + tc.lane; w[r][0] = yr[0]; w[r][1] = yr[64]; }
#pragma unroll
        for (int r = 0; r < 2; ++r) { const int m = m0 + r * NGW; if (r == 1 && !two) break;
        f32x4 v[4]; float s = 0.f;
#pragma unroll
        for (int j = 0; j < 2; ++j) { const v4u x = w[r][j]; v[2 * j] = (f32x4){bflo(x.x), bfhi(x.x), bflo(x.y), bfhi(x.y)}; v[2 * j + 1] = (f32x4){bflo(x.z), bfhi(x.z), bflo(x.w), bfhi(x.w)}; }
        if (comb) {
            const GAS f32x4* pa = (const GAS f32x4*)((const float*)WSB(F, WS_ACT) + (size_t)(m - MP) * D) + 2 * tc.lane; const GAS f32x4* pb = pa + (size_t)512 * D / 4;
#pragma unroll
            for (int j = 0; j < 2; ++j) { v[2 * j] = v[2 * j] * ALPHA + (pa[128 * j] + pb[128 * j]) * 0.5f; v[2 * j + 1] = v[2 * j + 1] * ALPHA + (pa[128 * j + 1] + pb[128 * j + 1]) * 0.5f; } }
#pragma unroll
        for (int j = 0; j < 4; ++j) s += (v[j].x + v[j].y) + (v[j].z + v[j].w);
        const float mean = wave_sum(s) * (1.f / D); float s2 = 0.f;
#pragma unroll
        for (int j = 0; j < 4; ++j) { v[j] = v[j] - mean; s2 += (v[j].x * v[j].x + v[j].y * v[j].y) + (v[j].z * v[j].z + v[j].w * v[j].w); }
        const float rstd = 1.f / sqrtf(wave_sum(s2) * (1.f / D) + LN_EPS);
#pragma unroll
        for (int j = 0; j < 4; ++j) v[j] = v[j] * rstd * gv[j] + bv[j];
        if (!final_out) { GAS v4u* o = (GAS v4u*)(WSB(F, WS_HB) + (size_t)m * D) + tc.lane;
#pragma unroll
            for (int j = 0; j < 2; ++j) o[64 * j] = (v4u){pk2(v[2 * j].x, v[2 * j].y), pk2(v[2 * j].z, v[2 * j].w), pk2(v[2 * j + 1].x, v[2 * j + 1].y), pk2(v[2 * j + 1].z, v[2 * j + 1].w)}; }
        else { float* yo = yrow(F, m); if (yo) { GAS f32x4* o = (GAS f32x4*)yo + 2 * tc.lane;
#pragma unroll
            for (int j = 0; j < 2; ++j) { o[128 * j] = v[2 * j]; o[128 * j + 1] = v[2 * j + 1]; } } }
        }
    }
}
__device__ __forceinline__ void ln_phase(const Frame& F, int idx, bool final_out, int row_lo, int row_hi, int cu_lo, bool comb = false) { ln_rows(F, idx, final_out, row_lo, row_hi, ((int)blockIdx.x - cu_lo) * 8, (F.G - cu_lo) * 8, comb); }
__device__ __forceinline__ float ret_lg2(int h);

using pg8::Unit;
typedef f32x4 AccT[2][2][4][2];
#ifndef LANE_TR
#define LANE_TR 1
#endif
struct LaneT { int tfr, tfq, pull, push; };
#if LANE_TR
__device__ __forceinline__ LaneT lane_t(int fr, int fq) { LaneT t; const int L = fq * 16 + fr; t.tfr = L >> 2; t.tfq = L & 3; t.pull = ((t.tfq << 4) + t.tfr) << 2; t.push = ((fr << 2) + fq) << 2; return t; }
__device__ __forceinline__ unsigned bperm(int a, unsigned x) { return (unsigned)__builtin_amdgcn_ds_bpermute(a, (int)x); }
__device__ __forceinline__ v4u tr4(int a, v4u x) { return (v4u){bperm(a, x.x), bperm(a, x.y), bperm(a, x.z), bperm(a, x.w)}; }
__device__ __forceinline__ v2u tr2(int a, v2u x) { return (v2u){bperm(a, x.x), bperm(a, x.y)}; }
#else
__device__ __forceinline__ LaneT lane_t(int fr, int fq) { LaneT t; t.tfr = fr; t.tfq = fq; t.pull = 0; t.push = 0; return t; }
__device__ __forceinline__ v4u tr4(int, v4u x) { return x; }
__device__ __forceinline__ v2u tr2(int, v2u x) { return x; }
#endif
__device__ __forceinline__ f32x4 tr4f(int a, f32x4 x) { return __builtin_bit_cast(f32x4, tr4(a, __builtin_bit_cast(v4u, x))); }
__device__ __forceinline__ v4u pack8(const f32x4& a, const f32x4& b) { return (v4u){pg8::cvt_pk_bf16(a[0], a[1]), pg8::cvt_pk_bf16(a[2], a[3]), pg8::cvt_pk_bf16(b[0], b[1]), pg8::cvt_pk_bf16(b[2], b[3])}; }

struct EpiSwiglu {
    static constexpr bool PERM = true; static constexpr int NS = 8;
    bf16* act;
    __device__ __forceinline__ bool operator()(AccT& acc, const Unit& u, int wr, int wc, int fr, int fq) const {
        asm volatile("" : "+s"(wr), "+s"(wc), "+v"(fr), "+v"(fq));
        const int row0 = u.pm * 256 + wr * 64 + fr + 16 * (fq & 1), col0 = u.pn * 128 + wc * 16 + 4 * (fq & 2);
#pragma unroll
        for (int ai = 0; ai < 2; ++ai)
#pragma unroll
            for (int mp = 0; mp < 2; ++mp) { bf16* rowp = act + (size_t)(row0 + ai * 128 + mp * 32) * DFF + col0;
#pragma unroll
                for (int bj = 0; bj < 2; ++bj) { unsigned pk[2][2];
#pragma unroll
                    for (int k = 0; k < 2; ++k) { const f32x4 g = acc[ai][bj][2 * mp + k][0], up = acc[ai][bj][2 * mp + k][1];
                        pk[k][0] = pg8::cvt_pk_bf16(siluf_(g[0]) * up[0], siluf_(g[1]) * up[1]); pk[k][1] = pg8::cvt_pk_bf16(siluf_(g[2]) * up[2], siluf_(g[3]) * up[3]); }
                    const auto sx = __builtin_amdgcn_permlane16_swap(pk[0][0], pk[1][0], false, false), sy = __builtin_amdgcn_permlane16_swap(pk[0][1], pk[1][1], false, false);
                    *(GAS v4u*)(rowp + bj * 64) = (v4u){sx[0], sy[0], sx[1], sy[1]}; } }
        return false;
    }
};

struct EpiResid {
    static constexpr bool PERM = true; static constexpr int NS = 16;
    unsigned char* ws; float ca, cb;
    __device__ __forceinline__ bool operator()(AccT& acc, const Unit& u, int wr, int wc, int fr, int fq) const {
        asm volatile("" : "+s"(wr), "+s"(wc), "+v"(fr), "+v"(fq));
        const LaneT t = lane_t(fr, fq);
        const bf16* src = (const bf16*)(ws + WS_HB); bf16* dst = (bf16*)(ws + WS_YB);
        const int row0 = u.pm * 256 + wr * 64 + t.tfr, col0 = u.pn * 256 + wc * 32 + 8 * t.tfq;
#pragma unroll
        for (int ai = 0; ai < 2; ++ai)
#pragma unroll
            for (int m = 0; m < 4; ++m) { const size_t off = (size_t)(row0 + ai * 128 + m * 16) * D + col0;
#pragma unroll
                for (int bj = 0; bj < 2; ++bj) { const v4u r = tr4(t.push, *(const GAS v4u*)(src + off + bj * 128));
                    const f32x4 y0 = (f32x4){bflo(r.x), bfhi(r.x), bflo(r.y), bfhi(r.y)} * ca + acc[ai][bj][m][0] * cb, y1 = (f32x4){bflo(r.z), bfhi(r.z), bflo(r.w), bfhi(r.w)} * ca + acc[ai][bj][m][1] * cb;
                    *(GAS v4u*)(dst + off + bj * 128) = tr4(t.pull, pack8(y0, y1)); } }
        return false;
    }
};

struct EpiGate {
    static constexpr bool PERM = true; static constexpr int NS = 0;
    unsigned char* ws;
    __device__ __forceinline__ bool operator()(AccT& acc, const Unit& u, int wr, int wc, int fr, int fq) const {
        asm volatile("" : "+s"(wr), "+s"(wc), "+v"(fr), "+v"(fq));
        const LaneT t = lane_t(fr, fq);
        const bf16* Gt = (const bf16*)(ws + WS_GT); bf16* mix = (bf16*)(ws + WS_MIX);
        const int n = u.pm / NPANEL, pm = u.pm - n * NPANEL, pn = u.pn & 3;
        const int row0 = pm * 256 + wr * 64 + t.tfr, col0 = pn * 256 + wc * 32 + 8 * t.tfq;
#pragma unroll
        for (int ai = 0; ai < 2; ++ai)
#pragma unroll
            for (int m = 0; m < 4; ++m) { const size_t r = (size_t)(row0 + ai * 128 + m * 16);
#pragma unroll
                for (int bj = 0; bj < 2; ++bj) {
                    const v4u ga = tr4(t.push, *(const GAS v4u*)(Gt + r * (3 * D) + n * D + col0 + bj * 128));
                    float f[8] = {bflo(ga.x), bfhi(ga.x), bflo(ga.y), bfhi(ga.y), bflo(ga.z), bfhi(ga.z), bflo(ga.w), bfhi(ga.w)};
                    if (n < 2) { const v4u gb = tr4(t.push, *(const GAS v4u*)(Gt + r * (3 * D) + (n + 1) * D + col0 + bj * 128));
                        const float h[8] = {bflo(gb.x), bfhi(gb.x), bflo(gb.y), bfhi(gb.y), bflo(gb.z), bfhi(gb.z), bflo(gb.w), bfhi(gb.w)};
#pragma unroll
                        for (int e = 0; e < 8; ++e) f[e] = f[e] * fast_rcp(fmaxf(h[e], 1e-30f)); }
                    f32x4 v0 = acc[ai][bj][m][0], v1 = acc[ai][bj][m][1];
                    v0 = v0 * (f32x4){f[0], f[1], f[2], f[3]}; v1 = v1 * (f32x4){f[4], f[5], f[6], f[7]};
                    acc[ai][bj][m][0] = v0; acc[ai][bj][m][1] = v1;
                    if (n == 2) *(GAS v4u*)(mix + r * D + col0 + bj * 128) = tr4(t.pull, pack8(v0, v1));
                } }
        return n < 2;
    }
};
struct Order3 : pg8::StaticOrder {
    __device__ __forceinline__ bool next(int i, Unit& u) const { Unit t; if (!pg8::StaticOrder::next(i / 3, t)) return false; const int k = i % 3; u.pm = t.pm + k * NPANEL; u.pn = t.pn + 4 * k; return true; }
};

struct SmallOrder {
    int c;
    __device__ __forceinline__ bool next(int i, Unit& u) const { if (i > 0 || c >= 8) return false; u.pm = 256 + (c >> 2); u.pn = c & 3; return true; }
    __device__ __forceinline__ void a_ready(const Unit&) const {}
    __device__ __forceinline__ void done(const Unit&) const {}
};

struct SmallOrderH {
    int c;
    __device__ __forceinline__ bool next(int i, Unit& u) const { if (i > 0 || c >= 16) return false; u.pm = 256 + ((c >> 2) & 1); u.pn = c & 3; return true; }
    __device__ __forceinline__ void a_ready(const Unit&) const {}
    __device__ __forceinline__ void done(const Unit&) const {}
};
struct EpiPart {
    static constexpr bool PERM = true; static constexpr int NS = 16;
    float* part;
    __device__ __forceinline__ bool operator()(AccT& acc, const Unit& u, int wr, int wc, int fr, int fq) const {
        asm volatile("" : "+s"(wr), "+s"(wc), "+v"(fr), "+v"(fq));
        float* p0 = part + (size_t)((u.pm - 256) * 256 + wr * 64 + fr) * D + u.pn * 256 + wc * 32 + 8 * fq;
#pragma unroll
        for (int ai = 0; ai < 2; ++ai)
#pragma unroll
            for (int m = 0; m < 4; ++m)
#pragma unroll
                for (int bj = 0; bj < 2; ++bj)
#pragma unroll
                    for (int n = 0; n < 2; ++n) *(GAS f32x4*)(p0 + (size_t)(ai * 128 + m * 16) * D + bj * 128 + 4 * n) = acc[ai][bj][m][n];
        return false;
    }
};

struct SmallOrder3 {
    int c;
    __device__ __forceinline__ bool next(int i, Unit& u) const { if (i > 2) return false; u.pm = 256 + (c >> 2) + i * NPANEL; u.pn = (c & 3) + 4 * i; return true; }
    __device__ __forceinline__ void a_ready(const Unit&) const {}
    __device__ __forceinline__ void done(const Unit&) const {}
};
struct SmallOrderW {
    int c;
    __device__ __forceinline__ bool next(int i, Unit& u) const { if (i > 0) return false; const int p = c >= 22 ? 1 : 0; u.pm = 256 + p; u.pn = c - 22 * p; return true; }
    __device__ __forceinline__ void a_ready(const Unit&) const {}
    __device__ __forceinline__ void done(const Unit&) const {}
};

struct EpiWin {
    static constexpr bool PERM = true; static constexpr int NS = 16;
    unsigned char* ws; float* out; int layer;
    __device__ __forceinline__ bool operator()(AccT& acc, const Unit& u, int wr, int wc, int fr, int fq) const {
        asm volatile("" : "+s"(wr), "+s"(wc), "+v"(fr), "+v"(fq));
        const LaneT t = lane_t(fr, fq);
        const int pn = u.pn, pm = u.pm, rl0 = wr * 64 + fr, trl0 = wr * 64 + t.tfr;
        if (pn < 4) {
            const bool isk = pn >= 2; bf16* dst = (bf16*)(ws + (isk ? WS_KR : WS_QR)); const float sc = isk ? 0.08838834764831845f : 1.0f;
            const float lgA = ret_lg2(2 * (pn & 1)) * (isk ? -1.f : 1.f), lgB = ret_lg2(2 * (pn & 1) + 1) * (isk ? -1.f : 1.f);
            float invf[4];
#pragma unroll
            for (int e = 0; e < 4; ++e) invf[e] = fast_exp2(-(float)(16 * wc + 4 * fq + e) * (13.287712379549449f / 64.0f)) * 0.15915494309189535f;
#pragma unroll
            for (int ai = 0; ai < 2; ++ai)
#pragma unroll
                for (int mp = 0; mp < 2; ++mp) { unsigned pk1[2][2][2], pk2[2][2][2];
#pragma unroll
                    for (int k = 0; k < 2; ++k) { const int rl = rl0 + ai * 128 + (2 * mp + k) * 16, r = pm * 256 + rl;
                        const float pos = (float)(pm < 256 ? NMETA + (r & (T - 1)) : (pm == 256 ? NMETA + PAST + (rl & (ST - 1)) : rl));
                        const float jp1 = (float)((pm < 256 ? (r & 63) : (pm == 256 ? (rl & (ST - 1)) : rl)) + 1);
                        const float dsc[2] = {sc * fast_exp2(jp1 * lgA), sc * fast_exp2(jp1 * lgB)};
                        f32x4 cs, sn;
#pragma unroll
                        for (int e = 0; e < 4; ++e) { float rev = pos * invf[e]; rev = rev - floorf(rev); cs[e] = __builtin_amdgcn_cosf(rev); sn[e] = __builtin_amdgcn_sinf(rev); }
#pragma unroll
                        for (int bj = 0; bj < 2; ++bj) { const f32x4 x1 = acc[ai][bj][2 * mp + k][0], x2 = acc[ai][bj][2 * mp + k][1];
                            const f32x4 o1 = (x1 * cs - x2 * sn) * dsc[bj], o2 = (x2 * cs + x1 * sn) * dsc[bj];
                            pk1[k][bj][0] = pg8::cvt_pk_bf16(o1[0], o1[1]); pk1[k][bj][1] = pg8::cvt_pk_bf16(o1[2], o1[3]);
                            pk2[k][bj][0] = pg8::cvt_pk_bf16(o2[0], o2[1]); pk2[k][bj][1] = pg8::cvt_pk_bf16(o2[2], o2[3]); } }
                    const size_t srow = (size_t)(pm * 256 + rl0 + ai * 128 + (2 * mp + (fq & 1)) * 16);
#pragma unroll
                    for (int bj = 0; bj < 2; ++bj) { bf16* rowp = dst + srow * 512 + (2 * (pn & 1) + bj) * 128 + 16 * wc + 4 * (fq & 2);
                        { const auto sx = __builtin_amdgcn_permlane16_swap(pk1[0][bj][0], pk1[1][bj][0], false, false), sy = __builtin_amdgcn_permlane16_swap(pk1[0][bj][1], pk1[1][bj][1], false, false);
                          *(GAS v4u*)rowp = (v4u){sx[0], sy[0], sx[1], sy[1]}; }
                        { const auto sx = __builtin_amdgcn_permlane16_swap(pk2[0][bj][0], pk2[1][bj][0], false, false), sy = __builtin_amdgcn_permlane16_swap(pk2[0][bj][1], pk2[1][bj][1], false, false);
                          *(GAS v4u*)(rowp + 64) = (v4u){sx[0], sy[0], sx[1], sy[1]}; } } }
            return false;
        }
        const int seg = (pn - 4) >> 2;
        const int colt = ((pn - 4) & 3) * 256 + wc * 32 + 8 * t.tfq;
        if (seg == 0 || seg == 1 || seg == 2 || seg >= 6) {
            bf16* dst = (bf16*)(ws + (seg == 0 ? WS_VR : seg == 1 ? WS_GR : seg == 2 ? WS_QS : WS_GT)); const int ld = seg >= 6 ? 3 * D : D; const int cofs = seg >= 6 ? (seg - 6) * D : 0;
#pragma unroll
            for (int ai = 0; ai < 2; ++ai)
#pragma unroll
                for (int m = 0; m < 4; ++m) { const size_t r = (size_t)(pm * 256 + trl0 + ai * 128 + m * 16);
#pragma unroll
                    for (int bj = 0; bj < 2; ++bj) { f32x4 v0 = acc[ai][bj][m][0], v1 = acc[ai][bj][m][1];
                        if (seg == 1) {
#pragma unroll
                            for (int e = 0; e < 4; ++e) { v0[e] = siluf_(v0[e]); v1[e] = siluf_(v1[e]); } }
                        else if (seg == 2) { v0 = v0 * (0.08838834764831845f * LOG2E); v1 = v1 * (0.08838834764831845f * LOG2E); }
                        else if (seg >= 6) {
#pragma unroll
                            for (int e = 0; e < 4; ++e) { v0[e] = sigmoidf_(v0[e]); v1[e] = sigmoidf_(v1[e]); } }
                        *(GAS v4u*)(dst + r * ld + cofs + colt + bj * 128) = tr4(t.pull, pack8(v0, v1)); } }
            return false;
        }
        if (seg == 3 || seg == 4) {
            bf16* dst = (bf16*)(ws + (seg == 3 ? WS_KS : WS_VS));
            float* op = out + (seg == 3 ? O_KP : O_VP) + (size_t)layer * NB * KT_PP * D;
            float* os = out + (seg == 3 ? O_KS : O_VS) + (size_t)layer * SBATCH * ST * D;
#pragma unroll
            for (int ai = 0; ai < 2; ++ai)
#pragma unroll
                for (int m = 0; m < 4; ++m) { const int rl = trl0 + ai * 128 + m * 16; const size_t r = (size_t)(pm * 256 + rl);
#pragma unroll
                    for (int bj = 0; bj < 2; ++bj) { const f32x4 v0 = tr4f(t.pull, acc[ai][bj][m][0]), v1 = tr4f(t.pull, acc[ai][bj][m][1]); const int c = colt + bj * 128;
                        *(GAS v4u*)(dst + r * D + c) = pack8(v0, v1);
                        if (pm < 256) { float* o = op + ((size_t)(r >> 11) * KT_PP + NMETA + (r & (T - 1))) * D + c; *(GAS f32x4*)o = v0; *(GAS f32x4*)(o + 4) = v1; }
                        else if (pm == 256) { float* o = os + (size_t)rl * D + c; *(GAS f32x4*)o = v0; *(GAS f32x4*)(o + 4) = v1; }
                        else if (rl < NMETA) { for (int bb = 0; bb < NB; ++bb) { float* o = op + ((size_t)bb * KT_PP + rl) * D + c; *(GAS f32x4*)o = v0; *(GAS f32x4*)(o + 4) = v1; } }
                    } }
            return false;
        }
        {
            float* op = out + O_PP + (size_t)layer * NB * PBUF * D;
            float* os = out + O_PS + (size_t)layer * SBATCH * PBUF * D;
#pragma unroll
            for (int ai = 0; ai < 2; ++ai)
#pragma unroll
                for (int m = 0; m < 4; ++m) { const int rl = trl0 + ai * 128 + m * 16; const size_t r = (size_t)(pm * 256 + rl);
#pragma unroll
                    for (int bj = 0; bj < 2; ++bj) { const f32x4 v0 = tr4f(t.pull, acc[ai][bj][m][0]), v1 = tr4f(t.pull, acc[ai][bj][m][1]); const int c = colt + bj * 128;
                        *(GAS v4u*)((bf16*)(ws + WS_U) + r * D + c) = pack8(v0, v1);
                        if (pm < 256) { const int tt = (int)(r & (T - 1)); if (tt >= T - PBUF) { float* o = op + ((size_t)(r >> 11) * PBUF + (tt - (T - PBUF))) * D + c; *(GAS f32x4*)o = v0; *(GAS f32x4*)(o + 4) = v1; } }
                        else if (pm == 256) { const int tt = rl & (ST - 1); if (tt >= ST - PBUF) { float* o = os + ((size_t)(rl >> 5) * PBUF + (tt - (ST - PBUF))) * D + c; *(GAS f32x4*)o = v0; *(GAS f32x4*)(o + 4) = v1; } }
                    } }
            return false;
        }
    }
};

__device__ __forceinline__ int grab(const Frame& F, gu32* ctr) {
    __syncthreads();
    if (F.wave == 0 && lane_lo_() == 0u) F.MISC[16] = __hip_atomic_fetch_add(ctr, 1u, RLX_AGENT);
    __syncthreads();
    return (int)F.MISC[16];
}
__device__ __forceinline__ unsigned grab_issue(const Frame& F, gu32* ctr) { return (F.wave == 0 && lane_lo_() == 0u) ? __hip_atomic_fetch_add(ctr, 1u, RLX_AGENT) : 0u; }
__device__ __forceinline__ int grab_publish(const Frame& F, unsigned nxt) {
    __syncthreads();
    if (F.wave == 0 && lane_lo_() == 0u) F.MISC[16] = nxt;
    __syncthreads();
    return (int)F.MISC[16];
}
typedef float f32x4_t __attribute__((ext_vector_type(4)));
#define MFMA16(a, b, c) __builtin_amdgcn_mfma_f32_16x16x32_bf16((a), (b), (c), 0, 0, 0)
__device__ __forceinline__ s16x4 tr16(const LAS unsigned char* p) { typedef short v4i16_t __attribute__((ext_vector_type(4))); return __builtin_bit_cast(s16x4, __builtin_amdgcn_ds_read_tr16_b64_v4i16((LAS v4i16_t*)p)); }

constexpr int RT_QS = 272, RT_VS = 528, RT_AS = 144;
constexpr int RT_Q = 0, RT_K = 64 * RT_QS, RT_V = 2 * 64 * RT_QS, RT_A = RT_V + 64 * RT_VS, RT_END = RT_A + 64 * RT_AS;
static_assert(RT_END <= RING_BYTES && 64 * 256 * 4 <= RT_END, "retention LDS map");
__device__ __forceinline__ float ret_lg2(int h) { return fast_log2(1.0f - fast_exp2(-5.0f - (float)h * (4.0f / 3.0f))); }
__device__ __forceinline__ void ret_unit(const Frame& F, int layer, int uid) {
    const int h = uid & 3; int stream, b;
    if (uid < 128) { stream = 0; b = uid >> 2; } else if (uid < 160) { stream = 1; b = (uid - 128) >> 2; } else { stream = 2; b = 0; }
    const TC tc = thread_coords(F.wave); const int tid = tc.tid, lane = tc.lane, w = tc.wave, l15 = lane & 15, g = lane >> 4, q4 = l15 >> 2, p4 = l15 & 3;
    const float lg2 = ret_lg2(h);
    const int nch = stream == 0 ? 1 + T / 64 : 1;
    f32x4 accS[8][2];
#pragma unroll
    for (int m = 0; m < 8; ++m)
#pragma unroll
        for (int n = 0; n < 2; ++n) accS[m][n] = (f32x4){0.f, 0.f, 0.f, 0.f};
    if (stream == 1) { const float* s0 = in_ptr(IN_SRET) + (((size_t)layer * SBATCH + b) * HRET + h) * DKR * DVR;
#pragma unroll
        for (int m = 0; m < 8; ++m)
#pragma unroll
            for (int n = 0; n < 2; ++n)
#pragma unroll
                for (int r = 0; r < 4; ++r) accS[m][n][r] = s0[(size_t)(16 * m + 4 * g + r) * DVR + 32 * w + 16 * n + l15]; }
    v4u qreg[2], kreg[2], vreg[4];
    const int lrow = tid >> 4, lch = tid & 15, vrow = tid >> 5, vch = tid & 31;
#define RT_CHUNK(c, rb, vl) do { if (stream == 0) { if ((c) == 0) { rb = ROW_M; vl = NMETA; } else { rb = b * T + 64 * ((c) - 1); vl = 64; } } \
        else if (stream == 1) { rb = ROW_S + b * ST; vl = ST; } else { rb = ROW_M; vl = NMETA; } } while (0)
#define RT_LOAD(c) do { int rb_, vl_; RT_CHUNK(c, rb_, vl_); \
        _Pragma("unroll") for (int i_ = 0; i_ < 2; ++i_) { const int r_ = lrow + 32 * i_; qreg[i_] = (v4u){0u, 0u, 0u, 0u}; kreg[i_] = (v4u){0u, 0u, 0u, 0u}; \
            if (r_ < vl_) { const size_t o_ = (size_t)(rb_ + r_) * 512 + h * 128 + lch * 8; qreg[i_] = *(const GAS v4u*)(WSB(F, WS_QR) + o_); kreg[i_] = *(const GAS v4u*)(WSB(F, WS_KR) + o_); } } \
        _Pragma("unroll") for (int i_ = 0; i_ < 4; ++i_) { const int r_ = vrow + 16 * i_; vreg[i_] = (v4u){0u, 0u, 0u, 0u}; \
            if (r_ < vl_) vreg[i_] = *(const GAS v4u*)(WSB(F, WS_VR) + (size_t)(rb_ + r_) * D + h * 256 + vch * 8); } } while (0)
    RT_LOAD(0);
    const LAS unsigned char* Ql = F.lds + RT_Q; const LAS unsigned char* Kl = F.lds + RT_K; const LAS unsigned char* Vl = F.lds + RT_V; const LAS unsigned char* Al = F.lds + RT_A;
    for (int c = 0; c < nch; ++c) {
        int rowbase, valid; RT_CHUNK(c, rowbase, valid);
        const bool write_out = !(stream == 0 && c == 0);
        const float dc = fast_exp2((float)valid * lg2);
        __syncthreads();
#pragma unroll
        for (int i = 0; i < 2; ++i) { *(LAS v4u*)(F.lds + RT_Q + (lrow + 32 * i) * RT_QS + lch * 16) = qreg[i]; *(LAS v4u*)(F.lds + RT_K + (lrow + 32 * i) * RT_QS + lch * 16) = kreg[i]; }
#pragma unroll
        for (int i = 0; i < 4; ++i) *(LAS v4u*)(F.lds + RT_V + (vrow + 16 * i) * RT_VS + vch * 16) = vreg[i];
        __syncthreads();
        if (c + 1 < nch) RT_LOAD(c + 1);
#pragma unroll
        for (int tt = 0; tt < 2; ++tt) { const int id = 2 * w + tt, mt = id >> 2, nt = id & 3;
            f32x4 a4 = (f32x4){0.f, 0.f, 0.f, 0.f};
            if (mt <= nt) {
#pragma unroll
                for (int ks = 0; ks < 4; ++ks) { const bf16x8 A = *(const LAS bf16x8*)(Kl + (16 * mt + l15) * RT_QS + 64 * ks + 16 * g); const bf16x8 B = *(const LAS bf16x8*)(Ql + (16 * nt + l15) * RT_QS + 64 * ks + 16 * g);
                    a4 = MFMA16(A, B, a4); }
#pragma unroll
                for (int r = 0; r < 4; ++r) a4[r] = (16 * mt + 4 * g + r <= 16 * nt + l15) ? a4[r] : 0.f;
            }
            *(LAS v2u*)(F.lds + RT_A + (16 * nt + l15) * RT_AS + (16 * mt + 4 * g) * 2) = (v2u){pg8::cvt_pk_bf16(a4[0], a4[1]), pg8::cvt_pk_bf16(a4[2], a4[3])}; }
        __syncthreads();
        f32x4 accO[4][2];
#pragma unroll
        for (int m = 0; m < 4; ++m)
#pragma unroll
            for (int n = 0; n < 2; ++n) accO[m][n] = (f32x4){0.f, 0.f, 0.f, 0.f};
#pragma unroll
        for (int ks = 0; ks < 4; ++ks) {
            bf16x8 Sf[2];
#pragma unroll
            for (int n = 0; n < 2; ++n) Sf[n] = __builtin_bit_cast(bf16x8, (v4u){pg8::cvt_pk_bf16(accS[2 * ks][n][0], accS[2 * ks][n][1]), pg8::cvt_pk_bf16(accS[2 * ks][n][2], accS[2 * ks][n][3]),
                                                                               pg8::cvt_pk_bf16(accS[2 * ks + 1][n][0], accS[2 * ks + 1][n][1]), pg8::cvt_pk_bf16(accS[2 * ks + 1][n][2], accS[2 * ks + 1][n][3])});
#pragma unroll
            for (int m = 0; m < 4; ++m) { const v2u lo = *(const LAS v2u*)(Ql + (16 * m + l15) * RT_QS + (32 * ks + 4 * g) * 2), hi = *(const LAS v2u*)(Ql + (16 * m + l15) * RT_QS + (32 * ks + 16 + 4 * g) * 2);
                const bf16x8 A = __builtin_bit_cast(bf16x8, (v4u){lo.x, lo.y, hi.x, hi.y});
#pragma unroll
                for (int n = 0; n < 2; ++n) accO[m][n] = MFMA16(A, Sf[n], accO[m][n]); }
        }
        bf16x8 Bv[2][2];
#pragma unroll
        for (int k2 = 0; k2 < 2; ++k2)
#pragma unroll
            for (int n = 0; n < 2; ++n) { const s16x4 lo = tr16(Vl + (32 * k2 + 8 * g + q4) * RT_VS + (32 * w + 16 * n + 4 * p4) * 2), hi = tr16(Vl + (32 * k2 + 8 * g + 4 + q4) * RT_VS + (32 * w + 16 * n + 4 * p4) * 2);
                Bv[k2][n] = __builtin_shufflevector(lo, hi, 0, 1, 2, 3, 4, 5, 6, 7); }
#pragma unroll
        for (int k2 = 0; k2 < 2; ++k2)
#pragma unroll
            for (int m = 0; m < 4; ++m) { const bf16x8 A = *(const LAS bf16x8*)(Al + (16 * m + l15) * RT_AS + (32 * k2 + 8 * g) * 2);
#pragma unroll
                for (int n = 0; n < 2; ++n) accO[m][n] = MFMA16(A, Bv[k2][n], accO[m][n]); }
#pragma unroll
        for (int m = 0; m < 8; ++m)
#pragma unroll
            for (int k2 = 0; k2 < 2; ++k2) { const s16x4 lo = tr16(Kl + (32 * k2 + 8 * g + q4) * RT_QS + (16 * m + 4 * p4) * 2), hi = tr16(Kl + (32 * k2 + 8 * g + 4 + q4) * RT_QS + (16 * m + 4 * p4) * 2);
                const bf16x8 A = __builtin_shufflevector(lo, hi, 0, 1, 2, 3, 4, 5, 6, 7);
#pragma unroll
                for (int n = 0; n < 2; ++n) accS[m][n] = MFMA16(A, Bv[k2][n], accS[m][n]); }
#pragma unroll
        for (int m = 0; m < 8; ++m)
#pragma unroll
            for (int n = 0; n < 2; ++n) accS[m][n] = accS[m][n] * dc;
        if (write_out) {
            __syncthreads();
            LAS float* oL = (LAS float*)F.lds;
#pragma unroll
            for (int m = 0; m < 4; ++m)
#pragma unroll
                for (int n = 0; n < 2; ++n)
#pragma unroll
                    for (int r = 0; r < 4; ++r) oL[(16 * m + 4 * g + r) * 256 + 32 * w + 16 * n + l15] = accO[m][n][r];
            __syncthreads();
            const f32x4 gn = *(const GAS f32x4*)(in_ptr(IN_RETG) + ((size_t)layer * HRET + h) * DVR + lane * 4);
#pragma unroll
            for (int hb2 = 0; hb2 < 2; ++hb2) {
            f32x4 x[4]; v2u gr[4]; float s1[4], s2[4];
#pragma unroll
            for (int tt = 0; tt < 4; ++tt) { const int t = w * 8 + hb2 * 4 + tt; x[tt] = *(const LAS f32x4*)(oL + t * 256 + lane * 4); gr[tt] = *(const GAS v2u*)(WSB(F, WS_GR) + (size_t)(rowbase + t) * D + h * 256 + lane * 4);
                s1[tt] = (x[tt][0] + x[tt][1]) + (x[tt][2] + x[tt][3]); }
#pragma unroll
            for (int o = 1; o < 64; o <<= 1)
#pragma unroll
                for (int tt = 0; tt < 4; ++tt) s1[tt] += __shfl_xor(s1[tt], o);
#pragma unroll
            for (int tt = 0; tt < 4; ++tt) { x[tt] = x[tt] - s1[tt] * (1.f / 256.f); s2[tt] = (x[tt][0] * x[tt][0] + x[tt][1] * x[tt][1]) + (x[tt][2] * x[tt][2] + x[tt][3] * x[tt][3]); }
#pragma unroll
            for (int o = 1; o < 64; o <<= 1)
#pragma unroll
                for (int tt = 0; tt < 4; ++tt) s2[tt] += __shfl_xor(s2[tt], o);
#pragma unroll
            for (int tt = 0; tt < 4; ++tt) { const int t = w * 8 + hb2 * 4 + tt; const float rstd = 1.f / sqrtf(s2[tt] * (1.f / 256.f) + LN_EPS);
                const f32x4 y = x[tt] * rstd * gn * (f32x4){bflo(gr[tt].x), bfhi(gr[tt].x), bflo(gr[tt].y), bfhi(gr[tt].y)};
                if (t < valid) *(GAS v2u*)(WSB(F, WS_BR) + (size_t)(rowbase + t) * D + h * 256 + lane * 4) = (v2u){pk2(y[0], y[1]), pk2(y[2], y[3])}; }
            }
        }
    }
#undef RT_LOAD
#undef RT_CHUNK
    if (stream != 2) { float* d = F.out + (stream == 0 ? O_RP + (((size_t)layer * NB + b) * HRET + h) * DKR * DVR : O_RS + (((size_t)layer * SBATCH + b) * HRET + h) * DKR * DVR);
#pragma unroll
        for (int m = 0; m < 8; ++m)
#pragma unroll
            for (int n = 0; n < 2; ++n)
#pragma unroll
                for (int r = 0; r < 4; ++r) d[(size_t)(16 * m + 4 * g + r) * DVR + 32 * w + 16 * n + l15] = accS[m][n][r]; }
}

constexpr int AT_RS = 272;
constexpr int AT_VOFF = 64 * AT_RS;
constexpr int AT_QOFF = 36864;
static_assert(AT_QOFF >= 2 * 64 * AT_RS && AT_QOFF + 8 * 8 * 1024 <= RING_BYTES, "attention LDS map");
template <bool F32KV> __device__ __forceinline__ void attn_unit(const Frame& F, int layer, int uid) {
    int stream, b, h, qb;
    if (uid < 64) { stream = 1; b = uid >> 3; h = uid & 7; qb = 0; }
    else if (uid < 64 + 2048) { const int idx = uid - 64; qb = 7 - (idx >> 8); b = (idx & 255) >> 3; h = idx & 7; stream = 0; }
    else { stream = 2; b = 0; h = (uid - (64 + 2048)) & 7; qb = 0; }
    const bf16 *k0p = nullptr, *k1p = nullptr, *v0p = nullptr, *v1p = nullptr; const float *k0f = nullptr, *k1f = nullptr, *v0f = nullptr, *v1f = nullptr; int len0, Tq, rowbase;
    if (stream == 0) { k0p = WSB(F, WS_KS) + (size_t)ROW_M * D; v0p = WSB(F, WS_VS) + (size_t)ROW_M * D; len0 = NMETA; k1p = WSB(F, WS_KS) + (size_t)b * T * D; v1p = WSB(F, WS_VS) + (size_t)b * T * D; Tq = T; rowbase = b * T; }
    else if (stream == 1) { k0f = in_ptr(IN_CK) + ((size_t)layer * SBATCH + b) * PAST * D; v0f = in_ptr(IN_CV) + ((size_t)layer * SBATCH + b) * PAST * D; len0 = PAST;
        k1f = F.out + O_KS + ((size_t)layer * SBATCH + b) * ST * D; v1f = F.out + O_VS + ((size_t)layer * SBATCH + b) * ST * D; Tq = ST; rowbase = ROW_S + b * ST; }
    else { k0p = k1p = WSB(F, WS_KS) + (size_t)ROW_M * D; v0p = v1p = WSB(F, WS_VS) + (size_t)ROW_M * D; len0 = 0; Tq = NMETA; rowbase = ROW_M; }
    constexpr int NQ = F32KV ? 1 : 2, QPW = 16 * NQ, QBLK = 8 * QPW;
    const int Stot = len0 + Tq, q0 = qb * QBLK;
    const TC tc = thread_coords(F.wave); const int tid = tc.tid, lane = tc.lane, w = tc.wave, l15 = lane & 15, g = lane >> 4;
    int qi[NQ]; bool valid_q[NQ]; int lim[NQ];
#pragma unroll
    for (int nb = 0; nb < NQ; ++nb) { qi[nb] = q0 + 16 * (NQ == 2 ? (nb == 0 ? w : 15 - w) : w) + l15; valid_q[nb] = qi[nb] < Tq; lim[nb] = len0 + qi[nb]; }
    bf16x8 qf[NQ][4];
#pragma unroll
    for (int nb = 0; nb < NQ; ++nb)
#pragma unroll
    for (int ks = 0; ks < 4; ++ks) { v4u t4 = (v4u){0u, 0u, 0u, 0u}; if (valid_q[nb]) t4 = *(const GAS v4u*)(WSB(F, WS_QS) + (size_t)(rowbase + qi[nb]) * D + h * 128 + 32 * ks + 8 * g); qf[nb][ks] = __builtin_bit_cast(bf16x8, t4); }
    float zq[NQ];
#pragma unroll
    for (int nb = 0; nb < NQ; ++nb) zq[nb] = 64.0f;
    f32x4 o[NQ][8];
#pragma unroll
    for (int nb = 0; nb < NQ; ++nb)
#pragma unroll
    for (int i = 0; i < 8; ++i) o[nb][i] = (f32x4){0.f, 0.f, 0.f, 0.f};
    float R[NQ]; bool anyv_ = false;
#pragma unroll
    for (int nb = 0; nb < NQ; ++nb) { R[nb] = 0.f; anyv_ = anyv_ || valid_q[nb]; }
    bool done1 = false;
    bool wave_done = __all(!anyv_) != 0;
    const int qend = (q0 + QBLK < Tq) ? q0 + QBLK : Tq;
    const int kt_max = (len0 + qend - 2) >> 6;
    const int lrow = tid >> 4, lch = tid & 15;
    constexpr int NR = F32KV ? 4 : 2;
    constexpr int DIST = F32KV ? 1 : 2;
    v4u kregA[NR], vregA[NR], kregB[NR], vregB[NR];
#define AT_LOAD(kt, KR, VR) do { _Pragma("unroll") for (int i_ = 0; i_ < 2; ++i_) { int s_ = ((kt) > 0 ? (kt) : 0) * 64 + lrow + 32 * i_; s_ = s_ < Stot ? s_ : Stot - 1; \
        const size_t off_ = (s_ < len0 ? (size_t)s_ : (size_t)(s_ - len0)) * D + h * 128 + lch * 8; \
        if constexpr (F32KV) { const float* kp_ = (s_ < len0 ? k0f : k1f) + off_; const float* vp_ = (s_ < len0 ? v0f : v1f) + off_; \
            asm volatile("global_load_dwordx4 %0, %1, off" : "=&v"(KR[2 * i_]) : "v"(kp_) : "memory"); asm volatile("global_load_dwordx4 %0, %1, off offset:16" : "=&v"(KR[2 * i_ + 1]) : "v"(kp_) : "memory"); \
            asm volatile("global_load_dwordx4 %0, %1, off" : "=&v"(VR[2 * i_]) : "v"(vp_) : "memory"); asm volatile("global_load_dwordx4 %0, %1, off offset:16" : "=&v"(VR[2 * i_ + 1]) : "v"(vp_) : "memory"); } \
        else { const bf16* kp_ = (s_ < len0 ? k0p : k1p) + off_; const bf16* vp_ = (s_ < len0 ? v0p : v1p) + off_; \
            asm volatile("global_load_dwordx4 %0, %1, off" : "=&v"(KR[i_]) : "v"(kp_) : "memory"); asm volatile("global_load_dwordx4 %0, %1, off" : "=&v"(VR[i_]) : "v"(vp_) : "memory"); } } } while (0)
    AT_LOAD(kt_max, kregA, vregA);
    if constexpr (!F32KV) AT_LOAD(kt_max - 1, kregB, vregB);
    const LAS unsigned char* Ql = F.lds + AT_QOFF + w * (NQ * 4096);
#pragma unroll
    for (int nb = 0; nb < NQ; ++nb)
#pragma unroll
        for (int ks = 0; ks < 4; ++ks) *(LAS v4u*)(F.lds + AT_QOFF + w * (NQ * 4096) + ((nb * 4 + ks) * 64 + lane) * 16) = __builtin_bit_cast(v4u, qf[nb][ks]);
    const LAS unsigned char* Kl = F.lds; const LAS unsigned char* Vl = F.lds + AT_VOFF;
    const int q4 = l15 >> 2, p4 = l15 & 3;
#define AT_BODY(NB0_, NB1_) { \
        f32x4 z[NQ][4]; \
        _Pragma("unroll") \
        for (int mt = 0; mt < 4; ++mt) { _Pragma("unroll") for (int nb = (NB0_); nb < (NB1_); ++nb) z[nb][mt] = (f32x4){0.f, 0.f, 0.f, 0.f}; } \
        _Pragma("unroll") \
        for (int ks = 0; ks < 4; ++ks) { bf16x8 qa[NQ]; _Pragma("unroll") for (int nb = (NB0_); nb < (NB1_); ++nb) qa[nb] = *(const LAS bf16x8*)(Ql + ((nb * 4 + ks) * 64 + lane) * 16); \
        _Pragma("unroll") \
            for (int mt = 0; mt < 4; ++mt) { const bf16x8 a = *(const LAS bf16x8*)(Kl + (16 * mt + l15) * AT_RS + 64 * ks + 16 * g); _Pragma("unroll") for (int nb = (NB0_); nb < (NB1_); ++nb) z[nb][mt] = MFMA16(a, qa[nb], z[nb][mt]); } } \
        bf16x8 pf[NQ][2]; \
        _Pragma("unroll") \
        for (int nb = (NB0_); nb < (NB1_); ++nb) { \
        bf16x8 triA, triB, ones; \
        _Pragma("unroll") \
        for (int e = 0; e < 8; ++e) { const int jl = 16 * (e >> 2) + 4 * g + (e & 3); triA[e] = (short)(jl >= l15 ? 0x3f80 : 0); triB[e] = (short)(jl >= l15 + 16 ? 0x3f80 : 0); ones[e] = (short)0x3f80; } \
        f32x4 sp[4]; \
        if (need_mask) { \
        _Pragma("unroll") \
            for (int mt = 0; mt < 4; ++mt) \
        _Pragma("unroll") \
                for (int r = 0; r < 4; ++r) { const bool vis = (tb + 16 * mt + 4 * g + r) < lim[nb]; const float zz = fminf(z[nb][mt][r], 80.f); z[nb][mt][r] = vis ? zz : -1.0e30f; \
                    sp[mt][r] = vis ? fast_log2(1.0f + fast_exp2(zz)) : 0.f; } \
        } else { \
        _Pragma("unroll") \
            for (int mt = 0; mt < 4; ++mt) \
        _Pragma("unroll") \
                for (int r = 0; r < 4; ++r) { const float zz = fminf(z[nb][mt][r], 80.f); z[nb][mt][r] = zz; sp[mt][r] = fast_log2(1.0f + fast_exp2(zz)); } \
        } \
        bf16x8 spf[2]; \
        _Pragma("unroll") \
        for (int k2 = 0; k2 < 2; ++k2) spf[k2] = __builtin_bit_cast(bf16x8, (v4u){pg8::cvt_pk_bf16(sp[2 * k2][0], sp[2 * k2][1]), pg8::cvt_pk_bf16(sp[2 * k2][2], sp[2 * k2][3]), \
                                                                                  pg8::cvt_pk_bf16(sp[2 * k2 + 1][0], sp[2 * k2 + 1][1]), pg8::cvt_pk_bf16(sp[2 * k2 + 1][2], sp[2 * k2 + 1][3])}); \
        const f32x4 zero4 = (f32x4){0.f, 0.f, 0.f, 0.f}; \
        f32x4 I0 = MFMA16(triA, spf[0], zero4); I0 = MFMA16(ones, spf[1], I0); \
        f32x4 I1 = MFMA16(triB, spf[0], zero4); I1 = MFMA16(ones, spf[1], I1); \
        f32x4 I2 = MFMA16(triA, spf[1], zero4); \
        f32x4 I3 = MFMA16(triB, spf[1], zero4); \
        f32x4 tot = MFMA16(ones, spf[0], zero4); tot = MFMA16(ones, spf[1], tot); \
        const f32x4 II[4] = {I0, I1, I2, I3}; \
        f32x4 wv[4]; \
        _Pragma("unroll") \
        for (int mt = 0; mt < 4; ++mt) \
        _Pragma("unroll") \
            for (int r = 0; r < 4; ++r) wv[mt][r] = fast_exp2(z[nb][mt][r] - II[mt][r] - R[nb]); \
        _Pragma("unroll") \
        for (int k2 = 0; k2 < 2; ++k2) pf[nb][k2] = __builtin_bit_cast(bf16x8, (v4u){pg8::cvt_pk_bf16(wv[2 * k2][0], wv[2 * k2][1]), pg8::cvt_pk_bf16(wv[2 * k2][2], wv[2 * k2][3]), \
                                                                                 pg8::cvt_pk_bf16(wv[2 * k2 + 1][0], wv[2 * k2 + 1][1]), pg8::cvt_pk_bf16(wv[2 * k2 + 1][2], wv[2 * k2 + 1][3])}); \
        R[nb] += tot[0]; \
        } \
        _Pragma("unroll") \
        for (int mt8 = 0; mt8 < 8; ++mt8) \
        _Pragma("unroll") \
            for (int k2 = 0; k2 < 2; ++k2) { \
                const s16x4 lo = tr16(Vl + (32 * k2 + 4 * g + q4) * AT_RS + (16 * mt8 + 4 * p4) * 2); \
                const s16x4 hi = tr16(Vl + (32 * k2 + 16 + 4 * g + q4) * AT_RS + (16 * mt8 + 4 * p4) * 2); \
                const bf16x8 a = __builtin_shufflevector(lo, hi, 0, 1, 2, 3, 4, 5, 6, 7); \
                _Pragma("unroll") for (int nb = (NB0_); nb < (NB1_); ++nb) o[nb][mt8] = MFMA16(a, pf[nb][k2], o[nb][mt8]); } \
        }
#define AT_ITER(KT_, KR_, VR_) { const int kt = (KT_); \
        __syncthreads(); \
        if (kt < kt_max) { unsigned allok = 1u; \
        _Pragma("unroll") \
            for (int i = 0; i < 8; ++i) allok &= F.MISC[24 + i]; \
            if (allok) break; } \
        if constexpr (F32KV) asm volatile("s_waitcnt vmcnt(0)" : "+v"(KR_[0]), "+v"(VR_[0]), "+v"(KR_[1]), "+v"(VR_[1]), "+v"(KR_[NR - 2]), "+v"(VR_[NR - 2]), "+v"(KR_[NR - 1]), "+v"(VR_[NR - 1]) :: "memory"); \
        else asm volatile("s_waitcnt vmcnt(4)" : "+v"(KR_[0]), "+v"(VR_[0]), "+v"(KR_[1]), "+v"(VR_[1]) :: "memory");     \
        _Pragma("unroll") \
        for (int i = 0; i < 2; ++i) { const bool in_ = (kt * 64 + lrow + 32 * i) < Stot; const v4u z4_ = (v4u){0u, 0u, 0u, 0u}; v4u kk_, vv_; \
            if constexpr (F32KV) { kk_ = pack8(__builtin_bit_cast(f32x4, KR_[(2 * i) % NR]), __builtin_bit_cast(f32x4, KR_[(2 * i + 1) % NR])); vv_ = pack8(__builtin_bit_cast(f32x4, VR_[(2 * i) % NR]), __builtin_bit_cast(f32x4, VR_[(2 * i + 1) % NR])); } \
            else { kk_ = KR_[i % NR]; vv_ = VR_[i % NR]; } \
            *(LAS v4u*)(F.lds + (lrow + 32 * i) * AT_RS + lch * 16) = in_ ? kk_ : z4_; *(LAS v4u*)(F.lds + AT_VOFF + (lrow + 32 * i) * AT_RS + lch * 16) = in_ ? vv_ : z4_; } \
        __syncthreads(); \
        AT_LOAD(kt - DIST, KR_, VR_); \
        const int tb = kt * 64; \
        const int lim_lo = len0 + q0 + 16 * w, lim_hi = NQ == 2 ? len0 + q0 + 16 * (15 - w) : lim_lo;      \
        const bool act0 = tb < lim_lo + 15, act1 = tb < lim_hi + 15;                                           \
        if (!wave_done && act1 && (act0 || !done1)) { \
        const bool need_mask = (tb + 64 > (act0 ? lim_lo : lim_hi)); \
        if (NQ == 2 && !act0) AT_BODY(NQ - 1, NQ) else if (NQ == 2 && done1) AT_BODY(0, 1) else AT_BODY(0, NQ)        \
        { bool dn_ = true; _Pragma("unroll") for (int nb = 0; nb < NQ; ++nb) dn_ = dn_ && ((!valid_q[nb]) || (R[nb] > zq[nb])); wave_done = __all(dn_) != 0; if constexpr (NQ == 2) done1 = __all((!valid_q[NQ - 1]) || (R[NQ - 1] > zq[NQ - 1])) != 0; } \
        } \
        if (lane == 0) F.MISC[24 + w] = wave_done ? 1u : 0u; \
    }
    for (int kt2 = kt_max; kt2 >= 0; kt2 -= 2) {
        AT_ITER(kt2, kregA, vregA)
        if (kt2 == 0) break;
        if constexpr (F32KV) { AT_ITER(kt2 - 1, kregA, vregA) } else { AT_ITER(kt2 - 1, kregB, vregB) }
    }
#undef AT_ITER
#undef AT_BODY
    if constexpr (F32KV) asm volatile("s_waitcnt vmcnt(0)" : "+v"(kregA[0]), "+v"(vregA[0]), "+v"(kregA[1]), "+v"(vregA[1]), "+v"(kregA[NR - 2]), "+v"(vregA[NR - 2]), "+v"(kregA[NR - 1]), "+v"(vregA[NR - 1]) :: "memory");
    else asm volatile("s_waitcnt vmcnt(0)" : "+v"(kregA[0]), "+v"(vregA[0]), "+v"(kregA[1]), "+v"(vregA[1]), "+v"(kregB[0]), "+v"(vregB[0]), "+v"(kregB[1]), "+v"(vregB[1]) :: "memory");
#undef AT_LOAD
#pragma unroll
    for (int nb = 0; nb < NQ; ++nb)
    if (valid_q[nb]) { bf16* orow = WSB(F, WS_BR) + (size_t)M_PAD * D + (size_t)(rowbase + qi[nb]) * D + h * 128 + 4 * g;
#pragma unroll
        for (int mt8 = 0; mt8 < 8; ++mt8) *(GAS v2u*)(orow + 16 * mt8) = (v2u){pg8::cvt_pk_bf16(o[nb][mt8][0], o[nb][mt8][1]), pg8::cvt_pk_bf16(o[nb][mt8][2], o[nb][mt8][3])}; }
}

__device__ __forceinline__ void pool_row(const Frame& F, int layer, int stream, int b, int rowbase, int tp, int ch, float (&v)[8]) {
    if (tp >= 0 || stream == 0) { const size_t row = tp >= 0 ? (size_t)(rowbase + tp) : (size_t)(ROW_M + NMETA + tp);
        const v4u x = *(const GAS v4u*)(WSB(F, WS_U) + row * D + ch * 8);
        v[0] = bflo(x.x); v[1] = bfhi(x.x); v[2] = bflo(x.y); v[3] = bfhi(x.y); v[4] = bflo(x.z); v[5] = bfhi(x.z); v[6] = bflo(x.w); v[7] = bfhi(x.w); }
    else if (stream == 1) { const float* sp = in_ptr(IN_SPOOL) + (((size_t)layer * SBATCH + b) * PBUF + (PBUF + tp)) * D + ch * 8;
        const f32x4 a = *(const GAS f32x4*)sp, c = *(const GAS f32x4*)(sp + 4);
        v[0] = a[0]; v[1] = a[1]; v[2] = a[2]; v[3] = a[3]; v[4] = c[0]; v[5] = c[1]; v[6] = c[2]; v[7] = c[3]; }
    else {
#pragma unroll
        for (int e = 0; e < 8; ++e) v[e] = 0.f; }
}
__device__ __forceinline__ void pool_unit(const Frame& F, int layer, int uid) {
    int stream, b, t0, Tlen, rowbase;
    if (uid < 1024) { stream = 0; b = uid >> 5; t0 = (uid & 31) * 64; Tlen = T; rowbase = b * T; }
    else if (uid < 1032) { stream = 1; b = uid - 1024; t0 = 0; Tlen = ST; rowbase = ROW_S + b * ST; }
    else { stream = 2; b = 0; t0 = 0; Tlen = NMETA; rowbase = ROW_M; }
    const TC tc = thread_coords(F.wave); const int ch = tc.tid & 127, tsub = tc.tid >> 7, win = 2 << (ch >> 5);
    const int ts = t0 + tsub * 16; if (ts >= Tlen) return;
    float acc[8];
#pragma unroll
    for (int e = 0; e < 8; ++e) acc[e] = 0.f;
#pragma unroll
    for (int j = 1; j < 16; ++j) if (j < win) { float v[8]; pool_row(F, layer, stream, b, rowbase, ts - j, ch, v);
#pragma unroll
        for (int e = 0; e < 8; ++e) acc[e] += v[e]; }
#pragma unroll 4
    for (int tt = 0; tt < 16; ++tt) {
        const int t = ts + tt;
        float vn[8], vo[8]; pool_row(F, layer, stream, b, rowbase, t, ch, vn);
        if (tt > 0) pool_row(F, layer, stream, b, rowbase, t - win, ch, vo);
#pragma unroll
        for (int e = 0; e < 8; ++e) acc[e] += vn[e] - (tt > 0 ? vo[e] : 0.f);
        const int have = (stream == 2) ? (t + 1 < win ? t + 1 : win) : win;
        const float inv = 1.0f / (float)have;
        float y[8];
#pragma unroll
        for (int e = 0; e < 8; ++e) y[e] = acc[e] * inv - vn[e];
        *(GAS v4u*)(WSB(F, WS_BR) + (size_t)2 * M_PAD * D + (size_t)(rowbase + t) * D + ch * 8) = (v4u){pk2(y[0], y[1]), pk2(y[2], y[3]), pk2(y[4], y[5]), pk2(y[6], y[7])};
    }
}

struct Args { const float* in[19]; float* out; unsigned char* ws; };

__device__ __forceinline__ int opq(int x) { asm volatile("" : "+s"(x)); return x; }

constexpr int CH_TOTAL = 25;
__device__ __forceinline__ int ch_stage(int ci) { return ci < 8 ? 1 : ci < 16 ? 2 : 3; }
__device__ __forceinline__ int ch_first(int s) { return s == 1 ? 0 : s == 2 ? 8 : s == 3 ? 16 : CH_TOTAL; }
__device__ __forceinline__ unsigned ch_cnt(int s) { return s == 0 ? 117u : s == 3 ? 9u : 8u; }
__device__ __forceinline__ void chain_signal(const Frame& F, gu32* ch, int s) {
    asm volatile("s_waitcnt vmcnt(0)" ::: "memory");
    __syncthreads();
    if (F.wave == 0 && lane_lo_() == 0u) {
        __builtin_amdgcn_fence(__ATOMIC_RELEASE, "agent");
        asm volatile("s_waitcnt vmcnt(0)" ::: "memory");
        const unsigned old = __hip_atomic_fetch_add(ch + 64 * (2 + s), 1u, RLX_AGENT);
        if (old + 1u == ch_cnt(s) && s < 3) __hip_atomic_store(ch + 64, (unsigned)ch_first(s + 2), RLX_AGENT);
    }
}
__device__ __forceinline__ void chain_item(const Frame& F, int l, gu32* ch, int ci) {
    const int s = ch_stage(ci);
    if (s == 1) { pg8::Gemm g{WSB(F, WS_BR), lw(F, l, LW_BR), 3 * M_PAD, 3 * D, D}; SmallOrder3 S{ci}; EpiGate E{F.ws};
        pg8::gemm_phase<EpiGate, SmallOrder3, true, true>(F.lds, g, S, E, F.wave); }
    else if (s == 2) { pg8::Gemm g{WSB(F, WS_MIX), lw(F, l, LW_OUT), M_PAD, D, D}; SmallOrder S{ci - 8}; EpiResid E{F.ws, ALPHA, 1.0f};
        pg8::gemm_phase<EpiResid, SmallOrder, true, true>(F.lds, g, S, E, F.wave); }
    else { const int i = ci - 16; ln_rows(F, l * 3 + 1, false, MP + 32 * i, MP + 32 * i + 32, 0, 8); }
    chain_signal(F, ch, s);
}
__device__ __forceinline__ int mq_count(int kq) { return kq == 0 ? 164 : kq == 1 ? 9 : kq == 2 ? 64 : kq == 3 ? 2056 : 1024; }

__global__ void __launch_bounds__(512, 2) mega_fwd(Args args) {
    extern __shared__ __attribute__((aligned(16))) unsigned char lds[];
    Frame F;
    F.lds = (LAS unsigned char*)lds;
    F.MISC = (volatile LAS unsigned*)(F.lds + MISC_OFF);
    F.G = gridDim.x; F.wave = __builtin_amdgcn_readfirstlane((int)threadIdx.x >> 6);
    F.ws = args.ws; F.out = args.out; F.ctl = (gu32*)(args.ws + WS_CTL);
    for (int u = threadIdx.x; u < (LDS_BYTES - LDSCTL_OFF) / 4; u += 512) ((LAS unsigned*)(F.lds + LDSCTL_OFF))[u] = 0u;
    __syncthreads();
    XcdBarrier bar = xcd_barrier_post((unsigned*)(F.ctl + CW_BAR), F.MISC + 8);
#define GRID_BAR() xcd_barrier(bar)

    p0_prologue(F);

    GRID_BAR();

    for (int l = 0; l < DEPTH; ++l) {
        { pg8::Gemm g{WSB(F, WS_HB), lw(F, l, LW_UP1), M_PAD, 2 * DFF, D}; pg8::StaticOrder S; S.init(M_PAD, 2 * DFF, opq(F.G), opq((int)blockIdx.x)); EpiSwiglu E{WSB(F, WS_ACT)};
          pg8::gemm_phase<EpiSwiglu, pg8::StaticOrder, true, true>(F.lds, g, S, E, F.wave); }

        GRID_BAR();
        { pg8::Gemm g{WSB(F, WS_ACT), lw(F, l, LW_DN1), M_PAD, D, DFF}; pg8::StaticOrder S; S.init(MP, D, opq(F.G), opq((int)blockIdx.x));
          EpiResid E{F.ws, ALPHA, 0.5f};
          pg8::gemm_phase<EpiResid, pg8::StaticOrder, true, true>(F.lds, g, S, E, F.wave); }

        GRID_BAR();
        if (blockIdx.x < 16) { const int kh = opq((int)blockIdx.x) >> 3; pg8::Gemm g{WSB(F, WS_ACT) + kh * (DFF / 2), lw(F, l, LW_DN1) + kh * (DFF / 2), M_PAD, D, DFF / 2, DFF}; SmallOrderH S{opq((int)blockIdx.x)};
            EpiPart E{(float*)WSB(F, WS_ACT) + (size_t)kh * 512 * D};
            pg8::gemm_phase<EpiPart, SmallOrderH, true, true>(F.lds, g, S, E, F.wave); }
        else ln_phase(F, l * 3 + 0, false, 0, MP, 16);
        GRID_BAR();
        ln_phase(F, l * 3 + 0, false, MP, M_PAD, 0, true);
        GRID_BAR();
        { pg8::Gemm g{WSB(F, WS_HB), lw(F, l, LW_IN), M_PAD, DIN, D}; pg8::StaticOrder S; S.init(M_PAD, DIN, opq(F.G), opq((int)blockIdx.x));
          EpiWin E{F.ws, F.out, l};
          pg8::gemm_phase<EpiWin, pg8::StaticOrder, true, true>(F.lds, g, S, E, F.wave);
        }

        GRID_BAR();
        { gu32* q = F.ctl + CW_Q + 64 * (l * 8); gu32* ch = F.ctl + CW_CH + 1024 * l;
          const int swp = opq((int)blockIdx.x) & 1;
#define MQ_ID(s_) ((swp && (s_) >= 3 && (s_) < 5) ? 7 - (s_) : (s_))
          int kq = 0, u = __builtin_amdgcn_readfirstlane(grab(F, q)), chain_open = 1, wst = 0;
          for (;;) {
              while (kq < 5 && u >= mq_count(MQ_ID(kq))) { ++kq; if (kq < 5) u = __builtin_amdgcn_readfirstlane(grab(F, q + 64 * MQ_ID(kq))); }
              const int qk = MQ_ID(kq);
              unsigned l0_ = lane_lo_(); asm volatile("" : "+v"(l0_));
              const bool t0 = F.wave == 0 && l0_ == 0u;
              unsigned nx = 0u, hd = 0u, rd = 0u;
              if (t0) { if (kq < 5) nx = __hip_atomic_fetch_add(q + 64 * qk, 1u, RLX_AGENT); if (chain_open) { hd = __hip_atomic_load(ch, RLX_AGENT); rd = __hip_atomic_load(ch + 64, RLX_AGENT); } }
              if (qk == 0) { ret_unit(F, l, u < 36 ? 128 + u : u - 36); if (u < 36) chain_signal(F, ch, 0); }
              else if (qk == 1 || qk == 4) { pool_unit(F, l, qk == 1 ? 1024 + u : u); if (qk == 1) chain_signal(F, ch, 0); }
              else if (qk == 2) { attn_unit<true>(F, l, u); chain_signal(F, ch, 0); }
              else if (qk == 3) { attn_unit<false>(F, l, u < 8 ? 64 + 2048 + u : 64 + u - 8); if (u < 8) chain_signal(F, ch, 0); }
              __syncthreads();
              if (t0) { int ci = -1;
                  if (chain_open) {
                      if (kq == 5 || wst > 0) { unsigned sp = 0u;
                          for (;;) { hd = __hip_atomic_load(ch, RLX_AGENT); if (hd >= (unsigned)CH_TOTAL) { ci = kq == 5 ? -2 : -3; break; } if (kq != 5 && hd >= (unsigned)ch_first(wst + 1)) break; rd = __hip_atomic_load(ch + 64, RLX_AGENT);
                              if (hd < rd) { unsigned e = hd; if (__hip_atomic_compare_exchange_strong(ch, &e, hd + 1u, __ATOMIC_RELAXED, __ATOMIC_RELAXED, __HIP_MEMORY_SCOPE_AGENT)) { ci = (int)hd; break; } }
                              else { __builtin_amdgcn_s_sleep(2); if ((++sp & 255u) == 0u) { if (xb_ld((unsigned*)(F.ctl + CW_BAR) + XB_TMO)) { ci = kq == 5 ? -2 : -1; break; } if (sp > XB_SPIN_CAP) { atomicAdd((unsigned*)(F.ctl + CW_BAR) + XB_TMO, 1u); ci = kq == 5 ? -2 : -1; break; } } } } }
                      else if (hd >= (unsigned)CH_TOTAL) ci = -3;
                      else if (hd < rd) { unsigned e = hd; if (__hip_atomic_compare_exchange_strong(ch, &e, hd + 1u, __ATOMIC_RELAXED, __ATOMIC_RELAXED, __HIP_MEMORY_SCOPE_AGENT)) ci = (int)hd; }
                      if (ci >= 0) { __builtin_amdgcn_fence(__ATOMIC_ACQUIRE, "agent"); asm volatile("s_waitcnt vmcnt(0)" ::: "memory"); }
                  } else if (kq == 5) ci = -2;
                  F.MISC[16] = nx; F.MISC[17] = (unsigned)ci; }
              __syncthreads();
              u = __builtin_amdgcn_readfirstlane((int)F.MISC[16]); const int ci = __builtin_amdgcn_readfirstlane((int)F.MISC[17]);
              if (ci == -2) break;
              if (ci == -3) chain_open = 0;
              wst = 0;
              if (ci >= 0) { chain_item(F, l, ch, ci); const int s_ = ch_stage(ci); if (s_ < 3 && ci - ch_first(s_) < (int)ch_cnt(s_ + 1)) wst = s_ + 1; }
          }
          __syncthreads(); }
        GRID_BAR();
        { pg8::Gemm g{WSB(F, WS_BR), lw(F, l, LW_BR), 3 * M_PAD, 3 * D, D}; Order3 S; S.init(MP, D, opq(F.G), opq((int)blockIdx.x)); EpiGate E{F.ws};
          pg8::gemm_phase<EpiGate, Order3, true, true>(F.lds, g, S, E, F.wave); }

        GRID_BAR();
        { pg8::Gemm g{WSB(F, WS_MIX), lw(F, l, LW_OUT), M_PAD, D, D}; pg8::StaticOrder S; S.init(MP, D, opq(F.G), opq((int)blockIdx.x));
          EpiResid E{F.ws, ALPHA, 1.0f};
          pg8::gemm_phase<EpiResid, pg8::StaticOrder, true, true>(F.lds, g, S, E, F.wave); }

        GRID_BAR();
        if (blockIdx.x < 44) { pg8::Gemm g{WSB(F, WS_HB), lw(F, l, LW_UP2), M_PAD, 2 * DFF, D}; SmallOrderW S{opq((int)blockIdx.x)}; EpiSwiglu E{WSB(F, WS_ACT)};
            pg8::gemm_phase<EpiSwiglu, SmallOrderW, true, true>(F.lds, g, S, E, F.wave); }
        else ln_phase(F, l * 3 + 1, false, 0, MP, 44);
        GRID_BAR();
        { pg8::Gemm g{WSB(F, WS_HB), lw(F, l, LW_UP2), M_PAD, 2 * DFF, D}; pg8::StaticOrder S; S.init(MP, 2 * DFF, opq(F.G), opq((int)blockIdx.x)); EpiSwiglu E{WSB(F, WS_ACT)};
          pg8::gemm_phase<EpiSwiglu, pg8::StaticOrder, true, true>(F.lds, g, S, E, F.wave); }

        GRID_BAR();
        { pg8::Gemm g{WSB(F, WS_ACT), lw(F, l, LW_DN2), M_PAD, D, DFF}; pg8::StaticOrder S; S.init(MP, D, opq(F.G), opq((int)blockIdx.x));
          EpiResid E{F.ws, ALPHA, 0.5f};
          pg8::gemm_phase<EpiResid, pg8::StaticOrder, true, true>(F.lds, g, S, E, F.wave); }

        GRID_BAR();
        if (blockIdx.x < 16) { const int kh = opq((int)blockIdx.x) >> 3; pg8::Gemm g{WSB(F, WS_ACT) + kh * (DFF / 2), lw(F, l, LW_DN2) + kh * (DFF / 2), M_PAD, D, DFF / 2, DFF}; SmallOrderH S{opq((int)blockIdx.x)};
            EpiPart E{(float*)WSB(F, WS_ACT) + (size_t)kh * 512 * D};
            pg8::gemm_phase<EpiPart, SmallOrderH, true, true>(F.lds, g, S, E, F.wave); }
        else ln_phase(F, l * 3 + 2, l + 1 == DEPTH, 0, MP, 16);
        GRID_BAR();
        ln_phase(F, l * 3 + 2, l + 1 == DEPTH, MP, M_PAD, 0, true);
        if (l + 1 < DEPTH) GRID_BAR();
    }
}

extern "C" void kernel_launch(void* const* d_in, const int* in_sizes, int n_in, void* d_out, int out_size, void* d_ws, size_t ws_size, hipStream_t stream) {
    static int grid = 0;
    if (grid == 0) {
        if (n_in != 19 || (size_t)out_size != O_END || ws_size < WS_END) { fprintf(stderr, "kernel_launch: unexpected sizes (n_in %d out %d ws %zu need %zu)\n", n_in, out_size, ws_size, (size_t)WS_END); grid = -1; return; }
        int dev = 0, cus = 0, per_cu = 0;
        if (hipGetDevice(&dev) != hipSuccess || hipDeviceGetAttribute(&cus, hipDeviceAttributeMultiprocessorCount, dev) != hipSuccess) { grid = -1; return; }
        if (hipFuncSetAttribute((const void*)mega_fwd, hipFuncAttributeMaxDynamicSharedMemorySize, LDS_BYTES) != hipSuccess) { fprintf(stderr, "kernel_launch: hipFuncSetAttribute failed\n"); grid = -1; return; }
        if (hipOccupancyMaxActiveBlocksPerMultiprocessor(&per_cu, (const void*)mega_fwd, 512, LDS_BYTES) != hipSuccess || per_cu < 1) { fprintf(stderr, "kernel_launch: occupancy query says %d\n", per_cu); }
        (void)hipGetLastError();
        grid = cus;
    }
    if (grid < 0) return;
    if (hipMemsetAsync((char*)d_ws + WS_CTL, 0, CTL_ZERO_BYTES, stream) != hipSuccess) return;
    Args a{};
    for (int i = 0; i < 19; ++i) a.in[i] = (const float*)d_in[i];
    a.out = (float*)d_out; a.ws = (unsigned char*)d_ws;
    hipLaunchKernelGGL(mega_fwd, dim3(grid), dim3(512), LDS_BYTES, stream, a);
}
```
